# Optimizing an MI355X kernel written in HIP

```python
import jax
import jax.numpy as jnp
from jax import lax
import numpy as np

D_MODEL = 1024
BATCH = 2
SEQ = 16384
DEPTH = 4

GRID_W = 64
CTX_LEN = 256
HEAD_DIM = 64
N_BRANCH = 4
BRANCH_W = 256
A_WIDTH = 256
NA_HEADS = 4
NA_WIN_R = 8
NA_WIN_C = 16
GQA_Q_HEADS = 4
GQA_KV_HEADS = 2
GQA_GROUP = GQA_Q_HEADS // GQA_KV_HEADS
Q_BLOCK = 128
ROPE_THETA = 10000.0
RWKV_HEADS = 4
RW = RWKV_HEADS * HEAD_DIM
LORA_W = 64
LORA_A = 64
LORA_G = 128
RW_SHIFT = 3 * RW + LORA_W + LORA_A
D_FF = 2816
NORM_EPS = 1e-6
LN_X_EPS = 64e-5

COLS_A = 3 * A_WIDTH
COLS_NA = 3 * NA_HEADS * HEAD_DIM
COLS_GQA = (GQA_Q_HEADS + 2 * GQA_KV_HEADS) * HEAD_DIM
COLS_RW = RW_SHIFT + LORA_G
D_IN = COLS_A + COLS_NA + COLS_GQA + COLS_RW

kernel_name = 'hybrid_parallel_dit_block'


def rmsnorm(x, g):
    xf = x.astype(jnp.float32)
    y = xf * lax.rsqrt(jnp.mean(xf * xf, axis=-1, keepdims=True) + NORM_EPS)
    return (y * g.astype(jnp.float32)).astype(x.dtype)


def modulate(h, shift, scale):
    return h * (1 + scale) + shift


def dwconv3(x, w):
    xp = jnp.pad(x, ((0, 0), (1, 1), (0, 0)))
    return xp[:, :-2] * w[0] + xp[:, 1:-1] * w[1] + xp[:, 2:] * w[2]


def to_heads(x, n_heads):
    b, t, _ = x.shape
    return x.reshape(b, t, n_heads, HEAD_DIM).transpose(0, 2, 1, 3)


def from_heads(x):
    b, h, t, d = x.shape
    return x.transpose(0, 2, 1, 3).reshape(b, t, h * d)


def axial_rope_tables(n_tok):
    t = jnp.arange(n_tok)
    row = (t // GRID_W).astype(jnp.float32)
    col = (t % GRID_W).astype(jnp.float32)
    n_freq = HEAD_DIM // 4
    inv_freq = ROPE_THETA ** (-jnp.arange(n_freq, dtype=jnp.float32) / n_freq)
    ang = jnp.concatenate([row[:, None] * inv_freq, col[:, None] * inv_freq], axis=-1)
    return jnp.cos(ang), jnp.sin(ang)


def apply_rope(x, cos, sin):
    xf = x.astype(jnp.float32).reshape(x.shape[:-1] + (HEAD_DIM // 2, 2))
    x1, x2 = xf[..., 0], xf[..., 1]
    out = jnp.stack([x1 * cos - x2 * sin, x1 * sin + x2 * cos], axis=-1)
    return out.reshape(x.shape).astype(x.dtype)


def grouped_attend(q, k, v):
    s = jnp.einsum('bngqd,bnkd->bngqk', q, k, preferred_element_type=jnp.float32)
    p = jax.nn.softmax(s, axis=-1).astype(v.dtype)
    return jnp.einsum('bngqk,bnkd->bngqd', p, v)


def mixer_a(z, w_conv):
    bg, cg, xin = z[..., :A_WIDTH], z[..., A_WIDTH:2 * A_WIDTH], z[..., 2 * A_WIDTH:]
    return bg * dwconv3(cg * xin, w_conv)


def na_tables(rows):
    wr = min(NA_WIN_R, rows)
    i = jnp.arange(rows)
    j = jnp.arange(GRID_W)
    rs = jnp.clip(i - wr // 2, 0, rows - wr)
    cs = jnp.clip(j - NA_WIN_C // 2, 0, GRID_W - NA_WIN_C)
    kr = rs[:, None] + jnp.arange(wr)
    kc = cs[:, None] + jnp.arange(NA_WIN_C)
    key_idx = kr[:, None, :, None] * GRID_W + kc[None, :, None, :]
    dr = kr - i[:, None] + (NA_WIN_R - 1)
    dc = kc - j[:, None] + (NA_WIN_C - 1)
    bias_idx = dr[:, None, :, None] * (2 * NA_WIN_C - 1) + dc[None, :, None, :]
    n_keys = wr * NA_WIN_C
    return key_idx.reshape(rows, GRID_W, n_keys), bias_idx.reshape(rows, GRID_W, n_keys)


def na_latent(q, k, v, kc, vc, bias_flat, key_idx, bias_idx):
    b, h, t, d = q.shape
    rows = t // GRID_W
    q_rows = jnp.moveaxis(q.reshape(b, h, rows, GRID_W, d), 2, 0)

    def one_row(args):
        q_row, kidx, bidx = args
        k_nb = jnp.take(k, kidx, axis=2)
        v_nb = jnp.take(v, kidx, axis=2)
        s_loc = jnp.einsum('bhqd,bhqkd->bhqk', q_row, k_nb, preferred_element_type=jnp.float32)
        s_loc = s_loc + bias_flat[:, bidx].astype(jnp.float32)
        s_ctx = jnp.einsum('bhqd,bhkd->bhqk', q_row, kc, preferred_element_type=jnp.float32)
        p = jax.nn.softmax(jnp.concatenate([s_loc, s_ctx], axis=-1), axis=-1).astype(v.dtype)
        nk = k_nb.shape[3]
        return (jnp.einsum('bhqk,bhqkd->bhqd', p[..., :nk], v_nb)
                + jnp.einsum('bhqk,bhkd->bhqd', p[..., nk:], vc))

    out = lax.map(one_row, (q_rows, key_idx, bias_idx))
    return jnp.moveaxis(out, 0, 2).reshape(b, h, t, d)


def mixer_b(zc, zl, na_bias, key_idx, bias_idx, with_ctx):
    scale = HEAD_DIM ** -0.5
    w = NA_HEADS * HEAD_DIM
    qc, kc, vc = to_heads(zc[..., :w], NA_HEADS), to_heads(zc[..., w:2 * w], NA_HEADS), to_heads(zc[..., 2 * w:], NA_HEADS)
    ql, kl, vl = to_heads(zl[..., :w], NA_HEADS), to_heads(zl[..., w:2 * w], NA_HEADS), to_heads(zl[..., 2 * w:], NA_HEADS)
    yl = na_latent(ql * scale, kl, vl, kc, vc, na_bias.reshape(NA_HEADS, -1), key_idx, bias_idx)
    yc = None
    if with_ctx:
        yc = from_heads(grouped_attend((qc * scale)[:, :, None], kc, vc)[:, :, 0])
    return yc, from_heads(yl)


def gqa_qkv(z, q_norm, k_norm):
    nq = GQA_Q_HEADS * HEAD_DIM
    nkv = GQA_KV_HEADS * HEAD_DIM
    q = rmsnorm(to_heads(z[..., :nq], GQA_Q_HEADS), q_norm) * HEAD_DIM ** -0.5
    k = rmsnorm(to_heads(z[..., nq:nq + nkv], GQA_KV_HEADS), k_norm)
    v = to_heads(z[..., nq + nkv:], GQA_KV_HEADS)
    return q, k, v


def mixer_c(zc, zl, q_norm, k_norm, cos, sin, with_ctx):
    qc, kc, vc = gqa_qkv(zc, q_norm, k_norm)
    ql, kl, vl = gqa_qkv(zl, q_norm, k_norm)
    ql = apply_rope(ql, cos, sin)
    kl = apply_rope(kl, cos, sin)
    k_all = jnp.concatenate([kl, kc], axis=2)
    v_all = jnp.concatenate([vl, vc], axis=2)
    b, _, t, d = ql.shape
    q_blocks = jnp.moveaxis(ql.reshape(b, GQA_KV_HEADS, GQA_GROUP, t // Q_BLOCK, Q_BLOCK, d), 3, 0)
    out = lax.map(lambda blk: grouped_attend(blk, k_all, v_all), q_blocks)
    yl = jnp.moveaxis(out, 0, 3).reshape(b, GQA_Q_HEADS, t, d)
    yc = None
    if with_ctx:
        lc = qc.shape[2]
        oc = grouped_attend(qc.reshape(b, GQA_KV_HEADS, GQA_GROUP, lc, d), kc, vc)
        yc = from_heads(oc.reshape(b, GQA_Q_HEADS, lc, d))
    return yc, from_heads(yl)


def rwkv_streams(z, mu, w0, w2, a0, a2, k_k, k_a, reverse):
    b, t, _ = z.shape
    zs = z[..., :RW_SHIFT]
    if reverse:
        nb = jnp.pad(zs[:, 1:], ((0, 0), (0, 1), (0, 0)))
    else:
        nb = jnp.pad(zs[:, :-1], ((0, 0), (1, 0), (0, 0)))
    zs = zs + mu * (nb - zs)
    r, k, v = zs[..., :RW], zs[..., RW:2 * RW], zs[..., 2 * RW:3 * RW]
    lw = zs[..., 3 * RW:3 * RW + LORA_W]
    la = zs[..., 3 * RW + LORA_W:]
    w_log = (w0 + jnp.tanh(lw) @ w2).astype(jnp.float32)
    w = jnp.exp(-jnp.exp(-jax.nn.softplus(-w_log) - 0.5))
    a = jax.nn.sigmoid(a0 + la @ a2)
    kk = (k * k_k).reshape(b, t, RWKV_HEADS, HEAD_DIM).astype(jnp.float32)
    kk = kk * lax.rsqrt(jnp.maximum(jnp.sum(kk * kk, axis=-1, keepdims=True), 1e-24))
    k = k * (1 + (a - 1) * k_a)
    shp = (b, t, RWKV_HEADS, HEAD_DIM)
    return r.reshape(shp), w.reshape(shp), k.reshape(shp), v.reshape(shp), kk, a.reshape(shp)


def rwkv_scan(s0, r, w, k, v, kk, a, reverse, emit):
    seq = tuple(jnp.moveaxis(u.astype(jnp.float32), 1, 0) for u in (r, w, k, v, kk, a))

    def step(s, inp):
        r_t, w_t, k_t, v_t, kk_t, a_t = inp
        sa = jnp.einsum('bhvk,bhk->bhv', s, kk_t)
        s = (s * w_t[:, :, None, :] - sa[..., None] * (kk_t * a_t)[:, :, None, :]
             + v_t[..., None] * k_t[:, :, None, :])
        return s, (jnp.einsum('bhvk,bhk->bhv', s, r_t) if emit else None)

    s, y = lax.scan(step, s0, seq, reverse=reverse)
    return s, (jnp.moveaxis(y, 0, 1) if emit else None)


def rwkv_bonus(streams, r_k):
    r, _, k, v, _, _ = streams
    return jnp.sum(r * k * r_k, axis=-1, keepdims=True) * v


def rwkv_readout(ys, bonus, lg, g2, ln_w, ln_b):
    y = ys[0] + ys[1]
    mean = jnp.mean(y, axis=-1, keepdims=True)
    var = jnp.mean(jnp.square(y - mean), axis=-1, keepdims=True)
    y = (y - mean) * lax.rsqrt(var + LN_X_EPS) * ln_w.reshape(RWKV_HEADS, HEAD_DIM) + ln_b.reshape(RWKV_HEADS, HEAD_DIM)
    y = y.astype(lg.dtype) + bonus[0] + bonus[1]
    b, t = lg.shape[:2]
    return y.reshape(b, t, RW) * (jax.nn.sigmoid(lg) @ g2)


def mixer_d(zc, zl, mu, w0, w2, a0, a2, k_k, k_a, r_k, g2, ln_w, ln_b, with_ctx):
    b = zl.shape[0]
    ys_l, bon_l, ys_c, bon_c = [], [], [], []
    for d in range(2):
        rev = d == 1
        sc = rwkv_streams(zc, mu[d], w0[d], w2[d], a0[d], a2[d], k_k, k_a, rev)
        sl = rwkv_streams(zl, mu[d], w0[d], w2[d], a0[d], a2[d], k_k, k_a, rev)
        s0 = jnp.zeros((b, RWKV_HEADS, HEAD_DIM, HEAD_DIM), jnp.float32)
        s_ctx, yc = rwkv_scan(s0, *sc, reverse=rev, emit=with_ctx)
        _, yl = rwkv_scan(s_ctx, *sl, reverse=rev, emit=True)
        ys_l.append(yl)
        bon_l.append(rwkv_bonus(sl, r_k))
        if with_ctx:
            ys_c.append(yc)
            bon_c.append(rwkv_bonus(sc, r_k))
    out_l = rwkv_readout(ys_l, bon_l, zl[..., RW_SHIFT:], g2, ln_w, ln_b)
    out_c = rwkv_readout(ys_c, bon_c, zc[..., RW_SHIFT:], g2, ln_w, ln_b) if with_ctx else None
    return out_c, out_l


def merge_branches(h, ys, w_branch, w_gate, b_gate, w_o):
    gates = jax.nn.sigmoid(h @ w_gate + b_gate)
    acc = gates[..., :D_MODEL] * (ys[0] @ w_branch[0])
    for i in range(1, N_BRANCH):
        acc = acc + gates[..., i * D_MODEL:(i + 1) * D_MODEL] * (ys[i] @ w_branch[i])
    return acc @ w_o


def conv_ffn(h, w_up, w_conv, w_down):
    u = dwconv3(h @ w_up, w_conv)
    return (u[..., :D_FF] * jax.nn.silu(u[..., D_FF:])) @ w_down


def setup_inputs(seed: int = 0) -> dict:
    key = jax.random.key(seed)
    ks = iter(jax.random.split(key, 40))
    L = DEPTH
    D = D_MODEL

    def nrm(shape, scale):
        return jax.random.normal(next(ks), shape, jnp.float32) * scale

    def unif(shape, lo, hi):
        return jax.random.uniform(next(ks), shape, jnp.float32, lo, hi)

    return {
        'x': nrm((BATCH, SEQ, D), 1.0),
        'c': nrm((BATCH, D), 1.0),
        'ctx': nrm((BATCH, CTX_LEN, D), 1.0),
        'c_ctx': nrm((D,), 1.0),
        'ada_w': nrm((L, D, 6 * D), 0.5 * D ** -0.5),
        'ada_b': nrm((L, 6 * D), 0.02),
        'norm_mix_pre': 1.0 + nrm((L, D), 0.02),
        'norm_mix_post': 1.0 + nrm((L, D), 0.02),
        'norm_ffn_pre': 1.0 + nrm((L, D), 0.02),
        'norm_ffn_post': 1.0 + nrm((L, D), 0.02),
        'w_in': nrm((L, D, D_IN), D ** -0.5),
        'conv_a': nrm((L, 3, A_WIDTH), 3 ** -0.5),
        'na_bias': nrm((L, NA_HEADS, 2 * NA_WIN_R - 1, 2 * NA_WIN_C - 1), 0.1),
        'q_norm': 1.0 + nrm((L, HEAD_DIM), 0.02),
        'k_norm': 1.0 + nrm((L, HEAD_DIM), 0.02),
        'rw_mu': unif((L, 2, RW_SHIFT), 0.0, 1.0),
        'rw_w0': unif((L, 2, RW), -6.5, -1.5),
        'rw_w2': nrm((L, 2, LORA_W, RW), 0.1 * LORA_W ** -0.5),
        'rw_a0': nrm((L, 2, RW), 0.1),
        'rw_a2': nrm((L, 2, LORA_A, RW), 0.5 * LORA_A ** -0.5),
        'rw_kk': 0.85 + nrm((L, RW), 0.05),
        'rw_ka': 1.0 + nrm((L, RW), 0.05),
        'rw_rk': nrm((L, RWKV_HEADS, HEAD_DIM), 0.1),
        'rw_g2': nrm((L, LORA_G, RW), LORA_G ** -0.5),
        'rw_ln_w': 1.0 + nrm((L, RW), 0.02),
        'rw_ln_b': nrm((L, RW), 0.02),
        'w_branch': nrm((L, N_BRANCH, BRANCH_W, D), BRANCH_W ** -0.5),
        'w_gate': nrm((L, D, N_BRANCH * D), D ** -0.5),
        'b_gate': nrm((L, N_BRANCH * D), 0.02),
        'w_o': nrm((L, D, D), D ** -0.5),
        'ffn_up': nrm((L, D, 2 * D_FF), D ** -0.5),
        'ffn_conv': nrm((L, 3, 2 * D_FF), 3 ** -0.5),
        'ffn_down': nrm((L, D_FF, D), D_FF ** -0.5),
    }


def reference(x, c, ctx, c_ctx, ada_w, ada_b, norm_mix_pre, norm_mix_post, norm_ffn_pre, norm_ffn_post,
              w_in, conv_a, na_bias, q_norm, k_norm, rw_mu, rw_w0, rw_w2, rw_a0, rw_a2, rw_kk, rw_ka, rw_rk,
              rw_g2, rw_ln_w, rw_ln_b, w_branch, w_gate, b_gate, w_o, ffn_up, ffn_conv, ffn_down):
    n_lat = x.shape[1]
    rows = n_lat // GRID_W
    cos, sin = axial_rope_tables(n_lat)
    key_idx, bias_idx = na_tables(rows)
    e1 = COLS_A
    e2 = COLS_A + COLS_NA
    e3 = COLS_A + COLS_NA + COLS_GQA
    xl, xc = x, ctx
    for l in range(DEPTH):
        with_ctx = l < DEPTH - 1
        mod_l = jnp.split((jax.nn.silu(c) @ ada_w[l] + ada_b[l])[:, None, :], 6, axis=-1)
        mod_c = jnp.split(jax.nn.silu(c_ctx) @ ada_w[l] + ada_b[l], 6, axis=-1)
        hl = modulate(rmsnorm(xl, norm_mix_pre[l]), mod_l[0], mod_l[1])
        hc = modulate(rmsnorm(xc, norm_mix_pre[l]), mod_c[0], mod_c[1])
        zl = hl @ w_in[l]
        zc = hc @ w_in[l]
        ya_l = mixer_a(zl[..., :e1], conv_a[l])
        yb_c, yb_l = mixer_b(zc[..., e1:e2], zl[..., e1:e2], na_bias[l], key_idx, bias_idx, with_ctx)
        yc_c, yc_l = mixer_c(zc[..., e2:e3], zl[..., e2:e3], q_norm[l], k_norm[l], cos, sin, with_ctx)
        yd_c, yd_l = mixer_d(zc[..., e3:], zl[..., e3:], rw_mu[l], rw_w0[l], rw_w2[l], rw_a0[l], rw_a2[l],
                             rw_kk[l], rw_ka[l], rw_rk[l], rw_g2[l], rw_ln_w[l], rw_ln_b[l], with_ctx)
        m_l = merge_branches(hl, (ya_l, yb_l, yc_l, yd_l), w_branch[l], w_gate[l], b_gate[l], w_o[l])
        xl = xl + mod_l[2] * rmsnorm(m_l, norm_mix_post[l])
        f_l = conv_ffn(modulate(rmsnorm(xl, norm_ffn_pre[l]), mod_l[3], mod_l[4]), ffn_up[l], ffn_conv[l], ffn_down[l])
        xl = xl + mod_l[5] * rmsnorm(f_l, norm_ffn_post[l])
        if with_ctx:
            ya_c = mixer_a(zc[..., :e1], conv_a[l])
            m_c = merge_branches(hc, (ya_c, yb_c, yc_c, yd_c), w_branch[l], w_gate[l], b_gate[l], w_o[l])
            xc = xc + mod_c[2] * rmsnorm(m_c, norm_mix_post[l])
            f_c = conv_ffn(modulate(rmsnorm(xc, norm_ffn_pre[l]), mod_c[3], mod_c[4]), ffn_up[l], ffn_conv[l], ffn_down[l])
            xc = xc + mod_c[5] * rmsnorm(f_c, norm_ffn_post[l])
    return xl
```

```cpp
#include <hip/hip_runtime.h>
#include <hip/hip_cooperative_groups.h>
#include <hip/hip_bf16.h>
#include <cstdio>
#include <cstdint>
#include <cmath>
namespace cg = cooperative_groups;

#define DI __device__ __forceinline__
#define LAS __attribute__((address_space(3)))
#define CAS4 __attribute__((address_space(4)))
typedef unsigned short bf16_t;
typedef short bf16x8 __attribute__((ext_vector_type(8)));
typedef float f32x4 __attribute__((ext_vector_type(4)));
typedef float f32x2 __attribute__((ext_vector_type(2)));
typedef float f32x16 __attribute__((ext_vector_type(16)));
typedef unsigned u32x4 __attribute__((ext_vector_type(4)));
typedef short s16x4 __attribute__((ext_vector_type(4)));
typedef __bf16 bf16x2_t __attribute__((ext_vector_type(2)));

constexpr int DM = 1024, TLAT = 16384, NLAT = 32768, CTXL = 256, NROW = 33280, NLAYER = 4;
constexpr int DIN = 3072, DFF = 2816;
constexpr int C_NAQ = 768, C_NAK = 1024, C_NAV = 1280, C_GQ = 1536, C_GK = 1792, C_GV = 1920;
constexpr int C_RR = 2048, C_RK = 2304, C_RV = 2560, C_LW = 2816, C_LA = 2880, C_LG = 2944;
constexpr float C2 = 0.125f * 1.4426950408889634f;
constexpr float LOG2E = 1.4426950408889634f;
constexpr int NTHREADS = 512;

constexpr size_t MiB = 1u << 20;
constexpr size_t WS_CTL = 0, WS_MOD = 1 * MiB, WS_XC = 2 * MiB, WS_BONUS = 4 * MiB, WS_W = 6 * MiB;
constexpr size_t W_IN = 0, W_GATE = W_IN + (size_t)3072 * 1024 * 2, W_BR = W_GATE + (size_t)4096 * 1024 * 2, W_O = W_BR + (size_t)1024 * 1024 * 2,
                 W_UP = W_O + (size_t)1024 * 1024 * 2, W_DN = W_UP + (size_t)5632 * 1024 * 2, W_END = W_DN + (size_t)1024 * 2816 * 2;
static_assert(WS_W + W_END <= 42 * MiB, "weights");
constexpr size_t WS_H = 42 * MiB + 65536, WS_Z = 108 * MiB, WS_YS = 304 * MiB, WS_WA = 370 * MiB, WS_YSC = 436 * MiB, WS_END = 501 * MiB;
constexpr size_t WS_ACCM = WS_Z, WS_MBUF = WS_Z + 70 * MiB, WS_G = WS_Z, WS_F = WS_YS, WS_PSCR = WS_WA, WS_ASCR = WS_YSC;
constexpr size_t ROWB = (size_t)NROW * 1024 * 2;

DI float bf2f(unsigned u16) { return __uint_as_float(u16 << 16); }
DI unsigned cvtpk(float lo, float hi) { f32x2 v = {lo, hi}; bf16x2_t b = __builtin_convertvector(v, bf16x2_t); return __builtin_bit_cast(unsigned, b); }
DI void unpack8(const u32x4 w, float* f) {
#pragma unroll
  for (int i = 0; i < 4; ++i) { f[2 * i] = __uint_as_float(w[i] << 16); f[2 * i + 1] = __uint_as_float(w[i] & 0xffff0000u); }
}
DI u32x4 pack8(const float* f) { u32x4 w; w.x = cvtpk(f[0], f[1]); w.y = cvtpk(f[2], f[3]); w.z = cvtpk(f[4], f[5]); w.w = cvtpk(f[6], f[7]); return w; }
DI float sigmoidf_(float x) { return __builtin_amdgcn_rcpf(1.f + __builtin_amdgcn_exp2f(-1.4426950408889634f * x)); }
DI float dppf(float x, const int ctrl_dummy);
#define DPPF(x, CTRL) __int_as_float(__builtin_amdgcn_update_dpp(0, __float_as_int(x), (CTRL), 0xf, 0xf, false))
DI float allreduce16(float x) { x += DPPF(x, 0xB1); x += DPPF(x, 0x4E); x += DPPF(x, 0x141); x += DPPF(x, 0x140); return x; }
DI float red8(float x) { x += DPPF(x, 0xB1); x += DPPF(x, 0x4E); x += DPPF(x, 0x141); return x; }
DI float bperm(float v, int src_lane) { return __int_as_float(__builtin_amdgcn_ds_bpermute(src_lane << 2, __float_as_int(v))); }
DI float wave_sum(float v, int lane) { v = allreduce16(v); v += bperm(v, lane ^ 16); v += bperm(v, lane ^ 32); return v; }

DI void grid_barrier(unsigned* ctr, unsigned target, int tid) {
  __syncthreads();
  if (tid == 0) {
    __builtin_amdgcn_fence(__ATOMIC_RELEASE, "agent");
    __hip_atomic_fetch_add(ctr, 1u, __ATOMIC_RELAXED, __HIP_MEMORY_SCOPE_AGENT);
    while (__hip_atomic_load(ctr, __ATOMIC_RELAXED, __HIP_MEMORY_SCOPE_AGENT) < target) __builtin_amdgcn_s_sleep(1);
    __builtin_amdgcn_fence(__ATOMIC_ACQUIRE, "agent");
  }
  __syncthreads();
}
DI void row_seq(int row, int& t, int& len) { if (row < NLAT) { t = row & (TLAT - 1); len = TLAT; } else { t = (row - NLAT) & (CTXL - 1); len = CTXL; } }

namespace pg8 {
constexpr int BM = 256, BK = 64, HALF = 128, HTB = HALF * BK * 2, STAGE_BYTES = 8 * HTB;
DI int lds_byte(int r, int c) { const int st = (r >> 4) * 2 + (c >> 5), rr = r & 15, cc = c & 31, ob = rr * 64 + cc * 2; return st * 1024 + (ob ^ (((ob >> 9) & 1) << 5)); }
DI void stage_rc(int b, int& R, int& C) { const int st = b / 1024, sb = b % 1024, swz = sb ^ (((sb >> 9) & 1) << 5); R = (st >> 1) * 16 + swz / 64; C = (st & 1) * 32 + (swz % 64) / 2; }
DI int perm32(int rho) { const int n = rho >> 4, i = rho & 15; return 8 * (i >> 2) + 4 * n + (i & 3); }

struct Unit { int pm, pn, nt, kind; };
struct Gemm { const char* base; int lda, ldb; };

template <class Epi, class Sched, bool CONV>
DI void gemm_phase(LAS unsigned char* lds, const Gemm g, const Sched& S, const Epi& E, int tid) {
    const int wid = __builtin_amdgcn_readfirstlane(tid >> 6), lane = tid & 63, wr = wid >> 2, wc = wid & 3, fr = lane & 15, fq = lane >> 4;
    unsigned voffA[2], voffB[2];
#pragma unroll
    for (int i = 0; i < 2; ++i) { int R, C; stage_rc(tid * 16 + i * 8192, R, C); const int Rb = (R & ~31) + perm32(R & 31);
        const int Ra = CONV ? (62 * (R >> 6) + (R & 63)) : R;
        voffA[i] = (unsigned)(Ra * g.lda + C) * 2u; voffB[i] = (unsigned)(Rb * g.ldb + C) * 2u; }
    constexpr int kstep = BK * 2;
    const int hstepA = (CONV ? 124 : HALF) * g.lda * 2, hstepB = HALF * g.ldb * 2;
    const unsigned ldsw = (unsigned)wid * 1024u;
    const int aoff = lds_byte(wr * 64 + fr, fq * 8), boff = lds_byte(wc * 32 + fr, fq * 8);
#define PG8_SA(b, h) (((b) * 2 + (h)) * HTB)
#define PG8_SB(b, h) ((4 + (b) * 2 + (h)) * HTB)
#define PG8_STAGE(bufoff, gbase, voff) do { _Pragma("unroll") for (int _i = 0; _i < 2; ++_i) \
        __builtin_amdgcn_global_load_lds((const unsigned*)((const char*)(gbase) + (voff)[_i]), (LAS unsigned*)(lds + (bufoff) + ldsw + _i * 8192), 16, 0, 0); } while (0)
#define PG8_LDA(dst, b, h) do { _Pragma("unroll") for (int m = 0; m < 4; ++m) _Pragma("unroll") for (int k = 0; k < 2; ++k) dst[m][k] = *(const LAS bf16x8*)(lds + PG8_SA(b, h) + aoff + m * 2048 + k * 1024); } while (0)
#define PG8_LDB(dst, b, h) do { _Pragma("unroll") for (int n = 0; n < 2; ++n) _Pragma("unroll") for (int k = 0; k < 2; ++k) dst[n][k] = *(const LAS bf16x8*)(lds + PG8_SB(b, h) + boff + n * 2048 + k * 1024); } while (0)
#define PG8_MMA(ai, bj, At, Bt) do { __builtin_amdgcn_s_setprio(1); _Pragma("unroll") for (int m = 0; m < 4; ++m) _Pragma("unroll") for (int n = 0; n < 2; ++n) _Pragma("unroll") for (int k = 0; k < 2; ++k) \
        acc[ai][bj][m][n] = __builtin_amdgcn_mfma_f32_16x16x32_bf16(Bt[n][k], At[m][k], acc[ai][bj][m][n], 0, 0, 0); __builtin_amdgcn_s_setprio(0); } while (0)
#define PG8_WAIT_V(n) asm volatile("s_waitcnt vmcnt(" #n ")" ::: "memory")
#define PG8_WAIT_L(n) asm volatile("s_waitcnt lgkmcnt(" #n ")" ::: "memory")
#define PG8_BAR __builtin_amdgcn_s_barrier()
#define PG8_SCHED __builtin_amdgcn_sched_barrier(0)
    Unit cur, nxt; int ui = 0; long ao_, bo_;
    if (!S.next(0, cur, ao_, bo_)) return;
    f32x4 acc[2][2][4][2];
#pragma unroll
    for (int a = 0; a < 2; ++a)
#pragma unroll
        for (int b = 0; b < 2; ++b)
#pragma unroll
            for (int m = 0; m < 4; ++m)
#pragma unroll
                for (int n = 0; n < 2; ++n) acc[a][b][m][n] = (f32x4){0.f, 0.f, 0.f, 0.f};
    bf16x8 At[4][2], B0[2][2], B1[2][2];
    const char* cA = g.base + ao_; const char* cB = g.base + bo_;
    PG8_STAGE(PG8_SB(0, 0), cB, voffB); PG8_STAGE(PG8_SB(0, 1), cB + hstepB, voffB); PG8_STAGE(PG8_SA(0, 0), cA, voffA); PG8_STAGE(PG8_SA(0, 1), cA + hstepA, voffA);
    if (wr == 1) PG8_BAR;
    PG8_WAIT_V(2); PG8_BAR;
    PG8_STAGE(PG8_SB(1, 0), cB + kstep, voffB); PG8_STAGE(PG8_SA(1, 0), cA + kstep, voffA); PG8_STAGE(PG8_SB(1, 1), cB + hstepB + kstep, voffB);
    PG8_WAIT_V(6); PG8_BAR;
    for (;;) {
        const bool has_next = S.next(ui + 1, nxt, ao_, bo_);
        const char* nA = has_next ? g.base + ao_ : cA; const char* nB = has_next ? g.base + bo_ : cB;
        const int nt = cur.nt;
        for (int t = 0; t < nt; t += 2) {
            const bool last = (t == nt - 2);
            const char* a1 = cA + (size_t)(t + 1) * kstep;
            const char* a2 = last ? nA : cA + (size_t)(t + 2) * kstep; const char* b2 = last ? nB : cB + (size_t)(t + 2) * kstep;
            const char* a3 = a2 + kstep; const char* b3 = b2 + kstep;
            PG8_LDB(B0, 0, 0); PG8_LDB(B1, 0, 1); PG8_SCHED; PG8_LDA(At, 0, 0); PG8_STAGE(PG8_SA(1, 1), a1 + hstepA, voffA);
            PG8_WAIT_V(8); PG8_WAIT_L(0); PG8_BAR; PG8_MMA(0, 0, At, B0); PG8_MMA(0, 1, At, B1); PG8_BAR; PG8_SCHED;
            PG8_LDA(At, 0, 1); PG8_STAGE(PG8_SB(0, 0), b2, voffB); PG8_STAGE(PG8_SB(0, 1), b2 + hstepB, voffB); PG8_STAGE(PG8_SA(0, 0), a2, voffA);
            PG8_WAIT_V(8); PG8_WAIT_L(0); PG8_BAR; PG8_MMA(1, 0, At, B0); PG8_MMA(1, 1, At, B1); PG8_BAR; PG8_SCHED;
            PG8_LDB(B0, 1, 0); PG8_LDB(B1, 1, 1); PG8_SCHED; PG8_LDA(At, 1, 0); PG8_STAGE(PG8_SA(0, 1), a2 + hstepA, voffA);
            PG8_WAIT_V(8); PG8_WAIT_L(0); PG8_BAR; PG8_MMA(0, 0, At, B0); PG8_MMA(0, 1, At, B1); PG8_BAR; PG8_SCHED;
            PG8_LDA(At, 1, 1); PG8_STAGE(PG8_SB(1, 0), b3, voffB); PG8_STAGE(PG8_SB(1, 1), b3 + hstepB, voffB); PG8_STAGE(PG8_SA(1, 0), a3, voffA);
            PG8_WAIT_V(8); PG8_WAIT_L(0); PG8_BAR; PG8_MMA(1, 0, At, B0); PG8_MMA(1, 1, At, B1); PG8_BAR; PG8_SCHED;
        }
        if (wr == 0) PG8_BAR;
        E(acc, cur, wr, wc, fr, fq);
        if (!has_next) break;
#pragma unroll
        for (int a = 0; a < 2; ++a)
#pragma unroll
            for (int b = 0; b < 2; ++b)
#pragma unroll
                for (int m = 0; m < 4; ++m)
#pragma unroll
                    for (int n = 0; n < 2; ++n) acc[a][b][m][n] = (f32x4){0.f, 0.f, 0.f, 0.f};
        cur = nxt; cA = nA; cB = nB; ++ui;
        if (wr == 1) PG8_BAR;
    }
    PG8_WAIT_V(0);
    PG8_BAR;
#undef PG8_SA
#undef PG8_SB
#undef PG8_STAGE
#undef PG8_LDA
#undef PG8_LDB
#undef PG8_MMA
#undef PG8_WAIT_V
#undef PG8_WAIT_L
#undef PG8_BAR
#undef PG8_SCHED
}

DI void xcd_tile(int L, int nM, int nN, int& pm, int& pn) {
    const int nwg = nM * nN; int wgid = L; { const int q = nwg / 8, r = nwg % 8, xcd = wgid % 8, off = wgid / 8; wgid = (xcd < r ? xcd * (q + 1) : r * (q + 1) + (xcd - r) * q) + off; }
    const int nig = 8 * nN, gid = wgid / nig, fm = gid * 8, gsz = (nM - fm) < 8 ? (nM - fm) : 8;
    pm = fm + ((wgid % nig) % gsz); pn = (wgid % nig) / gsz;
}
struct SchedPlain {
    int nM, nN, G, c, nt; long a0, b0; int lda, ldb;
    DI bool next(int i, Unit& u, long& a_off, long& b_off) const {
        const int L = i * G + c; if (L >= nM * nN) return false;
        xcd_tile(L, nM, nN, u.pm, u.pn); a_off = a0 + (long)u.pm * 256 * lda * 2; b_off = b0 + (long)u.pn * 256 * ldb * 2; u.nt = nt; u.kind = 0; return true; }
};
struct SchedMerge {
    int G, c, nrt;
    DI bool next(int i, Unit& u, long& a_off, long& b_off) const {
        const int L = (i >> 3) * G + c; if (L >= nrt * 4) return false;
        const int sub = i & 7; xcd_tile(L, nrt, 4, u.pm, u.pn); u.kind = sub;
        if (sub < 4) { a_off = (long)WS_YS + ((long)u.pm * 256 * 1024 + sub * 256) * 2; b_off = (long)(WS_W + W_BR) + ((long)u.pn * 256 * 1024 + sub * 256) * 2; u.nt = 4; }
        else { a_off = (long)WS_H + (long)u.pm * 256 * 1024 * 2; b_off = (long)(WS_W + W_GATE) + ((long)((u.pn * 4 + (sub - 4)) * 256) * 1024) * 2; u.nt = 16; }
        return true; }
};
struct SchedUp {
    int G, c, ntm;
    DI static void tile_seq(int tm, int& base, int& len, int& j) {
        if (tm < 67) { base = 0; len = TLAT; j = tm; } else if (tm < 134) { base = TLAT; len = TLAT; j = tm - 67; }
        else { const int x = tm - 134; base = NLAT + (x >> 1) * CTXL; len = CTXL; j = x & 1; } }
    DI bool next(int i, Unit& u, long& a_off, long& b_off) const {
        const int L = i * G + c; if (L >= ntm * 22) return false;
        xcd_tile(L, ntm, 22, u.pm, u.pn); int base, len, j; tile_seq(u.pm, base, len, j);
        a_off = (long)WS_H + ((long)(base + 248 * j - 1) * 1024) * 2; b_off = (long)(WS_W + W_UP) + (long)u.pn * 256 * 1024 * 2; u.nt = 16; u.kind = 0; return true; }
};

struct EpiStore {
    bf16_t* O; int ldc;
    DI void operator()(const f32x4 (&acc)[2][2][4][2], const Unit& u, int wr, int wc, int fr_in, int fq_in) const {
        int ln_; asm volatile("v_mbcnt_lo_u32_b32 %0, -1, 0\n\tv_mbcnt_hi_u32_b32 %0, -1, %0" : "=v"(ln_)); const int fr = ln_ & 15, fq = ln_ >> 4; (void)fr_in; (void)fq_in;
        const int row0 = u.pm * 256 + wr * 64 + fr, col0 = u.pn * 256 + wc * 32 + 8 * fq;
#pragma unroll
        for (int ai = 0; ai < 2; ++ai)
#pragma unroll
            for (int m = 0; m < 4; ++m) { bf16_t* rowp = O + (size_t)(row0 + ai * 128 + m * 16) * ldc + col0;
#pragma unroll
                for (int bj = 0; bj < 2; ++bj) { const f32x4 v0 = acc[ai][bj][m][0], v1 = acc[ai][bj][m][1];
                    u32x4 w; w.x = cvtpk(v0[0], v0[1]); w.y = cvtpk(v0[2], v0[3]); w.z = cvtpk(v1[0], v1[1]); w.w = cvtpk(v1[2], v1[3]);
                    *(u32x4*)(rowp + bj * 128) = w; } }
    }
};
struct EpiMerge {
    unsigned char* stash; const float* bgate; bf16_t* O;
    DI void operator()(const f32x4 (&acc)[2][2][4][2], const Unit& u, int wr, int wc, int fr_in, int fq_in) const {
        int ln_; asm volatile("v_mbcnt_lo_u32_b32 %0, -1, 0\n\tv_mbcnt_hi_u32_b32 %0, -1, %0" : "=v"(ln_)); const int fr = ln_ & 15, fq = ln_ >> 4; (void)fr_in; (void)fq_in;
        unsigned char* st = stash + (size_t)blockIdx.x * 524288;
        if (u.kind < 4) {
            unsigned char* pb = st + (size_t)u.kind * 131072 + (size_t)(wr * 64 + fr) * 512 + (wc * 32 + 8 * fq) * 2;
#pragma unroll
            for (int ai = 0; ai < 2; ++ai)
#pragma unroll
                for (int m = 0; m < 4; ++m)
#pragma unroll
                    for (int bj = 0; bj < 2; ++bj) { const f32x4 v0 = acc[ai][bj][m][0], v1 = acc[ai][bj][m][1];
                        u32x4 w; w.x = cvtpk(v0[0], v0[1]); w.y = cvtpk(v0[2], v0[3]); w.z = cvtpk(v1[0], v1[1]); w.w = cvtpk(v1[2], v1[3]);
                        *(u32x4*)(pb + (size_t)(ai * 128 + m * 16) * 512 + bj * 256) = w; }
            asm volatile("s_waitcnt vmcnt(0)" ::: "memory");
        } else {
            __builtin_amdgcn_fence(__ATOMIC_ACQUIRE, "agent");
            const int q = u.kind - 4, cq = 64 * q + 16 * wc + 4 * fq, col = u.pn * 256 + cq;
            f32x4 bg[4];
#pragma unroll
            for (int i = 0; i < 4; ++i) bg[i] = *(const f32x4*)(bgate + i * 1024 + col);
            const unsigned char* pb = st + (size_t)(wr * 64 + fr) * 512 + cq * 2;
            bf16_t* ob = O + (size_t)(u.pm * 256 + wr * 64 + fr) * 1024 + col;
#pragma unroll
            for (int ai = 0; ai < 2; ++ai)
#pragma unroll
                for (int m = 0; m < 4; ++m) {
                    f32x4 o = (f32x4){0.f, 0.f, 0.f, 0.f};
#pragma unroll
                    for (int bj = 0; bj < 2; ++bj)
#pragma unroll
                        for (int n = 0; n < 2; ++n) { const int i = 2 * bj + n;
                            const uint2 pw = *(const uint2*)(pb + (size_t)i * 131072 + (size_t)(ai * 128 + m * 16) * 512);
                            const f32x4 p = (f32x4){__uint_as_float(pw.x << 16), __uint_as_float(pw.x & 0xffff0000u), __uint_as_float(pw.y << 16), __uint_as_float(pw.y & 0xffff0000u)};
                            const f32x4 gv = acc[ai][bj][m][n] + bg[i];
#pragma unroll
                            for (int e = 0; e < 4; ++e) o[e] += sigmoidf_(gv[e]) * p[e]; }
                    uint2 w; w.x = cvtpk(o[0], o[1]); w.y = cvtpk(o[2], o[3]);
                    *(uint2*)(ob + (size_t)(ai * 128 + m * 16) * 1024) = w;
                }
        }
    }
};
struct EpiConvGlu {
    bf16_t* Gout; const float* cw;
    DI void operator()(const f32x4 (&acc)[2][2][4][2], const Unit& u, int wr, int wc, int fr_in, int fq_in) const {
        int ln_; asm volatile("v_mbcnt_lo_u32_b32 %0, -1, 0\n\tv_mbcnt_hi_u32_b32 %0, -1, %0" : "=v"(ln_)); const int fr = ln_ & 15, fq = ln_ >> 4; (void)fr_in; (void)fq_in;
        int base, len, j; SchedUp::tile_seq(u.pm, base, len, j);
        const bool f0 = (fr == 0), f15 = (fr == 15);
#pragma unroll
        for (int n = 0; n < 2; ++n) {
            const int colv = u.pn * 128 + wc * 32 + 8 * fq + 4 * n;
            f32x4 wv[3], wg[3];
#pragma unroll
            for (int k = 0; k < 3; ++k) { wv[k] = *(const f32x4*)(cw + k * 5632 + colv); wg[k] = *(const f32x4*)(cw + k * 5632 + 2816 + colv); }
#pragma unroll
            for (int ai = 0; ai < 2; ++ai) {
#pragma unroll
                for (int m = 0; m < 4; ++m) {
                    const int rho = 16 * m + fr;
                    const int tl = 248 * j + 62 * (2 * ai + wr) - 1 + rho;
                    const bool valid = (rho >= 1) && (rho <= 62) && (tl >= 0) && (tl < len);
                    const bool lz = (tl <= 0), rz = (tl >= len - 1);
                    float outv[4];
#pragma unroll
                    for (int e = 0; e < 4; ++e) {
                        float cvv[2];
#pragma unroll
                        for (int bj = 0; bj < 2; ++bj) {
                            const float xc = acc[ai][bj][m][n][e];
                            const float xm1 = (m > 0) ? acc[ai][bj][m - 1][n][e] : xc, xp1 = (m < 3) ? acc[ai][bj][m + 1][n][e] : xc;
                            const float tl_ = f15 ? xm1 : xc, tr_ = f0 ? xp1 : xc;
                            const float lraw = DPPF(tl_, 0x121); const float left = lz ? 0.f : lraw;
                            const float rraw = DPPF(tr_, 0x12F); const float right = rz ? 0.f : rraw;
                            cvv[bj] = bj ? (left * wg[0][e] + xc * wg[1][e] + right * wg[2][e]) : (left * wv[0][e] + xc * wv[1][e] + right * wv[2][e]);
                        }
                        outv[e] = cvv[0] * cvv[1] * sigmoidf_(cvv[1]);
                    }
                    if (valid) { uint2 w; w.x = cvtpk(outv[0], outv[1]); w.y = cvtpk(outv[2], outv[3]); *(uint2*)(Gout + (size_t)(base + tl) * DFF + colv) = w; }
                }
            }
        }
    }
};
}

namespace attn_body {
constexpr int QP = DIN, OP = 1024;
constexpr int NW = 8, QBLK = 32, KVBLK = 64;
DI int crow(int r, int hi) { return (r & 3) + 8 * (r >> 2) + 4 * hi; }
#define SBAR() __builtin_amdgcn_sched_barrier(0)
constexpr int NSLOT = 3, SLOTB = 8192;
constexpr int LDS_K = 0, LDS_V = NSLOT * SLOTB, LDS_WS = 2 * NSLOT * SLOTB, LDS_OST = LDS_WS + NW * 64 * 4, LDS_BYTES = LDS_OST + NW * 4096;
constexpr int LDS_BIAS = 86016;
DI void glds16(const void* gsrc, unsigned lds_dst) { unsigned keep;
  asm volatile("s_mov_b32 %0, m0\n\ts_mov_b32 m0, %2\n\ts_nop 0\n\tglobal_load_lds_dwordx4 %1, off\n\ts_mov_b32 m0, %0" : "=&s"(keep) : "v"(gsrc), "s"(lds_dst) : "memory"); }
DI float max3f(float a, float b, float c) { float r; asm("v_max3_f32 %0, %1, %2, %3" : "=v"(r) : "v"(a), "v"(b), "v"(c)); return r; }
DI float max2f(float a, float b) { float r; asm("v_max_f32_e32 %0, %1, %2" : "=v"(r) : "v"(a), "v"(b)); return r; }
DI float fadd_s(float a, float b) { float r; asm("v_add_f32_e32 %0, %1, %2" : "=v"(r) : "v"(a), "v"(b)); return r; }
DI float fsub_s(float a, float b) { float r; asm("v_sub_f32_e32 %0, %1, %2" : "=v"(r) : "v"(a), "v"(b)); return r; }
DI unsigned cvtpk_s(float lo, float hi) { return cvtpk(lo, hi); }
#define WAIT_BAR(N) asm volatile("s_waitcnt vmcnt(" #N ") lgkmcnt(0)\n\ts_barrier" ::: "memory")

DI void qkt(f32x16& p0, f32x16& p1, const char* Kslot, const bf16x8* qr, int r32, int hi) {
  const f32x16 zz = f32x16{};
  const char* kb = Kslot + hi * 1024 + r32 * 16;
#pragma unroll
  for (int d0 = 0; d0 < 4; ++d0) {
    const bf16x8 b0 = *reinterpret_cast<const bf16x8*>(kb + d0 * 2048);
    const bf16x8 b1 = *reinterpret_cast<const bf16x8*>(kb + d0 * 2048 + 512);
    if (d0 == 0) { p0 = __builtin_amdgcn_mfma_f32_32x32x16_bf16(b0, qr[0], zz, 0, 0, 0); p1 = __builtin_amdgcn_mfma_f32_32x32x16_bf16(b1, qr[0], zz, 0, 0, 0); }
    else { p0 = __builtin_amdgcn_mfma_f32_32x32x16_bf16(b0, qr[d0], p0, 0, 0, 0); p1 = __builtin_amdgcn_mfma_f32_32x32x16_bf16(b1, qr[d0], p1, 0, 0, 0); } }
}
typedef __attribute__((address_space(3))) const char* lds_cptr;
typedef short v4i16_t __attribute__((ext_vector_type(4)));
DI void kload8(bf16x8* kf, lds_cptr kp) {
  kf[0] = *(const LAS bf16x8*)(kp);        kf[1] = *(const LAS bf16x8*)(kp + 512);
  kf[2] = *(const LAS bf16x8*)(kp + 2048); kf[3] = *(const LAS bf16x8*)(kp + 2560);
  kf[4] = *(const LAS bf16x8*)(kp + 4096); kf[5] = *(const LAS bf16x8*)(kp + 4608);
  kf[6] = *(const LAS bf16x8*)(kp + 6144); kf[7] = *(const LAS bf16x8*)(kp + 6656);
}
DI void kload2(bf16x8* kf, lds_cptr kp, int j) { kf[2 * j] = *(const LAS bf16x8*)(kp + j * 2048); kf[2 * j + 1] = *(const LAS bf16x8*)(kp + j * 2048 + 512); }
DI s16x4 vtr(lds_cptr p) { return __builtin_bit_cast(s16x4, __builtin_amdgcn_ds_read_tr16_b64_v4i16((LAS v4i16_t*)p)); }
DI float rowmax(const f32x16& p0, const f32x16& p1) {
  float a = max3f(p0[0], p0[1], p1[0]), b = max3f(p0[2], p0[3], p1[1]); a = max3f(a, p1[2], p1[3]);
#pragma unroll
  for (int r = 4; r < 16; r += 4) { a = max3f(a, p0[r], p0[r + 1]); b = max3f(b, p0[r + 2], p0[r + 3]); a = max3f(a, p1[r], p1[r + 1]); b = max3f(b, p1[r + 2], p1[r + 3]); }
  const float m = max2f(a, b);
  auto rr = __builtin_amdgcn_permlane32_swap(__float_as_uint(m), __float_as_uint(m), false, false);
  return max2f(__uint_as_float(rr[0]), __uint_as_float(rr[1]));
}
DI void pv(f32x16* o, int vb, bf16x8 pa0, bf16x8 pa1, bf16x8 pa2, bf16x8 pa3) {
#pragma unroll
  for (int d0 = 0; d0 < 2; ++d0) { s16x4 lo[4], hi[4];
#pragma unroll
    for (int ks = 0; ks < 4; ++ks) {
      asm volatile("ds_read_b64_tr_b16 %0,%1 offset:%c2" : "=&v"(lo[ks]) : "v"(vb), "i"(d0 * 4096 + ks * 1024) : "memory");
      asm volatile("ds_read_b64_tr_b16 %0,%1 offset:%c2" : "=&v"(hi[ks]) : "v"(vb), "i"(d0 * 4096 + ks * 1024 + 512) : "memory"); }
    asm volatile("s_waitcnt lgkmcnt(0)" ::: "memory"); SBAR();
#define PK(k) (bf16x8){lo[k][0], lo[k][1], lo[k][2], lo[k][3], hi[k][0], hi[k][1], hi[k][2], hi[k][3]}
    o[d0] = __builtin_amdgcn_mfma_f32_32x32x16_bf16(pa0, PK(0), o[d0], 0, 0, 0);
    o[d0] = __builtin_amdgcn_mfma_f32_32x32x16_bf16(pa1, PK(1), o[d0], 0, 0, 0);
    o[d0] = __builtin_amdgcn_mfma_f32_32x32x16_bf16(pa2, PK(2), o[d0], 0, 0, 0);
    o[d0] = __builtin_amdgcn_mfma_f32_32x32x16_bf16(pa3, PK(3), o[d0], 0, 0, 0);
#undef PK
  }
}
struct TileMap { int n1, base1, base2, NT; };
struct NaInfo { int i0, rmin; };

template <int MODE, int THRL>
DI void attn_unit(const bf16_t* Qw0, const bf16_t* __restrict__ Kh, const bf16_t* __restrict__ Vh, bf16_t* Ow0, const TileMap tm, const NaInfo na, char* shm, int tid) {
  const int lane = tid & 63, r32 = lane & 31, hi = lane >> 5; const int wid = __builtin_amdgcn_readfirstlane(tid >> 6);
  const bf16_t* Qw = Qw0 + (long)(wid * QBLK) * QP;
  const unsigned lds0 = (unsigned)(uintptr_t)shm;
  float* wsf = (float*)(shm + LDS_WS) + wid * 64;
  const bf16_t* ksrc = Kh + (long)lane * QP + wid * 8;
  const bf16_t* vsrc = Vh + (long)(16 * (wid & 3) + (lane >> 2)) * QP + (wid >> 2) * 32 + (lane & 3) * 8;
  const unsigned kdst = lds0 + LDS_K + wid * 1024, vdst = lds0 + LDS_V + wid * 1024;
#define TROW(t) ((long)(((t) < tm.n1) ? (tm.base1 + 64 * (t)) : (tm.base2 + 64 * ((t) - tm.n1))))
#define DMA_K(t, slot) glds16(ksrc + TROW(t) * QP, (unsigned)__builtin_amdgcn_readfirstlane(kdst + (slot)))
#define DMA_V(t, slot) glds16(vsrc + TROW(t) * QP, (unsigned)__builtin_amdgcn_readfirstlane(vdst + (slot)))
  const int vb0 = (int)(lds0 + LDS_V) + ((lane >> 4) & 1) * 32 + (lane & 3) * 8 + (4 * hi + ((lane & 15) >> 2)) * 64;
  const char* Kbase = shm + LDS_K; bf16x8 kf[8];
  const lds_cptr shm3 = (lds_cptr)shm; const lds_cptr kp0 = shm3 + LDS_K + hi * 1024 + r32 * 16; const lds_cptr vp0 = shm3 + LDS_V + ((lane >> 4) & 1) * 32 + (lane & 3) * 8 + (4 * hi + ((lane & 15) >> 2)) * 64;
  const int NT = tm.NT;
  DMA_K(0, 0); DMA_V(0, 0); DMA_K(1, SLOTB);
  bf16x8 qr[4];
#pragma unroll
  for (int d0 = 0; d0 < 4; ++d0) qr[d0] = *reinterpret_cast<const bf16x8*>(&Qw[(long)r32 * QP + d0 * 16 + hi * 8]);
  float mhat = 0.f, l_reg = 0.f; f32x16 o[2]; o[0] = f32x16{}; o[1] = f32x16{}; f32x16 zacc = f32x16{}; if (MODE == 0) asm volatile("" : "+v"(zacc));
#define CMASK(P0, P1, t) do { if (MODE == 1) { const int t_ = (t); const bool ctx_ = t_ < 4; \
      int lane_ = lane; asm volatile("" : "+v"(lane_)); const int r32_ = lane_ & 31, hi_ = lane_ >> 5; \
      const int qi_ = na.i0 + (wid >> 1), qj_ = (wid & 1) * 32 + r32_; const int rs_ = min(max(qi_ - 4, 0), 248), cs_ = min(max(qj_ - 8, 0), 48); \
      const int kr = na.rmin + t_ - 4; const bool rowok = (unsigned)(kr - rs_) < 8u; \
      const int bb = ctx_ ? 480 : ((kr - qi_ + 7) * 31 + 15 - qj_ + 4 * hi_); const int lo_ = ctx_ ? -4096 : ((rowok ? cs_ : 4096) - 4 * hi_); const unsigned wd_ = ctx_ ? 8192u : 16u; const int mul_ = ctx_ ? 0 : 1; \
      const LAS float* btab = (const LAS float*)((lds_cptr)shm + LDS_BIAS); \
      _Pragma("unroll") for (int g_ = 0; g_ < 8; ++g_) { \
        _Pragma("unroll") for (int q_ = 0; q_ < 2; ++q_) { const int r = 2 * g_ + q_; const int kc0 = (r & 3) + 8 * (r >> 2); \
          const int d0_ = kc0 - lo_; \
          const int i0_ = ((unsigned)d0_ < wd_) ? bb + kc0 * mul_ : -1, i1_ = ((unsigned)(d0_ + 32) < wd_) ? bb + (kc0 + 32) * mul_ : -1; \
          const float b0_ = btab[max(i0_, 0)], b1_ = btab[max(i1_, 0)]; \
          P0[r] = (i0_ >= 0) ? P0[r] + b0_ : -INFINITY; P1[r] = (i1_ >= 0) ? P1[r] + b1_ : -INFINITY; } \
        SBAR(); } } } while (0)
  bool resc = false;
#define START(P0, P1) do { const float rm = rowmax(P0, P1); resc = false; \
    { const float dl = rm; mhat = fadd_s(mhat, dl); \
      _Pragma("unroll") for (int r = 0; r < 16; ++r) { P0[r] = fsub_s(P0[r], dl); P1[r] = fsub_s(P1[r], dl); } \
      if (MODE == 0) { _Pragma("unroll") for (int r = 0; r < 16; ++r) zacc[r] = -mhat; asm volatile("" : "+v"(zacc)); } } \
    _Pragma("unroll") for (int r = 0; r < 16; ++r) P0[r] = __builtin_amdgcn_exp2f(P0[r]); } while (0)
#define RESC() do { if (resc) { asm volatile("s_waitcnt lgkmcnt(0)" ::: "memory"); \
      _Pragma("unroll") for (int d_ = 0; d_ < 2; ++d_) _Pragma("unroll") for (int r = 0; r < 16; ++r) o[d_][r] *= wsf[crow(r, hi)]; } } while (0)
  f32x16 pA0, pA1, pB0, pB1;
  int sl_prev = 0, sl_cur = 0, sl_next = SLOTB;
#define ROT() do { sl_prev = sl_cur; sl_cur = sl_next; sl_next = (sl_next == (NSLOT - 1) * SLOTB) ? 0 : sl_next + SLOTB; } while (0)
  DMA_K(2, 2 * SLOTB);
  WAIT_BAR(3);
  qkt(pA0, pA1, Kbase, qr, r32, hi); asm volatile("s_nop 15\n\ts_nop 7" : "+v"(pA0), "+v"(pA1)); CMASK(pA0, pA1, 0);
  START(pA0, pA1);
  _Pragma("unroll") for (int r = 0; r < 16; ++r) pA1[r] = __builtin_amdgcn_exp2f(pA1[r]);
  WAIT_BAR(0);
  DMA_K(3, 0); DMA_V(1, SLOTB);
  ROT();
  kload8(kf, kp0 + sl_cur);
  WAIT_BAR(2);
  s16x4 vlo[8], vhi[8]; u32x4 pw0, pw1, pw2, pw3;
#define PKW(P, B) cvtpk_s(P[B], P[B + 1])
#define PAF(k) __builtin_bit_cast(bf16x8, pw##k)
#define VFR(i) (bf16x8){vlo[i][0], vlo[i][1], vlo[i][2], vlo[i][3], vhi[i][0], vhi[i][1], vhi[i][2], vhi[i][3]}
#define PIN(x) asm volatile("" : "+v"(x))
#define MX3(a, b, c) __builtin_fmaxf(__builtin_fmaxf((a), (b)), (c))
#define GAPA(MF, A0, A1, A2, A3, W0, W1, PW) do { MF; sacc += A0; sacc += A1; sacc += A2; sacc += A3; PIN(sacc); W0; W1; PIN(PW); SBAR(); } while (0)
#define EX(v) __builtin_amdgcn_exp2f(v)
#define GAPB(MF, X, B) do { MF; X[B] = EX(X[B]); X[B + 1] = EX(X[B + 1]); X[B + 2] = EX(X[B + 2]); X[B + 3] = EX(X[B + 3]); PIN(X); SBAR(); } while (0)
#define VRD(i) do { vlo[i] = vtr(vp_ + (((i) >> 2) * 4096 + ((i) & 3) * 1024)); vhi[i] = vtr(vp_ + (((i) >> 2) * 4096 + ((i) & 3) * 1024 + 512)); } while (0)
#define KRD(G, j) do { if (G) { kload2(kf, kp0 + sl_next, j); SBAR(); } } while (0)
#define STEP(C0, C1, P0, P1, t, GK, GV, GL) do { SBAR(); \
    const lds_cptr vp_ = vp0 + sl_prev; \
    VRD(0); SBAR(); float sacc = (P0[0] + P0[1]); \
    GAPA(C0 = __builtin_amdgcn_mfma_f32_32x32x16_bf16(kf[0], qr[0], zacc, 0, 0, 0), P0[2], P0[3], P0[4], P0[5],     pw0[0] = PKW(P0, 0), pw0[1] = PKW(P0, 2), pw0); \
    VRD(4); SBAR(); GAPA(C1 = __builtin_amdgcn_mfma_f32_32x32x16_bf16(kf[1], qr[0], zacc, 0, 0, 0), P0[6], P0[7], P0[8], P0[9],     pw0[2] = PKW(P0, 4), pw0[3] = PKW(P0, 6), pw0); \
    VRD(1); SBAR(); GAPA(C0 = __builtin_amdgcn_mfma_f32_32x32x16_bf16(kf[2], qr[1], C0, 0, 0, 0),   P0[10], P0[11], P0[12], P0[13], pw1[0] = PKW(P0, 8), pw1[1] = PKW(P0, 10), pw1); \
    VRD(5); SBAR(); GAPA(C1 = __builtin_amdgcn_mfma_f32_32x32x16_bf16(kf[3], qr[1], C1, 0, 0, 0),   P0[14], P0[15], P1[0], P1[1],   pw1[2] = PKW(P0, 12), pw1[3] = PKW(P0, 14), pw1); \
    VRD(2); SBAR(); GAPA(C0 = __builtin_amdgcn_mfma_f32_32x32x16_bf16(kf[4], qr[2], C0, 0, 0, 0),   P1[2], P1[3], P1[4], P1[5],     pw2[0] = PKW(P1, 0), pw2[1] = PKW(P1, 2), pw2); \
    VRD(6); SBAR(); GAPA(C1 = __builtin_amdgcn_mfma_f32_32x32x16_bf16(kf[5], qr[2], C1, 0, 0, 0),   P1[6], P1[7], P1[8], P1[9],     pw2[2] = PKW(P1, 4), pw2[3] = PKW(P1, 6), pw2); \
    VRD(3); SBAR(); GAPA(C0 = __builtin_amdgcn_mfma_f32_32x32x16_bf16(kf[6], qr[3], C0, 0, 0, 0),   P1[10], P1[11], P1[12], P1[13], pw3[0] = PKW(P1, 8), pw3[1] = PKW(P1, 10), pw3); \
    VRD(7); SBAR(); GAPA(C1 = __builtin_amdgcn_mfma_f32_32x32x16_bf16(kf[7], qr[3], C1, 0, 0, 0),   P1[14], P1[15], 0.f, 0.f,       pw3[2] = PKW(P1, 12), pw3[3] = PKW(P1, 14), pw3); \
    l_reg += sacc; \
    if (GK) { DMA_K((t) + 3, sl_cur); } if (GV) { DMA_V((t) + 1, sl_next); } \
    if (MODE == 1) { _Pragma("unroll") for (int r = 0; r < 16; ++r) { C0[r] -= mhat; C1[r] -= mhat; } } \
    CMASK(C0, C1, t); \
    { float a = MX3(C0[0], C0[1], C1[0]), b = MX3(C0[2], C0[3], C1[1]); a = MX3(a, C1[2], C1[3]); \
      _Pragma("unroll") for (int r = 4; r < 16; r += 4) { a = MX3(a, C0[r], C0[r + 1]); b = MX3(b, C0[r + 2], C0[r + 3]); a = MX3(a, C1[r], C1[r + 1]); b = MX3(b, C1[r + 2], C1[r + 3]); } \
      float rm = __builtin_fmaxf(a, b); { auto rr = __builtin_amdgcn_permlane32_swap(__float_as_uint(rm), __float_as_uint(rm), false, false); rm = __builtin_fmaxf(__uint_as_float(rr[0]), __uint_as_float(rr[1])); } \
      resc = false; \
      if (__builtin_expect(__any(rm > (float)THRL), 0)) { const float dl = __builtin_fmaxf(rm, 0.f); mhat += dl; \
        _Pragma("unroll") for (int r = 0; r < 16; ++r) { C0[r] -= dl; C1[r] -= dl; } \
        if (MODE == 0) { _Pragma("unroll") for (int r = 0; r < 16; ++r) zacc[r] = -mhat; asm volatile("" : "+v"(zacc)); } \
        const float f = __builtin_amdgcn_exp2f(-dl); l_reg *= f; if (hi == 0) wsf[r32] = f; resc = true; } } \
    SBAR(); \
    GAPB(o[0] = __builtin_amdgcn_mfma_f32_32x32x16_bf16(PAF(0), VFR(0), o[0], 0, 0, 0), C0, 0); \
    GAPB(o[1] = __builtin_amdgcn_mfma_f32_32x32x16_bf16(PAF(0), VFR(4), o[1], 0, 0, 0), C0, 4); \
    KRD(GL, 0); GAPB(o[0] = __builtin_amdgcn_mfma_f32_32x32x16_bf16(PAF(1), VFR(1), o[0], 0, 0, 0), C0, 8); \
    KRD(GL, 1); GAPB(o[1] = __builtin_amdgcn_mfma_f32_32x32x16_bf16(PAF(1), VFR(5), o[1], 0, 0, 0), C0, 12); \
    KRD(GL, 2); GAPB(o[0] = __builtin_amdgcn_mfma_f32_32x32x16_bf16(PAF(2), VFR(2), o[0], 0, 0, 0), C1, 0); \
    KRD(GL, 3); GAPB(o[1] = __builtin_amdgcn_mfma_f32_32x32x16_bf16(PAF(2), VFR(6), o[1], 0, 0, 0), C1, 4); \
    GAPB(o[0] = __builtin_amdgcn_mfma_f32_32x32x16_bf16(PAF(3), VFR(3), o[0], 0, 0, 0), C1, 8); \
    GAPB(o[1] = __builtin_amdgcn_mfma_f32_32x32x16_bf16(PAF(3), VFR(7), o[1], 0, 0, 0), C1, 12); \
    } while (0)
  int t = 1;
  for (; t + 5 < NT; t += 2) {
    STEP(pB0, pB1, pA0, pA1, t, true, true, true);     WAIT_BAR(2); RESC(); ROT();
    STEP(pA0, pA1, pB0, pB1, t + 1, true, true, true); WAIT_BAR(2); RESC(); ROT();
  }
#define ENDW(tt) do { if ((tt) + 3 < NT) { WAIT_BAR(2); } else if ((tt) + 2 < NT) { WAIT_BAR(1); } else { WAIT_BAR(0); } } while (0)
  for (; t + 1 < NT; t += 2) {
    STEP(pB0, pB1, pA0, pA1, t, (t + 3 < NT), (t + 1 < NT), (t + 1 < NT));         ENDW(t);     RESC(); ROT();
    STEP(pA0, pA1, pB0, pB1, t + 1, (t + 4 < NT), (t + 2 < NT), (t + 2 < NT));     ENDW(t + 1); RESC(); ROT();
  }
  STEP(pB0, pB1, pA0, pA1, NT - 1, false, false, false); RESC();
  { float sacc = pB0[0] + pB0[1]; _Pragma("unroll") for (int r = 2; r < 16; ++r) sacc += pB0[r]; _Pragma("unroll") for (int r = 0; r < 16; ++r) sacc += pB1[r]; l_reg += sacc;
    pw0 = (u32x4){PKW(pB0, 0), PKW(pB0, 2), PKW(pB0, 4), PKW(pB0, 6)}; pw1 = (u32x4){PKW(pB0, 8), PKW(pB0, 10), PKW(pB0, 12), PKW(pB0, 14)}; pw2 = (u32x4){PKW(pB1, 0), PKW(pB1, 2), PKW(pB1, 4), PKW(pB1, 6)}; pw3 = (u32x4){PKW(pB1, 8), PKW(pB1, 10), PKW(pB1, 12), PKW(pB1, 14)};
    SBAR(); pv(o, vb0 + sl_cur, PAF(0), PAF(1), PAF(2), PAF(3)); }
#undef PKW
#undef PAF
#undef VFR
#undef PIN
#undef MX3
#undef GAPA
#undef GAPB
#undef EX
#undef VRD
#undef KRD
#undef STEP
#undef ENDW
  { auto rr = __builtin_amdgcn_permlane32_swap(__float_as_uint(l_reg), __float_as_uint(l_reg), false, false); l_reg = __uint_as_float(rr[0]) + __uint_as_float(rr[1]); }
  if (hi == 0) wsf[32 + r32] = l_reg; asm volatile("s_waitcnt lgkmcnt(0)" ::: "memory");
  float rli[16];
#pragma unroll
  for (int r = 0; r < 16; ++r) rli[r] = __builtin_amdgcn_rcpf(wsf[32 + crow(r, hi)]);
  bf16_t* Ow = Ow0 + (long)(wid * QBLK) * OP;
  { __hip_bfloat16* stg = (__hip_bfloat16*)(shm + LDS_OST) + wid * 2048;
#pragma unroll
    for (int r = 0; r < 16; ++r) { const int orow = crow(r, hi);
#pragma unroll
      for (int d0 = 0; d0 < 2; ++d0) stg[orow * 64 + d0 * 32 + r32] = __float2bfloat16(o[d0][r] * rli[r]); }
    asm volatile("s_waitcnt lgkmcnt(0)" ::: "memory");
#pragma unroll
    for (int i = 0; i < 4; ++i) { const int row = i * 8 + (lane >> 3), ch = lane & 7; const u32x4 v = *(const u32x4*)(stg + row * 64 + ch * 8); *(u32x4*)(Ow + (long)row * OP + ch * 8) = v; } }
  asm volatile("s_waitcnt lgkmcnt(0)\n\ts_barrier" ::: "memory");
#undef DMA_K
#undef DMA_V
#undef TROW
#undef CMASK
#undef START
#undef RESC
#undef ROT
}
#undef SBAR
#undef WAIT_BAR
}

struct Args {
  const float* in[33];
  float* out; unsigned char* ws;
  int ph_lo, ph_hi;
};
enum { I_X = 0, I_C, I_CTX, I_CCTX, I_ADAW, I_ADAB, I_NMIXPRE, I_NMIXPOST, I_NFFNPRE, I_NFFNPOST, I_WIN, I_CONVA, I_NABIAS, I_QNORM, I_KNORM,
       I_MU, I_W0, I_W2, I_A0, I_A2, I_KK, I_KA, I_RK, I_G2, I_LNW, I_LNB, I_WBR, I_WGATE, I_BGATE, I_WO, I_FUP, I_FCONV, I_FDN };

DI void transpose_item(const float* W, int N, bf16_t* WT, int ld, int koff, int mode, LAS float* scr, int item, int lane) {
  const int nblk = N / 32, kb = item / nblk, nb = item % nblk, k0 = 64 * kb, n0 = 32 * nb;
#pragma unroll 8
  for (int i = 0; i < 32; ++i) { const int kk = 2 * i + (lane >> 5); scr[kk * 33 + (lane & 31)] = W[(size_t)(k0 + kk) * N + n0 + (lane & 31)]; }
  asm volatile("s_waitcnt lgkmcnt(0)" ::: "memory");
  const int c = lane & 7;
#pragma unroll
  for (int j = 0; j < 4; ++j) { const int n = (lane >> 3) + 8 * j; const LAS float* s = scr + (8 * c) * 33 + n;
    int nn = n0 + n;
    if (mode == 1) nn = (nn < DFF) ? (256 * (nn >> 7) + (nn & 127)) : (256 * ((nn - DFF) >> 7) + 128 + ((nn - DFF) & 127));
    if (mode == 2) { const int i = nn >> 10, cc = nn & 1023, c64 = cc & 63;
      nn = ((cc >> 6) * 256) + 128 * (i >> 1) + 32 * (c64 >> 4) + 8 * ((c64 >> 2) & 3) + 4 * (i & 1) + (c64 & 3); }
    u32x4 o; o.x = cvtpk(s[0 * 33], s[1 * 33]); o.y = cvtpk(s[2 * 33], s[3 * 33]); o.z = cvtpk(s[4 * 33], s[5 * 33]); o.w = cvtpk(s[6 * 33], s[7 * 33]);
    *(u32x4*)(WT + (size_t)nn * ld + koff + k0 + 8 * c) = o; }
  asm volatile("s_waitcnt lgkmcnt(0)" ::: "memory");
}
DI void convert_weights(const CAS4 Args& A, int l, LAS unsigned char* lds, int gw, int NGW, int wave, int lane) {
  LAS float* scr = (LAS float*)(lds + wave * 8704);
  unsigned char* wb = A.ws + WS_W;
  constexpr int I_IN_ = 16 * 96, I_G = 16 * 128, I_B = 4 * 4 * 32, I_O_ = 16 * 32, I_U = 16 * 176, I_D = 44 * 32;
  constexpr int NIT = I_IN_ + I_G + I_B + I_O_ + I_U + I_D;
  for (int it = gw; it < NIT; it += NGW) {
    int r = it;
    if (r < I_IN_) { transpose_item(A.in[I_WIN] + (size_t)l * 1024 * 3072, 3072, (bf16_t*)(wb + W_IN), 1024, 0, 0, scr, r, lane); continue; } r -= I_IN_;
    if (r < I_G) { transpose_item(A.in[I_WGATE] + (size_t)l * 1024 * 4096, 4096, (bf16_t*)(wb + W_GATE), 1024, 0, 2, scr, r, lane); continue; } r -= I_G;
    if (r < I_B) { const int br = r / 128; transpose_item(A.in[I_WBR] + ((size_t)l * 4 + br) * 256 * 1024, 1024, (bf16_t*)(wb + W_BR), 1024, br * 256, 0, scr, r % 128, lane); continue; } r -= I_B;
    if (r < I_O_) { transpose_item(A.in[I_WO] + (size_t)l * 1024 * 1024, 1024, (bf16_t*)(wb + W_O), 1024, 0, 0, scr, r, lane); continue; } r -= I_O_;
    if (r < I_U) { transpose_item(A.in[I_FUP] + (size_t)l * 1024 * 5632, 5632, (bf16_t*)(wb + W_UP), 1024, 0, 1, scr, r, lane); continue; } r -= I_U;
    transpose_item(A.in[I_FDN] + (size_t)l * 2816 * 1024, 1024, (bf16_t*)(wb + W_DN), 2816, 0, 0, scr, r, lane);
  }
}

DI void row_phase(const float* xold, float* xdst, const bf16_t* src, const float* gate, const float* gpost,
                  bf16_t* hout, const float* gnext, const float* sh, const float* sc, int lane) {
  f32x4 v[4];
#pragma unroll
  for (int j = 0; j < 4; ++j) v[j] = ((const f32x4*)xold)[lane + 64 * j];
  if (src) {
    f32x4 s[4]; float ss = 0.f;
#pragma unroll
    for (int j = 0; j < 4; ++j) { const uint2 w = ((const uint2*)src)[lane + 64 * j];
      s[j] = (f32x4){__uint_as_float(w.x << 16), __uint_as_float(w.x & 0xffff0000u), __uint_as_float(w.y << 16), __uint_as_float(w.y & 0xffff0000u)};
      ss += (s[j].x * s[j].x + s[j].y * s[j].y) + (s[j].z * s[j].z + s[j].w * s[j].w); }
    const float rs = __builtin_amdgcn_rsqf(wave_sum(ss, lane) * (1.f / 1024.f) + 1e-6f);
#pragma unroll
    for (int j = 0; j < 4; ++j) { const f32x4 g = ((const f32x4*)gate)[lane + 64 * j], p = ((const f32x4*)gpost)[lane + 64 * j];
      v[j] = v[j] + g * (s[j] * rs * p); ((f32x4*)xdst)[lane + 64 * j] = v[j]; }
  }
  if (hout) {
    float ss = 0.f;
#pragma unroll
    for (int j = 0; j < 4; ++j) ss += (v[j].x * v[j].x + v[j].y * v[j].y) + (v[j].z * v[j].z + v[j].w * v[j].w);
    const float rs = __builtin_amdgcn_rsqf(wave_sum(ss, lane) * (1.f / 1024.f) + 1e-6f);
#pragma unroll
    for (int j = 0; j < 4; ++j) { const f32x4 g = ((const f32x4*)gnext)[lane + 64 * j], a = ((const f32x4*)sh)[lane + 64 * j], b = ((const f32x4*)sc)[lane + 64 * j];
      const f32x4 h = (v[j] * rs * g) * (b + 1.f) + a;
      uint2 w; w.x = cvtpk(h.x, h.y); w.y = cvtpk(h.z, h.w); ((uint2*)hout)[lane + 64 * j] = w; }
  }
}

DI void row_phase_blk(const float* xlat_in, const float* xctx_in, float* xlat_out, float* xctx_out, const bf16_t* srcb,
                      const float* modl, int gate_off, const float* gpost, bf16_t* hb, const float* gnext, const float* modn, int sh_off, int sc_off,
                      int bx, int wave, int lane) {
  const int R0 = bx * 130;
  f32x4 gpv[4], gnv[4], gav[4], shv[4], scv[4];
#pragma unroll
  for (int j = 0; j < 4; ++j) { gpv[j] = ((const f32x4*)gpost)[lane + 64 * j]; gnv[j] = hb ? ((const f32x4*)gnext)[lane + 64 * j] : (f32x4){0.f, 0.f, 0.f, 0.f}; }
  int cur_s = -1;
  f32x4 xv[4], xn[4]; uint2 sv[4], sn[4];
  int row = R0 + wave;
  { const float* xo = (row < NLAT) ? xlat_in + (size_t)row * 1024 : xctx_in + (size_t)(row - NLAT) * 1024;
#pragma unroll
    for (int j = 0; j < 4; ++j) { xv[j] = ((const f32x4*)xo)[lane + 64 * j]; sv[j] = ((const uint2*)(srcb + (size_t)row * 1024))[lane + 64 * j]; } }
  for (; row < R0 + 130; row += 8) {
    const int nrow = row + 8; const bool hn = nrow < R0 + 130;
    if (hn) { const float* xo = (nrow < NLAT) ? xlat_in + (size_t)nrow * 1024 : xctx_in + (size_t)(nrow - NLAT) * 1024;
#pragma unroll
      for (int j = 0; j < 4; ++j) { xn[j] = ((const f32x4*)xo)[lane + 64 * j]; sn[j] = ((const uint2*)(srcb + (size_t)nrow * 1024))[lane + 64 * j]; } }
    const int s = (row < NLAT) ? (row >> 14) : 2;
    if (s != cur_s) { cur_s = s; const float* md = modl + (size_t)s * 6144; const float* mn = modn + (size_t)s * 6144;
#pragma unroll
      for (int j = 0; j < 4; ++j) { gav[j] = ((const f32x4*)(md + gate_off))[lane + 64 * j];
        shv[j] = hb ? ((const f32x4*)(mn + sh_off))[lane + 64 * j] : (f32x4){0.f, 0.f, 0.f, 0.f}; scv[j] = hb ? ((const f32x4*)(mn + sc_off))[lane + 64 * j] : (f32x4){0.f, 0.f, 0.f, 0.f}; } }
    f32x4 sf[4]; float ss = 0.f;
#pragma unroll
    for (int j = 0; j < 4; ++j) { const uint2 w = sv[j];
      sf[j] = (f32x4){__uint_as_float(w.x << 16), __uint_as_float(w.x & 0xffff0000u), __uint_as_float(w.y << 16), __uint_as_float(w.y & 0xffff0000u)};
      ss += (sf[j].x * sf[j].x + sf[j].y * sf[j].y) + (sf[j].z * sf[j].z + sf[j].w * sf[j].w); }
    const float rs = __builtin_amdgcn_rsqf(wave_sum(ss, lane) * (1.f / 1024.f) + 1e-6f);
    float* xd = (row < NLAT) ? xlat_out + (size_t)row * 1024 : xctx_out + (size_t)(row - NLAT) * 1024;
    float s2 = 0.f;
#pragma unroll
    for (int j = 0; j < 4; ++j) { xv[j] = xv[j] + gav[j] * (sf[j] * rs * gpv[j]); ((f32x4*)xd)[lane + 64 * j] = xv[j];
      s2 += (xv[j].x * xv[j].x + xv[j].y * xv[j].y) + (xv[j].z * xv[j].z + xv[j].w * xv[j].w); }
    if (hb) {
      const float r2 = __builtin_amdgcn_rsqf(wave_sum(s2, lane) * (1.f / 1024.f) + 1e-6f);
#pragma unroll
      for (int j = 0; j < 4; ++j) { const f32x4 h = (xv[j] * r2 * gnv[j]) * (scv[j] + 1.f) + shv[j];
        uint2 w; w.x = cvtpk(h.x, h.y); w.y = cvtpk(h.z, h.w); ((uint2*)(hb + (size_t)row * 1024))[lane + 64 * j] = w; }
    }
#pragma unroll
    for (int j = 0; j < 4; ++j) { xv[j] = xn[j]; sv[j] = sn[j]; }
  }
}

__global__ void __launch_bounds__(NTHREADS, 2) fwd_megakernel(Args A_) {
  extern __shared__ __attribute__((aligned(16))) unsigned char lds_raw[];
  LAS unsigned char* lds = (LAS unsigned char*)lds_raw;
  const int wave0_ = __builtin_amdgcn_readfirstlane((int)threadIdx.x >> 6);
  const int G = gridDim.x, bx = blockIdx.x;
  const int NGW = G * 8;
  const int lo = A_.ph_lo, hi = A_.ph_hi;
  if (hi < 0) cg::this_grid().sync();
  int ph = 0, nbar_ = 0;
#ifndef NBARX
#define NBARX 1
#endif
#ifndef SKIPMASK
#define SKIPMASK 0
#endif
#ifndef REPMASK
#define REPMASK 0
#endif
#define PHASE_BEGIN(id) if (ph >= lo && ph < hi && !((SKIPMASK >> (id)) & 1)) for (int rep_ = 0; rep_ < ((((REPMASK) >> (id)) & 1) ? 2 : 1); ++rep_) { const CAS4 Args* Ap_ = (const CAS4 Args*)__builtin_amdgcn_kernarg_segment_ptr(); asm volatile("" : "+s"(Ap_)); const CAS4 Args& A = *Ap_; \
  unsigned char* ws = A.ws; unsigned* ctl = (unsigned*)(ws + WS_CTL); float* MOD = (float*)(ws + WS_MOD); float* XC = (float*)(ws + WS_XC); float* BONUS = (float*)(ws + WS_BONUS); \
  bf16_t* H = (bf16_t*)(ws + WS_H); bf16_t* Z = (bf16_t*)(ws + WS_Z); bf16_t* YS = (bf16_t*)(ws + WS_YS); bf16_t* WAE = (bf16_t*)(ws + WS_WA); bf16_t* WAA = WAE + (size_t)2 * NROW * 256; float* YSC = (float*)(ws + WS_YSC); \
  (void)ctl; (void)MOD; (void)XC; (void)BONUS; (void)H; (void)Z; (void)YS; (void)WAE; (void)WAA; (void)YSC; \
  int tid; asm volatile("v_mbcnt_lo_u32_b32 %0, -1, 0\n\tv_mbcnt_hi_u32_b32 %0, -1, %0" : "=v"(tid)); tid += wave0_ * 64; const int lane = tid & 63, wave = __builtin_amdgcn_readfirstlane(tid >> 6); const int gw = bx * 8 + wave; (void)lane; (void)gw;
#define FRESH_TID(v) int v; asm volatile("v_mbcnt_lo_u32_b32 %0, -1, 0\n\tv_mbcnt_hi_u32_b32 %0, -1, %0" : "=v"(v)); v += wave0_ * 64;
#define PHASE_END } if (ph >= lo && ph + 1 < hi) { FRESH_TID(tb_) const CAS4 Args* Ab_ = (const CAS4 Args*)__builtin_amdgcn_kernarg_segment_ptr(); asm volatile("" : "+s"(Ab_)); for (int bi_ = 0; bi_ < NBARX; ++bi_) { ++nbar_; grid_barrier((unsigned*)(Ab_->ws + WS_CTL), (unsigned)nbar_ * (unsigned)G, tb_); } } ++ph;

  PHASE_BEGIN(0)
    {
      LAS float* sl = (LAS float*)(lds + 72 * 1024);
      for (int i = tid; i < 3 * 1024; i += NTHREADS) { const int s = i >> 10, k = i & 1023;
        const float c = (s < 2) ? A.in[I_C][s * 1024 + k] : A.in[I_CCTX][k]; sl[i] = c * sigmoidf_(c); }
      __syncthreads();
      LAS float* red = (LAS float*)(lds + 88 * 1024);
      for (int it = bx; it < NLAYER * 96; it += G) {
        const int l = it / 96, c0 = (it % 96) * 64;
        const float* wp = A.in[I_ADAW] + (size_t)l * 1024 * 6144 + c0 + lane;
        float a0 = 0.f, a1 = 0.f, a2 = 0.f;
        for (int k = wave * 128; k < wave * 128 + 128; ++k) { const float w = wp[(size_t)k * 6144]; a0 += sl[k] * w; a1 += sl[1024 + k] * w; a2 += sl[2048 + k] * w; }
        red[(wave * 3 + 0) * 64 + lane] = a0; red[(wave * 3 + 1) * 64 + lane] = a1; red[(wave * 3 + 2) * 64 + lane] = a2;
        __syncthreads();
        if (tid < 192) { const int s = tid >> 6, ln = tid & 63; float r = A.in[I_ADAB][l * 6144 + c0 + ln];
          for (int w = 0; w < 8; ++w) r += red[(w * 3 + s) * 64 + ln];
          MOD[((size_t)(l * 3 + s)) * 6144 + c0 + ln] = r; }
        __syncthreads();
      }
    }
    convert_weights(A, 0, lds, gw, NGW, wave, lane);
  PHASE_END

  PHASE_BEGIN(1)
    for (int row = gw; row < NROW; row += NGW) {
      const int s = (row < NLAT) ? (row >> 14) : 2;
      const float* xo = (row < NLAT) ? A.in[I_X] + (size_t)row * 1024 : A.in[I_CTX] + (size_t)(row - NLAT) * 1024;
      const float* md = MOD + (size_t)(0 * 3 + s) * 6144;
      row_phase(xo, nullptr, nullptr, nullptr, nullptr, H + (size_t)row * 1024, A.in[I_NMIXPRE], md, md + 1024, lane);
    }
  PHASE_END

  for (int l = 0; l < NLAYER; ++l) {
    PHASE_BEGIN(2)
      pg8::Gemm g{(const char*)ws, 1024, 1024};
      pg8::SchedPlain S{130, 12, G, bx, 16, (long)WS_H, (long)(WS_W + W_IN), 1024, 1024};
      pg8::EpiStore E{Z, DIN};
      pg8::gemm_phase<pg8::EpiStore, pg8::SchedPlain, false>(lds, g, S, E, tid);
    PHASE_END

    PHASE_BEGIN(3)
      if (rep_ == 0) {
        const float* qn = A.in[I_QNORM] + l * 64; const float* kn = A.in[I_KNORM] + l * 64;
        for (long idx = (long)bx * NTHREADS + tid; idx < (long)NROW * 48; idx += (long)G * NTHREADS) {
          const int part = (int)(idx & 7), h6 = (int)((idx >> 3) % 6), row = (int)(idx / 48);
          bf16_t* p = Z + (size_t)row * DIN + C_GQ + 64 * h6 + 8 * part;
          float f[8]; unpack8(*(const u32x4*)p, f);
          float ss = 0.f;
#pragma unroll
          for (int i = 0; i < 8; ++i) ss += f[i] * f[i];
          ss = red8(ss);
          const float rs = __builtin_amdgcn_rsqf(ss * (1.f / 64.f) + 1e-6f);
          const bool isq = h6 < 4; const float* nw = isq ? qn : kn; const float scl = isq ? C2 : 1.f;
#pragma unroll
          for (int i = 0; i < 8; ++i) f[i] = f[i] * rs * nw[8 * part + i] * scl;
          if (row < NLAT) {
            const int t = row & (TLAT - 1); const float gr = (float)(t >> 6), gc = (float)(t & 63);
#pragma unroll
            for (int pp = 0; pp < 4; ++pp) { const int pi = 4 * part + pp;
              const float invf = exp2f(-(float)(pi & 15) * (13.287712379549449f / 16.f));
              const float ang = (pi < 16 ? gr : gc) * invf; const float cs = __cosf(ang), sn = __sinf(ang);
              const float x1 = f[2 * pp], x2 = f[2 * pp + 1]; f[2 * pp] = x1 * cs - x2 * sn; f[2 * pp + 1] = x1 * sn + x2 * cs; }
          }
          *(u32x4*)p = pack8(f);
        }
      }
      {
        FRESH_TID(tid)
        const float* cw = A.in[I_CONVA] + l * 3 * 256;
        for (long idx = (long)bx * NTHREADS + tid; idx < (long)NROW * 32; idx += (long)G * NTHREADS) {
          const int g8 = (int)(idx & 31), row = (int)(idx >> 5); int t, len; row_seq(row, t, len);
          const bf16_t* zr = Z + (size_t)row * DIN;
          if (rep_ == 0) { bf16_t* qp = Z + (size_t)row * DIN + C_NAQ + 8 * g8; float f[8]; unpack8(*(const u32x4*)qp, f);
#pragma unroll
            for (int i = 0; i < 8; ++i) f[i] *= C2;
            *(u32x4*)qp = pack8(f); }
          float bg[8], c0[8], x0[8], c1[8], x1[8], c2[8], x2[8];
          unpack8(*(const u32x4*)(zr + 8 * g8), bg);
          unpack8(*(const u32x4*)(zr + 256 + 8 * g8), c1); unpack8(*(const u32x4*)(zr + 512 + 8 * g8), x1);
          if (t > 0) { unpack8(*(const u32x4*)(zr - DIN + 256 + 8 * g8), c0); unpack8(*(const u32x4*)(zr - DIN + 512 + 8 * g8), x0); }
          else {
#pragma unroll
            for (int i = 0; i < 8; ++i) { c0[i] = 0.f; x0[i] = 0.f; } }
          if (t < len - 1) { unpack8(*(const u32x4*)(zr + DIN + 256 + 8 * g8), c2); unpack8(*(const u32x4*)(zr + DIN + 512 + 8 * g8), x2); }
          else {
#pragma unroll
            for (int i = 0; i < 8; ++i) { c2[i] = 0.f; x2[i] = 0.f; } }
          float o[8];
#pragma unroll
          for (int i = 0; i < 8; ++i) { const int c = 8 * g8 + i; o[i] = bg[i] * (cw[c] * (c0[i] * x0[i]) + cw[256 + c] * (c1[i] * x1[i]) + cw[512 + c] * (c2[i] * x2[i])); }
          *(u32x4*)(YS + (size_t)row * 1024 + 8 * g8) = pack8(o);
        }
      }
      {
        FRESH_TID(tid)
        const int ln = tid & 63, wv = __builtin_amdgcn_readfirstlane(tid >> 6), d = wv >> 2, nq = wv & 3, r32 = ln & 31, hi = ln >> 5;
        LAS unsigned char* AT = lds;
        const float* mu = A.in[I_MU] + (size_t)l * 2 * 896;
        bf16x8 Bf[2][2][4]; float bias0[2], bias1[2];
#pragma unroll
        for (int nt = 0; nt < 2; ++nt) {
          const int c = 64 * nq + 32 * nt + r32;
          bias0[nt] = A.in[I_W0][(l * 2 + d) * 256 + c]; bias1[nt] = A.in[I_A0][(l * 2 + d) * 256 + c];
#pragma unroll
          for (int ks = 0; ks < 4; ++ks) { float f0[8], f1[8];
#pragma unroll
            for (int i = 0; i < 8; ++i) { const size_t o = ((size_t)(l * 2 + d) * 64 + 16 * ks + 8 * hi + i) * 256 + c; f0[i] = A.in[I_W2][o]; f1[i] = A.in[I_A2][o]; }
            Bf[0][nt][ks] = __builtin_bit_cast(bf16x8, pack8(f0)); Bf[1][nt][ks] = __builtin_bit_cast(bf16x8, pack8(f1)); }
        }
        for (int tile = bx; tile < 520; tile += G) {
          const int R0 = tile * 64;
          __syncthreads();
          for (int i = tid; i < 2 * 64 * 16; i += NTHREADS) {
            const int dd = i >> 10, rem = i & 1023, r = rem >> 4, j8 = (rem & 15) * 8, row = R0 + r; int t, len; row_seq(row, t, len);
            const int nb = dd ? t + 1 : t - 1; const bool nv = (nb >= 0) && (nb < len);
            float zc[8], zn[8];
            unpack8(*(const u32x4*)(Z + (size_t)row * DIN + C_LW + j8), zc);
            if (nv) unpack8(*(const u32x4*)(Z + (size_t)(row + (dd ? 1 : -1)) * DIN + C_LW + j8), zn);
            else {
#pragma unroll
              for (int e = 0; e < 8; ++e) zn[e] = 0.f; }
            const f32x4 m0 = *(const f32x4*)(mu + dd * 896 + 768 + j8), m1 = *(const f32x4*)(mu + dd * 896 + 768 + j8 + 4);
            float v[8];
#pragma unroll
            for (int e = 0; e < 8; ++e) { v[e] = zc[e] + (e < 4 ? m0[e] : m1[e - 4]) * (zn[e] - zc[e]); if (j8 < 64) v[e] = 1.f - 2.f * __builtin_amdgcn_rcpf(__builtin_amdgcn_exp2f(2.8853900817779268f * v[e]) + 1.f); }
            *(LAS u32x4*)(AT + ((dd * 2 + (j8 >> 6)) * 64 + r) * 144 + (j8 & 63) * 2) = pack8(v);
          }
          __syncthreads();
          f32x16 acc[2][2][2];
#pragma unroll
          for (int m = 0; m < 2; ++m)
#pragma unroll
            for (int mt = 0; mt < 2; ++mt)
#pragma unroll
              for (int nt = 0; nt < 2; ++nt) acc[m][mt][nt] = f32x16{};
#pragma unroll
          for (int m = 0; m < 2; ++m)
#pragma unroll
            for (int mt = 0; mt < 2; ++mt)
#pragma unroll
              for (int ks = 0; ks < 4; ++ks) {
                const bf16x8 af = *(const LAS bf16x8*)(AT + ((d * 2 + m) * 64 + 32 * mt + r32) * 144 + (16 * ks + 8 * hi) * 2);
#pragma unroll
                for (int nt = 0; nt < 2; ++nt) acc[m][mt][nt] = __builtin_amdgcn_mfma_f32_32x32x16_bf16(af, Bf[m][nt][ks], acc[m][mt][nt], 0, 0, 0);
              }
#pragma unroll
          for (int mt = 0; mt < 2; ++mt)
#pragma unroll
            for (int nt = 0; nt < 2; ++nt) {
              const int c = 64 * nq + 32 * nt + r32;
#pragma unroll
              for (int r = 0; r < 16; ++r) {
                const int row = R0 + 32 * mt + (r & 3) + 8 * (r >> 2) + 4 * hi;
                const float aw = acc[0][mt][nt][r] + bias0[nt], aa = acc[1][mt][nt][r] + bias1[nt];
                const float xx = -aw; const float sp = fmaxf(xx, 0.f) + __logf(1.f + __expf(-fabsf(xx)));
                const float e = -__expf(-sp - 0.5f);
                const float av = sigmoidf_(aa);
                const size_t o = ((size_t)d * NROW + row) * 256 + c;
                WAE[o] = (bf16_t)(cvtpk(e, 0.f) & 0xffffu); WAA[o] = (bf16_t)(cvtpk(av, 0.f) & 0xffffu);
              }
            }
        }
        __syncthreads();
      }
    PHASE_END

    PHASE_BEGIN(4)
#ifndef NO_SCAN
#ifndef REP_SCAN
#define REP_SCAN 1
#endif
#ifndef REP_ATTN
#define REP_ATTN 1
#endif
      if (bx < 64 && (rep_ == 0 || REP_SCAN)) {
        const int sb = bx, s = sb >> 2, qd = sb & 3, d = s >> 3, b = (s >> 2) & 1, hh = s & 3;
        LAS float* buf = (LAS float*)lds;
        float muR[8], muK[8], muV[8], kkc[8], kac[8], rkc[8];
        const int ptid = tid & 255, ts = (ptid >> 3) & 31, cgp = ptid & 7, ch0 = hh * 64 + 8 * cgp;
        {
#pragma unroll
          for (int i = 0; i < 8; ++i) { const float* mu = A.in[I_MU] + (size_t)(l * 2 + d) * 896;
            muR[i] = mu[ch0 + i]; muK[i] = mu[256 + ch0 + i]; muV[i] = mu[512 + ch0 + i];
            kkc[i] = A.in[I_KK][l * 256 + ch0 + i]; kac[i] = A.in[I_KA][l * 256 + ch0 + i]; rkc[i] = A.in[I_RK][l * 256 + ch0 + i]; }
        }
        const int rsub = lane >> 4, kg = lane & 15, vrow = 16 * qd + 4 * (wave & 3) + rsub;
#define SCAN_RLO(cc) (((cc) < 8) ? (NLAT + b * CTXL + (d ? 224 - 32 * (cc) : 32 * (cc))) : (b * TLAT + (d ? 16352 - 32 * ((cc) - 8) : 32 * ((cc) - 8))))
        const unsigned ro = (unsigned)(d ? 31 - ts : ts);
        const unsigned offz = ro * DIN + ch0, offw = ro * 256 + ch0;
        const unsigned roy = (unsigned)(d ? 31 - (ptid >> 3) : (ptid >> 3)), offy = roy * 256 + hh * 64 + 16 * qd + (ptid & 7) * 2;
#define SCAN_LOAD(cc, X) do { const int rlo_ = SCAN_RLO(cc); const bool nv = !((((cc) == 0) || ((cc) == 8)) && ts == 0); \
          const bf16_t* zb = Z + (size_t)rlo_ * DIN; const bf16_t* znb = zb + (d ? DIN : -DIN); const u32x4 z4 = (u32x4){0u, 0u, 0u, 0u}; \
          X[0] = *(const u32x4*)(zb + (offz + C_RR)); X[1] = *(const u32x4*)(zb + (offz + C_RK)); X[2] = *(const u32x4*)(zb + (offz + C_RV)); \
          X[3] = nv ? *(const u32x4*)(znb + (offz + C_RR)) : z4; X[4] = nv ? *(const u32x4*)(znb + (offz + C_RK)) : z4; X[5] = nv ? *(const u32x4*)(znb + (offz + C_RV)) : z4; \
          const bf16_t* wb_ = WAE + ((size_t)d * NROW + rlo_) * 256; const bf16_t* ab_ = WAA + ((size_t)d * NROW + rlo_) * 256; \
          X[6] = *(const u32x4*)(wb_ + offw); X[7] = *(const u32x4*)(ab_ + offw); } while (0)
#define SCAN_PREP(cc, X) do { const int rlo_ = SCAN_RLO(cc); \
          float r8[8], k8[8], v8[8], rn[8], kn[8], vn[8], e8[8], a8[8]; \
          unpack8(X[0], r8); unpack8(X[1], k8); unpack8(X[2], v8); unpack8(X[3], rn); unpack8(X[4], kn); unpack8(X[5], vn); unpack8(X[6], e8); unpack8(X[7], a8); \
          float kkv[8], ssq = 0.f, bsum = 0.f; \
          _Pragma("unroll") for (int i = 0; i < 8; ++i) { r8[i] += muR[i] * (rn[i] - r8[i]); k8[i] += muK[i] * (kn[i] - k8[i]); v8[i] += muV[i] * (vn[i] - v8[i]); \
            kkv[i] = k8[i] * kkc[i]; ssq += kkv[i] * kkv[i]; } \
          ssq = red8(ssq); \
          const float inv = __builtin_amdgcn_rsqf(fmaxf(ssq, 1e-24f)); \
          float wv[8], bb[8], kp[8]; \
          _Pragma("unroll") for (int i = 0; i < 8; ++i) { kkv[i] *= inv; kp[i] = k8[i] * (1.f + (a8[i] - 1.f) * kac[i]); bb[i] = kkv[i] * a8[i]; wv[i] = __expf(e8[i]); bsum += r8[i] * kp[i] * rkc[i]; } \
          bsum = red8(bsum); \
          if (qd == 0 && cgp == 0) (BONUS + ((size_t)d * NROW + rlo_) * 4)[ro * 4 + hh] = bsum; \
          LAS float* db = buf + ((cc) & 1) * (6 * 32 * 64) + ts * 64 + 8 * cgp; \
          *(LAS f32x4*)(db + 0 * 2048) = (f32x4){wv[0], wv[1], wv[2], wv[3]}; *(LAS f32x4*)(db + 0 * 2048 + 4) = (f32x4){wv[4], wv[5], wv[6], wv[7]}; \
          *(LAS f32x4*)(db + 1 * 2048) = (f32x4){kkv[0], kkv[1], kkv[2], kkv[3]}; *(LAS f32x4*)(db + 1 * 2048 + 4) = (f32x4){kkv[4], kkv[5], kkv[6], kkv[7]}; \
          *(LAS f32x4*)(db + 2 * 2048) = (f32x4){bb[0], bb[1], bb[2], bb[3]}; *(LAS f32x4*)(db + 2 * 2048 + 4) = (f32x4){bb[4], bb[5], bb[6], bb[7]}; \
          *(LAS f32x4*)(db + 3 * 2048) = (f32x4){kp[0], kp[1], kp[2], kp[3]}; *(LAS f32x4*)(db + 3 * 2048 + 4) = (f32x4){kp[4], kp[5], kp[6], kp[7]}; \
          *(LAS f32x4*)(db + 4 * 2048) = (f32x4){r8[0], r8[1], r8[2], r8[3]}; *(LAS f32x4*)(db + 4 * 2048 + 4) = (f32x4){r8[4], r8[5], r8[6], r8[7]}; \
          *(LAS f32x4*)(db + 5 * 2048) = (f32x4){v8[0], v8[1], v8[2], v8[3]}; *(LAS f32x4*)(db + 5 * 2048 + 4) = (f32x4){v8[4], v8[5], v8[6], v8[7]}; \
        } while (0)
#define SCAN_YOUT(cc) do { const int rlo_ = SCAN_RLO(cc); const int step_ = ptid >> 3, r2_ = (ptid & 7) * 2; \
          const LAS f32x4* yp_ = (const LAS f32x4*)(ybuf + ((cc) & 1) * 2048 + step_ * 64 + r2_ * 4); const f32x4 y0_ = yp_[0], y1_ = yp_[1]; \
          const f32x2 yv = (f32x2){(y0_[0] + y0_[1]) + (y0_[2] + y0_[3]), (y1_[0] + y1_[1]) + (y1_[2] + y1_[3])}; \
          *(f32x2*)(YSC + ((size_t)d * NROW + rlo_) * 256 + offy) = yv; } while (0)
        LAS float* ybuf = buf + 2 * 6 * 32 * 64;
        u32x4 RA[8], RB[8];
        __syncthreads();
        SCAN_LOAD(0, RA);
        if (wave >= 4) SCAN_PREP(0, RA);
        SCAN_LOAD(1, RA);
#pragma unroll
        for (int i = 0; i < 8; ++i) RB[i] = RA[i];
        __syncthreads();
        f32x2 Sa = (f32x2){0.f, 0.f}, Sb = (f32x2){0.f, 0.f};
        for (int cc = 0; cc < 520; ++cc) {
          if (wave >= 4) {
            if (cc + 2 < 520) SCAN_LOAD(cc + 2, RB);
            if (cc + 1 < 520) SCAN_PREP(cc + 1, RA);
            if (cc > 0) SCAN_YOUT(cc - 1);
#pragma unroll
            for (int i = 0; i < 8; ++i) RA[i] = RB[i];
          } else {
            const LAS float* sbuf = buf + (cc & 1) * (6 * 32 * 64) + 4 * kg;
            LAS float* yb = ybuf + (cc & 1) * 2048 + (4 * wave + rsub) * 4 + (kg >> 2);
            f32x4 W4 = *(const LAS f32x4*)(sbuf + 0 * 2048), K4 = *(const LAS f32x4*)(sbuf + 1 * 2048), B4 = *(const LAS f32x4*)(sbuf + 2 * 2048),
                  P4 = *(const LAS f32x4*)(sbuf + 3 * 2048), R4 = *(const LAS f32x4*)(sbuf + 4 * 2048);
            float vv = sbuf[5 * 2048 - 4 * kg + vrow];
            f32x4 Rp = R4;
#pragma unroll
            for (int st = 0; st < 32; ++st) {
              const int sn = (st + 1) & 31;
              const LAS float* sp = sbuf + sn * 64;
              const f32x4 W4n = *(const LAS f32x4*)(sp + 0 * 2048), K4n = *(const LAS f32x4*)(sp + 1 * 2048), B4n = *(const LAS f32x4*)(sp + 2 * 2048),
                          P4n = *(const LAS f32x4*)(sp + 3 * 2048), R4n = *(const LAS f32x4*)(sp + 4 * 2048);
              const float vvn = sp[5 * 2048 - 4 * kg + vrow];
              f32x2 p = Sa * (f32x2){K4[0], K4[1]}; p = __builtin_elementwise_fma(Sb, (f32x2){K4[2], K4[3]}, p);
              float sa = p[0] + p[1];
              if (st > 0) {
                f32x2 q = Sa * (f32x2){Rp[0], Rp[1]}; q = __builtin_elementwise_fma(Sb, (f32x2){Rp[2], Rp[3]}, q);
                float yq = q[0] + q[1]; yq += DPPF(yq, 0xB1); yq += DPPF(yq, 0x4E);
                yb[(st - 1) * 64] = yq;
              }
              sa = allreduce16(sa);
              const f32x2 vv2 = (f32x2){vv, vv}, nsa = (f32x2){-sa, -sa};
              f32x2 ta = __builtin_elementwise_fma(nsa, (f32x2){B4[0], B4[1]}, vv2 * (f32x2){P4[0], P4[1]});
              f32x2 tb = __builtin_elementwise_fma(nsa, (f32x2){B4[2], B4[3]}, vv2 * (f32x2){P4[2], P4[3]});
              Sa = __builtin_elementwise_fma(Sa, (f32x2){W4[0], W4[1]}, ta);
              Sb = __builtin_elementwise_fma(Sb, (f32x2){W4[2], W4[3]}, tb);
              Rp = R4;
              W4 = W4n; K4 = K4n; B4 = B4n; P4 = P4n; R4 = R4n; vv = vvn;
            }
            { f32x2 q = Sa * (f32x2){Rp[0], Rp[1]}; q = __builtin_elementwise_fma(Sb, (f32x2){Rp[2], Rp[3]}, q);
              float yq = q[0] + q[1]; yq += DPPF(yq, 0xB1); yq += DPPF(yq, 0x4E);
              yb[31 * 64] = yq; }
          }
          __syncthreads();
        }
        if (wave >= 4) SCAN_YOUT(519);
        __syncthreads();
#undef SCAN_LOAD
#undef SCAN_YOUT
#undef SCAN_PREP
#undef SCAN_RLO
      }
#endif
#ifndef NO_ATTN
      if (rep_ == 0 || REP_ATTN) {
        FRESH_TID(tid)
        volatile LAS unsigned* misc = (volatile LAS unsigned*)(lds + 92 * 1024);
        const float* nab = A.in[I_NABIAS] + (size_t)l * 4 * 465;
        for (;;) {
          __syncthreads();
          if (tid == 0) misc[0] = atomicAdd(ctl + 64 + 64 * l + 32 * rep_, 1u);
          __syncthreads();
          int u = (int)misc[0];
          if (l == NLAYER - 1 && u >= 1024) u += 16;
          if (u >= 1296) break;
          if (u >= 1040) {
            LAS float* SG = (LAS float*)lds;
            const int R0 = (u - 1040) * 130;
            for (int i = tid; i < 130 * 16; i += NTHREADS) { const int r = i >> 4, j8 = (i & 15) * 8; float f[8];
              unpack8(*(const u32x4*)(Z + (size_t)(R0 + r) * DIN + C_LG + j8), f);
#pragma unroll
              for (int e = 0; e < 8; ++e) f[e] = sigmoidf_(f[e]);
              *(LAS f32x4*)(SG + r * 128 + j8) = (f32x4){f[0], f[1], f[2], f[3]}; *(LAS f32x4*)(SG + r * 128 + j8 + 4) = (f32x4){f[4], f[5], f[6], f[7]}; }
            const int half = tid >> 8, c = tid & 255;
            float g2c[128];
#pragma unroll
            for (int j = 0; j < 128; ++j) g2c[j] = A.in[I_G2][((size_t)l * 128 + j) * 256 + c];
            __syncthreads();
            for (int r = half; r < 130; r += 2) {
              const LAS f32x4* sp = (const LAS f32x4*)(SG + r * 128);
              float gate = 0.f;
#pragma unroll
              for (int j4 = 0; j4 < 32; ++j4) { const f32x4 x = sp[j4]; gate += x[0] * g2c[4 * j4] + x[1] * g2c[4 * j4 + 1] + x[2] * g2c[4 * j4 + 2] + x[3] * g2c[4 * j4 + 3]; }
              YS[(size_t)(R0 + r) * 1024 + 768 + c] = (bf16_t)(cvtpk(gate, 0.f) & 0xffffu);
            }
            continue;
          }
          attn_body::TileMap tm; attn_body::NaInfo na{0, 0};
          const bf16_t *Qp, *Kp, *Vp; bf16_t* Op; int mode = 0;
          if (u < 512) {
            const int qb = u & 63, g2 = (u >> 6) & 1, kvh = (u >> 7) & 1, b = u >> 8, h = kvh * 2 + g2;
            tm = {256, b * TLAT, NLAT + b * CTXL, 260};
            const size_t q0 = (size_t)b * TLAT + qb * 256;
            Qp = Z + q0 * DIN + C_GQ + 64 * h; Kp = Z + C_GK + 64 * kvh; Vp = Z + C_GV + 64 * kvh; Op = YS + q0 * 1024 + 512 + 64 * h;
          } else if (u < 1024) {
            const int v = u - 512, ig = v & 63, h = (v >> 6) & 3, b = v >> 8, i0 = 4 * ig;
            int rmin = min(max(i0 - 4, 0), 248), rmax = min(max(i0 + 3 - 4, 0), 248) + 7;
            if (((rmax - rmin + 1) & 1) != 0) { if (rmax < 255) ++rmax; else --rmin; }
            tm = {4, NLAT + b * CTXL, b * TLAT + 64 * rmin, 4 + (rmax - rmin + 1)};
            na = {i0, rmin}; mode = 1;
            if (tid < 512) ((LAS float*)(lds + attn_body::LDS_BIAS))[tid] = (tid < 465) ? nab[h * 465 + tid] * LOG2E : 0.f;
            const size_t q0 = (size_t)b * TLAT + i0 * 64;
            Qp = Z + q0 * DIN + C_NAQ + 64 * h; Kp = Z + C_NAK + 64 * h; Vp = Z + C_NAV + 64 * h; Op = YS + q0 * 1024 + 256 + 64 * h;
          } else {
            const int v = u - 1024, isna = v >> 3, h = v & 3, b = (v >> 2) & 1;
            const size_t q0 = (size_t)NLAT + b * CTXL;
            tm = {4, NLAT + b * CTXL, 0, 4};
            if (isna) { Qp = Z + q0 * DIN + C_NAQ + 64 * h; Kp = Z + C_NAK + 64 * h; Vp = Z + C_NAV + 64 * h; Op = YS + q0 * 1024 + 256 + 64 * h; }
            else { Qp = Z + q0 * DIN + C_GQ + 64 * h; Kp = Z + C_GK + 64 * (h >> 1); Vp = Z + C_GV + 64 * (h >> 1); Op = YS + q0 * 1024 + 512 + 64 * h; }
          }
#ifndef NO_M1
          if (mode) { FRESH_TID(t1_) attn_body::attn_unit<1, 8>(Qp, Kp, Vp, Op, tm, na, (char*)lds_raw, t1_); }
#endif
#ifndef NO_M0
          if (!mode) { FRESH_TID(t0_) attn_body::attn_unit<0, 8>(Qp, Kp, Vp, Op, tm, na, (char*)lds_raw, t0_); }
#endif
        }
      }
#endif
    PHASE_END

    PHASE_BEGIN(5)
      {
        const int half = tid >> 8, c = tid & 255, hh = c >> 6;
        const float lnw = A.in[I_LNW][l * 256 + c], lnb = A.in[I_LNB][l * 256 + c];
        const float mv0 = A.in[I_MU][(size_t)(l * 2 + 0) * 896 + 512 + c], mv1 = A.in[I_MU][(size_t)(l * 2 + 1) * 896 + 512 + c];
        for (int tile = bx; tile < 256; tile += G) {
          const int R0 = tile * 130;
#pragma unroll 2
          for (int r = half; r < 130; r += 2) {
            const int row = R0 + r; int t, len; row_seq(row, t, len);
            const float y = YSC[((size_t)0 * NROW + row) * 256 + c] + YSC[((size_t)1 * NROW + row) * 256 + c];
            const bf16_t* zr = Z + (size_t)row * DIN + C_RV + c;
            const float zv = bf2f(zr[0]), zp = (t > 0) ? bf2f(zr[-DIN]) : 0.f, zq = (t < len - 1) ? bf2f(zr[DIN]) : 0.f;
            const float b0 = BONUS[((size_t)0 * NROW + row) * 4 + hh], b1 = BONUS[((size_t)1 * NROW + row) * 4 + hh];
            const float gate = bf2f(YS[(size_t)row * 1024 + 768 + c]);
            const float mean = wave_sum(y, lane) * (1.f / 64.f); const float dv = y - mean; const float var = wave_sum(dv * dv, lane) * (1.f / 64.f);
            const float yn = dv * __builtin_amdgcn_rsqf(var + 64e-5f) * lnw + lnb;
            const float v0 = zv + mv0 * (zp - zv), v1 = zv + mv1 * (zq - zv);
            const float bon = b0 * v0 + b1 * v1;
            YS[(size_t)row * 1024 + 768 + c] = (bf16_t)(cvtpk((yn + bon) * gate, 0.f) & 0xffffu);
          }
        }
      }
    PHASE_END

    PHASE_BEGIN(6)
      pg8::Gemm g{(const char*)ws, 1024, 1024};
      pg8::SchedMerge S{G, bx, (l == NLAYER - 1) ? 128 : 130};
      pg8::EpiMerge E{ws + WS_PSCR, A.in[I_BGATE] + (size_t)l * 4096, (bf16_t*)(ws + WS_ACCM)};
      pg8::gemm_phase<pg8::EpiMerge, pg8::SchedMerge, false>(lds, g, S, E, tid);
    PHASE_END

    PHASE_BEGIN(7)
      pg8::Gemm g{(const char*)ws, 1024, 1024};
      pg8::SchedPlain S{(l == NLAYER - 1) ? 128 : 130, 4, G, bx, 16, (long)WS_ACCM, (long)(WS_W + W_O), 1024, 1024};
      pg8::EpiStore E{(bf16_t*)(ws + WS_MBUF), 1024};
      pg8::gemm_phase<pg8::EpiStore, pg8::SchedPlain, false>(lds, g, S, E, tid);
    PHASE_END

    PHASE_BEGIN(8)
      for (int vb_ = bx; vb_ < 256; vb_ += G)
      row_phase_blk((l == 0) ? A.in[I_X] : (const float*)A.out, (l == 0) ? A.in[I_CTX] : (const float*)XC, A.out, XC, (const bf16_t*)(ws + WS_MBUF),
                    MOD + (size_t)l * 3 * 6144, 2 * 1024, A.in[I_NMIXPOST] + l * 1024, H, A.in[I_NFFNPRE] + l * 1024, MOD + (size_t)l * 3 * 6144, 3 * 1024, 4 * 1024, vb_, wave, lane);
    PHASE_END

    PHASE_BEGIN(9)
      pg8::Gemm g{(const char*)ws, 1024, 1024};
      pg8::SchedUp S{G, bx, (l == NLAYER - 1) ? 134 : 138};
      pg8::EpiConvGlu E{(bf16_t*)(ws + WS_G), A.in[I_FCONV] + (size_t)l * 3 * 5632};
      pg8::gemm_phase<pg8::EpiConvGlu, pg8::SchedUp, true>(lds, g, S, E, tid);
    PHASE_END

    PHASE_BEGIN(10)
      pg8::Gemm g{(const char*)ws, DFF, DFF};
      pg8::SchedPlain S{(l == NLAYER - 1) ? 128 : 130, 4, G, bx, 44, (long)WS_G, (long)(WS_W + W_DN), DFF, DFF};
      pg8::EpiStore E{(bf16_t*)(ws + WS_F), 1024};
      pg8::gemm_phase<pg8::EpiStore, pg8::SchedPlain, false>(lds, g, S, E, tid);
    PHASE_END

    PHASE_BEGIN(11)
      for (int vb_ = bx; vb_ < 256; vb_ += G)
      row_phase_blk((const float*)A.out, (const float*)XC, A.out, XC, (const bf16_t*)(ws + WS_F),
                    MOD + (size_t)l * 3 * 6144, 5 * 1024, A.in[I_NFFNPOST] + l * 1024, (l < NLAYER - 1) ? H : (bf16_t*)nullptr, A.in[I_NMIXPRE] + ((l + 1) & 3) * 1024,
                    MOD + (size_t)((l + 1) & 3) * 3 * 6144, 0, 1024, vb_, wave, lane);
      if (l < NLAYER - 1) convert_weights(A, l + 1, lds, gw, NGW, wave, lane);
    PHASE_END
  }
}

constexpr int LDS_BYTES = 147456;
constexpr int NPHASES = 2 + NLAYER * 10;
extern "C" void kernel_launch(void* const* d_in, const int* in_sizes, int n_in, void* d_out, int out_size, void* d_ws, size_t ws_size, hipStream_t stream) {
  static int grid = 0;
  if (grid == 0) {
    int dev = 0, cus = 0, per_cu = 0;
    hipGetDevice(&dev);
    hipDeviceGetAttribute(&cus, hipDeviceAttributeMultiprocessorCount, dev);
    if (hipFuncSetAttribute((const void*)fwd_megakernel, hipFuncAttributeMaxDynamicSharedMemorySize, LDS_BYTES) != hipSuccess) fprintf(stderr, "kernel_launch: hipFuncSetAttribute failed\n");
    hipOccupancyMaxActiveBlocksPerMultiprocessor(&per_cu, (const void*)fwd_megakernel, NTHREADS, LDS_BYTES);
    (void)hipGetLastError();
    if (per_cu < 1) per_cu = 1;
    grid = cus;
    if (n_in != 33 || ws_size < WS_END) fprintf(stderr, "kernel_launch: unexpected n_in %d or ws %zu\n", n_in, ws_size);
  }
  (void)hipMemsetAsync((char*)d_ws + WS_CTL, 0, 4096, stream);
  Args a{};
  for (int i = 0; i < 33; ++i) a.in[i] = (const float*)d_in[i];
  a.out = (float*)d_out; a.ws = (unsigned char*)d_ws; a.ph_lo = 0; a.ph_hi = NPHASES;
  void* args[] = {&a};
  hipError_t e = hipLaunchCooperativeKernel((const void*)fwd_megakernel, dim3(grid), dim3(NTHREADS), args, LDS_BYTES, stream);
  if (e != hipSuccess) fprintf(stderr, "cooperative launch failed: %s (grid %d)\n", hipGetErrorString(e), grid);
}
```

```cpp
#include <hip/hip_runtime.h>
#include <hip/hip_cooperative_groups.h>
#include <hip/hip_bf16.h>
#include <cstdio>
#include <cstdint>
#include <cmath>
namespace cg = cooperative_groups;

#define DI __device__ __forceinline__
#define LAS __attribute__((address_space(3)))
#define CAS4 __attribute__((address_space(4)))
typedef unsigned short bf16_t;
typedef short bf16x8 __attribute__((ext_vector_type(8)));
typedef float f32x4 __attribute__((ext_vector_type(4)));
typedef float f32x2 __attribute__((ext_vector_type(2)));
typedef float f32x16 __attribute__((ext_vector_type(16)));
typedef unsigned u32x4 __attribute__((ext_vector_type(4)));
typedef short s16x4 __attribute__((ext_vector_type(4)));
typedef __bf16 bf16x2_t __attribute__((ext_vector_type(2)));

constexpr int DM = 1024, TLAT = 16384, NLAT = 32768, CTXL = 256, NROW = 33280, NLAYER = 4;
constexpr int DIN = 3072, DFF = 2816;
constexpr int C_NAQ = 768, C_NAK = 1024, C_NAV = 1280, C_GQ = 1536, C_GK = 1792, C_GV = 1920;
constexpr int C_RR = 2048, C_RK = 2304, C_RV = 2560, C_LW = 2816, C_LA = 2880, C_LG = 2944;
constexpr float C2 = 0.125f * 1.4426950408889634f;
constexpr float LOG2E = 1.4426950408889634f;
constexpr int NTHREADS = 512;

constexpr size_t MiB = 1u << 20;
constexpr size_t WS_CTL = 0, WS_MOD = 1 * MiB, WS_XC = 2 * MiB, WS_BONUS = 4 * MiB, WS_W = 6 * MiB;
constexpr size_t W_IN = 0, W_GATE = W_IN + (size_t)3072 * 1024 * 2, W_BR = W_GATE + (size_t)4096 * 1024 * 2, W_O = W_BR + (size_t)1024 * 1024 * 2,
                 W_UP = W_O + (size_t)1024 * 1024 * 2, W_DN = W_UP + (size_t)5632 * 1024 * 2, W_END = W_DN + (size_t)1024 * 2816 * 2;
static_assert(WS_W + W_END <= 42 * MiB, "weights");
constexpr size_t WS_H = 42 * MiB + 65536, WS_Z = 108 * MiB, WS_YS = 304 * MiB, WS_WA = 370 * MiB, WS_YSC = 436 * MiB, WS_END = 501 * MiB;
constexpr size_t WS_ACCM = WS_Z, WS_MBUF = WS_Z + 70 * MiB, WS_G = WS_Z, WS_F = WS_YS, WS_PSCR = WS_WA, WS_ASCR = WS_YSC;
constexpr size_t ROWB = (size_t)NROW * 1024 * 2;

DI float bf2f(unsigned u16) { return __uint_as_float(u16 << 16); }
DI unsigned cvtpk(float lo, float hi) { f32x2 v = {lo, hi}; bf16x2_t b = __builtin_convertvector(v, bf16x2_t); return __builtin_bit_cast(unsigned, b); }
DI void unpack8(const u32x4 w, float* f) {
#pragma unroll
  for (int i = 0; i < 4; ++i) { f[2 * i] = __uint_as_float(w[i] << 16); f[2 * i + 1] = __uint_as_float(w[i] & 0xffff0000u); }
}
DI u32x4 pack8(const float* f) { u32x4 w; w.x = cvtpk(f[0], f[1]); w.y = cvtpk(f[2], f[3]); w.z = cvtpk(f[4], f[5]); w.w = cvtpk(f[6], f[7]); return w; }
DI float sigmoidf_(float x) { return __builtin_amdgcn_rcpf(1.f + __builtin_amdgcn_exp2f(-1.4426950408889634f * x)); }
DI float dppf(float x, const int ctrl_dummy);
#define DPPF(x, CTRL) __int_as_float(__builtin_amdgcn_update_dpp(0, __float_as_int(x), (CTRL), 0xf, 0xf, false))
DI float allreduce16(float x) { x += DPPF(x, 0xB1); x += DPPF(x, 0x4E); x += DPPF(x, 0x141); x += DPPF(x, 0x140); return x; }
DI float red8(float x) { x += DPPF(x, 0xB1); x += DPPF(x, 0x4E); x += DPPF(x, 0x141); return x; }
DI float bperm(float v, int src_lane) { return __int_as_float(__builtin_amdgcn_ds_bpermute(src_lane << 2, __float_as_int(v))); }
DI float wave_sum(float v, int lane) { v = allreduce16(v); v += bperm(v, lane ^ 16); v += bperm(v, lane ^ 32); return v; }

DI void grid_barrier(unsigned* ctr, unsigned target, int tid) {
  __syncthreads();
  if (tid == 0) {
    __builtin_amdgcn_fence(__ATOMIC_RELEASE, "agent");
    __hip_atomic_fetch_add(ctr, 1u, __ATOMIC_RELAXED, __HIP_MEMORY_SCOPE_AGENT);
    while (__hip_atomic_load(ctr, __ATOMIC_RELAXED, __HIP_MEMORY_SCOPE_AGENT) < target) __builtin_amdgcn_s_sleep(1);
    __builtin_amdgcn_fence(__ATOMIC_ACQUIRE, "agent");
  }
  __syncthreads();
}
DI void row_seq(int row, int& t, int& len) { if (row < NLAT) { t = row & (TLAT - 1); len = TLAT; } else { t = (row - NLAT) & (CTXL - 1); len = CTXL; } }

namespace pg8 {
constexpr int BM = 256, BK = 64, HALF = 128, HTB = HALF * BK * 2, STAGE_BYTES = 8 * HTB;
DI int lds_byte(int r, int c) { const int st = (r >> 4) * 2 + (c >> 5), rr = r & 15, cc = c & 31, ob = rr * 64 + cc * 2; return st * 1024 + (ob ^ (((ob >> 9) & 1) << 5)); }
DI void stage_rc(int b, int& R, int& C) { const int st = b / 1024, sb = b % 1024, swz = sb ^ (((sb >> 9) & 1) << 5); R = (st >> 1) * 16 + swz / 64; C = (st & 1) * 32 + (swz % 64) / 2; }
DI int perm32(int rho) { const int n = rho >> 4, i = rho & 15; return 8 * (i >> 2) + 4 * n + (i & 3); }

struct Unit { int pm, pn, nt, kind; };
struct Gemm { const char* base; int lda, ldb; };

template <class Epi, class Sched, bool CONV>
DI void gemm_phase(LAS unsigned char* lds, const Gemm g, const Sched& S, const Epi& E, int tid) {
    const int wid = __builtin_amdgcn_readfirstlane(tid >> 6), lane = tid & 63, wr = wid >> 2, wc = wid & 3, fr = lane & 15, fq = lane >> 4;
    unsigned voffA[2], voffB[2];
#pragma unroll
    for (int i = 0; i < 2; ++i) { int R, C; stage_rc(tid * 16 + i * 8192, R, C); const int Rb = (R & ~31) + perm32(R & 31);
        const int Ra = CONV ? (62 * (R >> 6) + (R & 63)) : R;
        voffA[i] = (unsigned)(Ra * g.lda + C) * 2u; voffB[i] = (unsigned)(Rb * g.ldb + C) * 2u; }
    constexpr int kstep = BK * 2;
    const int hstepA = (CONV ? 124 : HALF) * g.lda * 2, hstepB = HALF * g.ldb * 2;
    const unsigned ldsw = (unsigned)wid * 1024u;
    const int aoff = lds_byte(wr * 64 + fr, fq * 8), boff = lds_byte(wc * 32 + fr, fq * 8);
#define PG8_SA(b, h) (((b) * 2 + (h)) * HTB)
#define PG8_SB(b, h) ((4 + (b) * 2 + (h)) * HTB)
#define PG8_STAGE(bufoff, gbase, voff) do { _Pragma("unroll") for (int _i = 0; _i < 2; ++_i) \
        __builtin_amdgcn_global_load_lds((const unsigned*)((const char*)(gbase) + (voff)[_i]), (LAS unsigned*)(lds + (bufoff) + ldsw + _i * 8192), 16, 0, 0); } while (0)
#define PG8_LDA(dst, b, h) do { _Pragma("unroll") for (int m = 0; m < 4; ++m) _Pragma("unroll") for (int k = 0; k < 2; ++k) dst[m][k] = *(const LAS bf16x8*)(lds + PG8_SA(b, h) + aoff + m * 2048 + k * 1024); } while (0)
#define PG8_LDB(dst, b, h) do { _Pragma("unroll") for (int n = 0; n < 2; ++n) _Pragma("unroll") for (int k = 0; k < 2; ++k) dst[n][k] = *(const LAS bf16x8*)(lds + PG8_SB(b, h) + boff + n * 2048 + k * 1024); } while (0)
#define PG8_MMA(ai, bj, At, Bt) do { __builtin_amdgcn_s_setprio(1); _Pragma("unroll") for (int m = 0; m < 4; ++m) _Pragma("unroll") for (int n = 0; n < 2; ++n) _Pragma("unroll") for (int k = 0; k < 2; ++k) \
        acc[ai][bj][m][n] = __builtin_amdgcn_mfma_f32_16x16x32_bf16(Bt[n][k], At[m][k], acc[ai][bj][m][n], 0, 0, 0); __builtin_amdgcn_s_setprio(0); } while (0)
#define PG8_WAIT_V(n) asm volatile("s_waitcnt vmcnt(" #n ")" ::: "memory")
#define PG8_WAIT_L(n) asm volatile("s_waitcnt lgkmcnt(" #n ")" ::: "memory")
#define PG8_BAR __builtin_amdgcn_s_barrier()
#define PG8_SCHED __builtin_amdgcn_sched_barrier(0)
    Unit cur, nxt; int ui = 0; long ao_, bo_;
    if (!S.next(0, cur, ao_, bo_)) return;
    f32x4 acc[2][2][4][2];
#pragma unroll
    for (int a = 0; a < 2; ++a)
#pragma unroll
        for (int b = 0; b < 2; ++b)
#pragma unroll
            for (int m = 0; m < 4; ++m)
#pragma unroll
                for (int n = 0; n < 2; ++n) acc[a][b][m][n] = (f32x4){0.f, 0.f, 0.f, 0.f};
    bf16x8 At[4][2], B0[2][2], B1[2][2];
    const char* cA = g.base + ao_; const char* cB = g.base + bo_;
    PG8_STAGE(PG8_SB(0, 0), cB, voffB); PG8_STAGE(PG8_SB(0, 1), cB + hstepB, voffB); PG8_STAGE(PG8_SA(0, 0), cA, voffA); PG8_STAGE(PG8_SA(0, 1), cA + hstepA, voffA);
    if (wr == 1) PG8_BAR;
    PG8_WAIT_V(2); PG8_BAR;
    PG8_STAGE(PG8_SB(1, 0), cB + kstep, voffB); PG8_STAGE(PG8_SA(1, 0), cA + kstep, voffA); PG8_STAGE(PG8_SB(1, 1), cB + hstepB + kstep, voffB);
    PG8_WAIT_V(6); PG8_BAR;
    for (;;) {
        const bool has_next = S.next(ui + 1, nxt, ao_, bo_);
        const char* nA = has_next ? g.base + ao_ : cA; const char* nB = has_next ? g.base + bo_ : cB;
        const int nt = cur.nt;
        for (int t = 0; t < nt; t += 2) {
            const bool last = (t == nt - 2);
            const char* a1 = cA + (size_t)(t + 1) * kstep;
            const char* a2 = last ? nA : cA + (size_t)(t + 2) * kstep; const char* b2 = last ? nB : cB + (size_t)(t + 2) * kstep;
            const char* a3 = a2 + kstep; const char* b3 = b2 + kstep;
            PG8_LDB(B0, 0, 0); PG8_LDB(B1, 0, 1); PG8_SCHED; PG8_LDA(At, 0, 0); PG8_STAGE(PG8_SA(1, 1), a1 + hstepA, voffA);
            PG8_WAIT_V(8); PG8_WAIT_L(0); PG8_BAR; PG8_MMA(0, 0, At, B0); PG8_MMA(0, 1, At, B1); PG8_BAR; PG8_SCHED;
            PG8_LDA(At, 0, 1); PG8_STAGE(PG8_SB(0, 0), b2, voffB); PG8_STAGE(PG8_SB(0, 1), b2 + hstepB, voffB); PG8_STAGE(PG8_SA(0, 0), a2, voffA);
            PG8_WAIT_V(8); PG8_WAIT_L(0); PG8_BAR; PG8_MMA(1, 0, At, B0); PG8_MMA(1, 1, At, B1); PG8_BAR; PG8_SCHED;
            PG8_LDB(B0, 1, 0); PG8_LDB(B1, 1, 1); PG8_SCHED; PG8_LDA(At, 1, 0); PG8_STAGE(PG8_SA(0, 1), a2 + hstepA, voffA);
            PG8_WAIT_V(8); PG8_WAIT_L(0); PG8_BAR; PG8_MMA(0, 0, At, B0); PG8_MMA(0, 1, At, B1); PG8_BAR; PG8_SCHED;
            PG8_LDA(At, 1, 1); PG8_STAGE(PG8_SB(1, 0), b3, voffB); PG8_STAGE(PG8_SB(1, 1), b3 + hstepB, voffB); PG8_STAGE(PG8_SA(1, 0), a3, voffA);
            PG8_WAIT_V(8); PG8_WAIT_L(0); PG8_BAR; PG8_MMA(1, 0, At, B0); PG8_MMA(1, 1, At, B1); PG8_BAR; PG8_SCHED;
        }
        if (wr == 0) PG8_BAR;
        E(acc, cur, wr, wc, fr, fq);
        if (!has_next) break;
#pragma unroll
        for (int a = 0; a < 2; ++a)
#pragma unroll
            for (int b = 0; b < 2; ++b)
#pragma unroll
                for (int m = 0; m < 4; ++m)
#pragma unroll
                    for (int n = 0; n < 2; ++n) acc[a][b][m][n] = (f32x4){0.f, 0.f, 0.f, 0.f};
        cur = nxt; cA = nA; cB = nB; ++ui;
        if (wr == 1) PG8_BAR;
    }
    PG8_WAIT_V(0);
    PG8_BAR;
#undef PG8_SA
#undef PG8_SB
#undef PG8_STAGE
#undef PG8_LDA
#undef PG8_LDB
#undef PG8_MMA
#undef PG8_WAIT_V
#undef PG8_WAIT_L
#undef PG8_BAR
#undef PG8_SCHED
}

DI void xcd_tile(int L, int nM, int nN, int& pm, int& pn) {
    const int nwg = nM * nN; int wgid = L; { const int q = nwg / 8, r = nwg % 8, xcd = wgid % 8, off = wgid / 8; wgid = (xcd < r ? xcd * (q + 1) : r * (q + 1) + (xcd - r) * q) + off; }
    const int nig = 8 * nN, gid = wgid / nig, fm = gid * 8, gsz = (nM - fm) < 8 ? (nM - fm) : 8;
    pm = fm + ((wgid % nig) % gsz); pn = (wgid % nig) / gsz;
}
struct SchedPlain {
    int nM, nN, G, c, nt; long a0, b0; int lda, ldb, pn0;
    DI bool next(int i, Unit& u, long& a_off, long& b_off) const {
        const int L = i * G + c; if (L >= nM * nN) return false;
        xcd_tile(L, nM, nN, u.pm, u.pn); u.pn += pn0; a_off = a0 + (long)u.pm * 256 * lda * 2; b_off = b0 + (long)u.pn * 256 * ldb * 2; u.nt = nt; u.kind = 0; return true; }
};
struct SchedMerge {
    int G, c, nrt;
    DI bool next(int i, Unit& u, long& a_off, long& b_off) const {
        const int L = (i >> 3) * G + c; if (L >= nrt * 4) return false;
        const int sub = i & 7; xcd_tile(L, nrt, 4, u.pm, u.pn); u.kind = sub;
        if (sub < 4) { a_off = (long)WS_YS + ((long)u.pm * 256 * 1024 + sub * 256) * 2; b_off = (long)(WS_W + W_BR) + ((long)u.pn * 256 * 1024 + sub * 256) * 2; u.nt = 4; }
        else { a_off = (long)WS_H + (long)u.pm * 256 * 1024 * 2; b_off = (long)(WS_W + W_GATE) + ((long)((u.pn * 4 + (sub - 4)) * 256) * 1024) * 2; u.nt = 16; }
        return true; }
};
struct SchedUp {
    int G, c, ntm;
    DI static void tile_seq(int tm, int& base, int& len, int& j) {
        if (tm < 67) { base = 0; len = TLAT; j = tm; } else if (tm < 134) { base = TLAT; len = TLAT; j = tm - 67; }
        else { const int x = tm - 134; base = NLAT + (x >> 1) * CTXL; len = CTXL; j = x & 1; } }
    DI bool next(int i, Unit& u, long& a_off, long& b_off) const {
        const int L = i * G + c; if (L >= ntm * 22) return false;
        xcd_tile(L, ntm, 22, u.pm, u.pn); int base, len, j; tile_seq(u.pm, base, len, j);
        a_off = (long)WS_H + ((long)(base + 248 * j - 1) * 1024) * 2; b_off = (long)(WS_W + W_UP) + (long)u.pn * 256 * 1024 * 2; u.nt = 16; u.kind = 0; return true; }
};

struct EpiStore {
    bf16_t* O; int ldc;
    DI void operator()(const f32x4 (&acc)[2][2][4][2], const Unit& u, int wr, int wc, int fr_in, int fq_in) const {
        int ln_; asm volatile("v_mbcnt_lo_u32_b32 %0, -1, 0\n\tv_mbcnt_hi_u32_b32 %0, -1, %0" : "=v"(ln_)); const int fr = ln_ & 15, fq = ln_ >> 4; (void)fr_in; (void)fq_in;
        const int row0 = u.pm * 256 + wr * 64 + fr, col0 = u.pn * 256 + wc * 32 + 8 * fq;
#pragma unroll
        for (int ai = 0; ai < 2; ++ai)
#pragma unroll
            for (int m = 0; m < 4; ++m) { bf16_t* rowp = O + (size_t)(row0 + ai * 128 + m * 16) * ldc + col0;
#pragma unroll
                for (int bj = 0; bj < 2; ++bj) { const f32x4 v0 = acc[ai][bj][m][0], v1 = acc[ai][bj][m][1];
                    u32x4 w; w.x = cvtpk(v0[0], v0[1]); w.y = cvtpk(v0[2], v0[3]); w.z = cvtpk(v1[0], v1[1]); w.w = cvtpk(v1[2], v1[3]);
                    *(u32x4*)(rowp + bj * 128) = w; } }
    }
};
struct EpiMerge {
    unsigned char* stash; const float* bgate; bf16_t* O;
    DI void operator()(const f32x4 (&acc)[2][2][4][2], const Unit& u, int wr, int wc, int fr_in, int fq_in) const {
        int ln_; asm volatile("v_mbcnt_lo_u32_b32 %0, -1, 0\n\tv_mbcnt_hi_u32_b32 %0, -1, %0" : "=v"(ln_)); const int fr = ln_ & 15, fq = ln_ >> 4; (void)fr_in; (void)fq_in;
        unsigned char* st = stash + (size_t)blockIdx.x * 524288;
        if (u.kind < 4) {
            unsigned char* pb = st + (size_t)u.kind * 131072 + (size_t)(wr * 64 + fr) * 512 + (wc * 32 + 8 * fq) * 2;
#pragma unroll
            for (int ai = 0; ai < 2; ++ai)
#pragma unroll
                for (int m = 0; m < 4; ++m)
#pragma unroll
                    for (int bj = 0; bj < 2; ++bj) { const f32x4 v0 = acc[ai][bj][m][0], v1 = acc[ai][bj][m][1];
                        u32x4 w; w.x = cvtpk(v0[0], v0[1]); w.y = cvtpk(v0[2], v0[3]); w.z = cvtpk(v1[0], v1[1]); w.w = cvtpk(v1[2], v1[3]);
                        *(u32x4*)(pb + (size_t)(ai * 128 + m * 16) * 512 + bj * 256) = w; }
            asm volatile("s_waitcnt vmcnt(0)" ::: "memory");
        } else {
            __builtin_amdgcn_fence(__ATOMIC_ACQUIRE, "agent");
            const int q = u.kind - 4, cq = 64 * q + 16 * wc + 4 * fq, col = u.pn * 256 + cq;
            f32x4 bg[4];
#pragma unroll
            for (int i = 0; i < 4; ++i) bg[i] = *(const f32x4*)(bgate + i * 1024 + col);
            const unsigned char* pb = st + (size_t)(wr * 64 + fr) * 512 + cq * 2;
            bf16_t* ob = O + (size_t)(u.pm * 256 + wr * 64 + fr) * 1024 + col;
#pragma unroll
            for (int ai = 0; ai < 2; ++ai)
#pragma unroll
                for (int m = 0; m < 4; ++m) {
                    f32x4 o = (f32x4){0.f, 0.f, 0.f, 0.f};
#pragma unroll
                    for (int bj = 0; bj < 2; ++bj)
#pragma unroll
                        for (int n = 0; n < 2; ++n) { const int i = 2 * bj + n;
                            const uint2 pw = *(const uint2*)(pb + (size_t)i * 131072 + (size_t)(ai * 128 + m * 16) * 512);
                            const f32x4 p = (f32x4){__uint_as_float(pw.x << 16), __uint_as_float(pw.x & 0xffff0000u), __uint_as_float(pw.y << 16), __uint_as_float(pw.y & 0xffff0000u)};
                            const f32x4 gv = acc[ai][bj][m][n] + bg[i];
#pragma unroll
                            for (int e = 0; e < 4; ++e) o[e] += sigmoidf_(gv[e]) * p[e]; }
                    uint2 w; w.x = cvtpk(o[0], o[1]); w.y = cvtpk(o[2], o[3]);
                    *(uint2*)(ob + (size_t)(ai * 128 + m * 16) * 1024) = w;
                }
        }
    }
};
struct EpiConvGlu {
    bf16_t* Gout; const float* cw;
    DI void operator()(const f32x4 (&acc)[2][2][4][2], const Unit& u, int wr, int wc, int fr_in, int fq_in) const {
        int ln_; asm volatile("v_mbcnt_lo_u32_b32 %0, -1, 0\n\tv_mbcnt_hi_u32_b32 %0, -1, %0" : "=v"(ln_)); const int fr = ln_ & 15, fq = ln_ >> 4; (void)fr_in; (void)fq_in;
        int base, len, j; SchedUp::tile_seq(u.pm, base, len, j);
        const bool f0 = (fr == 0), f15 = (fr == 15);
#pragma unroll
        for (int n = 0; n < 2; ++n) {
            const int colv = u.pn * 128 + wc * 32 + 8 * fq + 4 * n;
            f32x4 wv[3], wg[3];
#pragma unroll
            for (int k = 0; k < 3; ++k) { wv[k] = *(const f32x4*)(cw + k * 5632 + colv); wg[k] = *(const f32x4*)(cw + k * 5632 + 2816 + colv); }
#pragma unroll
            for (int ai = 0; ai < 2; ++ai) {
#pragma unroll
                for (int m = 0; m < 4; ++m) {
                    const int rho = 16 * m + fr;
                    const int tl = 248 * j + 62 * (2 * ai + wr) - 1 + rho;
                    const bool valid = (rho >= 1) && (rho <= 62) && (tl >= 0) && (tl < len);
                    const bool lz = (tl <= 0), rz = (tl >= len - 1);
                    float outv[4];
#pragma unroll
                    for (int e = 0; e < 4; ++e) {
                        float cvv[2];
#pragma unroll
                        for (int bj = 0; bj < 2; ++bj) {
                            const float xc = acc[ai][bj][m][n][e];
                            const float xm1 = (m > 0) ? acc[ai][bj][m - 1][n][e] : xc, xp1 = (m < 3) ? acc[ai][bj][m + 1][n][e] : xc;
                            const float tl_ = f15 ? xm1 : xc, tr_ = f0 ? xp1 : xc;
                            const float lraw = DPPF(tl_, 0x121); const float left = lz ? 0.f : lraw;
                            const float rraw = DPPF(tr_, 0x12F); const float right = rz ? 0.f : rraw;
                            cvv[bj] = bj ? (left * wg[0][e] + xc * wg[1][e] + right * wg[2][e]) : (left * wv[0][e] + xc * wv[1][e] + right * wv[2][e]);
                        }
                        outv[e] = cvv[0] * cvv[1] * sigmoidf_(cvv[1]);
                    }
                    if (valid) { uint2 w; w.x = cvtpk(outv[0], outv[1]); w.y = cvtpk(outv[2], outv[3]); *(uint2*)(Gout + (size_t)(base + tl) * DFF + colv) = w; }
                }
            }
        }
    }
};
}

namespace attn_body {
constexpr int QP = DIN, OP = 1024;
constexpr int NW = 8, QBLK = 32, KVBLK = 64;
DI int crow(int r, int hi) { return (r & 3) + 8 * (r >> 2) + 4 * hi; }
#define SBAR() __builtin_amdgcn_sched_barrier(0)
constexpr int NSLOT = 3, SLOTB = 8192;
constexpr int LDS_K = 0, LDS_V = NSLOT * SLOTB, LDS_WS = 2 * NSLOT * SLOTB, LDS_OST = LDS_WS + NW * 64 * 4, LDS_BYTES = LDS_OST + NW * 4096;
constexpr int LDS_BIAS = 86016;
DI void glds16(const void* gsrc, unsigned lds_dst) { unsigned keep;
  asm volatile("s_mov_b32 %0, m0\n\ts_mov_b32 m0, %2\n\ts_nop 0\n\tglobal_load_lds_dwordx4 %1, off\n\ts_mov_b32 m0, %0" : "=&s"(keep) : "v"(gsrc), "s"(lds_dst) : "memory"); }
DI float max3f(float a, float b, float c) { float r; asm("v_max3_f32 %0, %1, %2, %3" : "=v"(r) : "v"(a), "v"(b), "v"(c)); return r; }
DI float max2f(float a, float b) { float r; asm("v_max_f32_e32 %0, %1, %2" : "=v"(r) : "v"(a), "v"(b)); return r; }
DI float fadd_s(float a, float b) { float r; asm("v_add_f32_e32 %0, %1, %2" : "=v"(r) : "v"(a), "v"(b)); return r; }
DI float fsub_s(float a, float b) { float r; asm("v_sub_f32_e32 %0, %1, %2" : "=v"(r) : "v"(a), "v"(b)); return r; }
DI unsigned cvtpk_s(float lo, float hi) { return cvtpk(lo, hi); }
#define WAIT_BAR(N) asm volatile("s_waitcnt vmcnt(" #N ") lgkmcnt(0)\n\ts_barrier" ::: "memory")

DI void qkt(f32x16& p0, f32x16& p1, const char* Kslot, const bf16x8* qr, int r32, int hi) {
  const f32x16 zz = f32x16{};
  const char* kb = Kslot + hi * 1024 + r32 * 16;
#pragma unroll
  for (int d0 = 0; d0 < 4; ++d0) {
    const bf16x8 b0 = *reinterpret_cast<const bf16x8*>(kb + d0 * 2048);
    const bf16x8 b1 = *reinterpret_cast<const bf16x8*>(kb + d0 * 2048 + 512);
    if (d0 == 0) { p0 = __builtin_amdgcn_mfma_f32_32x32x16_bf16(b0, qr[0], zz, 0, 0, 0); p1 = __builtin_amdgcn_mfma_f32_32x32x16_bf16(b1, qr[0], zz, 0, 0, 0); }
    else { p0 = __builtin_amdgcn_mfma_f32_32x32x16_bf16(b0, qr[d0], p0, 0, 0, 0); p1 = __builtin_amdgcn_mfma_f32_32x32x16_bf16(b1, qr[d0], p1, 0, 0, 0); } }
}
typedef __attribute__((address_space(3))) const char* lds_cptr;
typedef short v4i16_t __attribute__((ext_vector_type(4)));
DI void kload8(bf16x8* kf, lds_cptr kp) {
  kf[0] = *(const LAS bf16x8*)(kp);        kf[1] = *(const LAS bf16x8*)(kp + 512);
  kf[2] = *(const LAS bf16x8*)(kp + 2048); kf[3] = *(const LAS bf16x8*)(kp + 2560);
  kf[4] = *(const LAS bf16x8*)(kp + 4096); kf[5] = *(const LAS bf16x8*)(kp + 4608);
  kf[6] = *(const LAS bf16x8*)(kp + 6144); kf[7] = *(const LAS bf16x8*)(kp + 6656);
}
DI void kload2(bf16x8* kf, lds_cptr kp, int j) { kf[2 * j] = *(const LAS bf16x8*)(kp + j * 2048); kf[2 * j + 1] = *(const LAS bf16x8*)(kp + j * 2048 + 512); }
DI s16x4 vtr(lds_cptr p) { return __builtin_bit_cast(s16x4, __builtin_amdgcn_ds_read_tr16_b64_v4i16((LAS v4i16_t*)p)); }
DI float rowmax(const f32x16& p0, const f32x16& p1) {
  float a = max3f(p0[0], p0[1], p1[0]), b = max3f(p0[2], p0[3], p1[1]); a = max3f(a, p1[2], p1[3]);
#pragma unroll
  for (int r = 4; r < 16; r += 4) { a = max3f(a, p0[r], p0[r + 1]); b = max3f(b, p0[r + 2], p0[r + 3]); a = max3f(a, p1[r], p1[r + 1]); b = max3f(b, p1[r + 2], p1[r + 3]); }
  const float m = max2f(a, b);
  auto rr = __builtin_amdgcn_permlane32_swap(__float_as_uint(m), __float_as_uint(m), false, false);
  return max2f(__uint_as_float(rr[0]), __uint_as_float(rr[1]));
}
DI void pv(f32x16* o, int vb, bf16x8 pa0, bf16x8 pa1, bf16x8 pa2, bf16x8 pa3) {
#pragma unroll
  for (int d0 = 0; d0 < 2; ++d0) { s16x4 lo[4], hi[4];
#pragma unroll
    for (int ks = 0; ks < 4; ++ks) {
      asm volatile("ds_read_b64_tr_b16 %0,%1 offset:%c2" : "=&v"(lo[ks]) : "v"(vb), "i"(d0 * 4096 + ks * 1024) : "memory");
      asm volatile("ds_read_b64_tr_b16 %0,%1 offset:%c2" : "=&v"(hi[ks]) : "v"(vb), "i"(d0 * 4096 + ks * 1024 + 512) : "memory"); }
    asm volatile("s_waitcnt lgkmcnt(0)" ::: "memory"); SBAR();
#define PK(k) (bf16x8){lo[k][0], lo[k][1], lo[k][2], lo[k][3], hi[k][0], hi[k][1], hi[k][2], hi[k][3]}
    o[d0] = __builtin_amdgcn_mfma_f32_32x32x16_bf16(pa0, PK(0), o[d0], 0, 0, 0);
    o[d0] = __builtin_amdgcn_mfma_f32_32x32x16_bf16(pa1, PK(1), o[d0], 0, 0, 0);
    o[d0] = __builtin_amdgcn_mfma_f32_32x32x16_bf16(pa2, PK(2), o[d0], 0, 0, 0);
    o[d0] = __builtin_amdgcn_mfma_f32_32x32x16_bf16(pa3, PK(3), o[d0], 0, 0, 0);
#undef PK
  }
}
struct TileMap { int n1, base1, base2, NT; };
struct NaInfo { int i0, rmin; };

template <int MODE, int THRL>
DI void attn_unit(const bf16_t* Qw0, const bf16_t* __restrict__ Kh, const bf16_t* __restrict__ Vh, bf16_t* Ow0, const TileMap tm, const NaInfo na, char* shm, int tid) {
  const int lane = tid & 63, r32 = lane & 31, hi = lane >> 5; const int wid = __builtin_amdgcn_readfirstlane(tid >> 6);
  const bf16_t* Qw = Qw0 + (long)(wid * QBLK) * QP;
  const unsigned lds0 = (unsigned)(uintptr_t)shm;
  float* wsf = (float*)(shm + LDS_WS) + wid * 64;
  const bf16_t* ksrc = Kh + (long)lane * QP + wid * 8;
  const bf16_t* vsrc = Vh + (long)(16 * (wid & 3) + (lane >> 2)) * QP + (wid >> 2) * 32 + (lane & 3) * 8;
  const unsigned kdst = lds0 + LDS_K + wid * 1024, vdst = lds0 + LDS_V + wid * 1024;
#define TROW(t) ((long)(((t) < tm.n1) ? (tm.base1 + 64 * (t)) : (tm.base2 + 64 * ((t) - tm.n1))))
#define DMA_K(t, slot) glds16(ksrc + TROW(t) * QP, (unsigned)__builtin_amdgcn_readfirstlane(kdst + (slot)))
#define DMA_V(t, slot) glds16(vsrc + TROW(t) * QP, (unsigned)__builtin_amdgcn_readfirstlane(vdst + (slot)))
  const int vb0 = (int)(lds0 + LDS_V) + ((lane >> 4) & 1) * 32 + (lane & 3) * 8 + (4 * hi + ((lane & 15) >> 2)) * 64;
  const char* Kbase = shm + LDS_K; bf16x8 kf[8];
  const lds_cptr shm3 = (lds_cptr)shm; const lds_cptr kp0 = shm3 + LDS_K + hi * 1024 + r32 * 16; const lds_cptr vp0 = shm3 + LDS_V + ((lane >> 4) & 1) * 32 + (lane & 3) * 8 + (4 * hi + ((lane & 15) >> 2)) * 64;
  const int NT = tm.NT;
  DMA_K(0, 0); DMA_V(0, 0); DMA_K(1, SLOTB);
  bf16x8 qr[4];
#pragma unroll
  for (int d0 = 0; d0 < 4; ++d0) qr[d0] = *reinterpret_cast<const bf16x8*>(&Qw[(long)r32 * QP + d0 * 16 + hi * 8]);
  float mhat = 0.f, l_reg = 0.f; f32x16 o[2]; o[0] = f32x16{}; o[1] = f32x16{}; f32x16 zacc = f32x16{}; if (MODE == 0) asm volatile("" : "+v"(zacc));
#define CMASK(P0, P1, t) do { if (MODE == 1) { const int t_ = (t); const bool ctx_ = t_ < 4; \
      int lane_ = lane; asm volatile("" : "+v"(lane_)); const int r32_ = lane_ & 31, hi_ = lane_ >> 5; \
      const int qi_ = na.i0 + (wid >> 1), qj_ = (wid & 1) * 32 + r32_; const int rs_ = min(max(qi_ - 4, 0), 248), cs_ = min(max(qj_ - 8, 0), 48); \
      const int kr = na.rmin + t_ - 4; const bool rowok = (unsigned)(kr - rs_) < 8u; \
      const int bb = ctx_ ? 480 : ((kr - qi_ + 7) * 31 + 15 - qj_ + 4 * hi_); const int lo_ = ctx_ ? -4096 : ((rowok ? cs_ : 4096) - 4 * hi_); const unsigned wd_ = ctx_ ? 8192u : 16u; const int mul_ = ctx_ ? 0 : 1; \
      const LAS float* btab = (const LAS float*)((lds_cptr)shm + LDS_BIAS); \
      _Pragma("unroll") for (int g_ = 0; g_ < 8; ++g_) { \
        _Pragma("unroll") for (int q_ = 0; q_ < 2; ++q_) { const int r = 2 * g_ + q_; const int kc0 = (r & 3) + 8 * (r >> 2); \
          const int d0_ = kc0 - lo_; \
          const int i0_ = ((unsigned)d0_ < wd_) ? bb + kc0 * mul_ : -1, i1_ = ((unsigned)(d0_ + 32) < wd_) ? bb + (kc0 + 32) * mul_ : -1; \
          const float b0_ = btab[max(i0_, 0)], b1_ = btab[max(i1_, 0)]; \
          P0[r] = (i0_ >= 0) ? P0[r] + b0_ : -INFINITY; P1[r] = (i1_ >= 0) ? P1[r] + b1_ : -INFINITY; } \
        SBAR(); } } } while (0)
  bool resc = false;
#define START(P0, P1) do { const float rm = rowmax(P0, P1); resc = false; \
    { const float dl = rm; mhat = fadd_s(mhat, dl); \
      _Pragma("unroll") for (int r = 0; r < 16; ++r) { P0[r] = fsub_s(P0[r], dl); P1[r] = fsub_s(P1[r], dl); } \
      if (MODE == 0) { _Pragma("unroll") for (int r = 0; r < 16; ++r) zacc[r] = -mhat; asm volatile("" : "+v"(zacc)); } } \
    _Pragma("unroll") for (int r = 0; r < 16; ++r) P0[r] = __builtin_amdgcn_exp2f(P0[r]); } while (0)
#define RESC() do { if (resc) { asm volatile("s_waitcnt lgkmcnt(0)" ::: "memory"); \
      _Pragma("unroll") for (int d_ = 0; d_ < 2; ++d_) _Pragma("unroll") for (int r = 0; r < 16; ++r) o[d_][r] *= wsf[crow(r, hi)]; } } while (0)
  f32x16 pA0, pA1, pB0, pB1;
  int sl_prev = 0, sl_cur = 0, sl_next = SLOTB;
#define ROT() do { sl_prev = sl_cur; sl_cur = sl_next; sl_next = (sl_next == (NSLOT - 1) * SLOTB) ? 0 : sl_next + SLOTB; } while (0)
  DMA_K(2, 2 * SLOTB);
  WAIT_BAR(3);
  qkt(pA0, pA1, Kbase, qr, r32, hi); asm volatile("s_nop 15\n\ts_nop 7" : "+v"(pA0), "+v"(pA1)); CMASK(pA0, pA1, 0);
  START(pA0, pA1);
  _Pragma("unroll") for (int r = 0; r < 16; ++r) pA1[r] = __builtin_amdgcn_exp2f(pA1[r]);
  WAIT_BAR(0);
  DMA_K(3, 0); DMA_V(1, SLOTB);
  ROT();
  kload8(kf, kp0 + sl_cur);
  WAIT_BAR(2);
  s16x4 vlo[8], vhi[8]; u32x4 pw0, pw1, pw2, pw3;
#define PKW(P, B) cvtpk_s(P[B], P[B + 1])
#define PAF(k) __builtin_bit_cast(bf16x8, pw##k)
#define VFR(i) (bf16x8){vlo[i][0], vlo[i][1], vlo[i][2], vlo[i][3], vhi[i][0], vhi[i][1], vhi[i][2], vhi[i][3]}
#define PIN(x) asm volatile("" : "+v"(x))
#define MX3(a, b, c) __builtin_fmaxf(__builtin_fmaxf((a), (b)), (c))
#define GAPA(MF, A0, A1, A2, A3, W0, W1, PW) do { MF; sacc += A0; sacc += A1; sacc += A2; sacc += A3; PIN(sacc); W0; W1; PIN(PW); SBAR(); } while (0)
#define EX(v) __builtin_amdgcn_exp2f(v)
#define GAPB(MF, X, B) do { MF; X[B] = EX(X[B]); X[B + 1] = EX(X[B + 1]); X[B + 2] = EX(X[B + 2]); X[B + 3] = EX(X[B + 3]); PIN(X); SBAR(); } while (0)
#define VRD(i) do { vlo[i] = vtr(vp_ + (((i) >> 2) * 4096 + ((i) & 3) * 1024)); vhi[i] = vtr(vp_ + (((i) >> 2) * 4096 + ((i) & 3) * 1024 + 512)); } while (0)
#define KRD(G, j) do { if (G) { kload2(kf, kp0 + sl_next, j); SBAR(); } } while (0)
#define STEP(C0, C1, P0, P1, t, GK, GV, GL) do { SBAR(); \
    const lds_cptr vp_ = vp0 + sl_prev; \
    VRD(0); SBAR(); float sacc = (P0[0] + P0[1]); \
    GAPA(C0 = __builtin_amdgcn_mfma_f32_32x32x16_bf16(kf[0], qr[0], zacc, 0, 0, 0), P0[2], P0[3], P0[4], P0[5],     pw0[0] = PKW(P0, 0), pw0[1] = PKW(P0, 2), pw0); \
    VRD(4); SBAR(); GAPA(C1 = __builtin_amdgcn_mfma_f32_32x32x16_bf16(kf[1], qr[0], zacc, 0, 0, 0), P0[6], P0[7], P0[8], P0[9],     pw0[2] = PKW(P0, 4), pw0[3] = PKW(P0, 6), pw0); \
    VRD(1); SBAR(); GAPA(C0 = __builtin_amdgcn_mfma_f32_32x32x16_bf16(kf[2], qr[1], C0, 0, 0, 0),   P0[10], P0[11], P0[12], P0[13], pw1[0] = PKW(P0, 8), pw1[1] = PKW(P0, 10), pw1); \
    VRD(5); SBAR(); GAPA(C1 = __builtin_amdgcn_mfma_f32_32x32x16_bf16(kf[3], qr[1], C1, 0, 0, 0),   P0[14], P0[15], P1[0], P1[1],   pw1[2] = PKW(P0, 12), pw1[3] = PKW(P0, 14), pw1); \
    VRD(2); SBAR(); GAPA(C0 = __builtin_amdgcn_mfma_f32_32x32x16_bf16(kf[4], qr[2], C0, 0, 0, 0),   P1[2], P1[3], P1[4], P1[5],     pw2[0] = PKW(P1, 0), pw2[1] = PKW(P1, 2), pw2); \
    VRD(6); SBAR(); GAPA(C1 = __builtin_amdgcn_mfma_f32_32x32x16_bf16(kf[5], qr[2], C1, 0, 0, 0),   P1[6], P1[7], P1[8], P1[9],     pw2[2] = PKW(P1, 4), pw2[3] = PKW(P1, 6), pw2); \
    VRD(3); SBAR(); GAPA(C0 = __builtin_amdgcn_mfma_f32_32x32x16_bf16(kf[6], qr[3], C0, 0, 0, 0),   P1[10], P1[11], P1[12], P1[13], pw3[0] = PKW(P1, 8), pw3[1] = PKW(P1, 10), pw3); \
    VRD(7); SBAR(); GAPA(C1 = __builtin_amdgcn_mfma_f32_32x32x16_bf16(kf[7], qr[3], C1, 0, 0, 0),   P1[14], P1[15], 0.f, 0.f,       pw3[2] = PKW(P1, 12), pw3[3] = PKW(P1, 14), pw3); \
    l_reg += sacc; \
    if (GK) { DMA_K((t) + 3, sl_cur); } if (GV) { DMA_V((t) + 1, sl_next); } \
    if (MODE == 1) { _Pragma("unroll") for (int r = 0; r < 16; ++r) { C0[r] -= mhat; C1[r] -= mhat; } } \
    CMASK(C0, C1, t); \
    { float a = MX3(C0[0], C0[1], C1[0]), b = MX3(C0[2], C0[3], C1[1]); a = MX3(a, C1[2], C1[3]); \
      _Pragma("unroll") for (int r = 4; r < 16; r += 4) { a = MX3(a, C0[r], C0[r + 1]); b = MX3(b, C0[r + 2], C0[r + 3]); a = MX3(a, C1[r], C1[r + 1]); b = MX3(b, C1[r + 2], C1[r + 3]); } \
      float rm = __builtin_fmaxf(a, b); { auto rr = __builtin_amdgcn_permlane32_swap(__float_as_uint(rm), __float_as_uint(rm), false, false); rm = __builtin_fmaxf(__uint_as_float(rr[0]), __uint_as_float(rr[1])); } \
      resc = false; \
      if (__builtin_expect(__any(rm > (float)THRL), 0)) { const float dl = __builtin_fmaxf(rm, 0.f); mhat += dl; \
        _Pragma("unroll") for (int r = 0; r < 16; ++r) { C0[r] -= dl; C1[r] -= dl; } \
        if (MODE == 0) { _Pragma("unroll") for (int r = 0; r < 16; ++r) zacc[r] = -mhat; asm volatile("" : "+v"(zacc)); } \
        const float f = __builtin_amdgcn_exp2f(-dl); l_reg *= f; if (hi == 0) wsf[r32] = f; resc = true; } } \
    SBAR(); \
    GAPB(o[0] = __builtin_amdgcn_mfma_f32_32x32x16_bf16(PAF(0), VFR(0), o[0], 0, 0, 0), C0, 0); \
    GAPB(o[1] = __builtin_amdgcn_mfma_f32_32x32x16_bf16(PAF(0), VFR(4), o[1], 0, 0, 0), C0, 4); \
    KRD(GL, 0); GAPB(o[0] = __builtin_amdgcn_mfma_f32_32x32x16_bf16(PAF(1), VFR(1), o[0], 0, 0, 0), C0, 8); \
    KRD(GL, 1); GAPB(o[1] = __builtin_amdgcn_mfma_f32_32x32x16_bf16(PAF(1), VFR(5), o[1], 0, 0, 0), C0, 12); \
    KRD(GL, 2); GAPB(o[0] = __builtin_amdgcn_mfma_f32_32x32x16_bf16(PAF(2), VFR(2), o[0], 0, 0, 0), C1, 0); \
    KRD(GL, 3); GAPB(o[1] = __builtin_amdgcn_mfma_f32_32x32x16_bf16(PAF(2), VFR(6), o[1], 0, 0, 0), C1, 4); \
    GAPB(o[0] = __builtin_amdgcn_mfma_f32_32x32x16_bf16(PAF(3), VFR(3), o[0], 0, 0, 0), C1, 8); \
    GAPB(o[1] = __builtin_amdgcn_mfma_f32_32x32x16_bf16(PAF(3), VFR(7), o[1], 0, 0, 0), C1, 12); \
    } while (0)
  int t = 1;
  for (; t + 5 < NT; t += 2) {
    STEP(pB0, pB1, pA0, pA1, t, true, true, true);     WAIT_BAR(2); RESC(); ROT();
    STEP(pA0, pA1, pB0, pB1, t + 1, true, true, true); WAIT_BAR(2); RESC(); ROT();
  }
#define ENDW(tt) do { if ((tt) + 3 < NT) { WAIT_BAR(2); } else if ((tt) + 2 < NT) { WAIT_BAR(1); } else { WAIT_BAR(0); } } while (0)
  for (; t + 1 < NT; t += 2) {
    STEP(pB0, pB1, pA0, pA1, t, (t + 3 < NT), (t + 1 < NT), (t + 1 < NT));         ENDW(t);     RESC(); ROT();
    STEP(pA0, pA1, pB0, pB1, t + 1, (t + 4 < NT), (t + 2 < NT), (t + 2 < NT));     ENDW(t + 1); RESC(); ROT();
  }
  STEP(pB0, pB1, pA0, pA1, NT - 1, false, false, false); RESC();
  { float sacc = pB0[0] + pB0[1]; _Pragma("unroll") for (int r = 2; r < 16; ++r) sacc += pB0[r]; _Pragma("unroll") for (int r = 0; r < 16; ++r) sacc += pB1[r]; l_reg += sacc;
    pw0 = (u32x4){PKW(pB0, 0), PKW(pB0, 2), PKW(pB0, 4), PKW(pB0, 6)}; pw1 = (u32x4){PKW(pB0, 8), PKW(pB0, 10), PKW(pB0, 12), PKW(pB0, 14)}; pw2 = (u32x4){PKW(pB1, 0), PKW(pB1, 2), PKW(pB1, 4), PKW(pB1, 6)}; pw3 = (u32x4){PKW(pB1, 8), PKW(pB1, 10), PKW(pB1, 12), PKW(pB1, 14)};
    SBAR(); pv(o, vb0 + sl_cur, PAF(0), PAF(1), PAF(2), PAF(3)); }
#undef PKW
#undef PAF
#undef VFR
#undef PIN
#undef MX3
#undef GAPA
#undef GAPB
#undef EX
#undef VRD
#undef KRD
#undef STEP
#undef ENDW
  { auto rr = __builtin_amdgcn_permlane32_swap(__float_as_uint(l_reg), __float_as_uint(l_reg), false, false); l_reg = __uint_as_float(rr[0]) + __uint_as_float(rr[1]); }
  if (hi == 0) wsf[32 + r32] = l_reg; asm volatile("s_waitcnt lgkmcnt(0)" ::: "memory");
  float rli[16];
#pragma unroll
  for (int r = 0; r < 16; ++r) rli[r] = __builtin_amdgcn_rcpf(wsf[32 + crow(r, hi)]);
  bf16_t* Ow = Ow0 + (long)(wid * QBLK) * OP;
  { __hip_bfloat16* stg = (__hip_bfloat16*)(shm + LDS_OST) + wid * 2048;
#pragma unroll
    for (int r = 0; r < 16; ++r) { const int orow = crow(r, hi);
#pragma unroll
      for (int d0 = 0; d0 < 2; ++d0) stg[orow * 64 + d0 * 32 + r32] = __float2bfloat16(o[d0][r] * rli[r]); }
    asm volatile("s_waitcnt lgkmcnt(0)" ::: "memory");
#pragma unroll
    for (int i = 0; i < 4; ++i) { const int row = i * 8 + (lane >> 3), ch = lane & 7; const u32x4 v = *(const u32x4*)(stg + row * 64 + ch * 8); *(u32x4*)(Ow + (long)row * OP + ch * 8) = v; } }
  asm volatile("s_waitcnt lgkmcnt(0)\n\ts_barrier" ::: "memory");
#undef DMA_K
#undef DMA_V
#undef TROW
#undef CMASK
#undef START
#undef RESC
#undef ROT
}
#undef SBAR
#undef WAIT_BAR
}

struct Args {
  const float* in[33];
  float* out; unsigned char* ws;
  int ph_lo, ph_hi;
};
enum { I_X = 0, I_C, I_CTX, I_CCTX, I_ADAW, I_ADAB, I_NMIXPRE, I_NMIXPOST, I_NFFNPRE, I_NFFNPOST, I_WIN, I_CONVA, I_NABIAS, I_QNORM, I_KNORM,
       I_MU, I_W0, I_W2, I_A0, I_A2, I_KK, I_KA, I_RK, I_G2, I_LNW, I_LNB, I_WBR, I_WGATE, I_BGATE, I_WO, I_FUP, I_FCONV, I_FDN };

DI void transpose_item(const float* W, int N, bf16_t* WT, int ld, int koff, int mode, LAS float* scr, int item, int lane) {
  const int nblk = N / 32, kb = item / nblk, nb = item % nblk, k0 = 64 * kb, n0 = 32 * nb;
#pragma unroll 8
  for (int i = 0; i < 32; ++i) { const int kk = 2 * i + (lane >> 5); scr[kk * 33 + (lane & 31)] = W[(size_t)(k0 + kk) * N + n0 + (lane & 31)]; }
  asm volatile("s_waitcnt lgkmcnt(0)" ::: "memory");
  const int c = lane & 7;
#pragma unroll
  for (int j = 0; j < 4; ++j) { const int n = (lane >> 3) + 8 * j; const LAS float* s = scr + (8 * c) * 33 + n;
    int nn = n0 + n;
    if (mode == 1) nn = (nn < DFF) ? (256 * (nn >> 7) + (nn & 127)) : (256 * ((nn - DFF) >> 7) + 128 + ((nn - DFF) & 127));
    if (mode == 2) { const int i = nn >> 10, cc = nn & 1023, c64 = cc & 63;
      nn = ((cc >> 6) * 256) + 128 * (i >> 1) + 32 * (c64 >> 4) + 8 * ((c64 >> 2) & 3) + 4 * (i & 1) + (c64 & 3); }
    u32x4 o; o.x = cvtpk(s[0 * 33], s[1 * 33]); o.y = cvtpk(s[2 * 33], s[3 * 33]); o.z = cvtpk(s[4 * 33], s[5 * 33]); o.w = cvtpk(s[6 * 33], s[7 * 33]);
    *(u32x4*)(WT + (size_t)nn * ld + koff + k0 + 8 * c) = o; }
  asm volatile("s_waitcnt lgkmcnt(0)" ::: "memory");
}
DI void convert_weights(const CAS4 Args& A, int l, LAS unsigned char* lds, int gw, int NGW, int wave, int lane) {
  LAS float* scr = (LAS float*)(lds + wave * 8704);
  unsigned char* wb = A.ws + WS_W;
  constexpr int I_IN_ = 16 * 96, I_G = 16 * 128, I_B = 4 * 4 * 32, I_O_ = 16 * 32, I_U = 16 * 176, I_D = 44 * 32;
  constexpr int NIT = I_IN_ + I_G + I_B + I_O_ + I_U + I_D;
  for (int it = gw; it < NIT; it += NGW) {
    int r = it;
    if (r < I_IN_) { transpose_item(A.in[I_WIN] + (size_t)l * 1024 * 3072, 3072, (bf16_t*)(wb + W_IN), 1024, 0, 0, scr, r, lane); continue; } r -= I_IN_;
    if (r < I_G) { transpose_item(A.in[I_WGATE] + (size_t)l * 1024 * 4096, 4096, (bf16_t*)(wb + W_GATE), 1024, 0, 2, scr, r, lane); continue; } r -= I_G;
    if (r < I_B) { const int br = r / 128; transpose_item(A.in[I_WBR] + ((size_t)l * 4 + br) * 256 * 1024, 1024, (bf16_t*)(wb + W_BR), 1024, br * 256, 0, scr, r % 128, lane); continue; } r -= I_B;
    if (r < I_O_) { transpose_item(A.in[I_WO] + (size_t)l * 1024 * 1024, 1024, (bf16_t*)(wb + W_O), 1024, 0, 0, scr, r, lane); continue; } r -= I_O_;
    if (r < I_U) { transpose_item(A.in[I_FUP] + (size_t)l * 1024 * 5632, 5632, (bf16_t*)(wb + W_UP), 1024, 0, 1, scr, r, lane); continue; } r -= I_U;
    transpose_item(A.in[I_FDN] + (size_t)l * 2816 * 1024, 1024, (bf16_t*)(wb + W_DN), 2816, 0, 0, scr, r, lane);
  }
}

DI void row_phase(const float* xold, float* xdst, const bf16_t* src, const float* gate, const float* gpost,
                  bf16_t* hout, const float* gnext, const float* sh, const float* sc, int lane) {
  f32x4 v[4];
#pragma unroll
  for (int j = 0; j < 4; ++j) v[j] = ((const f32x4*)xold)[lane + 64 * j];
  if (src) {
    f32x4 s[4]; float ss = 0.f;
#pragma unroll
    for (int j = 0; j < 4; ++j) { const uint2 w = ((const uint2*)src)[lane + 64 * j];
      s[j] = (f32x4){__uint_as_float(w.x << 16), __uint_as_float(w.x & 0xffff0000u), __uint_as_float(w.y << 16), __uint_as_float(w.y & 0xffff0000u)};
      ss += (s[j].x * s[j].x + s[j].y * s[j].y) + (s[j].z * s[j].z + s[j].w * s[j].w); }
    const float rs = __builtin_amdgcn_rsqf(wave_sum(ss, lane) * (1.f / 1024.f) + 1e-6f);
#pragma unroll
    for (int j = 0; j < 4; ++j) { const f32x4 g = ((const f32x4*)gate)[lane + 64 * j], p = ((const f32x4*)gpost)[lane + 64 * j];
      v[j] = v[j] + g * (s[j] * rs * p); ((f32x4*)xdst)[lane + 64 * j] = v[j]; }
  }
  if (hout) {
    float ss = 0.f;
#pragma unroll
    for (int j = 0; j < 4; ++j) ss += (v[j].x * v[j].x + v[j].y * v[j].y) + (v[j].z * v[j].z + v[j].w * v[j].w);
    const float rs = __builtin_amdgcn_rsqf(wave_sum(ss, lane) * (1.f / 1024.f) + 1e-6f);
#pragma unroll
    for (int j = 0; j < 4; ++j) { const f32x4 g = ((const f32x4*)gnext)[lane + 64 * j], a = ((const f32x4*)sh)[lane + 64 * j], b = ((const f32x4*)sc)[lane + 64 * j];
      const f32x4 h = (v[j] * rs * g) * (b + 1.f) + a;
      uint2 w; w.x = cvtpk(h.x, h.y); w.y = cvtpk(h.z, h.w); ((uint2*)hout)[lane + 64 * j] = w; }
  }
}

DI void row_phase_blk(const float* xlat_in, const float* xctx_in, float* xlat_out, float* xctx_out, const bf16_t* srcb,
                      const float* modl, int gate_off, const float* gpost, bf16_t* hb, const float* gnext, const float* modn, int sh_off, int sc_off,
                      int bx, int wave, int lane) {
  const int R0 = bx * 130;
  f32x4 gpv[4], gnv[4], gav[4], shv[4], scv[4];
#pragma unroll
  for (int j = 0; j < 4; ++j) { gpv[j] = ((const f32x4*)gpost)[lane + 64 * j]; gnv[j] = hb ? ((const f32x4*)gnext)[lane + 64 * j] : (f32x4){0.f, 0.f, 0.f, 0.f}; }
  int cur_s = -1;
  f32x4 xv[4], xn[4]; uint2 sv[4], sn[4];
  int row = R0 + wave;
  { const float* xo = (row < NLAT) ? xlat_in + (size_t)row * 1024 : xctx_in + (size_t)(row - NLAT) * 1024;
#pragma unroll
    for (int j = 0; j < 4; ++j) { xv[j] = ((const f32x4*)xo)[lane + 64 * j]; sv[j] = ((const uint2*)(srcb + (size_t)row * 1024))[lane + 64 * j]; } }
  for (; row < R0 + 130; row += 8) {
    const int nrow = row + 8; const bool hn = nrow < R0 + 130;
    if (hn) { const float* xo = (nrow < NLAT) ? xlat_in + (size_t)nrow * 1024 : xctx_in + (size_t)(nrow - NLAT) * 1024;
#pragma unroll
      for (int j = 0; j < 4; ++j) { xn[j] = ((const f32x4*)xo)[lane + 64 * j]; sn[j] = ((const uint2*)(srcb + (size_t)nrow * 1024))[lane + 64 * j]; } }
    const int s = (row < NLAT) ? (row >> 14) : 2;
    if (s != cur_s) { cur_s = s; const float* md = modl + (size_t)s * 6144; const float* mn = modn + (size_t)s * 6144;
#pragma unroll
      for (int j = 0; j < 4; ++j) { gav[j] = ((const f32x4*)(md + gate_off))[lane + 64 * j];
        shv[j] = hb ? ((const f32x4*)(mn + sh_off))[lane + 64 * j] : (f32x4){0.f, 0.f, 0.f, 0.f}; scv[j] = hb ? ((const f32x4*)(mn + sc_off))[lane + 64 * j] : (f32x4){0.f, 0.f, 0.f, 0.f}; } }
    f32x4 sf[4]; float ss = 0.f;
#pragma unroll
    for (int j = 0; j < 4; ++j) { const uint2 w = sv[j];
      sf[j] = (f32x4){__uint_as_float(w.x << 16), __uint_as_float(w.x & 0xffff0000u), __uint_as_float(w.y << 16), __uint_as_float(w.y & 0xffff0000u)};
      ss += (sf[j].x * sf[j].x + sf[j].y * sf[j].y) + (sf[j].z * sf[j].z + sf[j].w * sf[j].w); }
    const float rs = __builtin_amdgcn_rsqf(wave_sum(ss, lane) * (1.f / 1024.f) + 1e-6f);
    float* xd = (row < NLAT) ? xlat_out + (size_t)row * 1024 : xctx_out + (size_t)(row - NLAT) * 1024;
    float s2 = 0.f;
#pragma unroll
    for (int j = 0; j < 4; ++j) { xv[j] = xv[j] + gav[j] * (sf[j] * rs * gpv[j]); ((f32x4*)xd)[lane + 64 * j] = xv[j];
      s2 += (xv[j].x * xv[j].x + xv[j].y * xv[j].y) + (xv[j].z * xv[j].z + xv[j].w * xv[j].w); }
    if (hb) {
      const float r2 = __builtin_amdgcn_rsqf(wave_sum(s2, lane) * (1.f / 1024.f) + 1e-6f);
#pragma unroll
      for (int j = 0; j < 4; ++j) { const f32x4 h = (xv[j] * r2 * gnv[j]) * (scv[j] + 1.f) + shv[j];
        uint2 w; w.x = cvtpk(h.x, h.y); w.y = cvtpk(h.z, h.w); ((uint2*)(hb + (size_t)row * 1024))[lane + 64 * j] = w; }
    }
#pragma unroll
    for (int j = 0; j < 4; ++j) { xv[j] = xn[j]; sv[j] = sn[j]; }
  }
}

__global__ void __launch_bounds__(NTHREADS, 2) fwd_megakernel(Args A_) {
  extern __shared__ __attribute__((aligned(16))) unsigned char lds_raw[];
  LAS unsigned char* lds = (LAS unsigned char*)lds_raw;
  const int wave0_ = __builtin_amdgcn_readfirstlane((int)threadIdx.x >> 6);
  const int G = gridDim.x, bx = blockIdx.x;
  const int NGW = G * 8;
  const int lo = A_.ph_lo, hi = A_.ph_hi;
  if (hi < 0) cg::this_grid().sync();
  int ph = 0, nbar_ = 0;
#ifndef NBARX
#define NBARX 1
#endif
#ifndef SKIPMASK
#define SKIPMASK 0
#endif
#ifndef REPMASK
#define REPMASK 0
#endif
#define PHASE_BEGIN(id) if (ph >= lo && ph < hi && !((SKIPMASK >> (id)) & 1)) for (int rep_ = 0; rep_ < ((((REPMASK) >> (id)) & 1) ? 2 : 1); ++rep_) { const CAS4 Args* Ap_ = (const CAS4 Args*)__builtin_amdgcn_kernarg_segment_ptr(); asm volatile("" : "+s"(Ap_)); const CAS4 Args& A = *Ap_; \
  unsigned char* ws = A.ws; unsigned* ctl = (unsigned*)(ws + WS_CTL); float* MOD = (float*)(ws + WS_MOD); float* XC = (float*)(ws + WS_XC); float* BONUS = (float*)(ws + WS_BONUS); \
  bf16_t* H = (bf16_t*)(ws + WS_H); bf16_t* Z = (bf16_t*)(ws + WS_Z); bf16_t* YS = (bf16_t*)(ws + WS_YS); bf16_t* WAE = (bf16_t*)(ws + WS_WA); bf16_t* WAA = WAE + (size_t)2 * NROW * 256; float* YSC = (float*)(ws + WS_YSC); \
  (void)ctl; (void)MOD; (void)XC; (void)BONUS; (void)H; (void)Z; (void)YS; (void)WAE; (void)WAA; (void)YSC; \
  int tid; asm volatile("v_mbcnt_lo_u32_b32 %0, -1, 0\n\tv_mbcnt_hi_u32_b32 %0, -1, %0" : "=v"(tid)); tid += wave0_ * 64; const int lane = tid & 63, wave = __builtin_amdgcn_readfirstlane(tid >> 6); const int gw = bx * 8 + wave; (void)lane; (void)gw;
#define FRESH_TID(v) int v; asm volatile("v_mbcnt_lo_u32_b32 %0, -1, 0\n\tv_mbcnt_hi_u32_b32 %0, -1, %0" : "=v"(v)); v += wave0_ * 64;
#define PHASE_END } if (ph >= lo && ph + 1 < hi) { FRESH_TID(tb_) const CAS4 Args* Ab_ = (const CAS4 Args*)__builtin_amdgcn_kernarg_segment_ptr(); asm volatile("" : "+s"(Ab_)); for (int bi_ = 0; bi_ < NBARX; ++bi_) { ++nbar_; grid_barrier((unsigned*)(Ab_->ws + WS_CTL), (unsigned)nbar_ * (unsigned)G, tb_); } } ++ph;

  PHASE_BEGIN(0)
    {
      LAS float* sl = (LAS float*)(lds + 72 * 1024);
      for (int i = tid; i < 3 * 1024; i += NTHREADS) { const int s = i >> 10, k = i & 1023;
        const float c = (s < 2) ? A.in[I_C][s * 1024 + k] : A.in[I_CCTX][k]; sl[i] = c * sigmoidf_(c); }
      __syncthreads();
      LAS float* red = (LAS float*)(lds + 88 * 1024);
      for (int it = bx; it < NLAYER * 96; it += G) {
        const int l = it / 96, c0 = (it % 96) * 64;
        const float* wp = A.in[I_ADAW] + (size_t)l * 1024 * 6144 + c0 + lane;
        float a0 = 0.f, a1 = 0.f, a2 = 0.f;
        for (int k = wave * 128; k < wave * 128 + 128; ++k) { const float w = wp[(size_t)k * 6144]; a0 += sl[k] * w; a1 += sl[1024 + k] * w; a2 += sl[2048 + k] * w; }
        red[(wave * 3 + 0) * 64 + lane] = a0; red[(wave * 3 + 1) * 64 + lane] = a1; red[(wave * 3 + 2) * 64 + lane] = a2;
        __syncthreads();
        if (tid < 192) { const int s = tid >> 6, ln = tid & 63; float r = A.in[I_ADAB][l * 6144 + c0 + ln];
          for (int w = 0; w < 8; ++w) r += red[(w * 3 + s) * 64 + ln];
          MOD[((size_t)(l * 3 + s)) * 6144 + c0 + ln] = r; }
        __syncthreads();
      }
    }
    convert_weights(A, 0, lds, gw, NGW, wave, lane);
  PHASE_END

  PHASE_BEGIN(1)
    for (int row = gw; row < NROW; row += NGW) {
      const int s = (row < NLAT) ? (row >> 14) : 2;
      const float* xo = (row < NLAT) ? A.in[I_X] + (size_t)row * 1024 : A.in[I_CTX] + (size_t)(row - NLAT) * 1024;
      const float* md = MOD + (size_t)(0 * 3 + s) * 6144;
      row_phase(xo, nullptr, nullptr, nullptr, nullptr, H + (size_t)row * 1024, A.in[I_NMIXPRE], md, md + 1024, lane);
    }
  PHASE_END

  for (int l = 0; l < NLAYER; ++l) {
    PHASE_BEGIN(2)
      pg8::Gemm g{(const char*)ws, 1024, 1024};
      pg8::SchedPlain S{130, 5, G, bx, 16, (long)WS_H, (long)(WS_W + W_IN), 1024, 1024, 7};
      pg8::EpiStore E{Z, DIN};
      pg8::gemm_phase<pg8::EpiStore, pg8::SchedPlain, false>(lds, g, S, E, tid);
    PHASE_END

    PHASE_BEGIN(3)
      {
        FRESH_TID(tid)
        const int ln = tid & 63, wv = __builtin_amdgcn_readfirstlane(tid >> 6), d = wv >> 2, nq = wv & 3, r32 = ln & 31, hi = ln >> 5;
        LAS unsigned char* AT = lds;
        const float* mu = A.in[I_MU] + (size_t)l * 2 * 896;
        bf16x8 Bf[2][2][4]; float bias0[2], bias1[2];
#pragma unroll
        for (int nt = 0; nt < 2; ++nt) {
          const int c = 64 * nq + 32 * nt + r32;
          bias0[nt] = A.in[I_W0][(l * 2 + d) * 256 + c]; bias1[nt] = A.in[I_A0][(l * 2 + d) * 256 + c];
#pragma unroll
          for (int ks = 0; ks < 4; ++ks) { float f0[8], f1[8];
#pragma unroll
            for (int i = 0; i < 8; ++i) { const size_t o = ((size_t)(l * 2 + d) * 64 + 16 * ks + 8 * hi + i) * 256 + c; f0[i] = A.in[I_W2][o]; f1[i] = A.in[I_A2][o]; }
            Bf[0][nt][ks] = __builtin_bit_cast(bf16x8, pack8(f0)); Bf[1][nt][ks] = __builtin_bit_cast(bf16x8, pack8(f1)); }
        }
        for (int tile = bx; tile < 520; tile += G) {
          const int R0 = tile * 64;
          __syncthreads();
          for (int i = tid; i < 2 * 64 * 16; i += NTHREADS) {
            const int dd = i >> 10, rem = i & 1023, r = rem >> 4, j8 = (rem & 15) * 8, row = R0 + r; int t, len; row_seq(row, t, len);
            const int nb = dd ? t + 1 : t - 1; const bool nv = (nb >= 0) && (nb < len);
            float zc[8], zn[8];
            unpack8(*(const u32x4*)(Z + (size_t)row * DIN + C_LW + j8), zc);
            if (nv) unpack8(*(const u32x4*)(Z + (size_t)(row + (dd ? 1 : -1)) * DIN + C_LW + j8), zn);
            else {
#pragma unroll
              for (int e = 0; e < 8; ++e) zn[e] = 0.f; }
            const f32x4 m0 = *(const f32x4*)(mu + dd * 896 + 768 + j8), m1 = *(const f32x4*)(mu + dd * 896 + 768 + j8 + 4);
            float v[8];
#pragma unroll
            for (int e = 0; e < 8; ++e) { v[e] = zc[e] + (e < 4 ? m0[e] : m1[e - 4]) * (zn[e] - zc[e]); if (j8 < 64) v[e] = 1.f - 2.f * __builtin_amdgcn_rcpf(__builtin_amdgcn_exp2f(2.8853900817779268f * v[e]) + 1.f); }
            *(LAS u32x4*)(AT + ((dd * 2 + (j8 >> 6)) * 64 + r) * 144 + (j8 & 63) * 2) = pack8(v);
          }
          __syncthreads();
          f32x16 acc[2][2][2];
#pragma unroll
          for (int m = 0; m < 2; ++m)
#pragma unroll
            for (int mt = 0; mt < 2; ++mt)
#pragma unroll
              for (int nt = 0; nt < 2; ++nt) acc[m][mt][nt] = f32x16{};
#pragma unroll
          for (int m = 0; m < 2; ++m)
#pragma unroll
            for (int mt = 0; mt < 2; ++mt)
#pragma unroll
              for (int ks = 0; ks < 4; ++ks) {
                const bf16x8 af = *(const LAS bf16x8*)(AT + ((d * 2 + m) * 64 + 32 * mt + r32) * 144 + (16 * ks + 8 * hi) * 2);
#pragma unroll
                for (int nt = 0; nt < 2; ++nt) acc[m][mt][nt] = __builtin_amdgcn_mfma_f32_32x32x16_bf16(af, Bf[m][nt][ks], acc[m][mt][nt], 0, 0, 0);
              }
#pragma unroll
          for (int mt = 0; mt < 2; ++mt)
#pragma unroll
            for (int nt = 0; nt < 2; ++nt) {
              const int c = 64 * nq + 32 * nt + r32;
#pragma unroll
              for (int r = 0; r < 16; ++r) {
                const int row = R0 + 32 * mt + (r & 3) + 8 * (r >> 2) + 4 * hi;
                const float aw = acc[0][mt][nt][r] + bias0[nt], aa = acc[1][mt][nt][r] + bias1[nt];
                const float xx = -aw; const float sp = fmaxf(xx, 0.f) + __logf(1.f + __expf(-fabsf(xx)));
                const float e = -__expf(-sp - 0.5f);
                const float av = sigmoidf_(aa);
                const size_t o = ((size_t)d * NROW + row) * 256 + c;
                WAE[o] = (bf16_t)(cvtpk(e, 0.f) & 0xffffu); WAA[o] = (bf16_t)(cvtpk(av, 0.f) & 0xffffu);
              }
            }
        }
        __syncthreads();
      }
    PHASE_END

    PHASE_BEGIN(4)
#ifndef NO_SCAN
#ifndef REP_SCAN
#define REP_SCAN 1
#endif
#ifndef REP_ATTN
#define REP_ATTN 1
#endif
      if (bx < 64 && (rep_ == 0 || REP_SCAN)) {
        const int sb = bx, s = sb >> 2, qd = sb & 3, d = s >> 3, b = (s >> 2) & 1, hh = s & 3;
        LAS float* buf = (LAS float*)lds;
        float muR[8], muK[8], muV[8], kkc[8], kac[8], rkc[8];
        const int ptid = tid & 255, ts = (ptid >> 3) & 31, cgp = ptid & 7, ch0 = hh * 64 + 8 * cgp;
        {
#pragma unroll
          for (int i = 0; i < 8; ++i) { const float* mu = A.in[I_MU] + (size_t)(l * 2 + d) * 896;
            muR[i] = mu[ch0 + i]; muK[i] = mu[256 + ch0 + i]; muV[i] = mu[512 + ch0 + i];
            kkc[i] = A.in[I_KK][l * 256 + ch0 + i]; kac[i] = A.in[I_KA][l * 256 + ch0 + i]; rkc[i] = A.in[I_RK][l * 256 + ch0 + i]; }
        }
        const int rsub = lane >> 4, kg = lane & 15, vrow = 16 * qd + 4 * (wave & 3) + rsub;
#define SCAN_RLO(cc) (((cc) < 8) ? (NLAT + b * CTXL + (d ? 224 - 32 * (cc) : 32 * (cc))) : (b * TLAT + (d ? 16352 - 32 * ((cc) - 8) : 32 * ((cc) - 8))))
        const unsigned ro = (unsigned)(d ? 31 - ts : ts);
        const unsigned offz = ro * DIN + ch0, offw = ro * 256 + ch0;
        const unsigned roy = (unsigned)(d ? 31 - (ptid >> 3) : (ptid >> 3)), offy = roy * 256 + hh * 64 + 16 * qd + (ptid & 7) * 2;
#define SCAN_LOAD(cc, X) do { const int rlo_ = SCAN_RLO(cc); const bool nv = !((((cc) == 0) || ((cc) == 8)) && ts == 0); \
          const bf16_t* zb = Z + (size_t)rlo_ * DIN; const bf16_t* znb = zb + (d ? DIN : -DIN); const u32x4 z4 = (u32x4){0u, 0u, 0u, 0u}; \
          X[0] = *(const u32x4*)(zb + (offz + C_RR)); X[1] = *(const u32x4*)(zb + (offz + C_RK)); X[2] = *(const u32x4*)(zb + (offz + C_RV)); \
          X[3] = nv ? *(const u32x4*)(znb + (offz + C_RR)) : z4; X[4] = nv ? *(const u32x4*)(znb + (offz + C_RK)) : z4; X[5] = nv ? *(const u32x4*)(znb + (offz + C_RV)) : z4; \
          const bf16_t* wb_ = WAE + ((size_t)d * NROW + rlo_) * 256; const bf16_t* ab_ = WAA + ((size_t)d * NROW + rlo_) * 256; \
          X[6] = *(const u32x4*)(wb_ + offw); X[7] = *(const u32x4*)(ab_ + offw); } while (0)
#define SCAN_PREP(cc, X) do { const int rlo_ = SCAN_RLO(cc); \
          float r8[8], k8[8], v8[8], rn[8], kn[8], vn[8], e8[8], a8[8]; \
          unpack8(X[0], r8); unpack8(X[1], k8); unpack8(X[2], v8); unpack8(X[3], rn); unpack8(X[4], kn); unpack8(X[5], vn); unpack8(X[6], e8); unpack8(X[7], a8); \
          float kkv[8], ssq = 0.f, bsum = 0.f; \
          _Pragma("unroll") for (int i = 0; i < 8; ++i) { r8[i] += muR[i] * (rn[i] - r8[i]); k8[i] += muK[i] * (kn[i] - k8[i]); v8[i] += muV[i] * (vn[i] - v8[i]); \
            kkv[i] = k8[i] * kkc[i]; ssq += kkv[i] * kkv[i]; } \
          ssq = red8(ssq); \
          const float inv = __builtin_amdgcn_rsqf(fmaxf(ssq, 1e-24f)); \
          float wv[8], bb[8], kp[8]; \
          _Pragma("unroll") for (int i = 0; i < 8; ++i) { kkv[i] *= inv; kp[i] = k8[i] * (1.f + (a8[i] - 1.f) * kac[i]); bb[i] = kkv[i] * a8[i]; wv[i] = __expf(e8[i]); bsum += r8[i] * kp[i] * rkc[i]; } \
          bsum = red8(bsum); \
          if (qd == 0 && cgp == 0) (BONUS + ((size_t)d * NROW + rlo_) * 4)[ro * 4 + hh] = bsum; \
          LAS float* db = buf + ((cc) & 1) * (6 * 32 * 64) + ts * 64 + 8 * cgp; \
          *(LAS f32x4*)(db + 0 * 2048) = (f32x4){wv[0], wv[1], wv[2], wv[3]}; *(LAS f32x4*)(db + 0 * 2048 + 4) = (f32x4){wv[4], wv[5], wv[6], wv[7]}; \
          *(LAS f32x4*)(db + 1 * 2048) = (f32x4){kkv[0], kkv[1], kkv[2], kkv[3]}; *(LAS f32x4*)(db + 1 * 2048 + 4) = (f32x4){kkv[4], kkv[5], kkv[6], kkv[7]}; \
          *(LAS f32x4*)(db + 2 * 2048) = (f32x4){bb[0], bb[1], bb[2], bb[3]}; *(LAS f32x4*)(db + 2 * 2048 + 4) = (f32x4){bb[4], bb[5], bb[6], bb[7]}; \
          *(LAS f32x4*)(db + 3 * 2048) = (f32x4){kp[0], kp[1], kp[2], kp[3]}; *(LAS f32x4*)(db + 3 * 2048 + 4) = (f32x4){kp[4], kp[5], kp[6], kp[7]}; \
          *(LAS f32x4*)(db + 4 * 2048) = (f32x4){r8[0], r8[1], r8[2], r8[3]}; *(LAS f32x4*)(db + 4 * 2048 + 4) = (f32x4){r8[4], r8[5], r8[6], r8[7]}; \
          *(LAS f32x4*)(db + 5 * 2048) = (f32x4){v8[0], v8[1], v8[2], v8[3]}; *(LAS f32x4*)(db + 5 * 2048 + 4) = (f32x4){v8[4], v8[5], v8[6], v8[7]}; \
        } while (0)
#define SCAN_YOUT(cc) do { const int rlo_ = SCAN_RLO(cc); const int step_ = ptid >> 3, r2_ = (ptid & 7) * 2; \
          const LAS f32x4* yp_ = (const LAS f32x4*)(ybuf + ((cc) & 1) * 2048 + step_ * 64 + r2_ * 4); const f32x4 y0_ = yp_[0], y1_ = yp_[1]; \
          const f32x2 yv = (f32x2){(y0_[0] + y0_[1]) + (y0_[2] + y0_[3]), (y1_[0] + y1_[1]) + (y1_[2] + y1_[3])}; \
          *(f32x2*)(YSC + ((size_t)d * NROW + rlo_) * 256 + offy) = yv; } while (0)
        LAS float* ybuf = buf + 2 * 6 * 32 * 64;
        u32x4 RA[8], RB[8];
        __syncthreads();
        SCAN_LOAD(0, RA);
        if (wave >= 4) SCAN_PREP(0, RA);
        SCAN_LOAD(1, RA);
#pragma unroll
        for (int i = 0; i < 8; ++i) RB[i] = RA[i];
        __syncthreads();
        f32x2 Sa = (f32x2){0.f, 0.f}, Sb = (f32x2){0.f, 0.f};
        for (int cc = 0; cc < 520; ++cc) {
          if (wave >= 4) {
            if (cc + 2 < 520) SCAN_LOAD(cc + 2, RB);
            if (cc + 1 < 520) SCAN_PREP(cc + 1, RA);
            if (cc > 0) SCAN_YOUT(cc - 1);
#pragma unroll
            for (int i = 0; i < 8; ++i) RA[i] = RB[i];
          } else {
            const LAS float* sbuf = buf + (cc & 1) * (6 * 32 * 64) + 4 * kg;
            LAS float* yb = ybuf + (cc & 1) * 2048 + (4 * wave + rsub) * 4 + (kg >> 2);
            f32x4 W4 = *(const LAS f32x4*)(sbuf + 0 * 2048), K4 = *(const LAS f32x4*)(sbuf + 1 * 2048), B4 = *(const LAS f32x4*)(sbuf + 2 * 2048),
                  P4 = *(const LAS f32x4*)(sbuf + 3 * 2048), R4 = *(const LAS f32x4*)(sbuf + 4 * 2048);
            float vv = sbuf[5 * 2048 - 4 * kg + vrow];
            f32x4 Rp = R4;
#pragma unroll
            for (int st = 0; st < 32; ++st) {
              const int sn = (st + 1) & 31;
              const LAS float* sp = sbuf + sn * 64;
              const f32x4 W4n = *(const LAS f32x4*)(sp + 0 * 2048), K4n = *(const LAS f32x4*)(sp + 1 * 2048), B4n = *(const LAS f32x4*)(sp + 2 * 2048),
                          P4n = *(const LAS f32x4*)(sp + 3 * 2048), R4n = *(const LAS f32x4*)(sp + 4 * 2048);
              const float vvn = sp[5 * 2048 - 4 * kg + vrow];
              f32x2 p = Sa * (f32x2){K4[0], K4[1]}; p = __builtin_elementwise_fma(Sb, (f32x2){K4[2], K4[3]}, p);
              float sa = p[0] + p[1];
              if (st > 0) {
                f32x2 q = Sa * (f32x2){Rp[0], Rp[1]}; q = __builtin_elementwise_fma(Sb, (f32x2){Rp[2], Rp[3]}, q);
                float yq = q[0] + q[1]; yq += DPPF(yq, 0xB1); yq += DPPF(yq, 0x4E);
                yb[(st - 1) * 64] = yq;
              }
              sa = allreduce16(sa);
              const f32x2 vv2 = (f32x2){vv, vv}, nsa = (f32x2){-sa, -sa};
              f32x2 ta = __builtin_elementwise_fma(nsa, (f32x2){B4[0], B4[1]}, vv2 * (f32x2){P4[0], P4[1]});
              f32x2 tb = __builtin_elementwise_fma(nsa, (f32x2){B4[2], B4[3]}, vv2 * (f32x2){P4[2], P4[3]});
              Sa = __builtin_elementwise_fma(Sa, (f32x2){W4[0], W4[1]}, ta);
              Sb = __builtin_elementwise_fma(Sb, (f32x2){W4[2], W4[3]}, tb);
              Rp = R4;
              W4 = W4n; K4 = K4n; B4 = B4n; P4 = P4n; R4 = R4n; vv = vvn;
            }
            { f32x2 q = Sa * (f32x2){Rp[0], Rp[1]}; q = __builtin_elementwise_fma(Sb, (f32x2){Rp[2], Rp[3]}, q);
              float yq = q[0] + q[1]; yq += DPPF(yq, 0xB1); yq += DPPF(yq, 0x4E);
              yb[31 * 64] = yq; }
          }
          __syncthreads();
        }
        if (wave >= 4) SCAN_YOUT(519);
        __syncthreads();
#undef SCAN_LOAD
#undef SCAN_YOUT
#undef SCAN_PREP
#undef SCAN_RLO
      }
#endif
#ifndef NO_ATTN
      if (bx >= 64) {
        {
          FRESH_TID(tid)
          pg8::Gemm g{(const char*)ws, 1024, 1024};
          pg8::SchedPlain S{130, 7, 192, bx - 64, 16, (long)WS_H, (long)(WS_W + W_IN), 1024, 1024, 0};
          pg8::EpiStore E{Z, DIN};
          pg8::gemm_phase<pg8::EpiStore, pg8::SchedPlain, false>(lds, g, S, E, tid);
        }
        { FRESH_TID(tb1_) grid_barrier(ctl + 16, 192u * (unsigned)(2 * l + 1), tb1_); }
      {
        const float* qn = A.in[I_QNORM] + l * 64; const float* kn = A.in[I_KNORM] + l * 64;
        for (long idx = (long)(bx - 64) * NTHREADS + tid; idx < (long)NROW * 48; idx += (long)192 * NTHREADS) {
          const int part = (int)(idx & 7), h6 = (int)((idx >> 3) % 6), row = (int)(idx / 48);
          bf16_t* p = Z + (size_t)row * DIN + C_GQ + 64 * h6 + 8 * part;
          float f[8]; unpack8(*(const u32x4*)p, f);
          float ss = 0.f;
#pragma unroll
          for (int i = 0; i < 8; ++i) ss += f[i] * f[i];
          ss = red8(ss);
          const float rs = __builtin_amdgcn_rsqf(ss * (1.f / 64.f) + 1e-6f);
          const bool isq = h6 < 4; const float* nw = isq ? qn : kn; const float scl = isq ? C2 : 1.f;
#pragma unroll
          for (int i = 0; i < 8; ++i) f[i] = f[i] * rs * nw[8 * part + i] * scl;
          if (row < NLAT) {
            const int t = row & (TLAT - 1); const float gr = (float)(t >> 6), gc = (float)(t & 63);
#pragma unroll
            for (int pp = 0; pp < 4; ++pp) { const int pi = 4 * part + pp;
              const float invf = exp2f(-(float)(pi & 15) * (13.287712379549449f / 16.f));
              const float ang = (pi < 16 ? gr : gc) * invf; const float cs = __cosf(ang), sn = __sinf(ang);
              const float x1 = f[2 * pp], x2 = f[2 * pp + 1]; f[2 * pp] = x1 * cs - x2 * sn; f[2 * pp + 1] = x1 * sn + x2 * cs; }
          }
          *(u32x4*)p = pack8(f);
        }
      }
      {
        FRESH_TID(tid)
        const float* cw = A.in[I_CONVA] + l * 3 * 256;
        for (long idx = (long)(bx - 64) * NTHREADS + tid; idx < (long)NROW * 32; idx += (long)192 * NTHREADS) {
          const int g8 = (int)(idx & 31), row = (int)(idx >> 5); int t, len; row_seq(row, t, len);
          const bf16_t* zr = Z + (size_t)row * DIN;
          { bf16_t* qp = Z + (size_t)row * DIN + C_NAQ + 8 * g8; float f[8]; unpack8(*(const u32x4*)qp, f);
#pragma unroll
            for (int i = 0; i < 8; ++i) f[i] *= C2;
            *(u32x4*)qp = pack8(f); }
          float bg[8], c0[8], x0[8], c1[8], x1[8], c2[8], x2[8];
          unpack8(*(const u32x4*)(zr + 8 * g8), bg);
          unpack8(*(const u32x4*)(zr + 256 + 8 * g8), c1); unpack8(*(const u32x4*)(zr + 512 + 8 * g8), x1);
          if (t > 0) { unpack8(*(const u32x4*)(zr - DIN + 256 + 8 * g8), c0); unpack8(*(const u32x4*)(zr - DIN + 512 + 8 * g8), x0); }
          else {
#pragma unroll
            for (int i = 0; i < 8; ++i) { c0[i] = 0.f; x0[i] = 0.f; } }
          if (t < len - 1) { unpack8(*(const u32x4*)(zr + DIN + 256 + 8 * g8), c2); unpack8(*(const u32x4*)(zr + DIN + 512 + 8 * g8), x2); }
          else {
#pragma unroll
            for (int i = 0; i < 8; ++i) { c2[i] = 0.f; x2[i] = 0.f; } }
          float o[8];
#pragma unroll
          for (int i = 0; i < 8; ++i) { const int c = 8 * g8 + i; o[i] = bg[i] * (cw[c] * (c0[i] * x0[i]) + cw[256 + c] * (c1[i] * x1[i]) + cw[512 + c] * (c2[i] * x2[i])); }
          *(u32x4*)(YS + (size_t)row * 1024 + 8 * g8) = pack8(o);
        }
      }
        { FRESH_TID(tb2_) grid_barrier(ctl + 16, 192u * (unsigned)(2 * l + 2), tb2_); }
      } else {
        FRESH_TID(tw_)
        if (tw_ == 0) { while (__hip_atomic_load(ctl + 16, __ATOMIC_RELAXED, __HIP_MEMORY_SCOPE_AGENT) < 192u * (unsigned)(2 * l + 2)) __builtin_amdgcn_s_sleep(2);
          __builtin_amdgcn_fence(__ATOMIC_ACQUIRE, "agent"); }
        __syncthreads();
      }
      if (rep_ == 0 || REP_ATTN) {
        FRESH_TID(tid)
        volatile LAS unsigned* misc = (volatile LAS unsigned*)(lds + 92 * 1024);
        const float* nab = A.in[I_NABIAS] + (size_t)l * 4 * 465;
        for (;;) {
          __syncthreads();
          if (tid == 0) misc[0] = atomicAdd(ctl + 64 + 64 * l + 32 * rep_, 1u);
          __syncthreads();
          int u = (int)misc[0];
          if (l == NLAYER - 1 && u >= 1024) u += 16;
          if (u >= 1296) break;
          if (u >= 1040) {
            LAS float* SG = (LAS float*)lds;
            const int R0 = (u - 1040) * 130;
            for (int i = tid; i < 130 * 16; i += NTHREADS) { const int r = i >> 4, j8 = (i & 15) * 8; float f[8];
              unpack8(*(const u32x4*)(Z + (size_t)(R0 + r) * DIN + C_LG + j8), f);
#pragma unroll
              for (int e = 0; e < 8; ++e) f[e] = sigmoidf_(f[e]);
              *(LAS f32x4*)(SG + r * 128 + j8) = (f32x4){f[0], f[1], f[2], f[3]}; *(LAS f32x4*)(SG + r * 128 + j8 + 4) = (f32x4){f[4], f[5], f[6], f[7]}; }
            const int half = tid >> 8, c = tid & 255;
            float g2c[128];
#pragma unroll
            for (int j = 0; j < 128; ++j) g2c[j] = A.in[I_G2][((size_t)l * 128 + j) * 256 + c];
            __syncthreads();
            for (int r = half; r < 130; r += 2) {
              const LAS f32x4* sp = (const LAS f32x4*)(SG + r * 128);
              float gate = 0.f;
#pragma unroll
              for (int j4 = 0; j4 < 32; ++j4) { const f32x4 x = sp[j4]; gate += x[0] * g2c[4 * j4] + x[1] * g2c[4 * j4 + 1] + x[2] * g2c[4 * j4 + 2] + x[3] * g2c[4 * j4 + 3]; }
              YS[(size_t)(R0 + r) * 1024 + 768 + c] = (bf16_t)(cvtpk(gate, 0.f) & 0xffffu);
            }
            continue;
          }
          attn_body::TileMap tm; attn_body::NaInfo na{0, 0};
          const bf16_t *Qp, *Kp, *Vp; bf16_t* Op; int mode = 0;
          if (u < 512) {
            const int qb = u & 63, g2 = (u >> 6) & 1, kvh = (u >> 7) & 1, b = u >> 8, h = kvh * 2 + g2;
            tm = {256, b * TLAT, NLAT + b * CTXL, 260};
            const size_t q0 = (size_t)b * TLAT + qb * 256;
            Qp = Z + q0 * DIN + C_GQ + 64 * h; Kp = Z + C_GK + 64 * kvh; Vp = Z + C_GV + 64 * kvh; Op = YS + q0 * 1024 + 512 + 64 * h;
          } else if (u < 1024) {
            const int v = u - 512, ig = v & 63, h = (v >> 6) & 3, b = v >> 8, i0 = 4 * ig;
            int rmin = min(max(i0 - 4, 0), 248), rmax = min(max(i0 + 3 - 4, 0), 248) + 7;
            if (((rmax - rmin + 1) & 1) != 0) { if (rmax < 255) ++rmax; else --rmin; }
            tm = {4, NLAT + b * CTXL, b * TLAT + 64 * rmin, 4 + (rmax - rmin + 1)};
            na = {i0, rmin}; mode = 1;
            if (tid < 512) ((LAS float*)(lds + attn_body::LDS_BIAS))[tid] = (tid < 465) ? nab[h * 465 + tid] * LOG2E : 0.f;
            const size_t q0 = (size_t)b * TLAT + i0 * 64;
            Qp = Z + q0 * DIN + C_NAQ + 64 * h; Kp = Z + C_NAK + 64 * h; Vp = Z + C_NAV + 64 * h; Op = YS + q0 * 1024 + 256 + 64 * h;
          } else {
            const int v = u - 1024, isna = v >> 3, h = v & 3, b = (v >> 2) & 1;
            const size_t q0 = (size_t)NLAT + b * CTXL;
            tm = {4, NLAT + b * CTXL, 0, 4};
            if (isna) { Qp = Z + q0 * DIN + C_NAQ + 64 * h; Kp = Z + C_NAK + 64 * h; Vp = Z + C_NAV + 64 * h; Op = YS + q0 * 1024 + 256 + 64 * h; }
            else { Qp = Z + q0 * DIN + C_GQ + 64 * h; Kp = Z + C_GK + 64 * (h >> 1); Vp = Z + C_GV + 64 * (h >> 1); Op = YS + q0 * 1024 + 512 + 64 * h; }
          }
#ifndef NO_M1
          if (mode) { FRESH_TID(t1_) attn_body::attn_unit<1, 8>(Qp, Kp, Vp, Op, tm, na, (char*)lds_raw, t1_); }
#endif
#ifndef NO_M0
          if (!mode) { FRESH_TID(t0_) attn_body::attn_unit<0, 8>(Qp, Kp, Vp, Op, tm, na, (char*)lds_raw, t0_); }
#endif
        }
      }
#endif
    PHASE_END

    PHASE_BEGIN(5)
      {
        const int half = tid >> 8, c = tid & 255, hh = c >> 6;
        const float lnw = A.in[I_LNW][l * 256 + c], lnb = A.in[I_LNB][l * 256 + c];
        const float mv0 = A.in[I_MU][(size_t)(l * 2 + 0) * 896 + 512 + c], mv1 = A.in[I_MU][(size_t)(l * 2 + 1) * 896 + 512 + c];
        for (int tile = bx; tile < 256; tile += G) {
          const int R0 = tile * 130;
#pragma unroll 2
          for (int r = half; r < 130; r += 2) {
            const int row = R0 + r; int t, len; row_seq(row, t, len);
            const float y = YSC[((size_t)0 * NROW + row) * 256 + c] + YSC[((size_t)1 * NROW + row) * 256 + c];
            const bf16_t* zr = Z + (size_t)row * DIN + C_RV + c;
            const float zv = bf2f(zr[0]), zp = (t > 0) ? bf2f(zr[-DIN]) : 0.f, zq = (t < len - 1) ? bf2f(zr[DIN]) : 0.f;
            const float b0 = BONUS[((size_t)0 * NROW + row) * 4 + hh], b1 = BONUS[((size_t)1 * NROW + row) * 4 + hh];
            const float gate = bf2f(YS[(size_t)row * 1024 + 768 + c]);
            const float mean = wave_sum(y, lane) * (1.f / 64.f); const float dv = y - mean; const float var = wave_sum(dv * dv, lane) * (1.f / 64.f);
            const float yn = dv * __builtin_amdgcn_rsqf(var + 64e-5f) * lnw + lnb;
            const float v0 = zv + mv0 * (zp - zv), v1 = zv + mv1 * (zq - zv);
            const float bon = b0 * v0 + b1 * v1;
            YS[(size_t)row * 1024 + 768 + c] = (bf16_t)(cvtpk((yn + bon) * gate, 0.f) & 0xffffu);
          }
        }
      }
    PHASE_END

    PHASE_BEGIN(6)
      pg8::Gemm g{(const char*)ws, 1024, 1024};
      pg8::SchedMerge S{G, bx, (l == NLAYER - 1) ? 128 : 130};
      pg8::EpiMerge E{ws + WS_PSCR, A.in[I_BGATE] + (size_t)l * 4096, (bf16_t*)(ws + WS_ACCM)};
      pg8::gemm_phase<pg8::EpiMerge, pg8::SchedMerge, false>(lds, g, S, E, tid);
    PHASE_END

    PHASE_BEGIN(7)
      pg8::Gemm g{(const char*)ws, 1024, 1024};
      pg8::SchedPlain S{(l == NLAYER - 1) ? 128 : 130, 4, G, bx, 16, (long)WS_ACCM, (long)(WS_W + W_O), 1024, 1024, 0};
      pg8::EpiStore E{(bf16_t*)(ws + WS_MBUF), 1024};
      pg8::gemm_phase<pg8::EpiStore, pg8::SchedPlain, false>(lds, g, S, E, tid);
    PHASE_END

    PHASE_BEGIN(8)
      for (int vb_ = bx; vb_ < 256; vb_ += G)
      row_phase_blk((l == 0) ? A.in[I_X] : (const float*)A.out, (l == 0) ? A.in[I_CTX] : (const float*)XC, A.out, XC, (const bf16_t*)(ws + WS_MBUF),
                    MOD + (size_t)l * 3 * 6144, 2 * 1024, A.in[I_NMIXPOST] + l * 1024, H, A.in[I_NFFNPRE] + l * 1024, MOD + (size_t)l * 3 * 6144, 3 * 1024, 4 * 1024, vb_, wave, lane);
    PHASE_END

    PHASE_BEGIN(9)
      pg8::Gemm g{(const char*)ws, 1024, 1024};
      pg8::SchedUp S{G, bx, (l == NLAYER - 1) ? 134 : 138};
      pg8::EpiConvGlu E{(bf16_t*)(ws + WS_G), A.in[I_FCONV] + (size_t)l * 3 * 5632};
      pg8::gemm_phase<pg8::EpiConvGlu, pg8::SchedUp, true>(lds, g, S, E, tid);
    PHASE_END

    PHASE_BEGIN(10)
      pg8::Gemm g{(const char*)ws, DFF, DFF};
      pg8::SchedPlain S{(l == NLAYER - 1) ? 128 : 130, 4, G, bx, 44, (long)WS_G, (long)(WS_W + W_DN), DFF, DFF, 0};
      pg8::EpiStore E{(bf16_t*)(ws + WS_F), 1024};
      pg8::gemm_phase<pg8::EpiStore, pg8::SchedPlain, false>(lds, g, S, E, tid);
    PHASE_END

    PHASE_BEGIN(11)
      for (int vb_ = bx; vb_ < 256; vb_ += G)
      row_phase_blk((const float*)A.out, (const float*)XC, A.out, XC, (const bf16_t*)(ws + WS_F),
                    MOD + (size_t)l * 3 * 6144, 5 * 1024, A.in[I_NFFNPOST] + l * 1024, (l < NLAYER - 1) ? H : (bf16_t*)nullptr, A.in[I_NMIXPRE] + ((l + 1) & 3) * 1024,
                    MOD + (size_t)((l + 1) & 3) * 3 * 6144, 0, 1024, vb_, wave, lane);
      if (l < NLAYER - 1) convert_weights(A, l + 1, lds, gw, NGW, wave, lane);
    PHASE_END
  }
}

constexpr int LDS_BYTES = 147456;
constexpr int NPHASES = 2 + NLAYER * 10;
extern "C" void kernel_launch(void* const* d_in, const int* in_sizes, int n_in, void* d_out, int out_size, void* d_ws, size_t ws_size, hipStream_t stream) {
  static int grid = 0;
  if (grid == 0) {
    int dev = 0, cus = 0, per_cu = 0;
    hipGetDevice(&dev);
    hipDeviceGetAttribute(&cus, hipDeviceAttributeMultiprocessorCount, dev);
    if (hipFuncSetAttribute((const void*)fwd_megakernel, hipFuncAttributeMaxDynamicSharedMemorySize, LDS_BYTES) != hipSuccess) fprintf(stderr, "kernel_launch: hipFuncSetAttribute failed\n");
    hipOccupancyMaxActiveBlocksPerMultiprocessor(&per_cu, (const void*)fwd_megakernel, NTHREADS, LDS_BYTES);
    (void)hipGetLastError();
    if (per_cu < 1) per_cu = 1;
    grid = cus;
    if (n_in != 33 || ws_size < WS_END) fprintf(stderr, "kernel_launch: unexpected n_in %d or ws %zu\n", n_in, ws_size);
  }
  (void)hipMemsetAsync((char*)d_ws + WS_CTL, 0, 4096, stream);
  Args a{};
  for (int i = 0; i < 33; ++i) a.in[i] = (const float*)d_in[i];
  a.out = (float*)d_out; a.ws = (unsigned char*)d_ws; a.ph_lo = 0; a.ph_hi = NPHASES;
  void* args[] = {&a};
  hipError_t e = hipLaunchCooperativeKernel((const void*)fwd_megakernel, dim3(grid), dim3(NTHREADS), args, LDS_BYTES, stream);
  if (e != hipSuccess) fprintf(stderr, "cooperative launch failed: %s (grid %d)\n", hipGetErrorString(e), grid);
}
```

```cpp
#include <hip/hip_runtime.h>
#include <hip/hip_cooperative_groups.h>
#include <hip/hip_bf16.h>
#include <cstdio>
#include <cstdint>
#include <cmath>
namespace cg = cooperative_groups;

#define DI __device__ __forceinline__
#define LAS __attribute__((address_space(3)))
#define CAS4 __attribute__((address_space(4)))
typedef unsigned short bf16_t;
typedef short bf16x8 __attribute__((ext_vector_type(8)));
typedef float f32x4 __attribute__((ext_vector_type(4)));
typedef float f32x2 __attribute__((ext_vector_type(2)));
typedef float f32x16 __attribute__((ext_vector_type(16)));
typedef unsigned u32x4 __attribute__((ext_vector_type(4)));
typedef short s16x4 __attribute__((ext_vector_type(4)));
typedef __bf16 bf16x2_t __attribute__((ext_vector_type(2)));

constexpr int DM = 1024, TLAT = 16384, NLAT = 32768, CTXL = 256, NROW = 33280, NLAYER = 4;
constexpr int DIN = 3072, DFF = 2816;
constexpr int C_NAQ = 768, C_NAK = 1024, C_NAV = 1280, C_GQ = 1536, C_GK = 1792, C_GV = 1920;
constexpr int C_RR = 2048, C_RK = 2304, C_RV = 2560, C_LW = 2816, C_LA = 2880, C_LG = 2944;
constexpr float C2 = 0.125f * 1.4426950408889634f;
constexpr float LOG2E = 1.4426950408889634f;
constexpr int NTHREADS = 512;

constexpr size_t MiB = 1u << 20;
constexpr size_t WS_CTL = 0, WS_MOD = 1 * MiB, WS_XC = 2 * MiB, WS_BONUS = 4 * MiB, WS_W = 6 * MiB;
constexpr size_t W_IN = 0, W_GATE = W_IN + (size_t)3072 * 1024 * 2, W_BR = W_GATE + (size_t)4096 * 1024 * 2, W_O = W_BR + (size_t)1024 * 1024 * 2,
                 W_UP = W_O + (size_t)1024 * 1024 * 2, W_DN = W_UP + (size_t)5632 * 1024 * 2, W_END = W_DN + (size_t)1024 * 2816 * 2;
static_assert(WS_W + W_END <= 42 * MiB, "weights");
constexpr size_t WS_H = 42 * MiB + 65536, WS_Z = 108 * MiB, WS_YS = 304 * MiB, WS_WA = 370 * MiB, WS_YSC = 436 * MiB, WS_END = 501 * MiB;
constexpr size_t WS_ACCM = WS_Z, WS_MBUF = WS_Z + 70 * MiB, WS_G = WS_Z, WS_F = WS_YS, WS_PSCR = WS_WA, WS_ASCR = WS_YSC;
constexpr size_t ROWB = (size_t)NROW * 1024 * 2;

DI float bf2f(unsigned u16) { return __uint_as_float(u16 << 16); }
DI unsigned cvtpk(float lo, float hi) { f32x2 v = {lo, hi}; bf16x2_t b = __builtin_convertvector(v, bf16x2_t); return __builtin_bit_cast(unsigned, b); }
DI void unpack8(const u32x4 w, float* f) {
#pragma unroll
  for (int i = 0; i < 4; ++i) { f[2 * i] = __uint_as_float(w[i] << 16); f[2 * i + 1] = __uint_as_float(w[i] & 0xffff0000u); }
}
DI u32x4 pack8(const float* f) { u32x4 w; w.x = cvtpk(f[0], f[1]); w.y = cvtpk(f[2], f[3]); w.z = cvtpk(f[4], f[5]); w.w = cvtpk(f[6], f[7]); return w; }
DI float sigmoidf_(float x) { return __builtin_amdgcn_rcpf(1.f + __builtin_amdgcn_exp2f(-1.4426950408889634f * x)); }
DI float dppf(float x, const int ctrl_dummy);
#define DPPF(x, CTRL) __int_as_float(__builtin_amdgcn_update_dpp(0, __float_as_int(x), (CTRL), 0xf, 0xf, false))
DI float allreduce16(float x) { x += DPPF(x, 0xB1); x += DPPF(x, 0x4E); x += DPPF(x, 0x141); x += DPPF(x, 0x140); return x; }
DI float red8(float x) { x += DPPF(x, 0xB1); x += DPPF(x, 0x4E); x += DPPF(x, 0x141); return x; }
DI float bperm(float v, int src_lane) { return __int_as_float(__builtin_amdgcn_ds_bpermute(src_lane << 2, __float_as_int(v))); }
DI float wave_sum(float v, int lane) { v = allreduce16(v); v += bperm(v, lane ^ 16); v += bperm(v, lane ^ 32); return v; }

DI void grid_barrier(unsigned* ctr, unsigned target, int tid) {
  __syncthreads();
  if (tid == 0) {
    __builtin_amdgcn_fence(__ATOMIC_RELEASE, "agent");
    __hip_atomic_fetch_add(ctr, 1u, __ATOMIC_RELAXED, __HIP_MEMORY_SCOPE_AGENT);
    while (__hip_atomic_load(ctr, __ATOMIC_RELAXED, __HIP_MEMORY_SCOPE_AGENT) < target) __builtin_amdgcn_s_sleep(1);
    __builtin_amdgcn_fence(__ATOMIC_ACQUIRE, "agent");
  }
  __syncthreads();
}
DI void row_seq(int row, int& t, int& len) { if (row < NLAT) { t = row & (TLAT - 1); len = TLAT; } else { t = (row - NLAT) & (CTXL - 1); len = CTXL; } }

namespace pg8 {
constexpr int BM = 256, BK = 64, HALF = 128, HTB = HALF * BK * 2, STAGE_BYTES = 8 * HTB;
DI int lds_byte(int r, int c) { const int st = (r >> 4) * 2 + (c >> 5), rr = r & 15, cc = c & 31, ob = rr * 64 + cc * 2; return st * 1024 + (ob ^ (((ob >> 9) & 1) << 5)); }
DI void stage_rc(int b, int& R, int& C) { const int st = b / 1024, sb = b % 1024, swz = sb ^ (((sb >> 9) & 1) << 5); R = (st >> 1) * 16 + swz / 64; C = (st & 1) * 32 + (swz % 64) / 2; }
DI int perm32(int rho) { const int n = rho >> 4, i = rho & 15; return 8 * (i >> 2) + 4 * n + (i & 3); }

struct Unit { int pm, pn, nt, kind; };
struct Gemm { const char* base; int lda, ldb; };

template <class Epi, class Sched, bool CONV>
DI void gemm_phase(LAS unsigned char* lds, const Gemm g, const Sched& S, const Epi& E, int tid) {
    const int wid = __builtin_amdgcn_readfirstlane(tid >> 6), lane = tid & 63, wr = wid >> 2, wc = wid & 3, fr = lane & 15, fq = lane >> 4;
    unsigned voffA[2], voffB[2];
#pragma unroll
    for (int i = 0; i < 2; ++i) { int R, C; stage_rc(tid * 16 + i * 8192, R, C); const int Rb = (R & ~31) + perm32(R & 31);
        const int Ra = CONV ? (62 * (R >> 6) + (R & 63)) : R;
        voffA[i] = (unsigned)(Ra * g.lda + C) * 2u; voffB[i] = (unsigned)(Rb * g.ldb + C) * 2u; }
    constexpr int kstep = BK * 2;
    const int hstepA = (CONV ? 124 : HALF) * g.lda * 2, hstepB = HALF * g.ldb * 2;
    const unsigned ldsw = (unsigned)wid * 1024u;
    const int aoff = lds_byte(wr * 64 + fr, fq * 8), boff = lds_byte(wc * 32 + fr, fq * 8);
#define PG8_SA(b, h) (((b) * 2 + (h)) * HTB)
#define PG8_SB(b, h) ((4 + (b) * 2 + (h)) * HTB)
#define PG8_STAGE(bufoff, gbase, voff) do { _Pragma("unroll") for (int _i = 0; _i < 2; ++_i) \
        __builtin_amdgcn_global_load_lds((const unsigned*)((const char*)(gbase) + (voff)[_i]), (LAS unsigned*)(lds + (bufoff) + ldsw + _i * 8192), 16, 0, 0); } while (0)
#define PG8_LDA(dst, b, h) do { _Pragma("unroll") for (int m = 0; m < 4; ++m) _Pragma("unroll") for (int k = 0; k < 2; ++k) dst[m][k] = *(const LAS bf16x8*)(lds + PG8_SA(b, h) + aoff + m * 2048 + k * 1024); } while (0)
#define PG8_LDB(dst, b, h) do { _Pragma("unroll") for (int n = 0; n < 2; ++n) _Pragma("unroll") for (int k = 0; k < 2; ++k) dst[n][k] = *(const LAS bf16x8*)(lds + PG8_SB(b, h) + boff + n * 2048 + k * 1024); } while (0)
#define PG8_MMA(ai, bj, At, Bt) do { __builtin_amdgcn_s_setprio(1); _Pragma("unroll") for (int m = 0; m < 4; ++m) _Pragma("unroll") for (int n = 0; n < 2; ++n) _Pragma("unroll") for (int k = 0; k < 2; ++k) \
        acc[ai][bj][m][n] = __builtin_amdgcn_mfma_f32_16x16x32_bf16(Bt[n][k], At[m][k], acc[ai][bj][m][n], 0, 0, 0); __builtin_amdgcn_s_setprio(0); } while (0)
#define PG8_WAIT_V(n) asm volatile("s_waitcnt vmcnt(" #n ")" ::: "memory")
#define PG8_WAIT_L(n) asm volatile("s_waitcnt lgkmcnt(" #n ")" ::: "memory")
#define PG8_BAR __builtin_amdgcn_s_barrier()
#define PG8_SCHED __builtin_amdgcn_sched_barrier(0)
    Unit cur, nxt; int ui = 0; long ao_, bo_;
    if (!S.next(0, cur, ao_, bo_)) return;
    f32x4 acc[2][2][4][2];
#pragma unroll
    for (int a = 0; a < 2; ++a)
#pragma unroll
        for (int b = 0; b < 2; ++b)
#pragma unroll
            for (int m = 0; m < 4; ++m)
#pragma unroll
                for (int n = 0; n < 2; ++n) acc[a][b][m][n] = (f32x4){0.f, 0.f, 0.f, 0.f};
    bf16x8 At[4][2], B0[2][2], B1[2][2];
    const char* cA = g.base + ao_; const char* cB = g.base + bo_;
    PG8_STAGE(PG8_SB(0, 0), cB, voffB); PG8_STAGE(PG8_SB(0, 1), cB + hstepB, voffB); PG8_STAGE(PG8_SA(0, 0), cA, voffA); PG8_STAGE(PG8_SA(0, 1), cA + hstepA, voffA);
    if (wr == 1) PG8_BAR;
    PG8_WAIT_V(2); PG8_BAR;
    PG8_STAGE(PG8_SB(1, 0), cB + kstep, voffB); PG8_STAGE(PG8_SA(1, 0), cA + kstep, voffA); PG8_STAGE(PG8_SB(1, 1), cB + hstepB + kstep, voffB);
    PG8_WAIT_V(6); PG8_BAR;
    for (;;) {
        const bool has_next = S.next(ui + 1, nxt, ao_, bo_);
        const char* nA = has_next ? g.base + ao_ : cA; const char* nB = has_next ? g.base + bo_ : cB;
        const int nt = cur.nt;
        for (int t = 0; t < nt; t += 2) {
            const bool last = (t == nt - 2);
            const char* a1 = cA + (size_t)(t + 1) * kstep;
            const char* a2 = last ? nA : cA + (size_t)(t + 2) * kstep; const char* b2 = last ? nB : cB + (size_t)(t + 2) * kstep;
            const char* a3 = a2 + kstep; const char* b3 = b2 + kstep;
            PG8_LDB(B0, 0, 0); PG8_LDB(B1, 0, 1); PG8_SCHED; PG8_LDA(At, 0, 0); PG8_STAGE(PG8_SA(1, 1), a1 + hstepA, voffA);
            PG8_WAIT_V(8); PG8_WAIT_L(0); PG8_BAR; PG8_MMA(0, 0, At, B0); PG8_MMA(0, 1, At, B1); PG8_BAR; PG8_SCHED;
            PG8_LDA(At, 0, 1); PG8_STAGE(PG8_SB(0, 0), b2, voffB); PG8_STAGE(PG8_SB(0, 1), b2 + hstepB, voffB); PG8_STAGE(PG8_SA(0, 0), a2, voffA);
            PG8_WAIT_V(8); PG8_WAIT_L(0); PG8_BAR; PG8_MMA(1, 0, At, B0); PG8_MMA(1, 1, At, B1); PG8_BAR; PG8_SCHED;
            PG8_LDB(B0, 1, 0); PG8_LDB(B1, 1, 1); PG8_SCHED; PG8_LDA(At, 1, 0); PG8_STAGE(PG8_SA(0, 1), a2 + hstepA, voffA);
            PG8_WAIT_V(8); PG8_WAIT_L(0); PG8_BAR; PG8_MMA(0, 0, At, B0); PG8_MMA(0, 1, At, B1); PG8_BAR; PG8_SCHED;
            PG8_LDA(At, 1, 1); PG8_STAGE(PG8_SB(1, 0), b3, voffB); PG8_STAGE(PG8_SB(1, 1), b3 + hstepB, voffB); PG8_STAGE(PG8_SA(1, 0), a3, voffA);
            PG8_WAIT_V(8); PG8_WAIT_L(0); PG8_BAR; PG8_MMA(1, 0, At, B0); PG8_MMA(1, 1, At, B1); PG8_BAR; PG8_SCHED;
        }
        if (wr == 0) PG8_BAR;
        E(acc, cur, wr, wc, fr, fq);
        if (!has_next) break;
#pragma unroll
        for (int a = 0; a < 2; ++a)
#pragma unroll
            for (int b = 0; b < 2; ++b)
#pragma unroll
                for (int m = 0; m < 4; ++m)
#pragma unroll
                    for (int n = 0; n < 2; ++n) acc[a][b][m][n] = (f32x4){0.f, 0.f, 0.f, 0.f};
        cur = nxt; cA = nA; cB = nB; ++ui;
        if (wr == 1) PG8_BAR;
    }
    PG8_WAIT_V(0);
    PG8_BAR;
#undef PG8_SA
#undef PG8_SB
#undef PG8_STAGE
#undef PG8_LDA
#undef PG8_LDB
#undef PG8_MMA
#undef PG8_WAIT_V
#undef PG8_WAIT_L
#undef PG8_BAR
#undef PG8_SCHED
}

DI void xcd_tile(int L, int nM, int nN, int& pm, int& pn) {
    const int nwg = nM * nN; int wgid = L; { const int q = nwg / 8, r = nwg % 8, xcd = wgid % 8, off = wgid / 8; wgid = (xcd < r ? xcd * (q + 1) : r * (q + 1) + (xcd - r) * q) + off; }
    const int nig = 8 * nN, gid = wgid / nig, fm = gid * 8, gsz = (nM - fm) < 8 ? (nM - fm) : 8;
    pm = fm + ((wgid % nig) % gsz); pn = (wgid % nig) / gsz;
}
struct SchedPlain {
    int nM, nN, G, c, nt; long a0, b0; int lda, ldb, pn0;
    DI bool next(int i, Unit& u, long& a_off, long& b_off) const {
        const int L = i * G + c; if (L >= nM * nN) return false;
        xcd_tile(L, nM, nN, u.pm, u.pn); u.pn += pn0; a_off = a0 + (long)u.pm * 256 * lda * 2; b_off = b0 + (long)u.pn * 256 * ldb * 2; u.nt = nt; u.kind = 0; return true; }
};
struct SchedMerge {
    int G, c, nrt;
    DI bool next(int i, Unit& u, long& a_off, long& b_off) const {
        const int nr = (c < 512) ? (512 - c + G - 1) / G : 0;
        int sub;
        if (i < 8 * nr) { const int L = (i >> 3) * G + c; xcd_tile(L, 128, 4, u.pm, u.pn); sub = i & 7; }
        else { if (nrt != 130) return false;
            const int ii = i - 8 * nr, k = ii / 5, j = ii - 5 * k, qid = c + k * G; if (qid >= 32) return false;
            const int tq = qid >> 2, q = qid & 3; u.pm = 128 + (tq >> 2); u.pn = tq & 3; sub = (j < 4) ? j : 4 + q; }
        u.kind = sub;
        if (sub < 4) { a_off = (long)WS_YS + ((long)u.pm * 256 * 1024 + sub * 256) * 2; b_off = (long)(WS_W + W_BR) + ((long)u.pn * 256 * 1024 + sub * 256) * 2; u.nt = 4; }
        else { a_off = (long)WS_H + (long)u.pm * 256 * 1024 * 2; b_off = (long)(WS_W + W_GATE) + ((long)((u.pn * 4 + (sub - 4)) * 256) * 1024) * 2; u.nt = 16; }
        return true; }
};
struct SchedUp {
    int G, c, ntm;
    DI static void tile_seq(int tm, int& base, int& len, int& j) {
        if (tm < 67) { base = 0; len = TLAT; j = tm; } else if (tm < 134) { base = TLAT; len = TLAT; j = tm - 67; }
        else { const int x = tm - 134; base = NLAT + (x >> 1) * CTXL; len = CTXL; j = x & 1; } }
    DI bool next(int i, Unit& u, long& a_off, long& b_off) const {
        const int L = i * G + c; if (L >= ntm * 22) return false;
        xcd_tile(L, ntm, 22, u.pm, u.pn); int base, len, j; tile_seq(u.pm, base, len, j);
        a_off = (long)WS_H + ((long)(base + 248 * j - 1) * 1024) * 2; b_off = (long)(WS_W + W_UP) + (long)u.pn * 256 * 1024 * 2; u.nt = 16; u.kind = 0; return true; }
};

struct EpiStore {
    bf16_t* O; int ldc;
    DI void operator()(const f32x4 (&acc)[2][2][4][2], const Unit& u, int wr, int wc, int fr_in, int fq_in) const {
        int ln_; asm volatile("v_mbcnt_lo_u32_b32 %0, -1, 0\n\tv_mbcnt_hi_u32_b32 %0, -1, %0" : "=v"(ln_)); const int fr = ln_ & 15, fq = ln_ >> 4; (void)fr_in; (void)fq_in;
        const int row0 = u.pm * 256 + wr * 64 + fr, col0 = u.pn * 256 + wc * 32 + 8 * fq;
#pragma unroll
        for (int ai = 0; ai < 2; ++ai)
#pragma unroll
            for (int m = 0; m < 4; ++m) { bf16_t* rowp = O + (size_t)(row0 + ai * 128 + m * 16) * ldc + col0;
#pragma unroll
                for (int bj = 0; bj < 2; ++bj) { const f32x4 v0 = acc[ai][bj][m][0], v1 = acc[ai][bj][m][1];
                    u32x4 w; w.x = cvtpk(v0[0], v0[1]); w.y = cvtpk(v0[2], v0[3]); w.z = cvtpk(v1[0], v1[1]); w.w = cvtpk(v1[2], v1[3]);
                    *(u32x4*)(rowp + bj * 128) = w; } }
    }
};
struct EpiMerge {
    unsigned char* stash; const float* bgate; bf16_t* O;
    DI void operator()(const f32x4 (&acc)[2][2][4][2], const Unit& u, int wr, int wc, int fr_in, int fq_in) const {
        int ln_; asm volatile("v_mbcnt_lo_u32_b32 %0, -1, 0\n\tv_mbcnt_hi_u32_b32 %0, -1, %0" : "=v"(ln_)); const int fr = ln_ & 15, fq = ln_ >> 4; (void)fr_in; (void)fq_in;
        unsigned char* st = stash + (size_t)blockIdx.x * 524288;
        if (u.kind < 4) {
            unsigned char* pb = st + (size_t)u.kind * 131072 + (size_t)(wr * 64 + fr) * 512 + (wc * 32 + 8 * fq) * 2;
#pragma unroll
            for (int ai = 0; ai < 2; ++ai)
#pragma unroll
                for (int m = 0; m < 4; ++m)
#pragma unroll
                    for (int bj = 0; bj < 2; ++bj) { const f32x4 v0 = acc[ai][bj][m][0], v1 = acc[ai][bj][m][1];
                        u32x4 w; w.x = cvtpk(v0[0], v0[1]); w.y = cvtpk(v0[2], v0[3]); w.z = cvtpk(v1[0], v1[1]); w.w = cvtpk(v1[2], v1[3]);
                        *(u32x4*)(pb + (size_t)(ai * 128 + m * 16) * 512 + bj * 256) = w; }
            asm volatile("s_waitcnt vmcnt(0)" ::: "memory");
        } else {
            __builtin_amdgcn_fence(__ATOMIC_ACQUIRE, "agent");
            const int q = u.kind - 4, cq = 64 * q + 16 * wc + 4 * fq, col = u.pn * 256 + cq;
            f32x4 bg[4];
#pragma unroll
            for (int i = 0; i < 4; ++i) bg[i] = *(const f32x4*)(bgate + i * 1024 + col);
            const unsigned char* pb = st + (size_t)(wr * 64 + fr) * 512 + cq * 2;
            bf16_t* ob = O + (size_t)(u.pm * 256 + wr * 64 + fr) * 1024 + col;
#pragma unroll
            for (int ai = 0; ai < 2; ++ai)
#pragma unroll
                for (int m = 0; m < 4; ++m) {
                    f32x4 o = (f32x4){0.f, 0.f, 0.f, 0.f};
#pragma unroll
                    for (int bj = 0; bj < 2; ++bj)
#pragma unroll
                        for (int n = 0; n < 2; ++n) { const int i = 2 * bj + n;
                            const uint2 pw = *(const uint2*)(pb + (size_t)i * 131072 + (size_t)(ai * 128 + m * 16) * 512);
                            const f32x4 p = (f32x4){__uint_as_float(pw.x << 16), __uint_as_float(pw.x & 0xffff0000u), __uint_as_float(pw.y << 16), __uint_as_float(pw.y & 0xffff0000u)};
                            const f32x4 gv = acc[ai][bj][m][n] + bg[i];
#pragma unroll
                            for (int e = 0; e < 4; ++e) o[e] += sigmoidf_(gv[e]) * p[e]; }
                    uint2 w; w.x = cvtpk(o[0], o[1]); w.y = cvtpk(o[2], o[3]);
                    *(uint2*)(ob + (size_t)(ai * 128 + m * 16) * 1024) = w;
                }
        }
    }
};
struct EpiConvGlu {
    bf16_t* Gout; const float* cw;
    DI void operator()(const f32x4 (&acc)[2][2][4][2], const Unit& u, int wr, int wc, int fr_in, int fq_in) const {
        int ln_; asm volatile("v_mbcnt_lo_u32_b32 %0, -1, 0\n\tv_mbcnt_hi_u32_b32 %0, -1, %0" : "=v"(ln_)); const int fr = ln_ & 15, fq = ln_ >> 4; (void)fr_in; (void)fq_in;
        int base, len, j; SchedUp::tile_seq(u.pm, base, len, j);
        const bool f0 = (fr == 0), f15 = (fr == 15);
#pragma unroll
        for (int n = 0; n < 2; ++n) {
            const int colv = u.pn * 128 + wc * 32 + 8 * fq + 4 * n;
            f32x4 wv[3], wg[3];
#pragma unroll
            for (int k = 0; k < 3; ++k) { wv[k] = *(const f32x4*)(cw + k * 5632 + colv); wg[k] = *(const f32x4*)(cw + k * 5632 + 2816 + colv); }
#pragma unroll
            for (int ai = 0; ai < 2; ++ai) {
#pragma unroll
                for (int m = 0; m < 4; ++m) {
                    const int rho = 16 * m + fr;
                    const int tl = 248 * j + 62 * (2 * ai + wr) - 1 + rho;
                    const bool valid = (rho >= 1) && (rho <= 62) && (tl >= 0) && (tl < len);
                    const bool lz = (tl <= 0), rz = (tl >= len - 1);
                    float outv[4];
#pragma unroll
                    for (int e = 0; e < 4; ++e) {
                        float cvv[2];
#pragma unroll
                        for (int bj = 0; bj < 2; ++bj) {
                            const float xc = acc[ai][bj][m][n][e];
                            const float xm1 = (m > 0) ? acc[ai][bj][m - 1][n][e] : xc, xp1 = (m < 3) ? acc[ai][bj][m + 1][n][e] : xc;
                            const float tl_ = f15 ? xm1 : xc, tr_ = f0 ? xp1 : xc;
                            const float lraw = DPPF(tl_, 0x121); const float left = lz ? 0.f : lraw;
                            const float rraw = DPPF(tr_, 0x12F); const float right = rz ? 0.f : rraw;
                            cvv[bj] = bj ? (left * wg[0][e] + xc * wg[1][e] + right * wg[2][e]) : (left * wv[0][e] + xc * wv[1][e] + right * wv[2][e]);
                        }
                        outv[e] = cvv[0] * cvv[1] * sigmoidf_(cvv[1]);
                    }
                    if (valid) { uint2 w; w.x = cvtpk(outv[0], outv[1]); w.y = cvtpk(outv[2], outv[3]); *(uint2*)(Gout + (size_t)(base + tl) * DFF + colv) = w; }
                }
            }
        }
    }
};
}

namespace attn_body {
constexpr int QP = DIN, OP = 1024;
constexpr int NW = 8, QBLK = 32, KVBLK = 64;
DI int crow(int r, int hi) { return (r & 3) + 8 * (r >> 2) + 4 * hi; }
#define SBAR() __builtin_amdgcn_sched_barrier(0)
constexpr int NSLOT = 3, SLOTB = 8192;
constexpr int LDS_K = 0, LDS_V = NSLOT * SLOTB, LDS_WS = 2 * NSLOT * SLOTB, LDS_OST = LDS_WS + NW * 64 * 4, LDS_BYTES = LDS_OST + NW * 4096;
constexpr int LDS_BIAS = 86016;
DI void glds16(const void* gsrc, unsigned lds_dst) { unsigned keep;
  asm volatile("s_mov_b32 %0, m0\n\ts_mov_b32 m0, %2\n\ts_nop 0\n\tglobal_load_lds_dwordx4 %1, off\n\ts_mov_b32 m0, %0" : "=&s"(keep) : "v"(gsrc), "s"(lds_dst) : "memory"); }
DI float max3f(float a, float b, float c) { float r; asm("v_max3_f32 %0, %1, %2, %3" : "=v"(r) : "v"(a), "v"(b), "v"(c)); return r; }
DI float max2f(float a, float b) { float r; asm("v_max_f32_e32 %0, %1, %2" : "=v"(r) : "v"(a), "v"(b)); return r; }
DI float fadd_s(float a, float b) { float r; asm("v_add_f32_e32 %0, %1, %2" : "=v"(r) : "v"(a), "v"(b)); return r; }
DI float fsub_s(float a, float b) { float r; asm("v_sub_f32_e32 %0, %1, %2" : "=v"(r) : "v"(a), "v"(b)); return r; }
DI unsigned cvtpk_s(float lo, float hi) { return cvtpk(lo, hi); }
#define WAIT_BAR(N) asm volatile("s_waitcnt vmcnt(" #N ") lgkmcnt(0)\n\ts_barrier" ::: "memory")

DI void qkt(f32x16& p0, f32x16& p1, const char* Kslot, const bf16x8* qr, int r32, int hi) {
  const f32x16 zz = f32x16{};
  const char* kb = Kslot + hi * 1024 + r32 * 16;
#pragma unroll
  for (int d0 = 0; d0 < 4; ++d0) {
    const bf16x8 b0 = *reinterpret_cast<const bf16x8*>(kb + d0 * 2048);
    const bf16x8 b1 = *reinterpret_cast<const bf16x8*>(kb + d0 * 2048 + 512);
    if (d0 == 0) { p0 = __builtin_amdgcn_mfma_f32_32x32x16_bf16(b0, qr[0], zz, 0, 0, 0); p1 = __builtin_amdgcn_mfma_f32_32x32x16_bf16(b1, qr[0], zz, 0, 0, 0); }
    else { p0 = __builtin_amdgcn_mfma_f32_32x32x16_bf16(b0, qr[d0], p0, 0, 0, 0); p1 = __builtin_amdgcn_mfma_f32_32x32x16_bf16(b1, qr[d0], p1, 0, 0, 0); } }
}
typedef __attribute__((address_space(3))) const char* lds_cptr;
typedef short v4i16_t __attribute__((ext_vector_type(4)));
DI void kload8(bf16x8* kf, lds_cptr kp) {
  kf[0] = *(const LAS bf16x8*)(kp);        kf[1] = *(const LAS bf16x8*)(kp + 512);
  kf[2] = *(const LAS bf16x8*)(kp + 2048); kf[3] = *(const LAS bf16x8*)(kp + 2560);
  kf[4] = *(const LAS bf16x8*)(kp + 4096); kf[5] = *(const LAS bf16x8*)(kp + 4608);
  kf[6] = *(const LAS bf16x8*)(kp + 6144); kf[7] = *(const LAS bf16x8*)(kp + 6656);
}
DI void kload2(bf16x8* kf, lds_cptr kp, int j) { kf[2 * j] = *(const LAS bf16x8*)(kp + j * 2048); kf[2 * j + 1] = *(const LAS bf16x8*)(kp + j * 2048 + 512); }
DI s16x4 vtr(lds_cptr p) { return __builtin_bit_cast(s16x4, __builtin_amdgcn_ds_read_tr16_b64_v4i16((LAS v4i16_t*)p)); }
DI float rowmax(const f32x16& p0, const f32x16& p1) {
  float a = max3f(p0[0], p0[1], p1[0]), b = max3f(p0[2], p0[3], p1[1]); a = max3f(a, p1[2], p1[3]);
#pragma unroll
  for (int r = 4; r < 16; r += 4) { a = max3f(a, p0[r], p0[r + 1]); b = max3f(b, p0[r + 2], p0[r + 3]); a = max3f(a, p1[r], p1[r + 1]); b = max3f(b, p1[r + 2], p1[r + 3]); }
  const float m = max2f(a, b);
  auto rr = __builtin_amdgcn_permlane32_swap(__float_as_uint(m), __float_as_uint(m), false, false);
  return max2f(__uint_as_float(rr[0]), __uint_as_float(rr[1]));
}
DI void pv(f32x16* o, int vb, bf16x8 pa0, bf16x8 pa1, bf16x8 pa2, bf16x8 pa3) {
#pragma unroll
  for (int d0 = 0; d0 < 2; ++d0) { s16x4 lo[4], hi[4];
#pragma unroll
    for (int ks = 0; ks < 4; ++ks) {
      asm volatile("ds_read_b64_tr_b16 %0,%1 offset:%c2" : "=&v"(lo[ks]) : "v"(vb), "i"(d0 * 4096 + ks * 1024) : "memory");
      asm volatile("ds_read_b64_tr_b16 %0,%1 offset:%c2" : "=&v"(hi[ks]) : "v"(vb), "i"(d0 * 4096 + ks * 1024 + 512) : "memory"); }
    asm volatile("s_waitcnt lgkmcnt(0)" ::: "memory"); SBAR();
#define PK(k) (bf16x8){lo[k][0], lo[k][1], lo[k][2], lo[k][3], hi[k][0], hi[k][1], hi[k][2], hi[k][3]}
    o[d0] = __builtin_amdgcn_mfma_f32_32x32x16_bf16(pa0, PK(0), o[d0], 0, 0, 0);
    o[d0] = __builtin_amdgcn_mfma_f32_32x32x16_bf16(pa1, PK(1), o[d0], 0, 0, 0);
    o[d0] = __builtin_amdgcn_mfma_f32_32x32x16_bf16(pa2, PK(2), o[d0], 0, 0, 0);
    o[d0] = __builtin_amdgcn_mfma_f32_32x32x16_bf16(pa3, PK(3), o[d0], 0, 0, 0);
#undef PK
  }
}
struct TileMap { int n1, base1, base2, NT; };
struct NaInfo { int i0, rmin; };

template <int MODE, int THRL>
DI void attn_unit(const bf16_t* Qw0, const bf16_t* __restrict__ Kh, const bf16_t* __restrict__ Vh, bf16_t* Ow0, const TileMap tm, const NaInfo na, char* shm, int tid) {
  const int lane = tid & 63, r32 = lane & 31, hi = lane >> 5; const int wid = __builtin_amdgcn_readfirstlane(tid >> 6);
  const bf16_t* Qw = Qw0 + (long)(wid * QBLK) * QP;
  const unsigned lds0 = (unsigned)(uintptr_t)shm;
  float* wsf = (float*)(shm + LDS_WS) + wid * 64;
  const bf16_t* ksrc = Kh + (long)lane * QP + wid * 8;
  const bf16_t* vsrc = Vh + (long)(16 * (wid & 3) + (lane >> 2)) * QP + (wid >> 2) * 32 + (lane & 3) * 8;
  const unsigned kdst = lds0 + LDS_K + wid * 1024, vdst = lds0 + LDS_V + wid * 1024;
#define TROW(t) ((long)(((t) < tm.n1) ? (tm.base1 + 64 * (t)) : (tm.base2 + 64 * ((t) - tm.n1))))
#define DMA_K(t, slot) glds16(ksrc + TROW(t) * QP, (unsigned)__builtin_amdgcn_readfirstlane(kdst + (slot)))
#define DMA_V(t, slot) glds16(vsrc + TROW(t) * QP, (unsigned)__builtin_amdgcn_readfirstlane(vdst + (slot)))
  const int vb0 = (int)(lds0 + LDS_V) + ((lane >> 4) & 1) * 32 + (lane & 3) * 8 + (4 * hi + ((lane & 15) >> 2)) * 64;
  const char* Kbase = shm + LDS_K; bf16x8 kf[8];
  const lds_cptr shm3 = (lds_cptr)shm; const lds_cptr kp0 = shm3 + LDS_K + hi * 1024 + r32 * 16; const lds_cptr vp0 = shm3 + LDS_V + ((lane >> 4) & 1) * 32 + (lane & 3) * 8 + (4 * hi + ((lane & 15) >> 2)) * 64;
  const int NT = tm.NT;
  DMA_K(0, 0); DMA_V(0, 0); DMA_K(1, SLOTB);
  bf16x8 qr[4];
#pragma unroll
  for (int d0 = 0; d0 < 4; ++d0) qr[d0] = *reinterpret_cast<const bf16x8*>(&Qw[(long)r32 * QP + d0 * 16 + hi * 8]);
  float mhat = 0.f, l_reg = 0.f; f32x16 o[2]; o[0] = f32x16{}; o[1] = f32x16{}; f32x16 zacc = f32x16{}; if (MODE == 0) asm volatile("" : "+v"(zacc));
#define CMASK(P0, P1, t) do { if (MODE == 1) { const int t_ = (t); const bool ctx_ = t_ < 4; \
      int lane_ = lane; asm volatile("" : "+v"(lane_)); const int r32_ = lane_ & 31, hi_ = lane_ >> 5; \
      const int qi_ = na.i0 + (wid >> 1), qj_ = (wid & 1) * 32 + r32_; const int rs_ = min(max(qi_ - 4, 0), 248), cs_ = min(max(qj_ - 8, 0), 48); \
      const int kr = na.rmin + t_ - 4; const bool rowok = (unsigned)(kr - rs_) < 8u; \
      const int bb = ctx_ ? 480 : ((kr - qi_ + 7) * 31 + 15 - qj_ + 4 * hi_); const int lo_ = ctx_ ? -4096 : ((rowok ? cs_ : 4096) - 4 * hi_); const unsigned wd_ = ctx_ ? 8192u : 16u; const int mul_ = ctx_ ? 0 : 1; \
      const LAS float* btab = (const LAS float*)((lds_cptr)shm + LDS_BIAS); \
      _Pragma("unroll") for (int g_ = 0; g_ < 8; ++g_) { \
        _Pragma("unroll") for (int q_ = 0; q_ < 2; ++q_) { const int r = 2 * g_ + q_; const int kc0 = (r & 3) + 8 * (r >> 2); \
          const int d0_ = kc0 - lo_; \
          const int i0_ = ((unsigned)d0_ < wd_) ? bb + kc0 * mul_ : -1, i1_ = ((unsigned)(d0_ + 32) < wd_) ? bb + (kc0 + 32) * mul_ : -1; \
          const float b0_ = btab[max(i0_, 0)], b1_ = btab[max(i1_, 0)]; \
          P0[r] = (i0_ >= 0) ? P0[r] + b0_ : -INFINITY; P1[r] = (i1_ >= 0) ? P1[r] + b1_ : -INFINITY; } \
        SBAR(); } } } while (0)
  bool resc = false;
#define START(P0, P1) do { const float rm = rowmax(P0, P1); resc = false; \
    { const float dl = rm; mhat = fadd_s(mhat, dl); \
      _Pragma("unroll") for (int r = 0; r < 16; ++r) { P0[r] = fsub_s(P0[r], dl); P1[r] = fsub_s(P1[r], dl); } \
      if (MODE == 0) { _Pragma("unroll") for (int r = 0; r < 16; ++r) zacc[r] = -mhat; asm volatile("" : "+v"(zacc)); } } \
    _Pragma("unroll") for (int r = 0; r < 16; ++r) P0[r] = __builtin_amdgcn_exp2f(P0[r]); } while (0)
#define RESC() do { if (resc) { asm volatile("s_waitcnt lgkmcnt(0)" ::: "memory"); \
      _Pragma("unroll") for (int d_ = 0; d_ < 2; ++d_) _Pragma("unroll") for (int r = 0; r < 16; ++r) o[d_][r] *= wsf[crow(r, hi)]; } } while (0)
  f32x16 pA0, pA1, pB0, pB1;
  int sl_prev = 0, sl_cur = 0, sl_next = SLOTB;
#define ROT() do { sl_prev = sl_cur; sl_cur = sl_next; sl_next = (sl_next == (NSLOT - 1) * SLOTB) ? 0 : sl_next + SLOTB; } while (0)
  DMA_K(2, 2 * SLOTB);
  WAIT_BAR(3);
  qkt(pA0, pA1, Kbase, qr, r32, hi); asm volatile("s_nop 15\n\ts_nop 7" : "+v"(pA0), "+v"(pA1)); CMASK(pA0, pA1, 0);
  START(pA0, pA1);
  _Pragma("unroll") for (int r = 0; r < 16; ++r) pA1[r] = __builtin_amdgcn_exp2f(pA1[r]);
  WAIT_BAR(0);
  DMA_K(3, 0); DMA_V(1, SLOTB);
  ROT();
  kload8(kf, kp0 + sl_cur);
  WAIT_BAR(2);
  s16x4 vlo[8], vhi[8]; u32x4 pw0, pw1, pw2, pw3;
#define PKW(P, B) cvtpk_s(P[B], P[B + 1])
#define PAF(k) __builtin_bit_cast(bf16x8, pw##k)
#define VFR(i) (bf16x8){vlo[i][0], vlo[i][1], vlo[i][2], vlo[i][3], vhi[i][0], vhi[i][1], vhi[i][2], vhi[i][3]}
#define PIN(x) asm volatile("" : "+v"(x))
#define MX3(a, b, c) __builtin_fmaxf(__builtin_fmaxf((a), (b)), (c))
#define GAPA(MF, A0, A1, A2, A3, W0, W1, PW) do { MF; sacc += A0; sacc += A1; sacc += A2; sacc += A3; PIN(sacc); W0; W1; PIN(PW); SBAR(); } while (0)
#define EX(v) __builtin_amdgcn_exp2f(v)
#define GAPB(MF, X, B) do { MF; X[B] = EX(X[B]); X[B + 1] = EX(X[B + 1]); X[B + 2] = EX(X[B + 2]); X[B + 3] = EX(X[B + 3]); PIN(X); SBAR(); } while (0)
#define VRD(i) do { vlo[i] = vtr(vp_ + (((i) >> 2) * 4096 + ((i) & 3) * 1024)); vhi[i] = vtr(vp_ + (((i) >> 2) * 4096 + ((i) & 3) * 1024 + 512)); } while (0)
#define KRD(G, j) do { if (G) { kload2(kf, kp0 + sl_next, j); SBAR(); } } while (0)
#define STEP(C0, C1, P0, P1, t, GK, GV, GL) do { SBAR(); \
    const lds_cptr vp_ = vp0 + sl_prev; \
    VRD(0); SBAR(); float sacc = (P0[0] + P0[1]); \
    GAPA(C0 = __builtin_amdgcn_mfma_f32_32x32x16_bf16(kf[0], qr[0], zacc, 0, 0, 0), P0[2], P0[3], P0[4], P0[5],     pw0[0] = PKW(P0, 0), pw0[1] = PKW(P0, 2), pw0); \
    VRD(4); SBAR(); GAPA(C1 = __builtin_amdgcn_mfma_f32_32x32x16_bf16(kf[1], qr[0], zacc, 0, 0, 0), P0[6], P0[7], P0[8], P0[9],     pw0[2] = PKW(P0, 4), pw0[3] = PKW(P0, 6), pw0); \
    VRD(1); SBAR(); GAPA(C0 = __builtin_amdgcn_mfma_f32_32x32x16_bf16(kf[2], qr[1], C0, 0, 0, 0),   P0[10], P0[11], P0[12], P0[13], pw1[0] = PKW(P0, 8), pw1[1] = PKW(P0, 10), pw1); \
    VRD(5); SBAR(); GAPA(C1 = __builtin_amdgcn_mfma_f32_32x32x16_bf16(kf[3], qr[1], C1, 0, 0, 0),   P0[14], P0[15], P1[0], P1[1],   pw1[2] = PKW(P0, 12), pw1[3] = PKW(P0, 14), pw1); \
    VRD(2); SBAR(); GAPA(C0 = __builtin_amdgcn_mfma_f32_32x32x16_bf16(kf[4], qr[2], C0, 0, 0, 0),   P1[2], P1[3], P1[4], P1[5],     pw2[0] = PKW(P1, 0), pw2[1] = PKW(P1, 2), pw2); \
    VRD(6); SBAR(); GAPA(C1 = __builtin_amdgcn_mfma_f32_32x32x16_bf16(kf[5], qr[2], C1, 0, 0, 0),   P1[6], P1[7], P1[8], P1[9],     pw2[2] = PKW(P1, 4), pw2[3] = PKW(P1, 6), pw2); \
    VRD(3); SBAR(); GAPA(C0 = __builtin_amdgcn_mfma_f32_32x32x16_bf16(kf[6], qr[3], C0, 0, 0, 0),   P1[10], P1[11], P1[12], P1[13], pw3[0] = PKW(P1, 8), pw3[1] = PKW(P1, 10), pw3); \
    VRD(7); SBAR(); GAPA(C1 = __builtin_amdgcn_mfma_f32_32x32x16_bf16(kf[7], qr[3], C1, 0, 0, 0),   P1[14], P1[15], 0.f, 0.f,       pw3[2] = PKW(P1, 12), pw3[3] = PKW(P1, 14), pw3); \
    l_reg += sacc; \
    if (GK) { DMA_K((t) + 3, sl_cur); } if (GV) { DMA_V((t) + 1, sl_next); } \
    if (MODE == 1) { _Pragma("unroll") for (int r = 0; r < 16; ++r) { C0[r] -= mhat; C1[r] -= mhat; } } \
    CMASK(C0, C1, t); \
    { float a = MX3(C0[0], C0[1], C1[0]), b = MX3(C0[2], C0[3], C1[1]); a = MX3(a, C1[2], C1[3]); \
      _Pragma("unroll") for (int r = 4; r < 16; r += 4) { a = MX3(a, C0[r], C0[r + 1]); b = MX3(b, C0[r + 2], C0[r + 3]); a = MX3(a, C1[r], C1[r + 1]); b = MX3(b, C1[r + 2], C1[r + 3]); } \
      float rm = __builtin_fmaxf(a, b); { auto rr = __builtin_amdgcn_permlane32_swap(__float_as_uint(rm), __float_as_uint(rm), false, false); rm = __builtin_fmaxf(__uint_as_float(rr[0]), __uint_as_float(rr[1])); } \
      resc = false; \
      if (__builtin_expect(__any(rm > (float)THRL), 0)) { const float dl = __builtin_fmaxf(rm, 0.f); mhat += dl; \
        _Pragma("unroll") for (int r = 0; r < 16; ++r) { C0[r] -= dl; C1[r] -= dl; } \
        if (MODE == 0) { _Pragma("unroll") for (int r = 0; r < 16; ++r) zacc[r] = -mhat; asm volatile("" : "+v"(zacc)); } \
        const float f = __builtin_amdgcn_exp2f(-dl); l_reg *= f; if (hi == 0) wsf[r32] = f; resc = true; } } \
    SBAR(); \
    GAPB(o[0] = __builtin_amdgcn_mfma_f32_32x32x16_bf16(PAF(0), VFR(0), o[0], 0, 0, 0), C0, 0); \
    GAPB(o[1] = __builtin_amdgcn_mfma_f32_32x32x16_bf16(PAF(0), VFR(4), o[1], 0, 0, 0), C0, 4); \
    KRD(GL, 0); GAPB(o[0] = __builtin_amdgcn_mfma_f32_32x32x16_bf16(PAF(1), VFR(1), o[0], 0, 0, 0), C0, 8); \
    KRD(GL, 1); GAPB(o[1] = __builtin_amdgcn_mfma_f32_32x32x16_bf16(PAF(1), VFR(5), o[1], 0, 0, 0), C0, 12); \
    KRD(GL, 2); GAPB(o[0] = __builtin_amdgcn_mfma_f32_32x32x16_bf16(PAF(2), VFR(2), o[0], 0, 0, 0), C1, 0); \
    KRD(GL, 3); GAPB(o[1] = __builtin_amdgcn_mfma_f32_32x32x16_bf16(PAF(2), VFR(6), o[1], 0, 0, 0), C1, 4); \
    GAPB(o[0] = __builtin_amdgcn_mfma_f32_32x32x16_bf16(PAF(3), VFR(3), o[0], 0, 0, 0), C1, 8); \
    GAPB(o[1] = __builtin_amdgcn_mfma_f32_32x32x16_bf16(PAF(3), VFR(7), o[1], 0, 0, 0), C1, 12); \
    } while (0)
  int t = 1;
  for (; t + 5 < NT; t += 2) {
    STEP(pB0, pB1, pA0, pA1, t, true, true, true);     WAIT_BAR(2); RESC(); ROT();
    STEP(pA0, pA1, pB0, pB1, t + 1, true, true, true); WAIT_BAR(2); RESC(); ROT();
  }
#define ENDW(tt) do { if ((tt) + 3 < NT) { WAIT_BAR(2); } else if ((tt) + 2 < NT) { WAIT_BAR(1); } else { WAIT_BAR(0); } } while (0)
  for (; t + 1 < NT; t += 2) {
    STEP(pB0, pB1, pA0, pA1, t, (t + 3 < NT), (t + 1 < NT), (t + 1 < NT));         ENDW(t);     RESC(); ROT();
    STEP(pA0, pA1, pB0, pB1, t + 1, (t + 4 < NT), (t + 2 < NT), (t + 2 < NT));     ENDW(t + 1); RESC(); ROT();
  }
  STEP(pB0, pB1, pA0, pA1, NT - 1, false, false, false); RESC();
  { float sacc = pB0[0] + pB0[1]; _Pragma("unroll") for (int r = 2; r < 16; ++r) sacc += pB0[r]; _Pragma("unroll") for (int r = 0; r < 16; ++r) sacc += pB1[r]; l_reg += sacc;
    pw0 = (u32x4){PKW(pB0, 0), PKW(pB0, 2), PKW(pB0, 4), PKW(pB0, 6)}; pw1 = (u32x4){PKW(pB0, 8), PKW(pB0, 10), PKW(pB0, 12), PKW(pB0, 14)}; pw2 = (u32x4){PKW(pB1, 0), PKW(pB1, 2), PKW(pB1, 4), PKW(pB1, 6)}; pw3 = (u32x4){PKW(pB1, 8), PKW(pB1, 10), PKW(pB1, 12), PKW(pB1, 14)};
    SBAR(); pv(o, vb0 + sl_cur, PAF(0), PAF(1), PAF(2), PAF(3)); }
#undef PKW
#undef PAF
#undef VFR
#undef PIN
#undef MX3
#undef GAPA
#undef GAPB
#undef EX
#undef VRD
#undef KRD
#undef STEP
#undef ENDW
  { auto rr = __builtin_amdgcn_permlane32_swap(__float_as_uint(l_reg), __float_as_uint(l_reg), false, false); l_reg = __uint_as_float(rr[0]) + __uint_as_float(rr[1]); }
  if (hi == 0) wsf[32 + r32] = l_reg; asm volatile("s_waitcnt lgkmcnt(0)" ::: "memory");
  float rli[16];
#pragma unroll
  for (int r = 0; r < 16; ++r) rli[r] = __builtin_amdgcn_rcpf(wsf[32 + crow(r, hi)]);
  bf16_t* Ow = Ow0 + (long)(wid * QBLK) * OP;
  { __hip_bfloat16* stg = (__hip_bfloat16*)(shm + LDS_OST) + wid * 2048;
#pragma unroll
    for (int r = 0; r < 16; ++r) { const int orow = crow(r, hi);
#pragma unroll
      for (int d0 = 0; d0 < 2; ++d0) stg[orow * 64 + d0 * 32 + r32] = __float2bfloat16(o[d0][r] * rli[r]); }
    asm volatile("s_waitcnt lgkmcnt(0)" ::: "memory");
#pragma unroll
    for (int i = 0; i < 4; ++i) { const int row = i * 8 + (lane >> 3), ch = lane & 7; const u32x4 v = *(const u32x4*)(stg + row * 64 + ch * 8); *(u32x4*)(Ow + (long)row * OP + ch * 8) = v; } }
  asm volatile("s_waitcnt lgkmcnt(0)\n\ts_barrier" ::: "memory");
#undef DMA_K
#undef DMA_V
#undef TROW
#undef CMASK
#undef START
#undef RESC
#undef ROT
}
#undef SBAR
#undef WAIT_BAR
}

struct Args {
  const float* in[33];
  float* out; unsigned char* ws;
  int ph_lo, ph_hi;
};
enum { I_X = 0, I_C, I_CTX, I_CCTX, I_ADAW, I_ADAB, I_NMIXPRE, I_NMIXPOST, I_NFFNPRE, I_NFFNPOST, I_WIN, I_CONVA, I_NABIAS, I_QNORM, I_KNORM,
       I_MU, I_W0, I_W2, I_A0, I_A2, I_KK, I_KA, I_RK, I_G2, I_LNW, I_LNB, I_WBR, I_WGATE, I_BGATE, I_WO, I_FUP, I_FCONV, I_FDN };

DI void transpose_item(const float* W, int N, bf16_t* WT, int ld, int koff, int mode, LAS float* scr, int item, int lane) {
  const int nblk = N / 32, kb = item / nblk, nb = item % nblk, k0 = 64 * kb, n0 = 32 * nb;
#pragma unroll 8
  for (int i = 0; i < 32; ++i) { const int kk = 2 * i + (lane >> 5); scr[kk * 33 + (lane & 31)] = W[(size_t)(k0 + kk) * N + n0 + (lane & 31)]; }
  asm volatile("s_waitcnt lgkmcnt(0)" ::: "memory");
  const int c = lane & 7;
#pragma unroll
  for (int j = 0; j < 4; ++j) { const int n = (lane >> 3) + 8 * j; const LAS float* s = scr + (8 * c) * 33 + n;
    int nn = n0 + n;
    if (mode == 1) nn = (nn < DFF) ? (256 * (nn >> 7) + (nn & 127)) : (256 * ((nn - DFF) >> 7) + 128 + ((nn - DFF) & 127));
    if (mode == 2) { const int i = nn >> 10, cc = nn & 1023, c64 = cc & 63;
      nn = ((cc >> 6) * 256) + 128 * (i >> 1) + 32 * (c64 >> 4) + 8 * ((c64 >> 2) & 3) + 4 * (i & 1) + (c64 & 3); }
    u32x4 o; o.x = cvtpk(s[0 * 33], s[1 * 33]); o.y = cvtpk(s[2 * 33], s[3 * 33]); o.z = cvtpk(s[4 * 33], s[5 * 33]); o.w = cvtpk(s[6 * 33], s[7 * 33]);
    *(u32x4*)(WT + (size_t)nn * ld + koff + k0 + 8 * c) = o; }
  asm volatile("s_waitcnt lgkmcnt(0)" ::: "memory");
}
DI void convert_weights(const CAS4 Args& A, int l, LAS unsigned char* lds, int gw, int NGW, int wave, int lane) {
  LAS float* scr = (LAS float*)(lds + wave * 8704);
  unsigned char* wb = A.ws + WS_W;
  constexpr int I_IN_ = 16 * 96, I_G = 16 * 128, I_B = 4 * 4 * 32, I_O_ = 16 * 32, I_U = 16 * 176, I_D = 44 * 32;
  constexpr int NIT = I_IN_ + I_G + I_B + I_O_ + I_U + I_D;
  for (int it = gw; it < NIT; it += NGW) {
    int r = it;
    if (r < I_IN_) { transpose_item(A.in[I_WIN] + (size_t)l * 1024 * 3072, 3072, (bf16_t*)(wb + W_IN), 1024, 0, 0, scr, r, lane); continue; } r -= I_IN_;
    if (r < I_G) { transpose_item(A.in[I_WGATE] + (size_t)l * 1024 * 4096, 4096, (bf16_t*)(wb + W_GATE), 1024, 0, 2, scr, r, lane); continue; } r -= I_G;
    if (r < I_B) { const int br = r / 128; transpose_item(A.in[I_WBR] + ((size_t)l * 4 + br) * 256 * 1024, 1024, (bf16_t*)(wb + W_BR), 1024, br * 256, 0, scr, r % 128, lane); continue; } r -= I_B;
    if (r < I_O_) { transpose_item(A.in[I_WO] + (size_t)l * 1024 * 1024, 1024, (bf16_t*)(wb + W_O), 1024, 0, 0, scr, r, lane); continue; } r -= I_O_;
    if (r < I_U) { transpose_item(A.in[I_FUP] + (size_t)l * 1024 * 5632, 5632, (bf16_t*)(wb + W_UP), 1024, 0, 1, scr, r, lane); continue; } r -= I_U;
    transpose_item(A.in[I_FDN] + (size_t)l * 2816 * 1024, 1024, (bf16_t*)(wb + W_DN), 2816, 0, 0, scr, r, lane);
  }
}

DI void row_phase(const float* xold, float* xdst, const bf16_t* src, const float* gate, const float* gpost,
                  bf16_t* hout, const float* gnext, const float* sh, const float* sc, int lane) {
  f32x4 v[4];
#pragma unroll
  for (int j = 0; j < 4; ++j) v[j] = ((const f32x4*)xold)[lane + 64 * j];
  if (src) {
    f32x4 s[4]; float ss = 0.f;
#pragma unroll
    for (int j = 0; j < 4; ++j) { const uint2 w = ((const uint2*)src)[lane + 64 * j];
      s[j] = (f32x4){__uint_as_float(w.x << 16), __uint_as_float(w.x & 0xffff0000u), __uint_as_float(w.y << 16), __uint_as_float(w.y & 0xffff0000u)};
      ss += (s[j].x * s[j].x + s[j].y * s[j].y) + (s[j].z * s[j].z + s[j].w * s[j].w); }
    const float rs = __builtin_amdgcn_rsqf(wave_sum(ss, lane) * (1.f / 1024.f) + 1e-6f);
#pragma unroll
    for (int j = 0; j < 4; ++j) { const f32x4 g = ((const f32x4*)gate)[lane + 64 * j], p = ((const f32x4*)gpost)[lane + 64 * j];
      v[j] = v[j] + g * (s[j] * rs * p); ((f32x4*)xdst)[lane + 64 * j] = v[j]; }
  }
  if (hout) {
    float ss = 0.f;
#pragma unroll
    for (int j = 0; j < 4; ++j) ss += (v[j].x * v[j].x + v[j].y * v[j].y) + (v[j].z * v[j].z + v[j].w * v[j].w);
    const float rs = __builtin_amdgcn_rsqf(wave_sum(ss, lane) * (1.f / 1024.f) + 1e-6f);
#pragma unroll
    for (int j = 0; j < 4; ++j) { const f32x4 g = ((const f32x4*)gnext)[lane + 64 * j], a = ((const f32x4*)sh)[lane + 64 * j], b = ((const f32x4*)sc)[lane + 64 * j];
      const f32x4 h = (v[j] * rs * g) * (b + 1.f) + a;
      uint2 w; w.x = cvtpk(h.x, h.y); w.y = cvtpk(h.z, h.w); ((uint2*)hout)[lane + 64 * j] = w; }
  }
}

DI void row_phase_blk(const float* xlat_in, const float* xctx_in, float* xlat_out, float* xctx_out, const bf16_t* srcb,
                      const float* modl, int gate_off, const float* gpost, bf16_t* hb, const float* gnext, const float* modn, int sh_off, int sc_off,
                      int bx, int wave, int lane) {
  const int R0 = bx * 130;
  f32x4 gpv[4], gnv[4], gav[4], shv[4], scv[4];
#pragma unroll
  for (int j = 0; j < 4; ++j) { gpv[j] = ((const f32x4*)gpost)[lane + 64 * j]; gnv[j] = hb ? ((const f32x4*)gnext)[lane + 64 * j] : (f32x4){0.f, 0.f, 0.f, 0.f}; }
  int cur_s = -1;
  f32x4 xv[4], xn[4]; uint2 sv[4], sn[4];
  int row = R0 + wave;
  { const float* xo = (row < NLAT) ? xlat_in + (size_t)row * 1024 : xctx_in + (size_t)(row - NLAT) * 1024;
#pragma unroll
    for (int j = 0; j < 4; ++j) { xv[j] = ((const f32x4*)xo)[lane + 64 * j]; sv[j] = ((const uint2*)(srcb + (size_t)row * 1024))[lane + 64 * j]; } }
  for (; row < R0 + 130; row += 8) {
    const int nrow = row + 8; const bool hn = nrow < R0 + 130;
    if (hn) { const float* xo = (nrow < NLAT) ? xlat_in + (size_t)nrow * 1024 : xctx_in + (size_t)(nrow - NLAT) * 1024;
#pragma unroll
      for (int j = 0; j < 4; ++j) { xn[j] = ((const f32x4*)xo)[lane + 64 * j]; sn[j] = ((const uint2*)(srcb + (size_t)nrow * 1024))[lane + 64 * j]; } }
    const int s = (row < NLAT) ? (row >> 14) : 2;
    if (s != cur_s) { cur_s = s; const float* md = modl + (size_t)s * 6144; const float* mn = modn + (size_t)s * 6144;
#pragma unroll
      for (int j = 0; j < 4; ++j) { gav[j] = ((const f32x4*)(md + gate_off))[lane + 64 * j];
        shv[j] = hb ? ((const f32x4*)(mn + sh_off))[lane + 64 * j] : (f32x4){0.f, 0.f, 0.f, 0.f}; scv[j] = hb ? ((const f32x4*)(mn + sc_off))[lane + 64 * j] : (f32x4){0.f, 0.f, 0.f, 0.f}; } }
    f32x4 sf[4]; float ss = 0.f;
#pragma unroll
    for (int j = 0; j < 4; ++j) { const uint2 w = sv[j];
      sf[j] = (f32x4){__uint_as_float(w.x << 16), __uint_as_float(w.x & 0xffff0000u), __uint_as_float(w.y << 16), __uint_as_float(w.y & 0xffff0000u)};
      ss += (sf[j].x * sf[j].x + sf[j].y * sf[j].y) + (sf[j].z * sf[j].z + sf[j].w * sf[j].w); }
    const float rs = __builtin_amdgcn_rsqf(wave_sum(ss, lane) * (1.f / 1024.f) + 1e-6f);
    float* xd = (row < NLAT) ? xlat_out + (size_t)row * 1024 : xctx_out + (size_t)(row - NLAT) * 1024;
    float s2 = 0.f;
#pragma unroll
    for (int j = 0; j < 4; ++j) { xv[j] = xv[j] + gav[j] * (sf[j] * rs * gpv[j]); ((f32x4*)xd)[lane + 64 * j] = xv[j];
      s2 += (xv[j].x * xv[j].x + xv[j].y * xv[j].y) + (xv[j].z * xv[j].z + xv[j].w * xv[j].w); }
    if (hb) {
      const float r2 = __builtin_amdgcn_rsqf(wave_sum(s2, lane) * (1.f / 1024.f) + 1e-6f);
#pragma unroll
      for (int j = 0; j < 4; ++j) { const f32x4 h = (xv[j] * r2 * gnv[j]) * (scv[j] + 1.f) + shv[j];
        uint2 w; w.x = cvtpk(h.x, h.y); w.y = cvtpk(h.z, h.w); ((uint2*)(hb + (size_t)row * 1024))[lane + 64 * j] = w; }
    }
#pragma unroll
    for (int j = 0; j < 4; ++j) { xv[j] = xn[j]; sv[j] = sn[j]; }
  }
}

__global__ void __launch_bounds__(NTHREADS, 2) fwd_megakernel(Args A_) {
  extern __shared__ __attribute__((aligned(16))) unsigned char lds_raw[];
  LAS unsigned char* lds = (LAS unsigned char*)lds_raw;
  const int wave0_ = __builtin_amdgcn_readfirstlane((int)threadIdx.x >> 6);
  const int G = gridDim.x, bx = blockIdx.x;
  const int NGW = G * 8;
  const int lo = A_.ph_lo, hi = A_.ph_hi;
  if (hi < 0) cg::this_grid().sync();
  int ph = 0, nbar_ = 0;
#ifndef NBARX
#define NBARX 1
#endif
#ifndef SKIPMASK
#define SKIPMASK 0
#endif
#ifndef REPMASK
#define REPMASK 0
#endif
#define PHASE_BEGIN(id) if (ph >= lo && ph < hi && !((SKIPMASK >> (id)) & 1)) for (int rep_ = 0; rep_ < ((((REPMASK) >> (id)) & 1) ? 2 : 1); ++rep_) { const CAS4 Args* Ap_ = (const CAS4 Args*)__builtin_amdgcn_kernarg_segment_ptr(); asm volatile("" : "+s"(Ap_)); const CAS4 Args& A = *Ap_; \
  unsigned char* ws = A.ws; unsigned* ctl = (unsigned*)(ws + WS_CTL); float* MOD = (float*)(ws + WS_MOD); float* XC = (float*)(ws + WS_XC); float* BONUS = (float*)(ws + WS_BONUS); \
  bf16_t* H = (bf16_t*)(ws + WS_H); bf16_t* Z = (bf16_t*)(ws + WS_Z); bf16_t* YS = (bf16_t*)(ws + WS_YS); bf16_t* WAE = (bf16_t*)(ws + WS_WA); bf16_t* WAA = WAE + (size_t)2 * NROW * 256; float* YSC = (float*)(ws + WS_YSC); \
  (void)ctl; (void)MOD; (void)XC; (void)BONUS; (void)H; (void)Z; (void)YS; (void)WAE; (void)WAA; (void)YSC; \
  int tid; asm volatile("v_mbcnt_lo_u32_b32 %0, -1, 0\n\tv_mbcnt_hi_u32_b32 %0, -1, %0" : "=v"(tid)); tid += wave0_ * 64; const int lane = tid & 63, wave = __builtin_amdgcn_readfirstlane(tid >> 6); const int gw = bx * 8 + wave; (void)lane; (void)gw;
#define FRESH_TID(v) int v; asm volatile("v_mbcnt_lo_u32_b32 %0, -1, 0\n\tv_mbcnt_hi_u32_b32 %0, -1, %0" : "=v"(v)); v += wave0_ * 64;
#define PHASE_END } if (ph >= lo && ph + 1 < hi) { FRESH_TID(tb_) const CAS4 Args* Ab_ = (const CAS4 Args*)__builtin_amdgcn_kernarg_segment_ptr(); asm volatile("" : "+s"(Ab_)); for (int bi_ = 0; bi_ < NBARX; ++bi_) { ++nbar_; grid_barrier((unsigned*)(Ab_->ws + WS_CTL), (unsigned)nbar_ * (unsigned)G, tb_); } } ++ph;

  PHASE_BEGIN(0)
    {
      LAS float* sl = (LAS float*)(lds + 72 * 1024);
      for (int i = tid; i < 3 * 1024; i += NTHREADS) { const int s = i >> 10, k = i & 1023;
        const float c = (s < 2) ? A.in[I_C][s * 1024 + k] : A.in[I_CCTX][k]; sl[i] = c * sigmoidf_(c); }
      __syncthreads();
      LAS float* red = (LAS float*)(lds + 88 * 1024);
      for (int it = bx; it < NLAYER * 96; it += G) {
        const int l = it / 96, c0 = (it % 96) * 64;
        const float* wp = A.in[I_ADAW] + (size_t)l * 1024 * 6144 + c0 + lane;
        float a0 = 0.f, a1 = 0.f, a2 = 0.f;
        for (int k = wave * 128; k < wave * 128 + 128; ++k) { const float w = wp[(size_t)k * 6144]; a0 += sl[k] * w; a1 += sl[1024 + k] * w; a2 += sl[2048 + k] * w; }
        red[(wave * 3 + 0) * 64 + lane] = a0; red[(wave * 3 + 1) * 64 + lane] = a1; red[(wave * 3 + 2) * 64 + lane] = a2;
        __syncthreads();
        if (tid < 192) { const int s = tid >> 6, ln = tid & 63; float r = A.in[I_ADAB][l * 6144 + c0 + ln];
          for (int w = 0; w < 8; ++w) r += red[(w * 3 + s) * 64 + ln];
          MOD[((size_t)(l * 3 + s)) * 6144 + c0 + ln] = r; }
        __syncthreads();
      }
    }
    convert_weights(A, 0, lds, gw, NGW, wave, lane);
  PHASE_END

  PHASE_BEGIN(1)
    for (int row = gw; row < NROW; row += NGW) {
      const int s = (row < NLAT) ? (row >> 14) : 2;
      const float* xo = (row < NLAT) ? A.in[I_X] + (size_t)row * 1024 : A.in[I_CTX] + (size_t)(row - NLAT) * 1024;
      const float* md = MOD + (size_t)(0 * 3 + s) * 6144;
      row_phase(xo, nullptr, nullptr, nullptr, nullptr, H + (size_t)row * 1024, A.in[I_NMIXPRE], md, md + 1024, lane);
    }
  PHASE_END

  for (int l = 0; l < NLAYER; ++l) {
    PHASE_BEGIN(2)
      pg8::Gemm g{(const char*)ws, 1024, 1024};
      pg8::SchedPlain S{130, 5, G, bx, 16, (long)WS_H, (long)(WS_W + W_IN), 1024, 1024, 7};
      pg8::EpiStore E{Z, DIN};
      pg8::gemm_phase<pg8::EpiStore, pg8::SchedPlain, false>(lds, g, S, E, tid);
    PHASE_END

    PHASE_BEGIN(3)
      {
        FRESH_TID(tid)
        const int ln = tid & 63, wv = __builtin_amdgcn_readfirstlane(tid >> 6), d = wv >> 2, nq = wv & 3, r32 = ln & 31, hi = ln >> 5;
        LAS unsigned char* AT = lds;
        const float* mu = A.in[I_MU] + (size_t)l * 2 * 896;
        bf16x8 Bf[2][2][4]; float bias0[2], bias1[2];
#pragma unroll
        for (int nt = 0; nt < 2; ++nt) {
          const int c = 64 * nq + 32 * nt + r32;
          bias0[nt] = A.in[I_W0][(l * 2 + d) * 256 + c]; bias1[nt] = A.in[I_A0][(l * 2 + d) * 256 + c];
#pragma unroll
          for (int ks = 0; ks < 4; ++ks) { float f0[8], f1[8];
#pragma unroll
            for (int i = 0; i < 8; ++i) { const size_t o = ((size_t)(l * 2 + d) * 64 + 16 * ks + 8 * hi + i) * 256 + c; f0[i] = A.in[I_W2][o]; f1[i] = A.in[I_A2][o]; }
            Bf[0][nt][ks] = __builtin_bit_cast(bf16x8, pack8(f0)); Bf[1][nt][ks] = __builtin_bit_cast(bf16x8, pack8(f1)); }
        }
        for (int tile = bx; tile < 520; tile += G) {
          const int R0 = tile * 64;
          __syncthreads();
          for (int i = tid; i < 2 * 64 * 16; i += NTHREADS) {
            const int dd = i >> 10, rem = i & 1023, r = rem >> 4, j8 = (rem & 15) * 8, row = R0 + r; int t, len; row_seq(row, t, len);
            const int nb = dd ? t + 1 : t - 1; const bool nv = (nb >= 0) && (nb < len);
            float zc[8], zn[8];
            unpack8(*(const u32x4*)(Z + (size_t)row * DIN + C_LW + j8), zc);
            if (nv) unpack8(*(const u32x4*)(Z + (size_t)(row + (dd ? 1 : -1)) * DIN + C_LW + j8), zn);
            else {
#pragma unroll
              for (int e = 0; e < 8; ++e) zn[e] = 0.f; }
            const f32x4 m0 = *(const f32x4*)(mu + dd * 896 + 768 + j8), m1 = *(const f32x4*)(mu + dd * 896 + 768 + j8 + 4);
            float v[8];
#pragma unroll
            for (int e = 0; e < 8; ++e) { v[e] = zc[e] + (e < 4 ? m0[e] : m1[e - 4]) * (zn[e] - zc[e]); if (j8 < 64) v[e] = 1.f - 2.f * __builtin_amdgcn_rcpf(__builtin_amdgcn_exp2f(2.8853900817779268f * v[e]) + 1.f); }
            *(LAS u32x4*)(AT + ((dd * 2 + (j8 >> 6)) * 64 + r) * 144 + (j8 & 63) * 2) = pack8(v);
          }
          __syncthreads();
          f32x16 acc[2][2][2];
#pragma unroll
          for (int m = 0; m < 2; ++m)
#pragma unroll
            for (int mt = 0; mt < 2; ++mt)
#pragma unroll
              for (int nt = 0; nt < 2; ++nt) acc[m][mt][nt] = f32x16{};
#pragma unroll
          for (int m = 0; m < 2; ++m)
#pragma unroll
            for (int mt = 0; mt < 2; ++mt)
#pragma unroll
              for (int ks = 0; ks < 4; ++ks) {
                const bf16x8 af = *(const LAS bf16x8*)(AT + ((d * 2 + m) * 64 + 32 * mt + r32) * 144 + (16 * ks + 8 * hi) * 2);
#pragma unroll
                for (int nt = 0; nt < 2; ++nt) acc[m][mt][nt] = __builtin_amdgcn_mfma_f32_32x32x16_bf16(af, Bf[m][nt][ks], acc[m][mt][nt], 0, 0, 0);
              }
#pragma unroll
          for (int mt = 0; mt < 2; ++mt)
#pragma unroll
            for (int nt = 0; nt < 2; ++nt) {
              const int c = 64 * nq + 32 * nt + r32;
#pragma unroll
              for (int r = 0; r < 16; ++r) {
                const int row = R0 + 32 * mt + (r & 3) + 8 * (r >> 2) + 4 * hi;
                const float aw = acc[0][mt][nt][r] + bias0[nt], aa = acc[1][mt][nt][r] + bias1[nt];
                const float xx = -aw; const float sp = fmaxf(xx, 0.f) + __logf(1.f + __expf(-fabsf(xx)));
                const float e = -__expf(-sp - 0.5f);
                const float av = sigmoidf_(aa);
                const size_t o = ((size_t)d * NROW + row) * 256 + c;
                WAE[o] = (bf16_t)(cvtpk(e, 0.f) & 0xffffu); WAA[o] = (bf16_t)(cvtpk(av, 0.f) & 0xffffu);
              }
            }
        }
        __syncthreads();
      }
    PHASE_END

    PHASE_BEGIN(4)
#ifndef NO_SCAN
#ifndef REP_SCAN
#define REP_SCAN 1
#endif
#ifndef REP_ATTN
#define REP_ATTN 1
#endif
      if (bx < 64 && (rep_ == 0 || REP_SCAN)) {
        const int sb = bx, s = sb >> 2, qd = sb & 3, d = s >> 3, b = (s >> 2) & 1, hh = s & 3;
        LAS float* buf = (LAS float*)lds;
        float muR[8], muK[8], muV[8], kkc[8], kac[8], rkc[8];
        const int ptid = tid & 255, ts = (ptid >> 3) & 31, cgp = ptid & 7, ch0 = hh * 64 + 8 * cgp;
        {
#pragma unroll
          for (int i = 0; i < 8; ++i) { const float* mu = A.in[I_MU] + (size_t)(l * 2 + d) * 896;
            muR[i] = mu[ch0 + i]; muK[i] = mu[256 + ch0 + i]; muV[i] = mu[512 + ch0 + i];
            kkc[i] = A.in[I_KK][l * 256 + ch0 + i]; kac[i] = A.in[I_KA][l * 256 + ch0 + i]; rkc[i] = A.in[I_RK][l * 256 + ch0 + i]; }
        }
        const int rsub = lane >> 4, kg = lane & 15, vrow = 16 * qd + 4 * (wave & 3) + rsub;
#define SCAN_RLO(cc) (((cc) < 8) ? (NLAT + b * CTXL + (d ? 224 - 32 * (cc) : 32 * (cc))) : (b * TLAT + (d ? 16352 - 32 * ((cc) - 8) : 32 * ((cc) - 8))))
        const unsigned ro = (unsigned)(d ? 31 - ts : ts);
        const unsigned offz = ro * DIN + ch0, offw = ro * 256 + ch0;
        const unsigned roy = (unsigned)(d ? 31 - (ptid >> 3) : (ptid >> 3)), offy = roy * 256 + hh * 64 + 16 * qd + (ptid & 7) * 2;
#define SCAN_LOAD(cc, X) do { const int rlo_ = SCAN_RLO(cc); const bool nv = !((((cc) == 0) || ((cc) == 8)) && ts == 0); \
          const bf16_t* zb = Z + (size_t)rlo_ * DIN; const bf16_t* znb = zb + (d ? DIN : -DIN); const u32x4 z4 = (u32x4){0u, 0u, 0u, 0u}; \
          X[0] = *(const u32x4*)(zb + (offz + C_RR)); X[1] = *(const u32x4*)(zb + (offz + C_RK)); X[2] = *(const u32x4*)(zb + (offz + C_RV)); \
          X[3] = nv ? *(const u32x4*)(znb + (offz + C_RR)) : z4; X[4] = nv ? *(const u32x4*)(znb + (offz + C_RK)) : z4; X[5] = nv ? *(const u32x4*)(znb + (offz + C_RV)) : z4; \
          const bf16_t* wb_ = WAE + ((size_t)d * NROW + rlo_) * 256; const bf16_t* ab_ = WAA + ((size_t)d * NROW + rlo_) * 256; \
          X[6] = *(const u32x4*)(wb_ + offw); X[7] = *(const u32x4*)(ab_ + offw); } while (0)
#define SCAN_PREP(cc, X) do { const int rlo_ = SCAN_RLO(cc); \
          float r8[8], k8[8], v8[8], rn[8], kn[8], vn[8], e8[8], a8[8]; \
          unpack8(X[0], r8); unpack8(X[1], k8); unpack8(X[2], v8); unpack8(X[3], rn); unpack8(X[4], kn); unpack8(X[5], vn); unpack8(X[6], e8); unpack8(X[7], a8); \
          float kkv[8], ssq = 0.f, bsum = 0.f; \
          _Pragma("unroll") for (int i = 0; i < 8; ++i) { r8[i] += muR[i] * (rn[i] - r8[i]); k8[i] += muK[i] * (kn[i] - k8[i]); v8[i] += muV[i] * (vn[i] - v8[i]); \
            kkv[i] = k8[i] * kkc[i]; ssq += kkv[i] * kkv[i]; } \
          ssq = red8(ssq); \
          const float inv = __builtin_amdgcn_rsqf(fmaxf(ssq, 1e-24f)); \
          float wv[8], bb[8], kp[8]; \
          _Pragma("unroll") for (int i = 0; i < 8; ++i) { kkv[i] *= inv; kp[i] = k8[i] * (1.f + (a8[i] - 1.f) * kac[i]); bb[i] = kkv[i] * a8[i]; wv[i] = __expf(e8[i]); bsum += r8[i] * kp[i] * rkc[i]; } \
          bsum = red8(bsum); \
          if (qd == 0 && cgp == 0) (BONUS + ((size_t)d * NROW + rlo_) * 4)[ro * 4 + hh] = bsum; \
          LAS float* db = buf + ((cc) & 1) * (6 * 32 * 64) + ts * 64 + 8 * cgp; \
          *(LAS f32x4*)(db + 0 * 2048) = (f32x4){wv[0], wv[1], wv[2], wv[3]}; *(LAS f32x4*)(db + 0 * 2048 + 4) = (f32x4){wv[4], wv[5], wv[6], wv[7]}; \
          *(LAS f32x4*)(db + 1 * 2048) = (f32x4){kkv[0], kkv[1], kkv[2], kkv[3]}; *(LAS f32x4*)(db + 1 * 2048 + 4) = (f32x4){kkv[4], kkv[5], kkv[6], kkv[7]}; \
          *(LAS f32x4*)(db + 2 * 2048) = (f32x4){bb[0], bb[1], bb[2], bb[3]}; *(LAS f32x4*)(db + 2 * 2048 + 4) = (f32x4){bb[4], bb[5], bb[6], bb[7]}; \
          *(LAS f32x4*)(db + 3 * 2048) = (f32x4){kp[0], kp[1], kp[2], kp[3]}; *(LAS f32x4*)(db + 3 * 2048 + 4) = (f32x4){kp[4], kp[5], kp[6], kp[7]}; \
          *(LAS f32x4*)(db + 4 * 2048) = (f32x4){r8[0], r8[1], r8[2], r8[3]}; *(LAS f32x4*)(db + 4 * 2048 + 4) = (f32x4){r8[4], r8[5], r8[6], r8[7]}; \
          *(LAS f32x4*)(db + 5 * 2048) = (f32x4){v8[0], v8[1], v8[2], v8[3]}; *(LAS f32x4*)(db + 5 * 2048 + 4) = (f32x4){v8[4], v8[5], v8[6], v8[7]}; \
        } while (0)
#define SCAN_YOUT(cc) do { const int rlo_ = SCAN_RLO(cc); const int step_ = ptid >> 3, r2_ = (ptid & 7) * 2; \
          const LAS f32x4* yp_ = (const LAS f32x4*)(ybuf + ((cc) & 1) * 2048 + step_ * 64 + r2_ * 4); const f32x4 y0_ = yp_[0], y1_ = yp_[1]; \
          const f32x2 yv = (f32x2){(y0_[0] + y0_[1]) + (y0_[2] + y0_[3]), (y1_[0] + y1_[1]) + (y1_[2] + y1_[3])}; \
          *(f32x2*)(YSC + ((size_t)d * NROW + rlo_) * 256 + offy) = yv; } while (0)
        LAS float* ybuf = buf + 2 * 6 * 32 * 64;
        u32x4 RA[8], RB[8];
        __syncthreads();
        SCAN_LOAD(0, RA);
        if (wave >= 4) SCAN_PREP(0, RA);
        SCAN_LOAD(1, RA);
#pragma unroll
        for (int i = 0; i < 8; ++i) RB[i] = RA[i];
        __syncthreads();
        f32x2 Sa = (f32x2){0.f, 0.f}, Sb = (f32x2){0.f, 0.f};
        for (int cc = 0; cc < 520; ++cc) {
          if (wave >= 4) {
            if (cc + 2 < 520) SCAN_LOAD(cc + 2, RB);
            if (cc + 1 < 520) SCAN_PREP(cc + 1, RA);
            if (cc > 0) SCAN_YOUT(cc - 1);
#pragma unroll
            for (int i = 0; i < 8; ++i) RA[i] = RB[i];
          } else {
            const LAS float* sbuf = buf + (cc & 1) * (6 * 32 * 64) + 4 * kg;
            LAS float* yb = ybuf + (cc & 1) * 2048 + (4 * wave + rsub) * 4 + (kg >> 2);
            f32x4 W4 = *(const LAS f32x4*)(sbuf + 0 * 2048), K4 = *(const LAS f32x4*)(sbuf + 1 * 2048), B4 = *(const LAS f32x4*)(sbuf + 2 * 2048),
                  P4 = *(const LAS f32x4*)(sbuf + 3 * 2048), R4 = *(const LAS f32x4*)(sbuf + 4 * 2048);
            float vv = sbuf[5 * 2048 - 4 * kg + vrow];
            f32x4 Rp = R4;
#pragma unroll
            for (int st = 0; st < 32; ++st) {
              const int sn = (st + 1) & 31;
              const LAS float* sp = sbuf + sn * 64;
              const f32x4 W4n = *(const LAS f32x4*)(sp + 0 * 2048), K4n = *(const LAS f32x4*)(sp + 1 * 2048), B4n = *(const LAS f32x4*)(sp + 2 * 2048),
                          P4n = *(const LAS f32x4*)(sp + 3 * 2048), R4n = *(const LAS f32x4*)(sp + 4 * 2048);
              const float vvn = sp[5 * 2048 - 4 * kg + vrow];
              f32x2 p = Sa * (f32x2){K4[0], K4[1]}; p = __builtin_elementwise_fma(Sb, (f32x2){K4[2], K4[3]}, p);
              float sa = p[0] + p[1];
              if (st > 0) {
                f32x2 q = Sa * (f32x2){Rp[0], Rp[1]}; q = __builtin_elementwise_fma(Sb, (f32x2){Rp[2], Rp[3]}, q);
                float yq = q[0] + q[1]; yq += DPPF(yq, 0xB1); yq += DPPF(yq, 0x4E);
                yb[(st - 1) * 64] = yq;
              }
              sa = allreduce16(sa);
              const f32x2 vv2 = (f32x2){vv, vv}, nsa = (f32x2){-sa, -sa};
              f32x2 ta = __builtin_elementwise_fma(nsa, (f32x2){B4[0], B4[1]}, vv2 * (f32x2){P4[0], P4[1]});
              f32x2 tb = __builtin_elementwise_fma(nsa, (f32x2){B4[2], B4[3]}, vv2 * (f32x2){P4[2], P4[3]});
              Sa = __builtin_elementwise_fma(Sa, (f32x2){W4[0], W4[1]}, ta);
              Sb = __builtin_elementwise_fma(Sb, (f32x2){W4[2], W4[3]}, tb);
              Rp = R4;
              W4 = W4n; K4 = K4n; B4 = B4n; P4 = P4n; R4 = R4n; vv = vvn;
            }
            { f32x2 q = Sa * (f32x2){Rp[0], Rp[1]}; q = __builtin_elementwise_fma(Sb, (f32x2){Rp[2], Rp[3]}, q);
              float yq = q[0] + q[1]; yq += DPPF(yq, 0xB1); yq += DPPF(yq, 0x4E);
              yb[31 * 64] = yq; }
          }
          __syncthreads();
        }
        if (wave >= 4) SCAN_YOUT(519);
        __syncthreads();
#undef SCAN_LOAD
#undef SCAN_YOUT
#undef SCAN_PREP
#undef SCAN_RLO
      }
#endif
#ifndef NO_ATTN
      if (bx >= 64) {
        {
          FRESH_TID(tid)
          pg8::Gemm g{(const char*)ws, 1024, 1024};
          pg8::SchedPlain S{130, 7, 192, bx - 64, 16, (long)WS_H, (long)(WS_W + W_IN), 1024, 1024, 0};
          pg8::EpiStore E{Z, DIN};
          pg8::gemm_phase<pg8::EpiStore, pg8::SchedPlain, false>(lds, g, S, E, tid);
        }
        { FRESH_TID(tb1_) grid_barrier(ctl + 16, 192u * (unsigned)(2 * l + 1), tb1_); }
      {
        const float* qn = A.in[I_QNORM] + l * 64; const float* kn = A.in[I_KNORM] + l * 64;
        for (long idx = (long)(bx - 64) * NTHREADS + tid; idx < (long)NROW * 48; idx += (long)192 * NTHREADS) {
          const int part = (int)(idx & 7), h6 = (int)((idx >> 3) % 6), row = (int)(idx / 48);
          bf16_t* p = Z + (size_t)row * DIN + C_GQ + 64 * h6 + 8 * part;
          float f[8]; unpack8(*(const u32x4*)p, f);
          float ss = 0.f;
#pragma unroll
          for (int i = 0; i < 8; ++i) ss += f[i] * f[i];
          ss = red8(ss);
          const float rs = __builtin_amdgcn_rsqf(ss * (1.f / 64.f) + 1e-6f);
          const bool isq = h6 < 4; const float* nw = isq ? qn : kn; const float scl = isq ? C2 : 1.f;
#pragma unroll
          for (int i = 0; i < 8; ++i) f[i] = f[i] * rs * nw[8 * part + i] * scl;
          if (row < NLAT) {
            const int t = row & (TLAT - 1); const float gr = (float)(t >> 6), gc = (float)(t & 63);
#pragma unroll
            for (int pp = 0; pp < 4; ++pp) { const int pi = 4 * part + pp;
              const float invf = exp2f(-(float)(pi & 15) * (13.287712379549449f / 16.f));
              const float ang = (pi < 16 ? gr : gc) * invf; const float cs = __cosf(ang), sn = __sinf(ang);
              const float x1 = f[2 * pp], x2 = f[2 * pp + 1]; f[2 * pp] = x1 * cs - x2 * sn; f[2 * pp + 1] = x1 * sn + x2 * cs; }
          }
          *(u32x4*)p = pack8(f);
        }
      }
      {
        FRESH_TID(tid)
        const float* cw = A.in[I_CONVA] + l * 3 * 256;
        for (long idx = (long)(bx - 64) * NTHREADS + tid; idx < (long)NROW * 32; idx += (long)192 * NTHREADS) {
          const int g8 = (int)(idx & 31), row = (int)(idx >> 5); int t, len; row_seq(row, t, len);
          const bf16_t* zr = Z + (size_t)row * DIN;
          { bf16_t* qp = Z + (size_t)row * DIN + C_NAQ + 8 * g8; float f[8]; unpack8(*(const u32x4*)qp, f);
#pragma unroll
            for (int i = 0; i < 8; ++i) f[i] *= C2;
            *(u32x4*)qp = pack8(f); }
          float bg[8], c0[8], x0[8], c1[8], x1[8], c2[8], x2[8];
          unpack8(*(const u32x4*)(zr + 8 * g8), bg);
          unpack8(*(const u32x4*)(zr + 256 + 8 * g8), c1); unpack8(*(const u32x4*)(zr + 512 + 8 * g8), x1);
          if (t > 0) { unpack8(*(const u32x4*)(zr - DIN + 256 + 8 * g8), c0); unpack8(*(const u32x4*)(zr - DIN + 512 + 8 * g8), x0); }
          else {
#pragma unroll
            for (int i = 0; i < 8; ++i) { c0[i] = 0.f; x0[i] = 0.f; } }
          if (t < len - 1) { unpack8(*(const u32x4*)(zr + DIN + 256 + 8 * g8), c2); unpack8(*(const u32x4*)(zr + DIN + 512 + 8 * g8), x2); }
          else {
#pragma unroll
            for (int i = 0; i < 8; ++i) { c2[i] = 0.f; x2[i] = 0.f; } }
          float o[8];
#pragma unroll
          for (int i = 0; i < 8; ++i) { const int c = 8 * g8 + i; o[i] = bg[i] * (cw[c] * (c0[i] * x0[i]) + cw[256 + c] * (c1[i] * x1[i]) + cw[512 + c] * (c2[i] * x2[i])); }
          *(u32x4*)(YS + (size_t)row * 1024 + 8 * g8) = pack8(o);
        }
      }
        { FRESH_TID(tb2_) grid_barrier(ctl + 16, 192u * (unsigned)(2 * l + 2), tb2_); }
      } else {
        FRESH_TID(tw_)
        if (tw_ == 0) { while (__hip_atomic_load(ctl + 16, __ATOMIC_RELAXED, __HIP_MEMORY_SCOPE_AGENT) < 192u * (unsigned)(2 * l + 2)) __builtin_amdgcn_s_sleep(2);
          __builtin_amdgcn_fence(__ATOMIC_ACQUIRE, "agent"); }
        __syncthreads();
      }
      if (rep_ == 0 || REP_ATTN) {
        FRESH_TID(tid)
        volatile LAS unsigned* misc = (volatile LAS unsigned*)(lds + 92 * 1024);
        const float* nab = A.in[I_NABIAS] + (size_t)l * 4 * 465;
        for (;;) {
          __syncthreads();
          if (tid == 0) misc[0] = atomicAdd(ctl + 64 + 64 * l + 32 * rep_, 1u);
          __syncthreads();
          int u = (int)misc[0];
          if (l == NLAYER - 1 && u >= 1024) u += 16;
          if (u >= 1296) break;
          if (u >= 1040) {
            LAS float* SG = (LAS float*)lds;
            const int R0 = (u - 1040) * 130;
            for (int i = tid; i < 130 * 16; i += NTHREADS) { const int r = i >> 4, j8 = (i & 15) * 8; float f[8];
              unpack8(*(const u32x4*)(Z + (size_t)(R0 + r) * DIN + C_LG + j8), f);
#pragma unroll
              for (int e = 0; e < 8; ++e) f[e] = sigmoidf_(f[e]);
              *(LAS f32x4*)(SG + r * 128 + j8) = (f32x4){f[0], f[1], f[2], f[3]}; *(LAS f32x4*)(SG + r * 128 + j8 + 4) = (f32x4){f[4], f[5], f[6], f[7]}; }
            const int half = tid >> 8, c = tid & 255;
            float g2c[128];
#pragma unroll
            for (int j = 0; j < 128; ++j) g2c[j] = A.in[I_G2][((size_t)l * 128 + j) * 256 + c];
            __syncthreads();
            for (int r = half; r < 130; r += 2) {
              const LAS f32x4* sp = (const LAS f32x4*)(SG + r * 128);
              float gate = 0.f;
#pragma unroll
              for (int j4 = 0; j4 < 32; ++j4) { const f32x4 x = sp[j4]; gate += x[0] * g2c[4 * j4] + x[1] * g2c[4 * j4 + 1] + x[2] * g2c[4 * j4 + 2] + x[3] * g2c[4 * j4 + 3]; }
              YS[(size_t)(R0 + r) * 1024 + 768 + c] = (bf16_t)(cvtpk(gate, 0.f) & 0xffffu);
            }
            continue;
          }
          attn_body::TileMap tm; attn_body::NaInfo na{0, 0};
          const bf16_t *Qp, *Kp, *Vp; bf16_t* Op; int mode = 0;
          if (u < 512) {
            const int qb = u & 63, g2 = (u >> 6) & 1, kvh = (u >> 7) & 1, b = u >> 8, h = kvh * 2 + g2;
            tm = {256, b * TLAT, NLAT + b * CTXL, 260};
            const size_t q0 = (size_t)b * TLAT + qb * 256;
            Qp = Z + q0 * DIN + C_GQ + 64 * h; Kp = Z + C_GK + 64 * kvh; Vp = Z + C_GV + 64 * kvh; Op = YS + q0 * 1024 + 512 + 64 * h;
          } else if (u < 1024) {
            const int v = u - 512, ig = v & 63, h = (v >> 6) & 3, b = v >> 8, i0 = 4 * ig;
            int rmin = min(max(i0 - 4, 0), 248), rmax = min(max(i0 + 3 - 4, 0), 248) + 7;
            if (((rmax - rmin + 1) & 1) != 0) { if (rmax < 255) ++rmax; else --rmin; }
            tm = {4, NLAT + b * CTXL, b * TLAT + 64 * rmin, 4 + (rmax - rmin + 1)};
            na = {i0, rmin}; mode = 1;
            if (tid < 512) ((LAS float*)(lds + attn_body::LDS_BIAS))[tid] = (tid < 465) ? nab[h * 465 + tid] * LOG2E : 0.f;
            const size_t q0 = (size_t)b * TLAT + i0 * 64;
            Qp = Z + q0 * DIN + C_NAQ + 64 * h; Kp = Z + C_NAK + 64 * h; Vp = Z + C_NAV + 64 * h; Op = YS + q0 * 1024 + 256 + 64 * h;
          } else {
            const int v = u - 1024, isna = v >> 3, h = v & 3, b = (v >> 2) & 1;
            const size_t q0 = (size_t)NLAT + b * CTXL;
            tm = {4, NLAT + b * CTXL, 0, 4};
            if (isna) { Qp = Z + q0 * DIN + C_NAQ + 64 * h; Kp = Z + C_NAK + 64 * h; Vp = Z + C_NAV + 64 * h; Op = YS + q0 * 1024 + 256 + 64 * h; }
            else { Qp = Z + q0 * DIN + C_GQ + 64 * h; Kp = Z + C_GK + 64 * (h >> 1); Vp = Z + C_GV + 64 * (h >> 1); Op = YS + q0 * 1024 + 512 + 64 * h; }
          }
#ifndef NO_M1
          if (mode) { FRESH_TID(t1_) attn_body::attn_unit<1, 8>(Qp, Kp, Vp, Op, tm, na, (char*)lds_raw, t1_); }
#endif
#ifndef NO_M0
          if (!mode) { FRESH_TID(t0_) attn_body::attn_unit<0, 8>(Qp, Kp, Vp, Op, tm, na, (char*)lds_raw, t0_); }
#endif
        }
      }
#endif
    PHASE_END

    PHASE_BEGIN(5)
      {
        const int half = tid >> 8, c = tid & 255, hh = c >> 6;
        const float lnw = A.in[I_LNW][l * 256 + c], lnb = A.in[I_LNB][l * 256 + c];
        const float mv0 = A.in[I_MU][(size_t)(l * 2 + 0) * 896 + 512 + c], mv1 = A.in[I_MU][(size_t)(l * 2 + 1) * 896 + 512 + c];
        for (int tile = bx; tile < 256; tile += G) {
          const int R0 = tile * 130;
#pragma unroll 2
          for (int r = half; r < 130; r += 2) {
            const int row = R0 + r; int t, len; row_seq(row, t, len);
            const float y = YSC[((size_t)0 * NROW + row) * 256 + c] + YSC[((size_t)1 * NROW + row) * 256 + c];
            const bf16_t* zr = Z + (size_t)row * DIN + C_RV + c;
            const float zv = bf2f(zr[0]), zp = (t > 0) ? bf2f(zr[-DIN]) : 0.f, zq = (t < len - 1) ? bf2f(zr[DIN]) : 0.f;
            const float b0 = BONUS[((size_t)0 * NROW + row) * 4 + hh], b1 = BONUS[((size_t)1 * NROW + row) * 4 + hh];
            const float gate = bf2f(YS[(size_t)row * 1024 + 768 + c]);
            const float mean = wave_sum(y, lane) * (1.f / 64.f); const float dv = y - mean; const float var = wave_sum(dv * dv, lane) * (1.f / 64.f);
            const float yn = dv * __builtin_amdgcn_rsqf(var + 64e-5f) * lnw + lnb;
            const float v0 = zv + mv0 * (zp - zv), v1 = zv + mv1 * (zq - zv);
            const float bon = b0 * v0 + b1 * v1;
            YS[(size_t)row * 1024 + 768 + c] = (bf16_t)(cvtpk((yn + bon) * gate, 0.f) & 0xffffu);
          }
        }
      }
    PHASE_END

    PHASE_BEGIN(6)
      pg8::Gemm g{(const char*)ws, 1024, 1024};
      pg8::SchedMerge S{G, bx, (l == NLAYER - 1) ? 128 : 130};
      pg8::EpiMerge E{ws + WS_PSCR, A.in[I_BGATE] + (size_t)l * 4096, (bf16_t*)(ws + WS_ACCM)};
      pg8::gemm_phase<pg8::EpiMerge, pg8::SchedMerge, false>(lds, g, S, E, tid);
    PHASE_END

    PHASE_BEGIN(7)
      pg8::Gemm g{(const char*)ws, 1024, 1024};
      pg8::SchedPlain S{(l == NLAYER - 1) ? 128 : 130, 4, G, bx, 16, (long)WS_ACCM, (long)(WS_W + W_O), 1024, 1024, 0};
      pg8::EpiStore E{(bf16_t*)(ws + WS_MBUF), 1024};
      pg8::gemm_phase<pg8::EpiStore, pg8::SchedPlain, false>(lds, g, S, E, tid);
    PHASE_END

    PHASE_BEGIN(8)
      for (int vb_ = bx; vb_ < 256; vb_ += G)
      row_phase_blk((l == 0) ? A.in[I_X] : (const float*)A.out, (l == 0) ? A.in[I_CTX] : (const float*)XC, A.out, XC, (const bf16_t*)(ws + WS_MBUF),
                    MOD + (size_t)l * 3 * 6144, 2 * 1024, A.in[I_NMIXPOST] + l * 1024, H, A.in[I_NFFNPRE] + l * 1024, MOD + (size_t)l * 3 * 6144, 3 * 1024, 4 * 1024, vb_, wave, lane);
    PHASE_END

    PHASE_BEGIN(9)
      pg8::Gemm g{(const char*)ws, 1024, 1024};
      pg8::SchedUp S{G, bx, (l == NLAYER - 1) ? 134 : 138};
      pg8::EpiConvGlu E{(bf16_t*)(ws + WS_G), A.in[I_FCONV] + (size_t)l * 3 * 5632};
      pg8::gemm_phase<pg8::EpiConvGlu, pg8::SchedUp, true>(lds, g, S, E, tid);
    PHASE_END

    PHASE_BEGIN(10)
      pg8::Gemm g{(const char*)ws, DFF, DFF};
      pg8::SchedPlain S{(l == NLAYER - 1) ? 128 : 130, 4, G, bx, 44, (long)WS_G, (long)(WS_W + W_DN), DFF, DFF, 0};
      pg8::EpiStore E{(bf16_t*)(ws + WS_F), 1024};
      pg8::gemm_phase<pg8::EpiStore, pg8::SchedPlain, false>(lds, g, S, E, tid);
    PHASE_END

    PHASE_BEGIN(11)
      for (int vb_ = bx; vb_ < 256; vb_ += G)
      row_phase_blk((const float*)A.out, (const float*)XC, A.out, XC, (const bf16_t*)(ws + WS_F),
                    MOD + (size_t)l * 3 * 6144, 5 * 1024, A.in[I_NFFNPOST] + l * 1024, (l < NLAYER - 1) ? H : (bf16_t*)nullptr, A.in[I_NMIXPRE] + ((l + 1) & 3) * 1024,
                    MOD + (size_t)((l + 1) & 3) * 3 * 6144, 0, 1024, vb_, wave, lane);
      if (l < NLAYER - 1) convert_weights(A, l + 1, lds, gw, NGW, wave, lane);
    PHASE_END
  }
}

constexpr int LDS_BYTES = 147456;
constexpr int NPHASES = 2 + NLAYER * 10;
extern "C" void kernel_launch(void* const* d_in, const int* in_sizes, int n_in, void* d_out, int out_size, void* d_ws, size_t ws_size, hipStream_t stream) {
  static int grid = 0;
  if (grid == 0) {
    int dev = 0, cus = 0, per_cu = 0;
    hipGetDevice(&dev);
    hipDeviceGetAttribute(&cus, hipDeviceAttributeMultiprocessorCount, dev);
    if (hipFuncSetAttribute((const void*)fwd_megakernel, hipFuncAttributeMaxDynamicSharedMemorySize, LDS_BYTES) != hipSuccess) fprintf(stderr, "kernel_launch: hipFuncSetAttribute failed\n");
    hipOccupancyMaxActiveBlocksPerMultiprocessor(&per_cu, (const void*)fwd_megakernel, NTHREADS, LDS_BYTES);
    (void)hipGetLastError();
    if (per_cu < 1) per_cu = 1;
    grid = cus;
    if (n_in != 33 || ws_size < WS_END) fprintf(stderr, "kernel_launch: unexpected n_in %d or ws %zu\n", n_in, ws_size);
  }
  (void)hipMemsetAsync((char*)d_ws + WS_CTL, 0, 4096, stream);
  Args a{};
  for (int i = 0; i < 33; ++i) a.in[i] = (const float*)d_in[i];
  a.out = (float*)d_out; a.ws = (unsigned char*)d_ws; a.ph_lo = 0; a.ph_hi = NPHASES;
  void* args[] = {&a};
  hipError_t e = hipLaunchCooperativeKernel((const void*)fwd_megakernel, dim3(grid), dim3(NTHREADS), args, LDS_BYTES, stream);
  if (e != hipSuccess) fprintf(stderr, "cooperative launch failed: %s (grid %d)\n", hipGetErrorString(e), grid);
}
```

```cpp
#include <hip/hip_runtime.h>
#include <hip/hip_cooperative_groups.h>
#include <hip/hip_bf16.h>
#include <cstdio>
#include <cstdint>
#include <cmath>
namespace cg = cooperative_groups;

#define DI __device__ __forceinline__
#define LAS __attribute__((address_space(3)))
#define CAS4 __attribute__((address_space(4)))
typedef unsigned short bf16_t;
typedef short bf16x8 __attribute__((ext_vector_type(8)));
typedef float f32x4 __attribute__((ext_vector_type(4)));
typedef float f32x2 __attribute__((ext_vector_type(2)));
typedef float f32x16 __attribute__((ext_vector_type(16)));
typedef unsigned u32x4 __attribute__((ext_vector_type(4)));
typedef short s16x4 __attribute__((ext_vector_type(4)));
typedef __bf16 bf16x2_t __attribute__((ext_vector_type(2)));

constexpr int DM = 1024, TLAT = 16384, NLAT = 32768, CTXL = 256, NROW = 33280, NLAYER = 4;
constexpr int DIN = 3072, DFF = 2816;
constexpr int C_NAQ = 768, C_NAK = 1024, C_NAV = 1280, C_GQ = 1536, C_GK = 1792, C_GV = 1920;
constexpr int C_RR = 2048, C_RK = 2304, C_RV = 2560, C_LW = 2816, C_LA = 2880, C_LG = 2944;
constexpr float C2 = 0.125f * 1.4426950408889634f;
constexpr float LOG2E = 1.4426950408889634f;
constexpr int NTHREADS = 512;

constexpr size_t MiB = 1u << 20;
constexpr size_t WS_CTL = 0, WS_MOD = 1 * MiB, WS_XC = 2 * MiB, WS_BONUS = 4 * MiB, WS_W = 6 * MiB;
constexpr size_t W_IN = 0, W_GATE = W_IN + (size_t)3072 * 1024 * 2, W_BR = W_GATE + (size_t)4096 * 1024 * 2, W_O = W_BR + (size_t)1024 * 1024 * 2,
                 W_UP = W_O + (size_t)1024 * 1024 * 2, W_DN = W_UP + (size_t)5632 * 1024 * 2, W_END = W_DN + (size_t)1024 * 2816 * 2;
static_assert(WS_W + W_END <= 42 * MiB, "weights");
constexpr size_t WS_H = 42 * MiB + 65536, WS_Z = 108 * MiB, WS_YS = 304 * MiB, WS_WA = 370 * MiB, WS_YSC = 436 * MiB, WS_END = 501 * MiB;
constexpr size_t WS_ACCM = WS_Z, WS_MBUF = WS_Z + 70 * MiB, WS_G = WS_Z, WS_F = WS_YS, WS_PSCR = WS_WA, WS_ASCR = WS_YSC;
constexpr size_t ROWB = (size_t)NROW * 1024 * 2;

DI float bf2f(unsigned u16) { return __uint_as_float(u16 << 16); }
DI unsigned cvtpk(float lo, float hi) { f32x2 v = {lo, hi}; bf16x2_t b = __builtin_convertvector(v, bf16x2_t); return __builtin_bit_cast(unsigned, b); }
DI void unpack8(const u32x4 w, float* f) {
#pragma unroll
  for (int i = 0; i < 4; ++i) { f[2 * i] = __uint_as_float(w[i] << 16); f[2 * i + 1] = __uint_as_float(w[i] & 0xffff0000u); }
}
DI u32x4 pack8(const float* f) { u32x4 w; w.x = cvtpk(f[0], f[1]); w.y = cvtpk(f[2], f[3]); w.z = cvtpk(f[4], f[5]); w.w = cvtpk(f[6], f[7]); return w; }
DI float sigmoidf_(float x) { return __builtin_amdgcn_rcpf(1.f + __builtin_amdgcn_exp2f(-1.4426950408889634f * x)); }
DI float dppf(float x, const int ctrl_dummy);
#define DPPF(x, CTRL) __int_as_float(__builtin_amdgcn_update_dpp(0, __float_as_int(x), (CTRL), 0xf, 0xf, false))
DI float allreduce16(float x) { x += DPPF(x, 0xB1); x += DPPF(x, 0x4E); x += DPPF(x, 0x141); x += DPPF(x, 0x140); return x; }
DI float red8(float x) { x += DPPF(x, 0xB1); x += DPPF(x, 0x4E); x += DPPF(x, 0x141); return x; }
DI float bperm(float v, int src_lane) { return __int_as_float(__builtin_amdgcn_ds_bpermute(src_lane << 2, __float_as_int(v))); }
DI float wave_sum(float v, int lane) { v = allreduce16(v); v += bperm(v, lane ^ 16); v += bperm(v, lane ^ 32); return v; }

DI void grid_barrier(unsigned* ctr, unsigned target, int tid) {
  __syncthreads();
  if (tid == 0) {
    __builtin_amdgcn_fence(__ATOMIC_RELEASE, "agent");
    __hip_atomic_fetch_add(ctr, 1u, __ATOMIC_RELAXED, __HIP_MEMORY_SCOPE_AGENT);
    while (__hip_atomic_load(ctr, __ATOMIC_RELAXED, __HIP_MEMORY_SCOPE_AGENT) < target) __builtin_amdgcn_s_sleep(1);
    __builtin_amdgcn_fence(__ATOMIC_ACQUIRE, "agent");
  }
  __syncthreads();
}
DI void row_seq(int row, int& t, int& len) { if (row < NLAT) { t = row & (TLAT - 1); len = TLAT; } else { t = (row - NLAT) & (CTXL - 1); len = CTXL; } }

namespace pg8 {
constexpr int BM = 256, BK = 64, HALF = 128, HTB = HALF * BK * 2, STAGE_BYTES = 8 * HTB;
DI int lds_byte(int r, int c) { const int st = (r >> 4) * 2 + (c >> 5), rr = r & 15, cc = c & 31, ob = rr * 64 + cc * 2; return st * 1024 + (ob ^ (((ob >> 9) & 1) << 5)); }
DI void stage_rc(int b, int& R, int& C) { const int st = b / 1024, sb = b % 1024, swz = sb ^ (((sb >> 9) & 1) << 5); R = (st >> 1) * 16 + swz / 64; C = (st & 1) * 32 + (swz % 64) / 2; }
DI int perm32(int rho) { const int n = rho >> 4, i = rho & 15; return 8 * (i >> 2) + 4 * n + (i & 3); }

struct Unit { int pm, pn, nt, kind; };
struct Gemm { const char* base; int lda, ldb; };

template <class Epi, class Sched, bool CONV>
DI void gemm_phase(LAS unsigned char* lds, const Gemm g, const Sched& S, const Epi& E, int tid) {
    const int wid = __builtin_amdgcn_readfirstlane(tid >> 6), lane = tid & 63, wr = wid >> 2, wc = wid & 3, fr = lane & 15, fq = lane >> 4;
    unsigned voffA[2], voffB[2];
#pragma unroll
    for (int i = 0; i < 2; ++i) { int R, C; stage_rc(tid * 16 + i * 8192, R, C); const int Rb = (R & ~31) + perm32(R & 31);
        const int Ra = CONV ? (62 * (R >> 6) + (R & 63)) : R;
        voffA[i] = (unsigned)(Ra * g.lda + C) * 2u; voffB[i] = (unsigned)(Rb * g.ldb + C) * 2u; }
    constexpr int kstep = BK * 2;
    const int hstepA = (CONV ? 124 : HALF) * g.lda * 2, hstepB = HALF * g.ldb * 2;
    const unsigned ldsw = (unsigned)wid * 1024u;
    const int aoff = lds_byte(wr * 64 + fr, fq * 8), boff = lds_byte(wc * 32 + fr, fq * 8);
#define PG8_SA(b, h) (((b) * 2 + (h)) * HTB)
#define PG8_SB(b, h) ((4 + (b) * 2 + (h)) * HTB)
#define PG8_STAGE(bufoff, gbase, voff) do { _Pragma("unroll") for (int _i = 0; _i < 2; ++_i) \
        __builtin_amdgcn_global_load_lds((const unsigned*)((const char*)(gbase) + (voff)[_i]), (LAS unsigned*)(lds + (bufoff) + ldsw + _i * 8192), 16, 0, 0); } while (0)
#define PG8_LDA(dst, b, h) do { _Pragma("unroll") for (int m = 0; m < 4; ++m) _Pragma("unroll") for (int k = 0; k < 2; ++k) dst[m][k] = *(const LAS bf16x8*)(lds + PG8_SA(b, h) + aoff + m * 2048 + k * 1024); } while (0)
#define PG8_LDB(dst, b, h) do { _Pragma("unroll") for (int n = 0; n < 2; ++n) _Pragma("unroll") for (int k = 0; k < 2; ++k) dst[n][k] = *(const LAS bf16x8*)(lds + PG8_SB(b, h) + boff + n * 2048 + k * 1024); } while (0)
#define PG8_MMA(ai, bj, At, Bt) do { __builtin_amdgcn_s_setprio(1); _Pragma("unroll") for (int m = 0; m < 4; ++m) _Pragma("unroll") for (int n = 0; n < 2; ++n) _Pragma("unroll") for (int k = 0; k < 2; ++k) \
        acc[ai][bj][m][n] = __builtin_amdgcn_mfma_f32_16x16x32_bf16(Bt[n][k], At[m][k], acc[ai][bj][m][n], 0, 0, 0); __builtin_amdgcn_s_setprio(0); } while (0)
#define PG8_WAIT_V(n) asm volatile("s_waitcnt vmcnt(" #n ")" ::: "memory")
#define PG8_WAIT_L(n) asm volatile("s_waitcnt lgkmcnt(" #n ")" ::: "memory")
#define PG8_BAR __builtin_amdgcn_s_barrier()
#define PG8_SCHED __builtin_amdgcn_sched_barrier(0)
    Unit cur, nxt; int ui = 0; long ao_, bo_;
    if (!S.next(0, cur, ao_, bo_)) return;
    f32x4 acc[2][2][4][2];
#pragma unroll
    for (int a = 0; a < 2; ++a)
#pragma unroll
        for (int b = 0; b < 2; ++b)
#pragma unroll
            for (int m = 0; m < 4; ++m)
#pragma unroll
                for (int n = 0; n < 2; ++n) acc[a][b][m][n] = (f32x4){0.f, 0.f, 0.f, 0.f};
    bf16x8 At[4][2], B0[2][2], B1[2][2];
    const char* cA = g.base + ao_; const char* cB = g.base + bo_;
    PG8_STAGE(PG8_SB(0, 0), cB, voffB); PG8_STAGE(PG8_SB(0, 1), cB + hstepB, voffB); PG8_STAGE(PG8_SA(0, 0), cA, voffA); PG8_STAGE(PG8_SA(0, 1), cA + hstepA, voffA);
    if (wr == 1) PG8_BAR;
    PG8_WAIT_V(2); PG8_BAR;
    PG8_STAGE(PG8_SB(1, 0), cB + kstep, voffB); PG8_STAGE(PG8_SA(1, 0), cA + kstep, voffA); PG8_STAGE(PG8_SB(1, 1), cB + hstepB + kstep, voffB);
    PG8_WAIT_V(6); PG8_BAR;
    for (;;) {
        const bool has_next = S.next(ui + 1, nxt, ao_, bo_);
        const char* nA = has_next ? g.base + ao_ : cA; const char* nB = has_next ? g.base + bo_ : cB;
        const int nt = cur.nt;
        for (int t = 0; t < nt; t += 2) {
            const bool last = (t == nt - 2);
            const char* a1 = cA + (size_t)(t + 1) * kstep;
            const char* a2 = last ? nA : cA + (size_t)(t + 2) * kstep; const char* b2 = last ? nB : cB + (size_t)(t + 2) * kstep;
            const char* a3 = a2 + kstep; const char* b3 = b2 + kstep;
            PG8_LDB(B0, 0, 0); PG8_LDB(B1, 0, 1); PG8_SCHED; PG8_LDA(At, 0, 0); PG8_STAGE(PG8_SA(1, 1), a1 + hstepA, voffA);
            PG8_WAIT_V(8); PG8_WAIT_L(0); PG8_BAR; PG8_MMA(0, 0, At, B0); PG8_MMA(0, 1, At, B1); PG8_BAR; PG8_SCHED;
            PG8_LDA(At, 0, 1); PG8_STAGE(PG8_SB(0, 0), b2, voffB); PG8_STAGE(PG8_SB(0, 1), b2 + hstepB, voffB); PG8_STAGE(PG8_SA(0, 0), a2, voffA);
            PG8_WAIT_V(8); PG8_WAIT_L(0); PG8_BAR; PG8_MMA(1, 0, At, B0); PG8_MMA(1, 1, At, B1); PG8_BAR; PG8_SCHED;
            PG8_LDB(B0, 1, 0); PG8_LDB(B1, 1, 1); PG8_SCHED; PG8_LDA(At, 1, 0); PG8_STAGE(PG8_SA(0, 1), a2 + hstepA, voffA);
            PG8_WAIT_V(8); PG8_WAIT_L(0); PG8_BAR; PG8_MMA(0, 0, At, B0); PG8_MMA(0, 1, At, B1); PG8_BAR; PG8_SCHED;
            PG8_LDA(At, 1, 1); PG8_STAGE(PG8_SB(1, 0), b3, voffB); PG8_STAGE(PG8_SB(1, 1), b3 + hstepB, voffB); PG8_STAGE(PG8_SA(1, 0), a3, voffA);
            PG8_WAIT_V(8); PG8_WAIT_L(0); PG8_BAR; PG8_MMA(1, 0, At, B0); PG8_MMA(1, 1, At, B1); PG8_BAR; PG8_SCHED;
        }
        if (wr == 0) PG8_BAR;
        E(acc, cur, wr, wc, fr, fq);
        if (!has_next) break;
#pragma unroll
        for (int a = 0; a < 2; ++a)
#pragma unroll
            for (int b = 0; b < 2; ++b)
#pragma unroll
                for (int m = 0; m < 4; ++m)
#pragma unroll
                    for (int n = 0; n < 2; ++n) acc[a][b][m][n] = (f32x4){0.f, 0.f, 0.f, 0.f};
        cur = nxt; cA = nA; cB = nB; ++ui;
        if (wr == 1) PG8_BAR;
    }
    PG8_WAIT_V(0);
    PG8_BAR;
#undef PG8_SA
#undef PG8_SB
#undef PG8_STAGE
#undef PG8_LDA
#undef PG8_LDB
#undef PG8_MMA
#undef PG8_WAIT_V
#undef PG8_WAIT_L
#undef PG8_BAR
#undef PG8_SCHED
}

DI void xcd_tile(int L, int nM, int nN, int& pm, int& pn) {
    const int nwg = nM * nN; int wgid = L; { const int q = nwg / 8, r = nwg % 8, xcd = wgid % 8, off = wgid / 8; wgid = (xcd < r ? xcd * (q + 1) : r * (q + 1) + (xcd - r) * q) + off; }
    const int nig = 8 * nN, gid = wgid / nig, fm = gid * 8, gsz = (nM - fm) < 8 ? (nM - fm) : 8;
    pm = fm + ((wgid % nig) % gsz); pn = (wgid % nig) / gsz;
}
struct SchedPlain {
    int nM, nN, G, c, nt; long a0, b0; int lda, ldb, pn0;
    DI bool next(int i, Unit& u, long& a_off, long& b_off) const {
        const int L = i * G + c; if (L >= nM * nN) return false;
        xcd_tile(L, nM, nN, u.pm, u.pn); u.pn += pn0; a_off = a0 + (long)u.pm * 256 * lda * 2; b_off = b0 + (long)u.pn * 256 * ldb * 2; u.nt = nt; u.kind = 0; return true; }
};
struct SchedMerge {
    int G, c, nrt;
    DI bool next(int i, Unit& u, long& a_off, long& b_off) const {
        const int nr = (c < 512) ? (512 - c + G - 1) / G : 0;
        int sub;
        if (i < 8 * nr) { const int L = (i >> 3) * G + c; xcd_tile(L, 128, 4, u.pm, u.pn); sub = i & 7; }
        else { if (nrt != 130) return false;
            const int ii = i - 8 * nr, k = ii / 5, j = ii - 5 * k, qid = c + k * G; if (qid >= 32) return false;
            const int tq = qid >> 2, q = qid & 3; u.pm = 128 + (tq >> 2); u.pn = tq & 3; sub = (j < 4) ? j : 12 + q; }
        u.kind = sub;
        if (sub < 4) { a_off = (long)WS_YS + ((long)u.pm * 256 * 1024 + sub * 256) * 2; b_off = (long)(WS_W + W_BR) + ((long)u.pn * 256 * 1024 + sub * 256) * 2; u.nt = 4; }
        else { a_off = (long)WS_H + (long)u.pm * 256 * 1024 * 2; b_off = (long)(WS_W + W_GATE) + ((long)((u.pn * 4 + ((sub - 4) & 3)) * 256) * 1024) * 2; u.nt = 16; }
        return true; }
};
struct SchedUp {
    int G, c, ntm;
    DI static void tile_seq(int tm, int& base, int& len, int& j) {
        if (tm < 67) { base = 0; len = TLAT; j = tm; } else if (tm < 134) { base = TLAT; len = TLAT; j = tm - 67; }
        else { const int x = tm - 134; base = NLAT + (x >> 1) * CTXL; len = CTXL; j = x & 1; } }
    DI bool next(int i, Unit& u, long& a_off, long& b_off) const {
        const int L = i * G + c; if (L >= ntm * 22) return false;
        xcd_tile(L, ntm, 22, u.pm, u.pn); int base, len, j; tile_seq(u.pm, base, len, j);
        a_off = (long)WS_H + ((long)(base + 248 * j - 1) * 1024) * 2; b_off = (long)(WS_W + W_UP) + (long)u.pn * 256 * 1024 * 2; u.nt = 16; u.kind = 0; return true; }
};

struct EpiStore {
    bf16_t* O; int ldc;
    DI void operator()(const f32x4 (&acc)[2][2][4][2], const Unit& u, int wr, int wc, int fr_in, int fq_in) const {
        int ln_; asm volatile("v_mbcnt_lo_u32_b32 %0, -1, 0\n\tv_mbcnt_hi_u32_b32 %0, -1, %0" : "=v"(ln_)); const int fr = ln_ & 15, fq = ln_ >> 4; (void)fr_in; (void)fq_in;
        const int row0 = u.pm * 256 + wr * 64 + fr, col0 = u.pn * 256 + wc * 32 + 8 * fq;
#pragma unroll
        for (int ai = 0; ai < 2; ++ai)
#pragma unroll
            for (int m = 0; m < 4; ++m) { bf16_t* rowp = O + (size_t)(row0 + ai * 128 + m * 16) * ldc + col0;
#pragma unroll
                for (int bj = 0; bj < 2; ++bj) { const f32x4 v0 = acc[ai][bj][m][0], v1 = acc[ai][bj][m][1];
                    u32x4 w; w.x = cvtpk(v0[0], v0[1]); w.y = cvtpk(v0[2], v0[3]); w.z = cvtpk(v1[0], v1[1]); w.w = cvtpk(v1[2], v1[3]);
                    *(u32x4*)(rowp + bj * 128) = w; } }
    }
};
struct EpiMerge {
    unsigned char* stash; const float* bgate; bf16_t* O;
    DI void operator()(const f32x4 (&acc)[2][2][4][2], const Unit& u, int wr, int wc, int fr_in, int fq_in) const {
        int ln_; asm volatile("v_mbcnt_lo_u32_b32 %0, -1, 0\n\tv_mbcnt_hi_u32_b32 %0, -1, %0" : "=v"(ln_)); const int fr = ln_ & 15, fq = ln_ >> 4; (void)fr_in; (void)fq_in;
        unsigned char* st = stash + (size_t)blockIdx.x * 524288;
        if (u.kind < 4) {
            unsigned char* pb = st + (size_t)u.kind * 131072 + (size_t)(wr * 64 + fr) * 512 + (wc * 32 + 8 * fq) * 2;
#pragma unroll
            for (int ai = 0; ai < 2; ++ai)
#pragma unroll
                for (int m = 0; m < 4; ++m)
#pragma unroll
                    for (int bj = 0; bj < 2; ++bj) { const f32x4 v0 = acc[ai][bj][m][0], v1 = acc[ai][bj][m][1];
                        u32x4 w; w.x = cvtpk(v0[0], v0[1]); w.y = cvtpk(v0[2], v0[3]); w.z = cvtpk(v1[0], v1[1]); w.w = cvtpk(v1[2], v1[3]);
                        *(u32x4*)(pb + (size_t)(ai * 128 + m * 16) * 512 + bj * 256) = w; }
            if (u.kind == 3) asm volatile("s_waitcnt vmcnt(0)" ::: "memory");
        } else {
            if (u.kind == 4 || u.kind >= 12) __builtin_amdgcn_fence(__ATOMIC_ACQUIRE, "agent");
            const int q = (u.kind - 4) & 3, cq = 64 * q + 16 * wc + 4 * fq, col = u.pn * 256 + cq;
            f32x4 bg[4];
#pragma unroll
            for (int i = 0; i < 4; ++i) bg[i] = *(const f32x4*)(bgate + i * 1024 + col);
            const unsigned char* pb = st + (size_t)(wr * 64 + fr) * 512 + cq * 2;
            bf16_t* ob = O + (size_t)(u.pm * 256 + wr * 64 + fr) * 1024 + col;
#pragma unroll
            for (int ai = 0; ai < 2; ++ai)
#pragma unroll
                for (int m = 0; m < 4; ++m) {
                    f32x4 o = (f32x4){0.f, 0.f, 0.f, 0.f};
#pragma unroll
                    for (int bj = 0; bj < 2; ++bj)
#pragma unroll
                        for (int n = 0; n < 2; ++n) { const int i = 2 * bj + n;
                            const uint2 pw = *(const uint2*)(pb + (size_t)i * 131072 + (size_t)(ai * 128 + m * 16) * 512);
                            const f32x4 p = (f32x4){__uint_as_float(pw.x << 16), __uint_as_float(pw.x & 0xffff0000u), __uint_as_float(pw.y << 16), __uint_as_float(pw.y & 0xffff0000u)};
                            const f32x4 gv = acc[ai][bj][m][n] + bg[i];
#pragma unroll
                            for (int e = 0; e < 4; ++e) o[e] += sigmoidf_(gv[e]) * p[e]; }
                    uint2 w; w.x = cvtpk(o[0], o[1]); w.y = cvtpk(o[2], o[3]);
                    *(uint2*)(ob + (size_t)(ai * 128 + m * 16) * 1024) = w;
                }
        }
    }
};
struct EpiConvGlu {
    bf16_t* Gout; const float* cw;
    DI void operator()(const f32x4 (&acc)[2][2][4][2], const Unit& u, int wr, int wc, int fr_in, int fq_in) const {
        int ln_; asm volatile("v_mbcnt_lo_u32_b32 %0, -1, 0\n\tv_mbcnt_hi_u32_b32 %0, -1, %0" : "=v"(ln_)); const int fr = ln_ & 15, fq = ln_ >> 4; (void)fr_in; (void)fq_in;
        int base, len, j; SchedUp::tile_seq(u.pm, base, len, j);
        const bool f0 = (fr == 0), f15 = (fr == 15);
#pragma unroll
        for (int n = 0; n < 2; ++n) {
            const int colv = u.pn * 128 + wc * 32 + 8 * fq + 4 * n;
            f32x4 wv[3], wg[3];
#pragma unroll
            for (int k = 0; k < 3; ++k) { wv[k] = *(const f32x4*)(cw + k * 5632 + colv); wg[k] = *(const f32x4*)(cw + k * 5632 + 2816 + colv); }
#pragma unroll
            for (int ai = 0; ai < 2; ++ai) {
#pragma unroll
                for (int m = 0; m < 4; ++m) {
                    const int rho = 16 * m + fr;
                    const int tl = 248 * j + 62 * (2 * ai + wr) - 1 + rho;
                    const bool valid = (rho >= 1) && (rho <= 62) && (tl >= 0) && (tl < len);
                    const bool lz = (tl <= 0), rz = (tl >= len - 1);
                    float outv[4];
#pragma unroll
                    for (int e = 0; e < 4; ++e) {
                        float cvv[2];
#pragma unroll
                        for (int bj = 0; bj < 2; ++bj) {
                            const float xc = acc[ai][bj][m][n][e];
                            const float xm1 = (m > 0) ? acc[ai][bj][m - 1][n][e] : xc, xp1 = (m < 3) ? acc[ai][bj][m + 1][n][e] : xc;
                            const float tl_ = f15 ? xm1 : xc, tr_ = f0 ? xp1 : xc;
                            const float lraw = DPPF(tl_, 0x121); const float left = lz ? 0.f : lraw;
                            const float rraw = DPPF(tr_, 0x12F); const float right = rz ? 0.f : rraw;
                            cvv[bj] = bj ? (left * wg[0][e] + xc * wg[1][e] + right * wg[2][e]) : (left * wv[0][e] + xc * wv[1][e] + right * wv[2][e]);
                        }
                        outv[e] = cvv[0] * cvv[1] * sigmoidf_(cvv[1]);
                    }
                    if (valid) { uint2 w; w.x = cvtpk(outv[0], outv[1]); w.y = cvtpk(outv[2], outv[3]); *(uint2*)(Gout + (size_t)(base + tl) * DFF + colv) = w; }
                }
            }
        }
    }
};
}

namespace attn_body {
constexpr int QP = DIN, OP = 1024;
constexpr int NW = 8, QBLK = 32, KVBLK = 64;
DI int crow(int r, int hi) { return (r & 3) + 8 * (r >> 2) + 4 * hi; }
#define SBAR() __builtin_amdgcn_sched_barrier(0)
constexpr int NSLOT = 3, SLOTB = 8192;
constexpr int LDS_K = 0, LDS_V = NSLOT * SLOTB, LDS_WS = 2 * NSLOT * SLOTB, LDS_OST = LDS_WS + NW * 64 * 4, LDS_BYTES = LDS_OST + NW * 4096;
constexpr int LDS_BIAS = 86016;
DI void glds16(const void* gsrc, unsigned lds_dst) { unsigned keep;
  asm volatile("s_mov_b32 %0, m0\n\ts_mov_b32 m0, %2\n\ts_nop 0\n\tglobal_load_lds_dwordx4 %1, off\n\ts_mov_b32 m0, %0" : "=&s"(keep) : "v"(gsrc), "s"(lds_dst) : "memory"); }
DI float max3f(float a, float b, float c) { float r; asm("v_max3_f32 %0, %1, %2, %3" : "=v"(r) : "v"(a), "v"(b), "v"(c)); return r; }
DI float max2f(float a, float b) { float r; asm("v_max_f32_e32 %0, %1, %2" : "=v"(r) : "v"(a), "v"(b)); return r; }
DI float fadd_s(float a, float b) { float r; asm("v_add_f32_e32 %0, %1, %2" : "=v"(r) : "v"(a), "v"(b)); return r; }
DI float fsub_s(float a, float b) { float r; asm("v_sub_f32_e32 %0, %1, %2" : "=v"(r) : "v"(a), "v"(b)); return r; }
DI unsigned cvtpk_s(float lo, float hi) { return cvtpk(lo, hi); }
#define WAIT_BAR(N) asm volatile("s_waitcnt vmcnt(" #N ") lgkmcnt(0)\n\ts_barrier" ::: "memory")

DI void qkt(f32x16& p0, f32x16& p1, const char* Kslot, const bf16x8* qr, int r32, int hi) {
  const f32x16 zz = f32x16{};
  const char* kb = Kslot + hi * 1024 + r32 * 16;
#pragma unroll
  for (int d0 = 0; d0 < 4; ++d0) {
    const bf16x8 b0 = *reinterpret_cast<const bf16x8*>(kb + d0 * 2048);
    const bf16x8 b1 = *reinterpret_cast<const bf16x8*>(kb + d0 * 2048 + 512);
    if (d0 == 0) { p0 = __builtin_amdgcn_mfma_f32_32x32x16_bf16(b0, qr[0], zz, 0, 0, 0); p1 = __builtin_amdgcn_mfma_f32_32x32x16_bf16(b1, qr[0], zz, 0, 0, 0); }
    else { p0 = __builtin_amdgcn_mfma_f32_32x32x16_bf16(b0, qr[d0], p0, 0, 0, 0); p1 = __builtin_amdgcn_mfma_f32_32x32x16_bf16(b1, qr[d0], p1, 0, 0, 0); } }
}
typedef __attribute__((address_space(3))) const char* lds_cptr;
typedef short v4i16_t __attribute__((ext_vector_type(4)));
DI void kload8(bf16x8* kf, lds_cptr kp) {
  kf[0] = *(const LAS bf16x8*)(kp);        kf[1] = *(const LAS bf16x8*)(kp + 512);
  kf[2] = *(const LAS bf16x8*)(kp + 2048); kf[3] = *(const LAS bf16x8*)(kp + 2560);
  kf[4] = *(const LAS bf16x8*)(kp + 4096); kf[5] = *(const LAS bf16x8*)(kp + 4608);
  kf[6] = *(const LAS bf16x8*)(kp + 6144); kf[7] = *(const LAS bf16x8*)(kp + 6656);
}
DI void kload2(bf16x8* kf, lds_cptr kp, int j) { kf[2 * j] = *(const LAS bf16x8*)(kp + j * 2048); kf[2 * j + 1] = *(const LAS bf16x8*)(kp + j * 2048 + 512); }
DI s16x4 vtr(lds_cptr p) { return __builtin_bit_cast(s16x4, __builtin_amdgcn_ds_read_tr16_b64_v4i16((LAS v4i16_t*)p)); }
DI float rowmax(const f32x16& p0, const f32x16& p1) {
  float a = max3f(p0[0], p0[1], p1[0]), b = max3f(p0[2], p0[3], p1[1]); a = max3f(a, p1[2], p1[3]);
#pragma unroll
  for (int r = 4; r < 16; r += 4) { a = max3f(a, p0[r], p0[r + 1]); b = max3f(b, p0[r + 2], p0[r + 3]); a = max3f(a, p1[r], p1[r + 1]); b = max3f(b, p1[r + 2], p1[r + 3]); }
  const float m = max2f(a, b);
  auto rr = __builtin_amdgcn_permlane32_swap(__float_as_uint(m), __float_as_uint(m), false, false);
  return max2f(__uint_as_float(rr[0]), __uint_as_float(rr[1]));
}
DI void pv(f32x16* o, int vb, bf16x8 pa0, bf16x8 pa1, bf16x8 pa2, bf16x8 pa3) {
#pragma unroll
  for (int d0 = 0; d0 < 2; ++d0) { s16x4 lo[4], hi[4];
#pragma unroll
    for (int ks = 0; ks < 4; ++ks) {
      asm volatile("ds_read_b64_tr_b16 %0,%1 offset:%c2" : "=&v"(lo[ks]) : "v"(vb), "i"(d0 * 4096 + ks * 1024) : "memory");
      asm volatile("ds_read_b64_tr_b16 %0,%1 offset:%c2" : "=&v"(hi[ks]) : "v"(vb), "i"(d0 * 4096 + ks * 1024 + 512) : "memory"); }
    asm volatile("s_waitcnt lgkmcnt(0)" ::: "memory"); SBAR();
#define PK(k) (bf16x8){lo[k][0], lo[k][1], lo[k][2], lo[k][3], hi[k][0], hi[k][1], hi[k][2], hi[k][3]}
    o[d0] = __builtin_amdgcn_mfma_f32_32x32x16_bf16(pa0, PK(0), o[d0], 0, 0, 0);
    o[d0] = __builtin_amdgcn_mfma_f32_32x32x16_bf16(pa1, PK(1), o[d0], 0, 0, 0);
    o[d0] = __builtin_amdgcn_mfma_f32_32x32x16_bf16(pa2, PK(2), o[d0], 0, 0, 0);
    o[d0] = __builtin_amdgcn_mfma_f32_32x32x16_bf16(pa3, PK(3), o[d0], 0, 0, 0);
#undef PK
  }
}
struct TileMap { int n1, base1, base2, NT; };
struct NaInfo { int i0, rmin; };

template <int MODE, int THRL>
DI void attn_unit(const bf16_t* Qw0, const bf16_t* __restrict__ Kh, const bf16_t* __restrict__ Vh, bf16_t* Ow0, const TileMap tm, const NaInfo na, char* shm, int tid) {
  const int lane = tid & 63, r32 = lane & 31, hi = lane >> 5; const int wid = __builtin_amdgcn_readfirstlane(tid >> 6);
  const bf16_t* Qw = Qw0 + (long)(wid * QBLK) * QP;
  const unsigned lds0 = (unsigned)(uintptr_t)shm;
  float* wsf = (float*)(shm + LDS_WS) + wid * 64;
  const bf16_t* ksrc = Kh + (long)lane * QP + wid * 8;
  const bf16_t* vsrc = Vh + (long)(16 * (wid & 3) + (lane >> 2)) * QP + (wid >> 2) * 32 + (lane & 3) * 8;
  const unsigned kdst = lds0 + LDS_K + wid * 1024, vdst = lds0 + LDS_V + wid * 1024;
#define TROW(t) ((long)(((t) < tm.n1) ? (tm.base1 + 64 * (t)) : (tm.base2 + 64 * ((t) - tm.n1))))
#define DMA_K(t, slot) glds16(ksrc + TROW(t) * QP, (unsigned)__builtin_amdgcn_readfirstlane(kdst + (slot)))
#define DMA_V(t, slot) glds16(vsrc + TROW(t) * QP, (unsigned)__builtin_amdgcn_readfirstlane(vdst + (slot)))
  const int vb0 = (int)(lds0 + LDS_V) + ((lane >> 4) & 1) * 32 + (lane & 3) * 8 + (4 * hi + ((lane & 15) >> 2)) * 64;
  const char* Kbase = shm + LDS_K; bf16x8 kf[8];
  const lds_cptr shm3 = (lds_cptr)shm; const lds_cptr kp0 = shm3 + LDS_K + hi * 1024 + r32 * 16; const lds_cptr vp0 = shm3 + LDS_V + ((lane >> 4) & 1) * 32 + (lane & 3) * 8 + (4 * hi + ((lane & 15) >> 2)) * 64;
  const int NT = tm.NT;
  DMA_K(0, 0); DMA_V(0, 0); DMA_K(1, SLOTB);
  bf16x8 qr[4];
#pragma unroll
  for (int d0 = 0; d0 < 4; ++d0) qr[d0] = *reinterpret_cast<const bf16x8*>(&Qw[(long)r32 * QP + d0 * 16 + hi * 8]);
  float mhat = 0.f, l_reg = 0.f; f32x16 o[2]; o[0] = f32x16{}; o[1] = f32x16{}; f32x16 zacc = f32x16{}; if (MODE == 0) asm volatile("" : "+v"(zacc));
#define CMASK(P0, P1, t) do { if (MODE == 1) { const int t_ = (t); const bool ctx_ = t_ < 4; \
      int lane_ = lane; asm volatile("" : "+v"(lane_)); const int r32_ = lane_ & 31, hi_ = lane_ >> 5; \
      const int qi_ = na.i0 + (wid >> 1), qj_ = (wid & 1) * 32 + r32_; const int rs_ = min(max(qi_ - 4, 0), 248), cs_ = min(max(qj_ - 8, 0), 48); \
      const int kr = na.rmin + t_ - 4; const bool rowok = (unsigned)(kr - rs_) < 8u; \
      const int bb = ctx_ ? 480 : ((kr - qi_ + 7) * 31 + 15 - qj_ + 4 * hi_); const int lo_ = ctx_ ? -4096 : ((rowok ? cs_ : 4096) - 4 * hi_); const unsigned wd_ = ctx_ ? 8192u : 16u; const int mul_ = ctx_ ? 0 : 1; \
      const LAS float* btab = (const LAS float*)((lds_cptr)shm + LDS_BIAS); \
      _Pragma("unroll") for (int g_ = 0; g_ < 8; ++g_) { \
        _Pragma("unroll") for (int q_ = 0; q_ < 2; ++q_) { const int r = 2 * g_ + q_; const int kc0 = (r & 3) + 8 * (r >> 2); \
          const int d0_ = kc0 - lo_; \
          const int i0_ = ((unsigned)d0_ < wd_) ? bb + kc0 * mul_ : -1, i1_ = ((unsigned)(d0_ + 32) < wd_) ? bb + (kc0 + 32) * mul_ : -1; \
          const float b0_ = btab[max(i0_, 0)], b1_ = btab[max(i1_, 0)]; \
          P0[r] = (i0_ >= 0) ? P0[r] + b0_ : -INFINITY; P1[r] = (i1_ >= 0) ? P1[r] + b1_ : -INFINITY; } \
        SBAR(); } } } while (0)
  bool resc = false;
#define START(P0, P1) do { const float rm = rowmax(P0, P1); resc = false; \
    { const float dl = rm; mhat = fadd_s(mhat, dl); \
      _Pragma("unroll") for (int r = 0; r < 16; ++r) { P0[r] = fsub_s(P0[r], dl); P1[r] = fsub_s(P1[r], dl); } \
      if (MODE == 0) { _Pragma("unroll") for (int r = 0; r < 16; ++r) zacc[r] = -mhat; asm volatile("" : "+v"(zacc)); } } \
    _Pragma("unroll") for (int r = 0; r < 16; ++r) P0[r] = __builtin_amdgcn_exp2f(P0[r]); } while (0)
#define RESC() do { if (resc) { asm volatile("s_waitcnt lgkmcnt(0)" ::: "memory"); \
      _Pragma("unroll") for (int d_ = 0; d_ < 2; ++d_) _Pragma("unroll") for (int r = 0; r < 16; ++r) o[d_][r] *= wsf[crow(r, hi)]; } } while (0)
  f32x16 pA0, pA1, pB0, pB1;
  int sl_prev = 0, sl_cur = 0, sl_next = SLOTB;
#define ROT() do { sl_prev = sl_cur; sl_cur = sl_next; sl_next = (sl_next == (NSLOT - 1) * SLOTB) ? 0 : sl_next + SLOTB; } while (0)
  DMA_K(2, 2 * SLOTB);
  WAIT_BAR(3);
  qkt(pA0, pA1, Kbase, qr, r32, hi); asm volatile("s_nop 15\n\ts_nop 7" : "+v"(pA0), "+v"(pA1)); CMASK(pA0, pA1, 0);
  START(pA0, pA1);
  _Pragma("unroll") for (int r = 0; r < 16; ++r) pA1[r] = __builtin_amdgcn_exp2f(pA1[r]);
  WAIT_BAR(0);
  DMA_K(3, 0); DMA_V(1, SLOTB);
  ROT();
  kload8(kf, kp0 + sl_cur);
  WAIT_BAR(2);
  s16x4 vlo[8], vhi[8]; u32x4 pw0, pw1, pw2, pw3;
#define PKW(P, B) cvtpk_s(P[B], P[B + 1])
#define PAF(k) __builtin_bit_cast(bf16x8, pw##k)
#define VFR(i) (bf16x8){vlo[i][0], vlo[i][1], vlo[i][2], vlo[i][3], vhi[i][0], vhi[i][1], vhi[i][2], vhi[i][3]}
#define PIN(x) asm volatile("" : "+v"(x))
#define MX3(a, b, c) __builtin_fmaxf(__builtin_fmaxf((a), (b)), (c))
#define GAPA(MF, A0, A1, A2, A3, W0, W1, PW) do { MF; sacc += A0; sacc += A1; sacc += A2; sacc += A3; PIN(sacc); W0; W1; PIN(PW); SBAR(); } while (0)
#define EX(v) __builtin_amdgcn_exp2f(v)
#define GAPB(MF, X, B) do { MF; X[B] = EX(X[B]); X[B + 1] = EX(X[B + 1]); X[B + 2] = EX(X[B + 2]); X[B + 3] = EX(X[B + 3]); PIN(X); SBAR(); } while (0)
#define VRD(i) do { vlo[i] = vtr(vp_ + (((i) >> 2) * 4096 + ((i) & 3) * 1024)); vhi[i] = vtr(vp_ + (((i) >> 2) * 4096 + ((i) & 3) * 1024 + 512)); } while (0)
#define KRD(G, j) do { if (G) { kload2(kf, kp0 + sl_next, j); SBAR(); } } while (0)
#define STEP(C0, C1, P0, P1, t, GK, GV, GL) do { SBAR(); \
    const lds_cptr vp_ = vp0 + sl_prev; \
    VRD(0); SBAR(); float sacc = (P0[0] + P0[1]); \
    GAPA(C0 = __builtin_amdgcn_mfma_f32_32x32x16_bf16(kf[0], qr[0], zacc, 0, 0, 0), P0[2], P0[3], P0[4], P0[5],     pw0[0] = PKW(P0, 0), pw0[1] = PKW(P0, 2), pw0); \
    VRD(4); SBAR(); GAPA(C1 = __builtin_amdgcn_mfma_f32_32x32x16_bf16(kf[1], qr[0], zacc, 0, 0, 0), P0[6], P0[7], P0[8], P0[9],     pw0[2] = PKW(P0, 4), pw0[3] = PKW(P0, 6), pw0); \
    VRD(1); SBAR(); GAPA(C0 = __builtin_amdgcn_mfma_f32_32x32x16_bf16(kf[2], qr[1], C0, 0, 0, 0),   P0[10], P0[11], P0[12], P0[13], pw1[0] = PKW(P0, 8), pw1[1] = PKW(P0, 10), pw1); \
    VRD(5); SBAR(); GAPA(C1 = __builtin_amdgcn_mfma_f32_32x32x16_bf16(kf[3], qr[1], C1, 0, 0, 0),   P0[14], P0[15], P1[0], P1[1],   pw1[2] = PKW(P0, 12), pw1[3] = PKW(P0, 14), pw1); \
    VRD(2); SBAR(); GAPA(C0 = __builtin_amdgcn_mfma_f32_32x32x16_bf16(kf[4], qr[2], C0, 0, 0, 0),   P1[2], P1[3], P1[4], P1[5],     pw2[0] = PKW(P1, 0), pw2[1] = PKW(P1, 2), pw2); \
    VRD(6); SBAR(); GAPA(C1 = __builtin_amdgcn_mfma_f32_32x32x16_bf16(kf[5], qr[2], C1, 0, 0, 0),   P1[6], P1[7], P1[8], P1[9],     pw2[2] = PKW(P1, 4), pw2[3] = PKW(P1, 6), pw2); \
    VRD(3); SBAR(); GAPA(C0 = __builtin_amdgcn_mfma_f32_32x32x16_bf16(kf[6], qr[3], C0, 0, 0, 0),   P1[10], P1[11], P1[12], P1[13], pw3[0] = PKW(P1, 8), pw3[1] = PKW(P1, 10), pw3); \
    VRD(7); SBAR(); GAPA(C1 = __builtin_amdgcn_mfma_f32_32x32x16_bf16(kf[7], qr[3], C1, 0, 0, 0),   P1[14], P1[15], 0.f, 0.f,       pw3[2] = PKW(P1, 12), pw3[3] = PKW(P1, 14), pw3); \
    l_reg += sacc; \
    if (GK) { DMA_K((t) + 3, sl_cur); } if (GV) { DMA_V((t) + 1, sl_next); } \
    if (MODE == 1) { _Pragma("unroll") for (int r = 0; r < 16; ++r) { C0[r] -= mhat; C1[r] -= mhat; } } \
    CMASK(C0, C1, t); \
    { float a = MX3(C0[0], C0[1], C1[0]), b = MX3(C0[2], C0[3], C1[1]); a = MX3(a, C1[2], C1[3]); \
      _Pragma("unroll") for (int r = 4; r < 16; r += 4) { a = MX3(a, C0[r], C0[r + 1]); b = MX3(b, C0[r + 2], C0[r + 3]); a = MX3(a, C1[r], C1[r + 1]); b = MX3(b, C1[r + 2], C1[r + 3]); } \
      float rm = __builtin_fmaxf(a, b); { auto rr = __builtin_amdgcn_permlane32_swap(__float_as_uint(rm), __float_as_uint(rm), false, false); rm = __builtin_fmaxf(__uint_as_float(rr[0]), __uint_as_float(rr[1])); } \
      resc = false; \
      if (__builtin_expect(__any(rm > (float)THRL), 0)) { const float dl = __builtin_fmaxf(rm, 0.f); mhat += dl; \
        _Pragma("unroll") for (int r = 0; r < 16; ++r) { C0[r] -= dl; C1[r] -= dl; } \
        if (MODE == 0) { _Pragma("unroll") for (int r = 0; r < 16; ++r) zacc[r] = -mhat; asm volatile("" : "+v"(zacc)); } \
        const float f = __builtin_amdgcn_exp2f(-dl); l_reg *= f; if (hi == 0) wsf[r32] = f; resc = true; } } \
    SBAR(); \
    GAPB(o[0] = __builtin_amdgcn_mfma_f32_32x32x16_bf16(PAF(0), VFR(0), o[0], 0, 0, 0), C0, 0); \
    GAPB(o[1] = __builtin_amdgcn_mfma_f32_32x32x16_bf16(PAF(0), VFR(4), o[1], 0, 0, 0), C0, 4); \
    KRD(GL, 0); GAPB(o[0] = __builtin_amdgcn_mfma_f32_32x32x16_bf16(PAF(1), VFR(1), o[0], 0, 0, 0), C0, 8); \
    KRD(GL, 1); GAPB(o[1] = __builtin_amdgcn_mfma_f32_32x32x16_bf16(PAF(1), VFR(5), o[1], 0, 0, 0), C0, 12); \
    KRD(GL, 2); GAPB(o[0] = __builtin_amdgcn_mfma_f32_32x32x16_bf16(PAF(2), VFR(2), o[0], 0, 0, 0), C1, 0); \
    KRD(GL, 3); GAPB(o[1] = __builtin_amdgcn_mfma_f32_32x32x16_bf16(PAF(2), VFR(6), o[1], 0, 0, 0), C1, 4); \
    GAPB(o[0] = __builtin_amdgcn_mfma_f32_32x32x16_bf16(PAF(3), VFR(3), o[0], 0, 0, 0), C1, 8); \
    GAPB(o[1] = __builtin_amdgcn_mfma_f32_32x32x16_bf16(PAF(3), VFR(7), o[1], 0, 0, 0), C1, 12); \
    } while (0)
  int t = 1;
  for (; t + 5 < NT; t += 2) {
    STEP(pB0, pB1, pA0, pA1, t, true, true, true);     WAIT_BAR(2); RESC(); ROT();
    STEP(pA0, pA1, pB0, pB1, t + 1, true, true, true); WAIT_BAR(2); RESC(); ROT();
  }
#define ENDW(tt) do { if ((tt) + 3 < NT) { WAIT_BAR(2); } else if ((tt) + 2 < NT) { WAIT_BAR(1); } else { WAIT_BAR(0); } } while (0)
  for (; t + 1 < NT; t += 2) {
    STEP(pB0, pB1, pA0, pA1, t, (t + 3 < NT), (t + 1 < NT), (t + 1 < NT));         ENDW(t);     RESC(); ROT();
    STEP(pA0, pA1, pB0, pB1, t + 1, (t + 4 < NT), (t + 2 < NT), (t + 2 < NT));     ENDW(t + 1); RESC(); ROT();
  }
  STEP(pB0, pB1, pA0, pA1, NT - 1, false, false, false); RESC();
  { float sacc = pB0[0] + pB0[1]; _Pragma("unroll") for (int r = 2; r < 16; ++r) sacc += pB0[r]; _Pragma("unroll") for (int r = 0; r < 16; ++r) sacc += pB1[r]; l_reg += sacc;
    pw0 = (u32x4){PKW(pB0, 0), PKW(pB0, 2), PKW(pB0, 4), PKW(pB0, 6)}; pw1 = (u32x4){PKW(pB0, 8), PKW(pB0, 10), PKW(pB0, 12), PKW(pB0, 14)}; pw2 = (u32x4){PKW(pB1, 0), PKW(pB1, 2), PKW(pB1, 4), PKW(pB1, 6)}; pw3 = (u32x4){PKW(pB1, 8), PKW(pB1, 10), PKW(pB1, 12), PKW(pB1, 14)};
    SBAR(); pv(o, vb0 + sl_cur, PAF(0), PAF(1), PAF(2), PAF(3)); }
#undef PKW
#undef PAF
#undef VFR
#undef PIN
#undef MX3
#undef GAPA
#undef GAPB
#undef EX
#undef VRD
#undef KRD
#undef STEP
#undef ENDW
  { auto rr = __builtin_amdgcn_permlane32_swap(__float_as_uint(l_reg), __float_as_uint(l_reg), false, false); l_reg = __uint_as_float(rr[0]) + __uint_as_float(rr[1]); }
  if (hi == 0) wsf[32 + r32] = l_reg; asm volatile("s_waitcnt lgkmcnt(0)" ::: "memory");
  float rli[16];
#pragma unroll
  for (int r = 0; r < 16; ++r) rli[r] = __builtin_amdgcn_rcpf(wsf[32 + crow(r, hi)]);
  bf16_t* Ow = Ow0 + (long)(wid * QBLK) * OP;
  { __hip_bfloat16* stg = (__hip_bfloat16*)(shm + LDS_OST) + wid * 2048;
#pragma unroll
    for (int r = 0; r < 16; ++r) { const int orow = crow(r, hi);
#pragma unroll
      for (int d0 = 0; d0 < 2; ++d0) stg[orow * 64 + d0 * 32 + r32] = __float2bfloat16(o[d0][r] * rli[r]); }
    asm volatile("s_waitcnt lgkmcnt(0)" ::: "memory");
#pragma unroll
    for (int i = 0; i < 4; ++i) { const int row = i * 8 + (lane >> 3), ch = lane & 7; const u32x4 v = *(const u32x4*)(stg + row * 64 + ch * 8); *(u32x4*)(Ow + (long)row * OP + ch * 8) = v; } }
  asm volatile("s_waitcnt lgkmcnt(0)\n\ts_barrier" ::: "memory");
#undef DMA_K
#undef DMA_V
#undef TROW
#undef CMASK
#undef START
#undef RESC
#undef ROT
}
#undef SBAR
#undef WAIT_BAR
}

struct Args {
  const float* in[33];
  float* out; unsigned char* ws;
  int ph_lo, ph_hi;
};
enum { I_X = 0, I_C, I_CTX, I_CCTX, I_ADAW, I_ADAB, I_NMIXPRE, I_NMIXPOST, I_NFFNPRE, I_NFFNPOST, I_WIN, I_CONVA, I_NABIAS, I_QNORM, I_KNORM,
       I_MU, I_W0, I_W2, I_A0, I_A2, I_KK, I_KA, I_RK, I_G2, I_LNW, I_LNB, I_WBR, I_WGATE, I_BGATE, I_WO, I_FUP, I_FCONV, I_FDN };

DI void transpose_item(const float* W, int N, bf16_t* WT, int ld, int koff, int mode, LAS float* scr, int item, int lane) {
  const int nblk = N / 32, kb = item / nblk, nb = item % nblk, k0 = 64 * kb, n0 = 32 * nb;
#pragma unroll 8
  for (int i = 0; i < 32; ++i) { const int kk = 2 * i + (lane >> 5); scr[kk * 33 + (lane & 31)] = W[(size_t)(k0 + kk) * N + n0 + (lane & 31)]; }
  asm volatile("s_waitcnt lgkmcnt(0)" ::: "memory");
  const int c = lane & 7;
#pragma unroll
  for (int j = 0; j < 4; ++j) { const int n = (lane >> 3) + 8 * j; const LAS float* s = scr + (8 * c) * 33 + n;
    int nn = n0 + n;
    if (mode == 1) nn = (nn < DFF) ? (256 * (nn >> 7) + (nn & 127)) : (256 * ((nn - DFF) >> 7) + 128 + ((nn - DFF) & 127));
    if (mode == 2) { const int i = nn >> 10, cc = nn & 1023, c64 = cc & 63;
      nn = ((cc >> 6) * 256) + 128 * (i >> 1) + 32 * (c64 >> 4) + 8 * ((c64 >> 2) & 3) + 4 * (i & 1) + (c64 & 3); }
    u32x4 o; o.x = cvtpk(s[0 * 33], s[1 * 33]); o.y = cvtpk(s[2 * 33], s[3 * 33]); o.z = cvtpk(s[4 * 33], s[5 * 33]); o.w = cvtpk(s[6 * 33], s[7 * 33]);
    *(u32x4*)(WT + (size_t)nn * ld + koff + k0 + 8 * c) = o; }
  asm volatile("s_waitcnt lgkmcnt(0)" ::: "memory");
}
DI void convert_weights(const CAS4 Args& A, int l, LAS unsigned char* lds, int gw, int NGW, int wave, int lane) {
  LAS float* scr = (LAS float*)(lds + wave * 8704);
  unsigned char* wb = A.ws + WS_W;
  constexpr int I_IN_ = 16 * 96, I_G = 16 * 128, I_B = 4 * 4 * 32, I_O_ = 16 * 32, I_U = 16 * 176, I_D = 44 * 32;
  constexpr int NIT = I_IN_ + I_G + I_B + I_O_ + I_U + I_D;
  for (int it = gw; it < NIT; it += NGW) {
    int r = it;
    if (r < I_IN_) { transpose_item(A.in[I_WIN] + (size_t)l * 1024 * 3072, 3072, (bf16_t*)(wb + W_IN), 1024, 0, 0, scr, r, lane); continue; } r -= I_IN_;
    if (r < I_G) { transpose_item(A.in[I_WGATE] + (size_t)l * 1024 * 4096, 4096, (bf16_t*)(wb + W_GATE), 1024, 0, 2, scr, r, lane); continue; } r -= I_G;
    if (r < I_B) { const int br = r / 128; transpose_item(A.in[I_WBR] + ((size_t)l * 4 + br) * 256 * 1024, 1024, (bf16_t*)(wb + W_BR), 1024, br * 256, 0, scr, r % 128, lane); continue; } r -= I_B;
    if (r < I_O_) { transpose_item(A.in[I_WO] + (size_t)l * 1024 * 1024, 1024, (bf16_t*)(wb + W_O), 1024, 0, 0, scr, r, lane); continue; } r -= I_O_;
    if (r < I_U) { transpose_item(A.in[I_FUP] + (size_t)l * 1024 * 5632, 5632, (bf16_t*)(wb + W_UP), 1024, 0, 1, scr, r, lane); continue; } r -= I_U;
    transpose_item(A.in[I_FDN] + (size_t)l * 2816 * 1024, 1024, (bf16_t*)(wb + W_DN), 2816, 0, 0, scr, r, lane);
  }
}

DI void row_phase(const float* xold, float* xdst, const bf16_t* src, const float* gate, const float* gpost,
                  bf16_t* hout, const float* gnext, const float* sh, const float* sc, int lane) {
  f32x4 v[4];
#pragma unroll
  for (int j = 0; j < 4; ++j) v[j] = ((const f32x4*)xold)[lane + 64 * j];
  if (src) {
    f32x4 s[4]; float ss = 0.f;
#pragma unroll
    for (int j = 0; j < 4; ++j) { const uint2 w = ((const uint2*)src)[lane + 64 * j];
      s[j] = (f32x4){__uint_as_float(w.x << 16), __uint_as_float(w.x & 0xffff0000u), __uint_as_float(w.y << 16), __uint_as_float(w.y & 0xffff0000u)};
      ss += (s[j].x * s[j].x + s[j].y * s[j].y) + (s[j].z * s[j].z + s[j].w * s[j].w); }
    const float rs = __builtin_amdgcn_rsqf(wave_sum(ss, lane) * (1.f / 1024.f) + 1e-6f);
#pragma unroll
    for (int j = 0; j < 4; ++j) { const f32x4 g = ((const f32x4*)gate)[lane + 64 * j], p = ((const f32x4*)gpost)[lane + 64 * j];
      v[j] = v[j] + g * (s[j] * rs * p); ((f32x4*)xdst)[lane + 64 * j] = v[j]; }
  }
  if (hout) {
    float ss = 0.f;
#pragma unroll
    for (int j = 0; j < 4; ++j) ss += (v[j].x * v[j].x + v[j].y * v[j].y) + (v[j].z * v[j].z + v[j].w * v[j].w);
    const float rs = __builtin_amdgcn_rsqf(wave_sum(ss, lane) * (1.f / 1024.f) + 1e-6f);
#pragma unroll
    for (int j = 0; j < 4; ++j) { const f32x4 g = ((const f32x4*)gnext)[lane + 64 * j], a = ((const f32x4*)sh)[lane + 64 * j], b = ((const f32x4*)sc)[lane + 64 * j];
      const f32x4 h = (v[j] * rs * g) * (b + 1.f) + a;
      uint2 w; w.x = cvtpk(h.x, h.y); w.y = cvtpk(h.z, h.w); ((uint2*)hout)[lane + 64 * j] = w; }
  }
}

DI void row_phase_blk(const float* xlat_in, const float* xctx_in, float* xlat_out, float* xctx_out, const bf16_t* srcb,
                      const float* modl, int gate_off, const float* gpost, bf16_t* hb, const float* gnext, const float* modn, int sh_off, int sc_off,
                      int bx, int wave, int lane) {
  const int R0 = bx * 130;
  f32x4 gpv[4], gnv[4], gav[4], shv[4], scv[4];
#pragma unroll
  for (int j = 0; j < 4; ++j) { gpv[j] = ((const f32x4*)gpost)[lane + 64 * j]; gnv[j] = hb ? ((const f32x4*)gnext)[lane + 64 * j] : (f32x4){0.f, 0.f, 0.f, 0.f}; }
  int cur_s = -1;
  f32x4 xv[4], xn[4]; uint2 sv[4], sn[4];
  int row = R0 + wave;
  { const float* xo = (row < NLAT) ? xlat_in + (size_t)row * 1024 : xctx_in + (size_t)(row - NLAT) * 1024;
#pragma unroll
    for (int j = 0; j < 4; ++j) { xv[j] = ((const f32x4*)xo)[lane + 64 * j]; sv[j] = ((const uint2*)(srcb + (size_t)row * 1024))[lane + 64 * j]; } }
  for (; row < R0 + 130; row += 8) {
    const int nrow = row + 8; const bool hn = nrow < R0 + 130;
    if (hn) { const float* xo = (nrow < NLAT) ? xlat_in + (size_t)nrow * 1024 : xctx_in + (size_t)(nrow - NLAT) * 1024;
#pragma unroll
      for (int j = 0; j < 4; ++j) { xn[j] = ((const f32x4*)xo)[lane + 64 * j]; sn[j] = ((const uint2*)(srcb + (size_t)nrow * 1024))[lane + 64 * j]; } }
    const int s = (row < NLAT) ? (row >> 14) : 2;
    if (s != cur_s) { cur_s = s; const float* md = modl + (size_t)s * 6144; const float* mn = modn + (size_t)s * 6144;
#pragma unroll
      for (int j = 0; j < 4; ++j) { gav[j] = ((const f32x4*)(md + gate_off))[lane + 64 * j];
        shv[j] = hb ? ((const f32x4*)(mn + sh_off))[lane + 64 * j] : (f32x4){0.f, 0.f, 0.f, 0.f}; scv[j] = hb ? ((const f32x4*)(mn + sc_off))[lane + 64 * j] : (f32x4){0.f, 0.f, 0.f, 0.f}; } }
    f32x4 sf[4]; float ss = 0.f;
#pragma unroll
    for (int j = 0; j < 4; ++j) { const uint2 w = sv[j];
      sf[j] = (f32x4){__uint_as_float(w.x << 16), __uint_as_float(w.x & 0xffff0000u), __uint_as_float(w.y << 16), __uint_as_float(w.y & 0xffff0000u)};
      ss += (sf[j].x * sf[j].x + sf[j].y * sf[j].y) + (sf[j].z * sf[j].z + sf[j].w * sf[j].w); }
    const float rs = __builtin_amdgcn_rsqf(wave_sum(ss, lane) * (1.f / 1024.f) + 1e-6f);
    float* xd = (row < NLAT) ? xlat_out + (size_t)row * 1024 : xctx_out + (size_t)(row - NLAT) * 1024;
    float s2 = 0.f;
#pragma unroll
    for (int j = 0; j < 4; ++j) { xv[j] = xv[j] + gav[j] * (sf[j] * rs * gpv[j]); ((f32x4*)xd)[lane + 64 * j] = xv[j];
      s2 += (xv[j].x * xv[j].x + xv[j].y * xv[j].y) + (xv[j].z * xv[j].z + xv[j].w * xv[j].w); }
    if (hb) {
      const float r2 = __builtin_amdgcn_rsqf(wave_sum(s2, lane) * (1.f / 1024.f) + 1e-6f);
#pragma unroll
      for (int j = 0; j < 4; ++j) { const f32x4 h = (xv[j] * r2 * gnv[j]) * (scv[j] + 1.f) + shv[j];
        uint2 w; w.x = cvtpk(h.x, h.y); w.y = cvtpk(h.z, h.w); ((uint2*)(hb + (size_t)row * 1024))[lane + 64 * j] = w; }
    }
#pragma unroll
    for (int j = 0; j < 4; ++j) { xv[j] = xn[j]; sv[j] = sn[j]; }
  }
}

__global__ void __launch_bounds__(NTHREADS, 2) fwd_megakernel(Args A_) {
  extern __shared__ __attribute__((aligned(16))) unsigned char lds_raw[];
  LAS unsigned char* lds = (LAS unsigned char*)lds_raw;
  const int wave0_ = __builtin_amdgcn_readfirstlane((int)threadIdx.x >> 6);
  const int G = gridDim.x, bx = blockIdx.x;
  const int NGW = G * 8;
  const int lo = A_.ph_lo, hi = A_.ph_hi;
  if (hi < 0) cg::this_grid().sync();
  int ph = 0, nbar_ = 0;
#ifndef NBARX
#define NBARX 1
#endif
#ifndef SKIPMASK
#define SKIPMASK 0
#endif
#ifndef REPMASK
#define REPMASK 0
#endif
#define PHASE_BEGIN(id) if (ph >= lo && ph < hi && !((SKIPMASK >> (id)) & 1)) for (int rep_ = 0; rep_ < ((((REPMASK) >> (id)) & 1) ? 2 : 1); ++rep_) { const CAS4 Args* Ap_ = (const CAS4 Args*)__builtin_amdgcn_kernarg_segment_ptr(); asm volatile("" : "+s"(Ap_)); const CAS4 Args& A = *Ap_; \
  unsigned char* ws = A.ws; unsigned* ctl = (unsigned*)(ws + WS_CTL); float* MOD = (float*)(ws + WS_MOD); float* XC = (float*)(ws + WS_XC); float* BONUS = (float*)(ws + WS_BONUS); \
  bf16_t* H = (bf16_t*)(ws + WS_H); bf16_t* Z = (bf16_t*)(ws + WS_Z); bf16_t* YS = (bf16_t*)(ws + WS_YS); bf16_t* WAE = (bf16_t*)(ws + WS_WA); bf16_t* WAA = WAE + (size_t)2 * NROW * 256; float* YSC = (float*)(ws + WS_YSC); \
  (void)ctl; (void)MOD; (void)XC; (void)BONUS; (void)H; (void)Z; (void)YS; (void)WAE; (void)WAA; (void)YSC; \
  int tid; asm volatile("v_mbcnt_lo_u32_b32 %0, -1, 0\n\tv_mbcnt_hi_u32_b32 %0, -1, %0" : "=v"(tid)); tid += wave0_ * 64; const int lane = tid & 63, wave = __builtin_amdgcn_readfirstlane(tid >> 6); const int gw = bx * 8 + wave; (void)lane; (void)gw;
#define FRESH_TID(v) int v; asm volatile("v_mbcnt_lo_u32_b32 %0, -1, 0\n\tv_mbcnt_hi_u32_b32 %0, -1, %0" : "=v"(v)); v += wave0_ * 64;
#define PHASE_END } if (ph >= lo && ph + 1 < hi) { FRESH_TID(tb_) const CAS4 Args* Ab_ = (const CAS4 Args*)__builtin_amdgcn_kernarg_segment_ptr(); asm volatile("" : "+s"(Ab_)); for (int bi_ = 0; bi_ < NBARX; ++bi_) { ++nbar_; grid_barrier((unsigned*)(Ab_->ws + WS_CTL), (unsigned)nbar_ * (unsigned)G, tb_); } } ++ph;

  PHASE_BEGIN(0)
    {
      LAS float* sl = (LAS float*)(lds + 72 * 1024);
      for (int i = tid; i < 3 * 1024; i += NTHREADS) { const int s = i >> 10, k = i & 1023;
        const float c = (s < 2) ? A.in[I_C][s * 1024 + k] : A.in[I_CCTX][k]; sl[i] = c * sigmoidf_(c); }
      __syncthreads();
      LAS float* red = (LAS float*)(lds + 88 * 1024);
      for (int it = bx; it < NLAYER * 96; it += G) {
        const int l = it / 96, c0 = (it % 96) * 64;
        const float* wp = A.in[I_ADAW] + (size_t)l * 1024 * 6144 + c0 + lane;
        float a0 = 0.f, a1 = 0.f, a2 = 0.f;
        for (int k = wave * 128; k < wave * 128 + 128; ++k) { const float w = wp[(size_t)k * 6144]; a0 += sl[k] * w; a1 += sl[1024 + k] * w; a2 += sl[2048 + k] * w; }
        red[(wave * 3 + 0) * 64 + lane] = a0; red[(wave * 3 + 1) * 64 + lane] = a1; red[(wave * 3 + 2) * 64 + lane] = a2;
        __syncthreads();
        if (tid < 192) { const int s = tid >> 6, ln = tid & 63; float r = A.in[I_ADAB][l * 6144 + c0 + ln];
          for (int w = 0; w < 8; ++w) r += red[(w * 3 + s) * 64 + ln];
          MOD[((size_t)(l * 3 + s)) * 6144 + c0 + ln] = r; }
        __syncthreads();
      }
    }
    convert_weights(A, 0, lds, gw, NGW, wave, lane);
  PHASE_END

  PHASE_BEGIN(1)
    for (int row = gw; row < NROW; row += NGW) {
      const int s = (row < NLAT) ? (row >> 14) : 2;
      const float* xo = (row < NLAT) ? A.in[I_X] + (size_t)row * 1024 : A.in[I_CTX] + (size_t)(row - NLAT) * 1024;
      const float* md = MOD + (size_t)(0 * 3 + s) * 6144;
      row_phase(xo, nullptr, nullptr, nullptr, nullptr, H + (size_t)row * 1024, A.in[I_NMIXPRE], md, md + 1024, lane);
    }
  PHASE_END

  for (int l = 0; l < NLAYER; ++l) {
    PHASE_BEGIN(2)
      pg8::Gemm g{(const char*)ws, 1024, 1024};
      pg8::SchedPlain S{130, 5, G, bx, 16, (long)WS_H, (long)(WS_W + W_IN), 1024, 1024, 7};
      pg8::EpiStore E{Z, DIN};
      pg8::gemm_phase<pg8::EpiStore, pg8::SchedPlain, false>(lds, g, S, E, tid);
    PHASE_END

    PHASE_BEGIN(3)
      {
        FRESH_TID(tid)
        const int ln = tid & 63, wv = __builtin_amdgcn_readfirstlane(tid >> 6), d = wv >> 2, nq = wv & 3, r32 = ln & 31, hi = ln >> 5;
        LAS unsigned char* AT = lds;
        const float* mu = A.in[I_MU] + (size_t)l * 2 * 896;
        bf16x8 Bf[2][2][4]; float bias0[2], bias1[2];
#pragma unroll
        for (int nt = 0; nt < 2; ++nt) {
          const int c = 64 * nq + 32 * nt + r32;
          bias0[nt] = A.in[I_W0][(l * 2 + d) * 256 + c]; bias1[nt] = A.in[I_A0][(l * 2 + d) * 256 + c];
#pragma unroll
          for (int ks = 0; ks < 4; ++ks) { float f0[8], f1[8];
#pragma unroll
            for (int i = 0; i < 8; ++i) { const size_t o = ((size_t)(l * 2 + d) * 64 + 16 * ks + 8 * hi + i) * 256 + c; f0[i] = A.in[I_W2][o]; f1[i] = A.in[I_A2][o]; }
            Bf[0][nt][ks] = __builtin_bit_cast(bf16x8, pack8(f0)); Bf[1][nt][ks] = __builtin_bit_cast(bf16x8, pack8(f1)); }
        }
        for (int tile = bx; tile < 520; tile += G) {
          const int R0 = tile * 64;
          __syncthreads();
          for (int i = tid; i < 2 * 64 * 16; i += NTHREADS) {
            const int dd = i >> 10, rem = i & 1023, r = rem >> 4, j8 = (rem & 15) * 8, row = R0 + r; int t, len; row_seq(row, t, len);
            const int nb = dd ? t + 1 : t - 1; const bool nv = (nb >= 0) && (nb < len);
            float zc[8], zn[8];
            unpack8(*(const u32x4*)(Z + (size_t)row * DIN + C_LW + j8), zc);
            if (nv) unpack8(*(const u32x4*)(Z + (size_t)(row + (dd ? 1 : -1)) * DIN + C_LW + j8), zn);
            else {
#pragma unroll
              for (int e = 0; e < 8; ++e) zn[e] = 0.f; }
            const f32x4 m0 = *(const f32x4*)(mu + dd * 896 + 768 + j8), m1 = *(const f32x4*)(mu + dd * 896 + 768 + j8 + 4);
            float v[8];
#pragma unroll
            for (int e = 0; e < 8; ++e) { v[e] = zc[e] + (e < 4 ? m0[e] : m1[e - 4]) * (zn[e] - zc[e]); if (j8 < 64) v[e] = 1.f - 2.f * __builtin_amdgcn_rcpf(__builtin_amdgcn_exp2f(2.8853900817779268f * v[e]) + 1.f); }
            *(LAS u32x4*)(AT + ((dd * 2 + (j8 >> 6)) * 64 + r) * 144 + (j8 & 63) * 2) = pack8(v);
          }
          __syncthreads();
          f32x16 acc[2][2][2];
#pragma unroll
          for (int m = 0; m < 2; ++m)
#pragma unroll
            for (int mt = 0; mt < 2; ++mt)
#pragma unroll
              for (int nt = 0; nt < 2; ++nt) acc[m][mt][nt] = f32x16{};
#pragma unroll
          for (int m = 0; m < 2; ++m)
#pragma unroll
            for (int mt = 0; mt < 2; ++mt)
#pragma unroll
              for (int ks = 0; ks < 4; ++ks) {
                const bf16x8 af = *(const LAS bf16x8*)(AT + ((d * 2 + m) * 64 + 32 * mt + r32) * 144 + (16 * ks + 8 * hi) * 2);
#pragma unroll
                for (int nt = 0; nt < 2; ++nt) acc[m][mt][nt] = __builtin_amdgcn_mfma_f32_32x32x16_bf16(af, Bf[m][nt][ks], acc[m][mt][nt], 0, 0, 0);
              }
#pragma unroll
          for (int mt = 0; mt < 2; ++mt)
#pragma unroll
            for (int nt = 0; nt < 2; ++nt) {
              const int c = 64 * nq + 32 * nt + r32;
#pragma unroll
              for (int r = 0; r < 16; ++r) {
                const int row = R0 + 32 * mt + (r & 3) + 8 * (r >> 2) + 4 * hi;
                const float aw = acc[0][mt][nt][r] + bias0[nt], aa = acc[1][mt][nt][r] + bias1[nt];
                const float xx = -aw; const float sp = fmaxf(xx, 0.f) + __logf(1.f + __expf(-fabsf(xx)));
                const float e = -__expf(-sp - 0.5f);
                const float av = sigmoidf_(aa);
                const size_t o = ((size_t)d * NROW + row) * 256 + c;
                WAE[o] = (bf16_t)(cvtpk(e, 0.f) & 0xffffu); WAA[o] = (bf16_t)(cvtpk(av, 0.f) & 0xffffu);
              }
            }
        }
        __syncthreads();
      }
    PHASE_END

    PHASE_BEGIN(4)
#ifndef NO_SCAN
#ifndef REP_SCAN
#define REP_SCAN 1
#endif
#ifndef REP_ATTN
#define REP_ATTN 1
#endif
      if (bx < 64 && (rep_ == 0 || REP_SCAN)) {
        const int sb = bx, s = sb >> 2, qd = sb & 3, d = s >> 3, b = (s >> 2) & 1, hh = s & 3;
        LAS float* buf = (LAS float*)lds;
        float muR[8], muK[8], muV[8], kkc[8], kac[8], rkc[8];
        const int ptid = tid & 255, ts = (ptid >> 3) & 31, cgp = ptid & 7, ch0 = hh * 64 + 8 * cgp;
        {
#pragma unroll
          for (int i = 0; i < 8; ++i) { const float* mu = A.in[I_MU] + (size_t)(l * 2 + d) * 896;
            muR[i] = mu[ch0 + i]; muK[i] = mu[256 + ch0 + i]; muV[i] = mu[512 + ch0 + i];
            kkc[i] = A.in[I_KK][l * 256 + ch0 + i]; kac[i] = A.in[I_KA][l * 256 + ch0 + i]; rkc[i] = A.in[I_RK][l * 256 + ch0 + i]; }
        }
        const int rsub = lane >> 4, kg = lane & 15, vrow = 16 * qd + 4 * (wave & 3) + rsub;
#define SCAN_RLO(cc) (((cc) < 8) ? (NLAT + b * CTXL + (d ? 224 - 32 * (cc) : 32 * (cc))) : (b * TLAT + (d ? 16352 - 32 * ((cc) - 8) : 32 * ((cc) - 8))))
        const unsigned ro = (unsigned)(d ? 31 - ts : ts);
        const unsigned offz = ro * DIN + ch0, offw = ro * 256 + ch0;
        const unsigned roy = (unsigned)(d ? 31 - (ptid >> 3) : (ptid >> 3)), offy = roy * 256 + hh * 64 + 16 * qd + (ptid & 7) * 2;
#define SCAN_LOAD(cc, X) do { const int rlo_ = SCAN_RLO(cc); const bool nv = !((((cc) == 0) || ((cc) == 8)) && ts == 0); \
          const bf16_t* zb = Z + (size_t)rlo_ * DIN; const bf16_t* znb = zb + (d ? DIN : -DIN); const u32x4 z4 = (u32x4){0u, 0u, 0u, 0u}; \
          X[0] = *(const u32x4*)(zb + (offz + C_RR)); X[1] = *(const u32x4*)(zb + (offz + C_RK)); X[2] = *(const u32x4*)(zb + (offz + C_RV)); \
          X[3] = nv ? *(const u32x4*)(znb + (offz + C_RR)) : z4; X[4] = nv ? *(const u32x4*)(znb + (offz + C_RK)) : z4; X[5] = nv ? *(const u32x4*)(znb + (offz + C_RV)) : z4; \
          const bf16_t* wb_ = WAE + ((size_t)d * NROW + rlo_) * 256; const bf16_t* ab_ = WAA + ((size_t)d * NROW + rlo_) * 256; \
          X[6] = *(const u32x4*)(wb_ + offw); X[7] = *(const u32x4*)(ab_ + offw); } while (0)
#define SCAN_PREP(cc, X) do { const int rlo_ = SCAN_RLO(cc); \
          float r8[8], k8[8], v8[8], rn[8], kn[8], vn[8], e8[8], a8[8]; \
          unpack8(X[0], r8); unpack8(X[1], k8); unpack8(X[2], v8); unpack8(X[3], rn); unpack8(X[4], kn); unpack8(X[5], vn); unpack8(X[6], e8); unpack8(X[7], a8); \
          float kkv[8], ssq = 0.f, bsum = 0.f; \
          _Pragma("unroll") for (int i = 0; i < 8; ++i) { r8[i] += muR[i] * (rn[i] - r8[i]); k8[i] += muK[i] * (kn[i] - k8[i]); v8[i] += muV[i] * (vn[i] - v8[i]); \
            kkv[i] = k8[i] * kkc[i]; ssq += kkv[i] * kkv[i]; } \
          ssq = red8(ssq); \
          const float inv = __builtin_amdgcn_rsqf(fmaxf(ssq, 1e-24f)); \
          float wv[8], bb[8], kp[8]; \
          _Pragma("unroll") for (int i = 0; i < 8; ++i) { kkv[i] *= inv; kp[i] = k8[i] * (1.f + (a8[i] - 1.f) * kac[i]); bb[i] = kkv[i] * a8[i]; wv[i] = __expf(e8[i]); bsum += r8[i] * kp[i] * rkc[i]; } \
          bsum = red8(bsum); \
          if (qd == 0 && cgp == 0) (BONUS + ((size_t)d * NROW + rlo_) * 4)[ro * 4 + hh] = bsum; \
          LAS float* db = buf + ((cc) & 1) * (6 * 32 * 64) + ts * 64 + 8 * cgp; \
          *(LAS f32x4*)(db + 0 * 2048) = (f32x4){wv[0], wv[1], wv[2], wv[3]}; *(LAS f32x4*)(db + 0 * 2048 + 4) = (f32x4){wv[4], wv[5], wv[6], wv[7]}; \
          *(LAS f32x4*)(db + 1 * 2048) = (f32x4){kkv[0], kkv[1], kkv[2], kkv[3]}; *(LAS f32x4*)(db + 1 * 2048 + 4) = (f32x4){kkv[4], kkv[5], kkv[6], kkv[7]}; \
          *(LAS f32x4*)(db + 2 * 2048) = (f32x4){bb[0], bb[1], bb[2], bb[3]}; *(LAS f32x4*)(db + 2 * 2048 + 4) = (f32x4){bb[4], bb[5], bb[6], bb[7]}; \
          *(LAS f32x4*)(db + 3 * 2048) = (f32x4){kp[0], kp[1], kp[2], kp[3]}; *(LAS f32x4*)(db + 3 * 2048 + 4) = (f32x4){kp[4], kp[5], kp[6], kp[7]}; \
          *(LAS f32x4*)(db + 4 * 2048) = (f32x4){r8[0], r8[1], r8[2], r8[3]}; *(LAS f32x4*)(db + 4 * 2048 + 4) = (f32x4){r8[4], r8[5], r8[6], r8[7]}; \
          *(LAS f32x4*)(db + 5 * 2048) = (f32x4){v8[0], v8[1], v8[2], v8[3]}; *(LAS f32x4*)(db + 5 * 2048 + 4) = (f32x4){v8[4], v8[5], v8[6], v8[7]}; \
        } while (0)
#define SCAN_YOUT(cc) do { const int rlo_ = SCAN_RLO(cc); const int step_ = ptid >> 3, r2_ = (ptid & 7) * 2; \
          const LAS f32x4* yp_ = (const LAS f32x4*)(ybuf + ((cc) & 1) * 2048 + step_ * 64 + r2_ * 4); const f32x4 y0_ = yp_[0], y1_ = yp_[1]; \
          const f32x2 yv = (f32x2){(y0_[0] + y0_[1]) + (y0_[2] + y0_[3]), (y1_[0] + y1_[1]) + (y1_[2] + y1_[3])}; \
          *(f32x2*)(YSC + ((size_t)d * NROW + rlo_) * 256 + offy) = yv; } while (0)
        LAS float* ybuf = buf + 2 * 6 * 32 * 64;
        u32x4 RA[8], RB[8];
        __syncthreads();
        SCAN_LOAD(0, RA);
        if (wave >= 4) SCAN_PREP(0, RA);
        SCAN_LOAD(1, RA);
#pragma unroll
        for (int i = 0; i < 8; ++i) RB[i] = RA[i];
        __syncthreads();
        f32x2 Sa = (f32x2){0.f, 0.f}, Sb = (f32x2){0.f, 0.f};
        for (int cc = 0; cc < 520; ++cc) {
          if (wave >= 4) {
            if (cc + 2 < 520) SCAN_LOAD(cc + 2, RB);
            if (cc + 1 < 520) SCAN_PREP(cc + 1, RA);
            if (cc > 0) SCAN_YOUT(cc - 1);
#pragma unroll
            for (int i = 0; i < 8; ++i) RA[i] = RB[i];
          } else {
            const LAS float* sbuf = buf + (cc & 1) * (6 * 32 * 64) + 4 * kg;
            LAS float* yb = ybuf + (cc & 1) * 2048 + (4 * wave + rsub) * 4 + (kg >> 2);
            f32x4 W4 = *(const LAS f32x4*)(sbuf + 0 * 2048), K4 = *(const LAS f32x4*)(sbuf + 1 * 2048), B4 = *(const LAS f32x4*)(sbuf + 2 * 2048),
                  P4 = *(const LAS f32x4*)(sbuf + 3 * 2048), R4 = *(const LAS f32x4*)(sbuf + 4 * 2048);
            float vv = sbuf[5 * 2048 - 4 * kg + vrow];
            f32x4 Rp = R4;
#pragma unroll
            for (int st = 0; st < 32; ++st) {
              const int sn = (st + 1) & 31;
              const LAS float* sp = sbuf + sn * 64;
              const f32x4 W4n = *(const LAS f32x4*)(sp + 0 * 2048), K4n = *(const LAS f32x4*)(sp + 1 * 2048), B4n = *(const LAS f32x4*)(sp + 2 * 2048),
                          P4n = *(const LAS f32x4*)(sp + 3 * 2048), R4n = *(const LAS f32x4*)(sp + 4 * 2048);
              const float vvn = sp[5 * 2048 - 4 * kg + vrow];
              f32x2 p = Sa * (f32x2){K4[0], K4[1]}; p = __builtin_elementwise_fma(Sb, (f32x2){K4[2], K4[3]}, p);
              float sa = p[0] + p[1];
              if (st > 0) {
                f32x2 q = Sa * (f32x2){Rp[0], Rp[1]}; q = __builtin_elementwise_fma(Sb, (f32x2){Rp[2], Rp[3]}, q);
                float yq = q[0] + q[1]; yq += DPPF(yq, 0xB1); yq += DPPF(yq, 0x4E);
                yb[(st - 1) * 64] = yq;
              }
              sa = allreduce16(sa);
              const f32x2 vv2 = (f32x2){vv, vv}, nsa = (f32x2){-sa, -sa};
              f32x2 ta = __builtin_elementwise_fma(nsa, (f32x2){B4[0], B4[1]}, vv2 * (f32x2){P4[0], P4[1]});
              f32x2 tb = __builtin_elementwise_fma(nsa, (f32x2){B4[2], B4[3]}, vv2 * (f32x2){P4[2], P4[3]});
              Sa = __builtin_elementwise_fma(Sa, (f32x2){W4[0], W4[1]}, ta);
              Sb = __builtin_elementwise_fma(Sb, (f32x2){W4[2], W4[3]}, tb);
              Rp = R4;
              W4 = W4n; K4 = K4n; B4 = B4n; P4 = P4n; R4 = R4n; vv = vvn;
            }
            { f32x2 q = Sa * (f32x2){Rp[0], Rp[1]}; q = __builtin_elementwise_fma(Sb, (f32x2){Rp[2], Rp[3]}, q);
              float yq = q[0] + q[1]; yq += DPPF(yq, 0xB1); yq += DPPF(yq, 0x4E);
              yb[31 * 64] = yq; }
          }
          __syncthreads();
        }
        if (wave >= 4) SCAN_YOUT(519);
        __syncthreads();
#undef SCAN_LOAD
#undef SCAN_YOUT
#undef SCAN_PREP
#undef SCAN_RLO
      }
#endif
#ifndef NO_ATTN
      if (bx >= 64) {
        {
          FRESH_TID(tid)
          pg8::Gemm g{(const char*)ws, 1024, 1024};
          pg8::SchedPlain S{130, 7, 192, bx - 64, 16, (long)WS_H, (long)(WS_W + W_IN), 1024, 1024, 0};
          pg8::EpiStore E{Z, DIN};
          pg8::gemm_phase<pg8::EpiStore, pg8::SchedPlain, false>(lds, g, S, E, tid);
        }
        { FRESH_TID(tb1_) grid_barrier(ctl + 16, 192u * (unsigned)(2 * l + 1), tb1_); }
      {
        const float* qn = A.in[I_QNORM] + l * 64; const float* kn = A.in[I_KNORM] + l * 64;
        for (long idx = (long)(bx - 64) * NTHREADS + tid; idx < (long)NROW * 48; idx += (long)192 * NTHREADS) {
          const int part = (int)(idx & 7), h6 = (int)((idx >> 3) % 6), row = (int)(idx / 48);
          bf16_t* p = Z + (size_t)row * DIN + C_GQ + 64 * h6 + 8 * part;
          float f[8]; unpack8(*(const u32x4*)p, f);
          float ss = 0.f;
#pragma unroll
          for (int i = 0; i < 8; ++i) ss += f[i] * f[i];
          ss = red8(ss);
          const float rs = __builtin_amdgcn_rsqf(ss * (1.f / 64.f) + 1e-6f);
          const bool isq = h6 < 4; const float* nw = isq ? qn : kn; const float scl = isq ? C2 : 1.f;
#pragma unroll
          for (int i = 0; i < 8; ++i) f[i] = f[i] * rs * nw[8 * part + i] * scl;
          if (row < NLAT) {
            const int t = row & (TLAT - 1); const float gr = (float)(t >> 6), gc = (float)(t & 63);
#pragma unroll
            for (int pp = 0; pp < 4; ++pp) { const int pi = 4 * part + pp;
              const float invf = exp2f(-(float)(pi & 15) * (13.287712379549449f / 16.f));
              const float ang = (pi < 16 ? gr : gc) * invf; const float cs = __cosf(ang), sn = __sinf(ang);
              const float x1 = f[2 * pp], x2 = f[2 * pp + 1]; f[2 * pp] = x1 * cs - x2 * sn; f[2 * pp + 1] = x1 * sn + x2 * cs; }
          }
          *(u32x4*)p = pack8(f);
        }
      }
      {
        FRESH_TID(tid)
        const float* cw = A.in[I_CONVA] + l * 3 * 256;
        for (long idx = (long)(bx - 64) * NTHREADS + tid; idx < (long)NROW * 32; idx += (long)192 * NTHREADS) {
          const int g8 = (int)(idx & 31), row = (int)(idx >> 5); int t, len; row_seq(row, t, len);
          const bf16_t* zr = Z + (size_t)row * DIN;
          { bf16_t* qp = Z + (size_t)row * DIN + C_NAQ + 8 * g8; float f[8]; unpack8(*(const u32x4*)qp, f);
#pragma unroll
            for (int i = 0; i < 8; ++i) f[i] *= C2;
            *(u32x4*)qp = pack8(f); }
          float bg[8], c0[8], x0[8], c1[8], x1[8], c2[8], x2[8];
          unpack8(*(const u32x4*)(zr + 8 * g8), bg);
          unpack8(*(const u32x4*)(zr + 256 + 8 * g8), c1); unpack8(*(const u32x4*)(zr + 512 + 8 * g8), x1);
          if (t > 0) { unpack8(*(const u32x4*)(zr - DIN + 256 + 8 * g8), c0); unpack8(*(const u32x4*)(zr - DIN + 512 + 8 * g8), x0); }
          else {
#pragma unroll
            for (int i = 0; i < 8; ++i) { c0[i] = 0.f; x0[i] = 0.f; } }
          if (t < len - 1) { unpack8(*(const u32x4*)(zr + DIN + 256 + 8 * g8), c2); unpack8(*(const u32x4*)(zr + DIN + 512 + 8 * g8), x2); }
          else {
#pragma unroll
            for (int i = 0; i < 8; ++i) { c2[i] = 0.f; x2[i] = 0.f; } }
          float o[8];
#pragma unroll
          for (int i = 0; i < 8; ++i) { const int c = 8 * g8 + i; o[i] = bg[i] * (cw[c] * (c0[i] * x0[i]) + cw[256 + c] * (c1[i] * x1[i]) + cw[512 + c] * (c2[i] * x2[i])); }
          *(u32x4*)(YS + (size_t)row * 1024 + 8 * g8) = pack8(o);
        }
      }
        { FRESH_TID(tb2_) grid_barrier(ctl + 16, 192u * (unsigned)(2 * l + 2), tb2_); }
      } else {
        FRESH_TID(tw_)
        if (tw_ == 0) { while (__hip_atomic_load(ctl + 16, __ATOMIC_RELAXED, __HIP_MEMORY_SCOPE_AGENT) < 192u * (unsigned)(2 * l + 2)) __builtin_amdgcn_s_sleep(2);
          __builtin_amdgcn_fence(__ATOMIC_ACQUIRE, "agent"); }
        __syncthreads();
      }
      if (rep_ == 0 || REP_ATTN) {
        FRESH_TID(tid)
        volatile LAS unsigned* misc = (volatile LAS unsigned*)(lds + 92 * 1024);
        const float* nab = A.in[I_NABIAS] + (size_t)l * 4 * 465;
        for (;;) {
          __syncthreads();
          if (tid == 0) misc[0] = atomicAdd(ctl + 64 + 64 * l + 32 * rep_, 1u);
          __syncthreads();
          int u = (int)misc[0];
          if (l == NLAYER - 1 && u >= 1024) u += 16;
          if (u >= 1296) break;
          if (u >= 1040) {
            LAS float* SG = (LAS float*)lds;
            const int R0 = (u - 1040) * 130;
            for (int i = tid; i < 130 * 16; i += NTHREADS) { const int r = i >> 4, j8 = (i & 15) * 8; float f[8];
              unpack8(*(const u32x4*)(Z + (size_t)(R0 + r) * DIN + C_LG + j8), f);
#pragma unroll
              for (int e = 0; e < 8; ++e) f[e] = sigmoidf_(f[e]);
              *(LAS f32x4*)(SG + r * 128 + j8) = (f32x4){f[0], f[1], f[2], f[3]}; *(LAS f32x4*)(SG + r * 128 + j8 + 4) = (f32x4){f[4], f[5], f[6], f[7]}; }
            const int half = tid >> 8, c = tid & 255;
            float g2c[128];
#pragma unroll
            for (int j = 0; j < 128; ++j) g2c[j] = A.in[I_G2][((size_t)l * 128 + j) * 256 + c];
            __syncthreads();
            for (int r = half; r < 130; r += 2) {
              const LAS f32x4* sp = (const LAS f32x4*)(SG + r * 128);
              float gate = 0.f;
#pragma unroll
              for (int j4 = 0; j4 < 32; ++j4) { const f32x4 x = sp[j4]; gate += x[0] * g2c[4 * j4] + x[1] * g2c[4 * j4 + 1] + x[2] * g2c[4 * j4 + 2] + x[3] * g2c[4 * j4 + 3]; }
              YS[(size_t)(R0 + r) * 1024 + 768 + c] = (bf16_t)(cvtpk(gate, 0.f) & 0xffffu);
            }
            continue;
          }
          attn_body::TileMap tm; attn_body::NaInfo na{0, 0};
          const bf16_t *Qp, *Kp, *Vp; bf16_t* Op; int mode = 0;
          if (u < 512) {
            const int qb = u & 63, g2 = (u >> 6) & 1, kvh = (u >> 7) & 1, b = u >> 8, h = kvh * 2 + g2;
            tm = {256, b * TLAT, NLAT + b * CTXL, 260};
            const size_t q0 = (size_t)b * TLAT + qb * 256;
            Qp = Z + q0 * DIN + C_GQ + 64 * h; Kp = Z + C_GK + 64 * kvh; Vp = Z + C_GV + 64 * kvh; Op = YS + q0 * 1024 + 512 + 64 * h;
          } else if (u < 1024) {
            const int v = u - 512, ig = v & 63, h = (v >> 6) & 3, b = v >> 8, i0 = 4 * ig;
            int rmin = min(max(i0 - 4, 0), 248), rmax = min(max(i0 + 3 - 4, 0), 248) + 7;
            if (((rmax - rmin + 1) & 1) != 0) { if (rmax < 255) ++rmax; else --rmin; }
            tm = {4, NLAT + b * CTXL, b * TLAT + 64 * rmin, 4 + (rmax - rmin + 1)};
            na = {i0, rmin}; mode = 1;
            if (tid < 512) ((LAS float*)(lds + attn_body::LDS_BIAS))[tid] = (tid < 465) ? nab[h * 465 + tid] * LOG2E : 0.f;
            const size_t q0 = (size_t)b * TLAT + i0 * 64;
            Qp = Z + q0 * DIN + C_NAQ + 64 * h; Kp = Z + C_NAK + 64 * h; Vp = Z + C_NAV + 64 * h; Op = YS + q0 * 1024 + 256 + 64 * h;
          } else {
            const int v = u - 1024, isna = v >> 3, h = v & 3, b = (v >> 2) & 1;
            const size_t q0 = (size_t)NLAT + b * CTXL;
            tm = {4, NLAT + b * CTXL, 0, 4};
            if (isna) { Qp = Z + q0 * DIN + C_NAQ + 64 * h; Kp = Z + C_NAK + 64 * h; Vp = Z + C_NAV + 64 * h; Op = YS + q0 * 1024 + 256 + 64 * h; }
            else { Qp = Z + q0 * DIN + C_GQ + 64 * h; Kp = Z + C_GK + 64 * (h >> 1); Vp = Z + C_GV + 64 * (h >> 1); Op = YS + q0 * 1024 + 512 + 64 * h; }
          }
#ifndef NO_M1
          if (mode) { FRESH_TID(t1_) attn_body::attn_unit<1, 8>(Qp, Kp, Vp, Op, tm, na, (char*)lds_raw, t1_); }
#endif
#ifndef NO_M0
          if (!mode) { FRESH_TID(t0_) attn_body::attn_unit<0, 8>(Qp, Kp, Vp, Op, tm, na, (char*)lds_raw, t0_); }
#endif
        }
      }
#endif
    PHASE_END

    PHASE_BEGIN(5)
      {
        const int half = tid >> 8, c = tid & 255, hh = c >> 6;
        const float lnw = A.in[I_LNW][l * 256 + c], lnb = A.in[I_LNB][l * 256 + c];
        const float mv0 = A.in[I_MU][(size_t)(l * 2 + 0) * 896 + 512 + c], mv1 = A.in[I_MU][(size_t)(l * 2 + 1) * 896 + 512 + c];
        for (int tile = bx; tile < 256; tile += G) {
          const int R0 = tile * 130;
#pragma unroll 2
          for (int r = half; r < 130; r += 2) {
            const int row = R0 + r; int t, len; row_seq(row, t, len);
            const float y = YSC[((size_t)0 * NROW + row) * 256 + c] + YSC[((size_t)1 * NROW + row) * 256 + c];
            const bf16_t* zr = Z + (size_t)row * DIN + C_RV + c;
            const float zv = bf2f(zr[0]), zp = (t > 0) ? bf2f(zr[-DIN]) : 0.f, zq = (t < len - 1) ? bf2f(zr[DIN]) : 0.f;
            const float b0 = BONUS[((size_t)0 * NROW + row) * 4 + hh], b1 = BONUS[((size_t)1 * NROW + row) * 4 + hh];
            const float gate = bf2f(YS[(size_t)row * 1024 + 768 + c]);
            const float mean = wave_sum(y, lane) * (1.f / 64.f); const float dv = y - mean; const float var = wave_sum(dv * dv, lane) * (1.f / 64.f);
            const float yn = dv * __builtin_amdgcn_rsqf(var + 64e-5f) * lnw + lnb;
            const float v0 = zv + mv0 * (zp - zv), v1 = zv + mv1 * (zq - zv);
            const float bon = b0 * v0 + b1 * v1;
            YS[(size_t)row * 1024 + 768 + c] = (bf16_t)(cvtpk((yn + bon) * gate, 0.f) & 0xffffu);
          }
        }
      }
    PHASE_END

    PHASE_BEGIN(6)
      pg8::Gemm g{(const char*)ws, 1024, 1024};
      pg8::SchedMerge S{G, bx, (l == NLAYER - 1) ? 128 : 130};
      pg8::EpiMerge E{ws + WS_PSCR, A.in[I_BGATE] + (size_t)l * 4096, (bf16_t*)(ws + WS_ACCM)};
      pg8::gemm_phase<pg8::EpiMerge, pg8::SchedMerge, false>(lds, g, S, E, tid);
    PHASE_END

    PHASE_BEGIN(7)
      pg8::Gemm g{(const char*)ws, 1024, 1024};
      pg8::SchedPlain S{(l == NLAYER - 1) ? 128 : 130, 4, G, bx, 16, (long)WS_ACCM, (long)(WS_W + W_O), 1024, 1024, 0};
      pg8::EpiStore E{(bf16_t*)(ws + WS_MBUF), 1024};
      pg8::gemm_phase<pg8::EpiStore, pg8::SchedPlain, false>(lds, g, S, E, tid);
    PHASE_END

    PHASE_BEGIN(8)
      for (int vb_ = bx; vb_ < 256; vb_ += G)
      row_phase_blk((l == 0) ? A.in[I_X] : (const float*)A.out, (l == 0) ? A.in[I_CTX] : (const float*)XC, A.out, XC, (const bf16_t*)(ws + WS_MBUF),
                    MOD + (size_t)l * 3 * 6144, 2 * 1024, A.in[I_NMIXPOST] + l * 1024, H, A.in[I_NFFNPRE] + l * 1024, MOD + (size_t)l * 3 * 6144, 3 * 1024, 4 * 1024, vb_, wave, lane);
    PHASE_END

    PHASE_BEGIN(9)
      pg8::Gemm g{(const char*)ws, 1024, 1024};
      pg8::SchedUp S{G, bx, (l == NLAYER - 1) ? 134 : 138};
      pg8::EpiConvGlu E{(bf16_t*)(ws + WS_G), A.in[I_FCONV] + (size_t)l * 3 * 5632};
      pg8::gemm_phase<pg8::EpiConvGlu, pg8::SchedUp, true>(lds, g, S, E, tid);
    PHASE_END

    PHASE_BEGIN(10)
      pg8::Gemm g{(const char*)ws, DFF, DFF};
      pg8::SchedPlain S{(l == NLAYER - 1) ? 128 : 130, 4, G, bx, 44, (long)WS_G, (long)(WS_W + W_DN), DFF, DFF, 0};
      pg8::EpiStore E{(bf16_t*)(ws + WS_F), 1024};
      pg8::gemm_phase<pg8::EpiStore, pg8::SchedPlain, false>(lds, g, S, E, tid);
    PHASE_END

    PHASE_BEGIN(11)
      for (int vb_ = bx; vb_ < 256; vb_ += G)
      row_phase_blk((const float*)A.out, (const float*)XC, A.out, XC, (const bf16_t*)(ws + WS_F),
                    MOD + (size_t)l * 3 * 6144, 5 * 1024, A.in[I_NFFNPOST] + l * 1024, (l < NLAYER - 1) ? H : (bf16_t*)nullptr, A.in[I_NMIXPRE] + ((l + 1) & 3) * 1024,
                    MOD + (size_t)((l + 1) & 3) * 3 * 6144, 0, 1024, vb_, wave, lane);
      if (l < NLAYER - 1) convert_weights(A, l + 1, lds, gw, NGW, wave, lane);
    PHASE_END
  }
}

constexpr int LDS_BYTES = 147456;
constexpr int NPHASES = 2 + NLAYER * 10;
extern "C" void kernel_launch(void* const* d_in, const int* in_sizes, int n_in, void* d_out, int out_size, void* d_ws, size_t ws_size, hipStream_t stream) {
  static int grid = 0;
  if (grid == 0) {
    int dev = 0, cus = 0, per_cu = 0;
    hipGetDevice(&dev);
    hipDeviceGetAttribute(&cus, hipDeviceAttributeMultiprocessorCount, dev);
    if (hipFuncSetAttribute((const void*)fwd_megakernel, hipFuncAttributeMaxDynamicSharedMemorySize, LDS_BYTES) != hipSuccess) fprintf(stderr, "kernel_launch: hipFuncSetAttribute failed\n");
    hipOccupancyMaxActiveBlocksPerMultiprocessor(&per_cu, (const void*)fwd_megakernel, NTHREADS, LDS_BYTES);
    (void)hipGetLastError();
    if (per_cu < 1) per_cu = 1;
    grid = cus;
    if (n_in != 33 || ws_size < WS_END) fprintf(stderr, "kernel_launch: unexpected n_in %d or ws %zu\n", n_in, ws_size);
  }
  (void)hipMemsetAsync((char*)d_ws + WS_CTL, 0, 4096, stream);
  Args a{};
  for (int i = 0; i < 33; ++i) a.in[i] = (const float*)d_in[i];
  a.out = (float*)d_out; a.ws = (unsigned char*)d_ws; a.ph_lo = 0; a.ph_hi = NPHASES;
  void* args[] = {&a};
  hipError_t e = hipLaunchCooperativeKernel((const void*)fwd_megakernel, dim3(grid), dim3(NTHREADS), args, LDS_BYTES, stream);
  if (e != hipSuccess) fprintf(stderr, "cooperative launch failed: %s (grid %d)\n", hipGetErrorString(e), grid);
}
```

```cpp
#include <hip/hip_runtime.h>
#include <hip/hip_cooperative_groups.h>
#include <hip/hip_bf16.h>
#include <cstdio>
#include <cstdint>
#include <cmath>
namespace cg = cooperative_groups;

#define DI __device__ __forceinline__
#define LAS __attribute__((address_space(3)))
#define CAS4 __attribute__((address_space(4)))
typedef unsigned short bf16_t;
typedef short bf16x8 __attribute__((ext_vector_type(8)));
typedef float f32x4 __attribute__((ext_vector_type(4)));
typedef float f32x2 __attribute__((ext_vector_type(2)));
typedef float f32x16 __attribute__((ext_vector_type(16)));
typedef unsigned u32x4 __attribute__((ext_vector_type(4)));
typedef short s16x4 __attribute__((ext_vector_type(4)));
typedef __bf16 bf16x2_t __attribute__((ext_vector_type(2)));

constexpr int DM = 1024, TLAT = 16384, NLAT = 32768, CTXL = 256, NROW = 33280, NLAYER = 4;
constexpr int DIN = 3072, DFF = 2816;
constexpr int C_NAQ = 768, C_NAK = 1024, C_NAV = 1280, C_GQ = 1536, C_GK = 1792, C_GV = 1920;
constexpr int C_RR = 2048, C_RK = 2304, C_RV = 2560, C_LW = 2816, C_LA = 2880, C_LG = 2944;
constexpr float C2 = 0.125f * 1.4426950408889634f;
constexpr float LOG2E = 1.4426950408889634f;
constexpr int NTHREADS = 512;

constexpr size_t MiB = 1u << 20;
constexpr size_t WS_CTL = 0, WS_MOD = 1 * MiB, WS_XC = 2 * MiB, WS_BONUS = 4 * MiB, WS_W = 6 * MiB;
constexpr size_t W_IN = 0, W_GATE = W_IN + (size_t)3072 * 1024 * 2, W_BR = W_GATE + (size_t)4096 * 1024 * 2, W_O = W_BR + (size_t)1024 * 1024 * 2,
                 W_UP = W_O + (size_t)1024 * 1024 * 2, W_DN = W_UP + (size_t)5632 * 1024 * 2, W_END = W_DN + (size_t)1024 * 2816 * 2;
static_assert(WS_W + W_END <= 42 * MiB, "weights");
constexpr size_t WS_H = 42 * MiB + 65536, WS_Z = 108 * MiB, WS_YS = 304 * MiB, WS_WA = 370 * MiB, WS_YSC = 436 * MiB, WS_END = 501 * MiB;
constexpr size_t WS_ACCM = WS_Z, WS_MBUF = WS_Z + 70 * MiB, WS_G = WS_Z, WS_F = WS_YS, WS_PSCR = WS_WA, WS_ASCR = WS_YSC;
constexpr size_t ROWB = (size_t)NROW * 1024 * 2;

DI float bf2f(unsigned u16) { return __uint_as_float(u16 << 16); }
DI unsigned cvtpk(float lo, float hi) { f32x2 v = {lo, hi}; bf16x2_t b = __builtin_convertvector(v, bf16x2_t); return __builtin_bit_cast(unsigned, b); }
DI void unpack8(const u32x4 w, float* f) {
#pragma unroll
  for (int i = 0; i < 4; ++i) { f[2 * i] = __uint_as_float(w[i] << 16); f[2 * i + 1] = __uint_as_float(w[i] & 0xffff0000u); }
}
DI u32x4 pack8(const float* f) { u32x4 w; w.x = cvtpk(f[0], f[1]); w.y = cvtpk(f[2], f[3]); w.z = cvtpk(f[4], f[5]); w.w = cvtpk(f[6], f[7]); return w; }
DI float sigmoidf_(float x) { return __builtin_amdgcn_rcpf(1.f + __builtin_amdgcn_exp2f(-1.4426950408889634f * x)); }
DI float dppf(float x, const int ctrl_dummy);
#define DPPF(x, CTRL) __int_as_float(__builtin_amdgcn_update_dpp(0, __float_as_int(x), (CTRL), 0xf, 0xf, false))
DI float allreduce16(float x) { x += DPPF(x, 0xB1); x += DPPF(x, 0x4E); x += DPPF(x, 0x141); x += DPPF(x, 0x140); return x; }
DI float red8(float x) { x += DPPF(x, 0xB1); x += DPPF(x, 0x4E); x += DPPF(x, 0x141); return x; }
DI float bperm(float v, int src_lane) { return __int_as_float(__builtin_amdgcn_ds_bpermute(src_lane << 2, __float_as_int(v))); }
DI float wave_sum(float v, int lane) { v = allreduce16(v); v += bperm(v, lane ^ 16); v += bperm(v, lane ^ 32); return v; }

DI void grid_barrier(unsigned* ctr, unsigned target, int tid) {
  __syncthreads();
  if (tid == 0) {
    __builtin_amdgcn_fence(__ATOMIC_RELEASE, "agent");
    __hip_atomic_fetch_add(ctr, 1u, __ATOMIC_RELAXED, __HIP_MEMORY_SCOPE_AGENT);
    while (__hip_atomic_load(ctr, __ATOMIC_RELAXED, __HIP_MEMORY_SCOPE_AGENT) < target) __builtin_amdgcn_s_sleep(1);
    __builtin_amdgcn_fence(__ATOMIC_ACQUIRE, "agent");
    asm volatile("s_waitcnt vmcnt(0)" ::: "memory");
  }
  __syncthreads();
}
DI void row_seq(int row, int& t, int& len) { if (row < NLAT) { t = row & (TLAT - 1); len = TLAT; } else { t = (row - NLAT) & (CTXL - 1); len = CTXL; } }

namespace pg8 {
constexpr int BM = 256, BK = 64, HALF = 128, HTB = HALF * BK * 2, STAGE_BYTES = 8 * HTB;
DI int lds_byte(int r, int c) { const int st = (r >> 4) * 2 + (c >> 5), rr = r & 15, cc = c & 31, ob = rr * 64 + cc * 2; return st * 1024 + (ob ^ (((ob >> 9) & 1) << 5)); }
DI void stage_rc(int b, int& R, int& C) { const int st = b / 1024, sb = b % 1024, swz = sb ^ (((sb >> 9) & 1) << 5); R = (st >> 1) * 16 + swz / 64; C = (st & 1) * 32 + (swz % 64) / 2; }
DI int perm32(int rho) { const int n = rho >> 4, i = rho & 15; return 8 * (i >> 2) + 4 * n + (i & 3); }

struct Unit { int pm, pn, nt, kind; };
struct Gemm { const char* base; int lda, ldb; };

template <class Epi, class Sched, bool CONV>
DI void gemm_phase(LAS unsigned char* lds, const Gemm g, const Sched& S, const Epi& E, int tid) {
    const int wid = __builtin_amdgcn_readfirstlane(tid >> 6), lane = tid & 63, wr = wid >> 2, wc = wid & 3, fr = lane & 15, fq = lane >> 4;
    unsigned voffA[2], voffB[2];
#pragma unroll
    for (int i = 0; i < 2; ++i) { int R, C; stage_rc(tid * 16 + i * 8192, R, C); const int Rb = (R & ~31) + perm32(R & 31);
        const int Ra = CONV ? (62 * (R >> 6) + (R & 63)) : R;
        voffA[i] = (unsigned)(Ra * g.lda + C) * 2u; voffB[i] = (unsigned)(Rb * g.ldb + C) * 2u; }
    constexpr int kstep = BK * 2;
    const int hstepA = (CONV ? 124 : HALF) * g.lda * 2, hstepB = HALF * g.ldb * 2;
    const unsigned ldsw = (unsigned)wid * 1024u;
    const int aoff = lds_byte(wr * 64 + fr, fq * 8), boff = lds_byte(wc * 32 + fr, fq * 8);
#define PG8_SA(b, h) (((b) * 2 + (h)) * HTB)
#define PG8_SB(b, h) ((4 + (b) * 2 + (h)) * HTB)
#define PG8_STAGE(bufoff, gbase, voff) do { _Pragma("unroll") for (int _i = 0; _i < 2; ++_i) \
        __builtin_amdgcn_global_load_lds((const unsigned*)((const char*)(gbase) + (voff)[_i]), (LAS unsigned*)(lds + (bufoff) + ldsw + _i * 8192), 16, 0, 0); } while (0)
#define PG8_LDA(dst, b, h) do { _Pragma("unroll") for (int m = 0; m < 4; ++m) _Pragma("unroll") for (int k = 0; k < 2; ++k) dst[m][k] = *(const LAS bf16x8*)(lds + PG8_SA(b, h) + aoff + m * 2048 + k * 1024); } while (0)
#define PG8_LDB(dst, b, h) do { _Pragma("unroll") for (int n = 0; n < 2; ++n) _Pragma("unroll") for (int k = 0; k < 2; ++k) dst[n][k] = *(const LAS bf16x8*)(lds + PG8_SB(b, h) + boff + n * 2048 + k * 1024); } while (0)
#define PG8_MMA(ai, bj, At, Bt) do { __builtin_amdgcn_s_setprio(1); _Pragma("unroll") for (int m = 0; m < 4; ++m) _Pragma("unroll") for (int n = 0; n < 2; ++n) _Pragma("unroll") for (int k = 0; k < 2; ++k) \
        acc[ai][bj][m][n] = __builtin_amdgcn_mfma_f32_16x16x32_bf16(Bt[n][k], At[m][k], acc[ai][bj][m][n], 0, 0, 0); __builtin_amdgcn_s_setprio(0); } while (0)
#define PG8_WAIT_V(n) asm volatile("s_waitcnt vmcnt(" #n ")" ::: "memory")
#define PG8_WAIT_L(n) asm volatile("s_waitcnt lgkmcnt(" #n ")" ::: "memory")
#define PG8_BAR __builtin_amdgcn_s_barrier()
#define PG8_SCHED __builtin_amdgcn_sched_barrier(0)
    Unit cur, nxt; int ui = 0; long ao_, bo_;
    if (!S.next(0, cur, ao_, bo_)) return;
    f32x4 acc[2][2][4][2];
#pragma unroll
    for (int a = 0; a < 2; ++a)
#pragma unroll
        for (int b = 0; b < 2; ++b)
#pragma unroll
            for (int m = 0; m < 4; ++m)
#pragma unroll
                for (int n = 0; n < 2; ++n) acc[a][b][m][n] = (f32x4){0.f, 0.f, 0.f, 0.f};
    bf16x8 At[4][2], B0[2][2], B1[2][2];
    const char* cA = g.base + ao_; const char* cB = g.base + bo_;
    PG8_STAGE(PG8_SB(0, 0), cB, voffB); PG8_STAGE(PG8_SB(0, 1), cB + hstepB, voffB); PG8_STAGE(PG8_SA(0, 0), cA, voffA); PG8_STAGE(PG8_SA(0, 1), cA + hstepA, voffA);
    if (wr == 1) PG8_BAR;
    PG8_WAIT_V(2); PG8_BAR;
    PG8_STAGE(PG8_SB(1, 0), cB + kstep, voffB); PG8_STAGE(PG8_SA(1, 0), cA + kstep, voffA); PG8_STAGE(PG8_SB(1, 1), cB + hstepB + kstep, voffB);
    PG8_WAIT_V(6); PG8_BAR;
    for (;;) {
        const bool has_next = S.next(ui + 1, nxt, ao_, bo_);
        const char* nA = has_next ? g.base + ao_ : cA; const char* nB = has_next ? g.base + bo_ : cB;
        const int nt = cur.nt;
        for (int t = 0; t < nt; t += 2) {
            const bool last = (t == nt - 2);
            const char* a1 = cA + (size_t)(t + 1) * kstep;
            const char* a2 = last ? nA : cA + (size_t)(t + 2) * kstep; const char* b2 = last ? nB : cB + (size_t)(t + 2) * kstep;
            const char* a3 = a2 + kstep; const char* b3 = b2 + kstep;
            PG8_LDB(B0, 0, 0); PG8_LDB(B1, 0, 1); PG8_SCHED; PG8_LDA(At, 0, 0); PG8_STAGE(PG8_SA(1, 1), a1 + hstepA, voffA);
            PG8_WAIT_V(8); PG8_WAIT_L(0); PG8_BAR; PG8_MMA(0, 0, At, B0); PG8_MMA(0, 1, At, B1); PG8_BAR; PG8_SCHED;
            PG8_LDA(At, 0, 1); PG8_STAGE(PG8_SB(0, 0), b2, voffB); PG8_STAGE(PG8_SB(0, 1), b2 + hstepB, voffB); PG8_STAGE(PG8_SA(0, 0), a2, voffA);
            PG8_WAIT_V(8); PG8_WAIT_L(0); PG8_BAR; PG8_MMA(1, 0, At, B0); PG8_MMA(1, 1, At, B1); PG8_BAR; PG8_SCHED;
            PG8_LDB(B0, 1, 0); PG8_LDB(B1, 1, 1); PG8_SCHED; PG8_LDA(At, 1, 0); PG8_STAGE(PG8_SA(0, 1), a2 + hstepA, voffA);
            PG8_WAIT_V(8); PG8_WAIT_L(0); PG8_BAR; PG8_MMA(0, 0, At, B0); PG8_MMA(0, 1, At, B1); PG8_BAR; PG8_SCHED;
            PG8_LDA(At, 1, 1); PG8_STAGE(PG8_SB(1, 0), b3, voffB); PG8_STAGE(PG8_SB(1, 1), b3 + hstepB, voffB); PG8_STAGE(PG8_SA(1, 0), a3, voffA);
            PG8_WAIT_V(8); PG8_WAIT_L(0); PG8_BAR; PG8_MMA(1, 0, At, B0); PG8_MMA(1, 1, At, B1); PG8_BAR; PG8_SCHED;
        }
        if (wr == 0) PG8_BAR;
        E(acc, cur, wr, wc, fr, fq);
        if (!has_next) break;
#pragma unroll
        for (int a = 0; a < 2; ++a)
#pragma unroll
            for (int b = 0; b < 2; ++b)
#pragma unroll
                for (int m = 0; m < 4; ++m)
#pragma unroll
                    for (int n = 0; n < 2; ++n) acc[a][b][m][n] = (f32x4){0.f, 0.f, 0.f, 0.f};
        cur = nxt; cA = nA; cB = nB; ++ui;
        if (wr == 1) PG8_BAR;
    }
    PG8_WAIT_V(0);
    PG8_BAR;
#undef PG8_SA
#undef PG8_SB
#undef PG8_STAGE
#undef PG8_LDA
#undef PG8_LDB
#undef PG8_MMA
#undef PG8_WAIT_V
#undef PG8_WAIT_L
#undef PG8_BAR
#undef PG8_SCHED
}

DI void xcd_tile(int L, int nM, int nN, int& pm, int& pn) {
    const int nwg = nM * nN; int wgid = L; { const int q = nwg / 8, r = nwg % 8, xcd = wgid % 8, off = wgid / 8; wgid = (xcd < r ? xcd * (q + 1) : r * (q + 1) + (xcd - r) * q) + off; }
    const int nig = 8 * nN, gid = wgid / nig, fm = gid * 8, gsz = (nM - fm) < 8 ? (nM - fm) : 8;
    pm = fm + ((wgid % nig) % gsz); pn = (wgid % nig) / gsz;
}
struct SchedPlain {
    int nM, nN, G, c, nt; long a0, b0; int lda, ldb, pn0;
    DI bool next(int i, Unit& u, long& a_off, long& b_off) const {
        const int L = i * G + c; if (L >= nM * nN) return false;
        xcd_tile(L, nM, nN, u.pm, u.pn); u.pn += pn0; a_off = a0 + (long)u.pm * 256 * lda * 2; b_off = b0 + (long)u.pn * 256 * ldb * 2; u.nt = nt; u.kind = 0; return true; }
};
struct SchedMerge {
    int G, c, nrt;
    DI bool next(int i, Unit& u, long& a_off, long& b_off) const {
        const int nr = (c < 512) ? (512 - c + G - 1) / G : 0;
        int sub;
        if (i < 8 * nr) { const int L = (i >> 3) * G + c; xcd_tile(L, 128, 4, u.pm, u.pn); sub = i & 7; }
        else { if (nrt != 130) return false;
            const int ii = i - 8 * nr, k = ii / 5, j = ii - 5 * k, qid = c + k * G; if (qid >= 32) return false;
            const int tq = qid >> 2, q = qid & 3; u.pm = 128 + (tq >> 2); u.pn = tq & 3; sub = (j < 4) ? j : 12 + q; }
        u.kind = sub;
        if (sub < 4) { a_off = (long)WS_YS + ((long)u.pm * 256 * 1024 + sub * 256) * 2; b_off = (long)(WS_W + W_BR) + ((long)u.pn * 256 * 1024 + sub * 256) * 2; u.nt = 4; }
        else { a_off = (long)WS_H + (long)u.pm * 256 * 1024 * 2; b_off = (long)(WS_W + W_GATE) + ((long)((u.pn * 4 + ((sub - 4) & 3)) * 256) * 1024) * 2; u.nt = 16; }
        return true; }
};
struct SchedUp {
    int G, c, ntm;
    DI static void tile_seq(int tm, int& base, int& len, int& j) {
        if (tm < 67) { base = 0; len = TLAT; j = tm; } else if (tm < 134) { base = TLAT; len = TLAT; j = tm - 67; }
        else { const int x = tm - 134; base = NLAT + (x >> 1) * CTXL; len = CTXL; j = x & 1; } }
    DI bool next(int i, Unit& u, long& a_off, long& b_off) const {
        const int L = i * G + c; if (L >= ntm * 22) return false;
        xcd_tile(L, ntm, 22, u.pm, u.pn); int base, len, j; tile_seq(u.pm, base, len, j);
        a_off = (long)WS_H + ((long)(base + 248 * j - 1) * 1024) * 2; b_off = (long)(WS_W + W_UP) + (long)u.pn * 256 * 1024 * 2; u.nt = 16; u.kind = 0; return true; }
};

struct EpiStore {
    bf16_t* O; int ldc;
    DI void operator()(const f32x4 (&acc)[2][2][4][2], const Unit& u, int wr, int wc, int fr_in, int fq_in) const {
        int ln_; asm volatile("v_mbcnt_lo_u32_b32 %0, -1, 0\n\tv_mbcnt_hi_u32_b32 %0, -1, %0" : "=v"(ln_)); const int fr = ln_ & 15, fq = ln_ >> 4; (void)fr_in; (void)fq_in;
        const int row0 = u.pm * 256 + wr * 64 + fr, col0 = u.pn * 256 + wc * 32 + 8 * fq;
#pragma unroll
        for (int ai = 0; ai < 2; ++ai)
#pragma unroll
            for (int m = 0; m < 4; ++m) { bf16_t* rowp = O + (size_t)(row0 + ai * 128 + m * 16) * ldc + col0;
#pragma unroll
                for (int bj = 0; bj < 2; ++bj) { const f32x4 v0 = acc[ai][bj][m][0], v1 = acc[ai][bj][m][1];
                    u32x4 w; w.x = cvtpk(v0[0], v0[1]); w.y = cvtpk(v0[2], v0[3]); w.z = cvtpk(v1[0], v1[1]); w.w = cvtpk(v1[2], v1[3]);
                    *(u32x4*)(rowp + bj * 128) = w; } }
    }
};
struct EpiMerge {
    unsigned char* stash; const float* bgate; bf16_t* O;
    DI void operator()(const f32x4 (&acc)[2][2][4][2], const Unit& u, int wr, int wc, int fr_in, int fq_in) const {
        int ln_; asm volatile("v_mbcnt_lo_u32_b32 %0, -1, 0\n\tv_mbcnt_hi_u32_b32 %0, -1, %0" : "=v"(ln_)); const int fr = ln_ & 15, fq = ln_ >> 4; (void)fr_in; (void)fq_in;
        unsigned char* st = stash + (size_t)blockIdx.x * 524288;
        if (u.kind < 4) {
            unsigned char* pb = st + (size_t)u.kind * 131072 + (size_t)(wr * 64 + fr) * 512 + (wc * 32 + 8 * fq) * 2;
#pragma unroll
            for (int ai = 0; ai < 2; ++ai)
#pragma unroll
                for (int m = 0; m < 4; ++m)
#pragma unroll
                    for (int bj = 0; bj < 2; ++bj) { const f32x4 v0 = acc[ai][bj][m][0], v1 = acc[ai][bj][m][1];
                        u32x4 w; w.x = cvtpk(v0[0], v0[1]); w.y = cvtpk(v0[2], v0[3]); w.z = cvtpk(v1[0], v1[1]); w.w = cvtpk(v1[2], v1[3]);
                        *(u32x4*)(pb + (size_t)(ai * 128 + m * 16) * 512 + bj * 256) = w; }
            if (u.kind == 3) asm volatile("s_waitcnt vmcnt(0)" ::: "memory");
        } else {
            if (u.kind == 4 || u.kind >= 12) { __builtin_amdgcn_fence(__ATOMIC_ACQUIRE, "agent"); asm volatile("s_waitcnt vmcnt(0)" ::: "memory"); }
            const int q = (u.kind - 4) & 3, cq = 64 * q + 16 * wc + 4 * fq, col = u.pn * 256 + cq;
            f32x4 bg[4];
#pragma unroll
            for (int i = 0; i < 4; ++i) bg[i] = *(const f32x4*)(bgate + i * 1024 + col);
            const unsigned char* pb = st + (size_t)(wr * 64 + fr) * 512 + cq * 2;
            bf16_t* ob = O + (size_t)(u.pm * 256 + wr * 64 + fr) * 1024 + col;
#pragma unroll
            for (int ai = 0; ai < 2; ++ai)
#pragma unroll
                for (int m = 0; m < 4; ++m) {
                    f32x4 o = (f32x4){0.f, 0.f, 0.f, 0.f};
#pragma unroll
                    for (int bj = 0; bj < 2; ++bj)
#pragma unroll
                        for (int n = 0; n < 2; ++n) { const int i = 2 * bj + n;
                            const uint2 pw = *(const uint2*)(pb + (size_t)i * 131072 + (size_t)(ai * 128 + m * 16) * 512);
                            const f32x4 p = (f32x4){__uint_as_float(pw.x << 16), __uint_as_float(pw.x & 0xffff0000u), __uint_as_float(pw.y << 16), __uint_as_float(pw.y & 0xffff0000u)};
                            const f32x4 gv = acc[ai][bj][m][n] + bg[i];
#pragma unroll
                            for (int e = 0; e < 4; ++e) o[e] += sigmoidf_(gv[e]) * p[e]; }
                    uint2 w; w.x = cvtpk(o[0], o[1]); w.y = cvtpk(o[2], o[3]);
                    *(uint2*)(ob + (size_t)(ai * 128 + m * 16) * 1024) = w;
                }
        }
    }
};
struct EpiConvGlu {
    bf16_t* Gout; const float* cw;
    DI void operator()(const f32x4 (&acc)[2][2][4][2], const Unit& u, int wr, int wc, int fr_in, int fq_in) const {
        int ln_; asm volatile("v_mbcnt_lo_u32_b32 %0, -1, 0\n\tv_mbcnt_hi_u32_b32 %0, -1, %0" : "=v"(ln_)); const int fr = ln_ & 15, fq = ln_ >> 4; (void)fr_in; (void)fq_in;
        int base, len, j; SchedUp::tile_seq(u.pm, base, len, j);
        const bool f0 = (fr == 0), f15 = (fr == 15);
#pragma unroll
        for (int n = 0; n < 2; ++n) {
            const int colv = u.pn * 128 + wc * 32 + 8 * fq + 4 * n;
            f32x4 wv[3], wg[3];
#pragma unroll
            for (int k = 0; k < 3; ++k) { wv[k] = *(const f32x4*)(cw + k * 5632 + colv); wg[k] = *(const f32x4*)(cw + k * 5632 + 2816 + colv); }
#pragma unroll
            for (int ai = 0; ai < 2; ++ai) {
#pragma unroll
                for (int m = 0; m < 4; ++m) {
                    const int rho = 16 * m + fr;
                    const int tl = 248 * j + 62 * (2 * ai + wr) - 1 + rho;
                    const bool valid = (rho >= 1) && (rho <= 62) && (tl >= 0) && (tl < len);
                    const bool lz = (tl <= 0), rz = (tl >= len - 1);
                    float outv[4];
#pragma unroll
                    for (int e = 0; e < 4; ++e) {
                        float cvv[2];
#pragma unroll
                        for (int bj = 0; bj < 2; ++bj) {
                            const float xc = acc[ai][bj][m][n][e];
                            const float xm1 = (m > 0) ? acc[ai][bj][m - 1][n][e] : xc, xp1 = (m < 3) ? acc[ai][bj][m + 1][n][e] : xc;
                            const float tl_ = f15 ? xm1 : xc, tr_ = f0 ? xp1 : xc;
                            const float lraw = DPPF(tl_, 0x121); const float left = lz ? 0.f : lraw;
                            const float rraw = DPPF(tr_, 0x12F); const float right = rz ? 0.f : rraw;
                            cvv[bj] = bj ? (left * wg[0][e] + xc * wg[1][e] + right * wg[2][e]) : (left * wv[0][e] + xc * wv[1][e] + right * wv[2][e]);
                        }
                        outv[e] = cvv[0] * cvv[1] * sigmoidf_(cvv[1]);
                    }
                    if (valid) { uint2 w; w.x = cvtpk(outv[0], outv[1]); w.y = cvtpk(outv[2], outv[3]); *(uint2*)(Gout + (size_t)(base + tl) * DFF + colv) = w; }
                }
            }
        }
    }
};
}

namespace attn_body {
constexpr int QP = DIN, OP = 1024;
constexpr int NW = 8, QBLK = 32, KVBLK = 64;
DI int crow(int r, int hi) { return (r & 3) + 8 * (r >> 2) + 4 * hi; }
#define SBAR() __builtin_amdgcn_sched_barrier(0)
constexpr int NSLOT = 3, SLOTB = 8192;
constexpr int LDS_K = 0, LDS_V = NSLOT * SLOTB, LDS_WS = 2 * NSLOT * SLOTB, LDS_OST = LDS_WS + NW * 64 * 4, LDS_BYTES = LDS_OST + NW * 4096;
constexpr int LDS_BIAS = 86016;
DI void glds16(const void* gsrc, unsigned lds_dst) { unsigned keep;
  asm volatile("s_mov_b32 %0, m0\n\ts_mov_b32 m0, %2\n\ts_nop 0\n\tglobal_load_lds_dwordx4 %1, off\n\ts_mov_b32 m0, %0" : "=&s"(keep) : "v"(gsrc), "s"(lds_dst) : "memory"); }
DI float max3f(float a, float b, float c) { float r; asm("v_max3_f32 %0, %1, %2, %3" : "=v"(r) : "v"(a), "v"(b), "v"(c)); return r; }
DI float max2f(float a, float b) { float r; asm("v_max_f32_e32 %0, %1, %2" : "=v"(r) : "v"(a), "v"(b)); return r; }
DI float fadd_s(float a, float b) { float r; asm("v_add_f32_e32 %0, %1, %2" : "=v"(r) : "v"(a), "v"(b)); return r; }
DI float fsub_s(float a, float b) { float r; asm("v_sub_f32_e32 %0, %1, %2" : "=v"(r) : "v"(a), "v"(b)); return r; }
DI unsigned cvtpk_s(float lo, float hi) { return cvtpk(lo, hi); }
#define WAIT_BAR(N) asm volatile("s_waitcnt vmcnt(" #N ") lgkmcnt(0)\n\ts_barrier" ::: "memory")

DI void qkt(f32x16& p0, f32x16& p1, const char* Kslot, const bf16x8* qr, int r32, int hi) {
  const f32x16 zz = f32x16{};
  const char* kb = Kslot + hi * 1024 + r32 * 16;
#pragma unroll
  for (int d0 = 0; d0 < 4; ++d0) {
    const bf16x8 b0 = *reinterpret_cast<const bf16x8*>(kb + d0 * 2048);
    const bf16x8 b1 = *reinterpret_cast<const bf16x8*>(kb + d0 * 2048 + 512);
    if (d0 == 0) { p0 = __builtin_amdgcn_mfma_f32_32x32x16_bf16(b0, qr[0], zz, 0, 0, 0); p1 = __builtin_amdgcn_mfma_f32_32x32x16_bf16(b1, qr[0], zz, 0, 0, 0); }
    else { p0 = __builtin_amdgcn_mfma_f32_32x32x16_bf16(b0, qr[d0], p0, 0, 0, 0); p1 = __builtin_amdgcn_mfma_f32_32x32x16_bf16(b1, qr[d0], p1, 0, 0, 0); } }
}
typedef __attribute__((address_space(3))) const char* lds_cptr;
typedef short v4i16_t __attribute__((ext_vector_type(4)));
DI void kload8(bf16x8* kf, lds_cptr kp) {
  kf[0] = *(const LAS bf16x8*)(kp);        kf[1] = *(const LAS bf16x8*)(kp + 512);
  kf[2] = *(const LAS bf16x8*)(kp + 2048); kf[3] = *(const LAS bf16x8*)(kp + 2560);
  kf[4] = *(const LAS bf16x8*)(kp + 4096); kf[5] = *(const LAS bf16x8*)(kp + 4608);
  kf[6] = *(const LAS bf16x8*)(kp + 6144); kf[7] = *(const LAS bf16x8*)(kp + 6656);
}
DI void kload2(bf16x8* kf, lds_cptr kp, int j) { kf[2 * j] = *(const LAS bf16x8*)(kp + j * 2048); kf[2 * j + 1] = *(const LAS bf16x8*)(kp + j * 2048 + 512); }
DI s16x4 vtr(lds_cptr p) { return __builtin_bit_cast(s16x4, __builtin_amdgcn_ds_read_tr16_b64_v4i16((LAS v4i16_t*)p)); }
DI float rowmax(const f32x16& p0, const f32x16& p1) {
  float a = max3f(p0[0], p0[1], p1[0]), b = max3f(p0[2], p0[3], p1[1]); a = max3f(a, p1[2], p1[3]);
#pragma unroll
  for (int r = 4; r < 16; r += 4) { a = max3f(a, p0[r], p0[r + 1]); b = max3f(b, p0[r + 2], p0[r + 3]); a = max3f(a, p1[r], p1[r + 1]); b = max3f(b, p1[r + 2], p1[r + 3]); }
  const float m = max2f(a, b);
  auto rr = __builtin_amdgcn_permlane32_swap(__float_as_uint(m), __float_as_uint(m), false, false);
  return max2f(__uint_as_float(rr[0]), __uint_as_float(rr[1]));
}
DI void pv(f32x16* o, int vb, bf16x8 pa0, bf16x8 pa1, bf16x8 pa2, bf16x8 pa3) {
#pragma unroll
  for (int d0 = 0; d0 < 2; ++d0) { s16x4 lo[4], hi[4];
#pragma unroll
    for (int ks = 0; ks < 4; ++ks) {
      asm volatile("ds_read_b64_tr_b16 %0,%1 offset:%c2" : "=&v"(lo[ks]) : "v"(vb), "i"(d0 * 4096 + ks * 1024) : "memory");
      asm volatile("ds_read_b64_tr_b16 %0,%1 offset:%c2" : "=&v"(hi[ks]) : "v"(vb), "i"(d0 * 4096 + ks * 1024 + 512) : "memory"); }
    asm volatile("s_waitcnt lgkmcnt(0)" ::: "memory"); SBAR();
#define PK(k) (bf16x8){lo[k][0], lo[k][1], lo[k][2], lo[k][3], hi[k][0], hi[k][1], hi[k][2], hi[k][3]}
    o[d0] = __builtin_amdgcn_mfma_f32_32x32x16_bf16(pa0, PK(0), o[d0], 0, 0, 0);
    o[d0] = __builtin_amdgcn_mfma_f32_32x32x16_bf16(pa1, PK(1), o[d0], 0, 0, 0);
    o[d0] = __builtin_amdgcn_mfma_f32_32x32x16_bf16(pa2, PK(2), o[d0], 0, 0, 0);
    o[d0] = __builtin_amdgcn_mfma_f32_32x32x16_bf16(pa3, PK(3), o[d0], 0, 0, 0);
#undef PK
  }
}
struct TileMap { int n1, base1, base2, NT; };
struct NaInfo { int i0, rmin; };

template <int MODE, int THRL>
DI void attn_unit(const bf16_t* Qw0, const bf16_t* __restrict__ Kh, const bf16_t* __restrict__ Vh, bf16_t* Ow0, const TileMap tm, const NaInfo na, char* shm, int tid) {
  const int lane = tid & 63, r32 = lane & 31, hi = lane >> 5; const int wid = __builtin_amdgcn_readfirstlane(tid >> 6);
  const bf16_t* Qw = Qw0 + (long)(wid * QBLK) * QP;
  const unsigned lds0 = (unsigned)(uintptr_t)shm;
  float* wsf = (float*)(shm + LDS_WS) + wid * 64;
  const bf16_t* ksrc = Kh + (long)lane * QP + wid * 8;
  const bf16_t* vsrc = Vh + (long)(16 * (wid & 3) + (lane >> 2)) * QP + (wid >> 2) * 32 + (lane & 3) * 8;
  const unsigned kdst = lds0 + LDS_K + wid * 1024, vdst = lds0 + LDS_V + wid * 1024;
#define TROW(t) ((long)(((t) < tm.n1) ? (tm.base1 + 64 * (t)) : (tm.base2 + 64 * ((t) - tm.n1))))
#define DMA_K(t, slot) glds16(ksrc + TROW(t) * QP, (unsigned)__builtin_amdgcn_readfirstlane(kdst + (slot)))
#define DMA_V(t, slot) glds16(vsrc + TROW(t) * QP, (unsigned)__builtin_amdgcn_readfirstlane(vdst + (slot)))
  const int vb0 = (int)(lds0 + LDS_V) + ((lane >> 4) & 1) * 32 + (lane & 3) * 8 + (4 * hi + ((lane & 15) >> 2)) * 64;
  const char* Kbase = shm + LDS_K; bf16x8 kf[8];
  const lds_cptr shm3 = (lds_cptr)shm; const lds_cptr kp0 = shm3 + LDS_K + hi * 1024 + r32 * 16; const lds_cptr vp0 = shm3 + LDS_V + ((lane >> 4) & 1) * 32 + (lane & 3) * 8 + (4 * hi + ((lane & 15) >> 2)) * 64;
  const int NT = tm.NT;
  DMA_K(0, 0); DMA_V(0, 0); DMA_K(1, SLOTB);
  bf16x8 qr[4];
#pragma unroll
  for (int d0 = 0; d0 < 4; ++d0) qr[d0] = *reinterpret_cast<const bf16x8*>(&Qw[(long)r32 * QP + d0 * 16 + hi * 8]);
  float mhat = 0.f, l_reg = 0.f; f32x16 o[2]; o[0] = f32x16{}; o[1] = f32x16{}; f32x16 zacc = f32x16{}; if (MODE == 0) asm volatile("" : "+v"(zacc));
#define CMASK(P0, P1, t) do { if (MODE == 1) { const int t_ = (t); const bool ctx_ = t_ < 4; \
      int lane_ = lane; asm volatile("" : "+v"(lane_)); const int r32_ = lane_ & 31, hi_ = lane_ >> 5; \
      const int qi_ = na.i0 + (wid >> 1), qj_ = (wid & 1) * 32 + r32_; const int rs_ = min(max(qi_ - 4, 0), 248), cs_ = min(max(qj_ - 8, 0), 48); \
      const int kr = na.rmin + t_ - 4; const bool rowok = (unsigned)(kr - rs_) < 8u; \
      const int bb = ctx_ ? 480 : ((kr - qi_ + 7) * 31 + 15 - qj_ + 4 * hi_); const int lo_ = ctx_ ? -4096 : ((rowok ? cs_ : 4096) - 4 * hi_); const unsigned wd_ = ctx_ ? 8192u : 16u; const int mul_ = ctx_ ? 0 : 1; \
      const LAS float* btab = (const LAS float*)((lds_cptr)shm + LDS_BIAS); \
      _Pragma("unroll") for (int g_ = 0; g_ < 8; ++g_) { \
        _Pragma("unroll") for (int q_ = 0; q_ < 2; ++q_) { const int r = 2 * g_ + q_; const int kc0 = (r & 3) + 8 * (r >> 2); \
          const int d0_ = kc0 - lo_; \
          const int i0_ = ((unsigned)d0_ < wd_) ? bb + kc0 * mul_ : -1, i1_ = ((unsigned)(d0_ + 32) < wd_) ? bb + (kc0 + 32) * mul_ : -1; \
          const float b0_ = btab[max(i0_, 0)], b1_ = btab[max(i1_, 0)]; \
          P0[r] = (i0_ >= 0) ? P0[r] + b0_ : -INFINITY; P1[r] = (i1_ >= 0) ? P1[r] + b1_ : -INFINITY; } \
        SBAR(); } } } while (0)
  bool resc = false;
#define START(P0, P1) do { const float rm = rowmax(P0, P1); resc = false; \
    { const float dl = rm; mhat = fadd_s(mhat, dl); \
      _Pragma("unroll") for (int r = 0; r < 16; ++r) { P0[r] = fsub_s(P0[r], dl); P1[r] = fsub_s(P1[r], dl); } \
      if (MODE == 0) { _Pragma("unroll") for (int r = 0; r < 16; ++r) zacc[r] = -mhat; asm volatile("" : "+v"(zacc)); } } \
    _Pragma("unroll") for (int r = 0; r < 16; ++r) P0[r] = __builtin_amdgcn_exp2f(P0[r]); } while (0)
#define RESC() do { if (resc) { asm volatile("s_waitcnt lgkmcnt(0)" ::: "memory"); \
      _Pragma("unroll") for (int d_ = 0; d_ < 2; ++d_) _Pragma("unroll") for (int r = 0; r < 16; ++r) o[d_][r] *= wsf[crow(r, hi)]; } } while (0)
  f32x16 pA0, pA1, pB0, pB1;
  int sl_prev = 0, sl_cur = 0, sl_next = SLOTB;
#define ROT() do { sl_prev = sl_cur; sl_cur = sl_next; sl_next = (sl_next == (NSLOT - 1) * SLOTB) ? 0 : sl_next + SLOTB; } while (0)
  DMA_K(2, 2 * SLOTB);
  WAIT_BAR(3);
  qkt(pA0, pA1, Kbase, qr, r32, hi); asm volatile("s_nop 15\n\ts_nop 7" : "+v"(pA0), "+v"(pA1)); CMASK(pA0, pA1, 0);
  START(pA0, pA1);
  _Pragma("unroll") for (int r = 0; r < 16; ++r) pA1[r] = __builtin_amdgcn_exp2f(pA1[r]);
  WAIT_BAR(0);
  DMA_K(3, 0); DMA_V(1, SLOTB);
  ROT();
  kload8(kf, kp0 + sl_cur);
  WAIT_BAR(2);
  s16x4 vlo[8], vhi[8]; u32x4 pw0, pw1, pw2, pw3;
#define PKW(P, B) cvtpk_s(P[B], P[B + 1])
#define PAF(k) __builtin_bit_cast(bf16x8, pw##k)
#define VFR(i) (bf16x8){vlo[i][0], vlo[i][1], vlo[i][2], vlo[i][3], vhi[i][0], vhi[i][1], vhi[i][2], vhi[i][3]}
#define PIN(x) asm volatile("" : "+v"(x))
#define MX3(a, b, c) __builtin_fmaxf(__builtin_fmaxf((a), (b)), (c))
#define GAPA(MF, A0, A1, A2, A3, W0, W1, PW) do { MF; sacc += A0; sacc += A1; sacc += A2; sacc += A3; PIN(sacc); W0; W1; PIN(PW); SBAR(); } while (0)
#define EX(v) __builtin_amdgcn_exp2f(v)
#define GAPB(MF, X, B) do { MF; X[B] = EX(X[B]); X[B + 1] = EX(X[B + 1]); X[B + 2] = EX(X[B + 2]); X[B + 3] = EX(X[B + 3]); PIN(X); SBAR(); } while (0)
#define VRD(i) do { vlo[i] = vtr(vp_ + (((i) >> 2) * 4096 + ((i) & 3) * 1024)); vhi[i] = vtr(vp_ + (((i) >> 2) * 4096 + ((i) & 3) * 1024 + 512)); } while (0)
#define KRD(G, j) do { if (G) { kload2(kf, kp0 + sl_next, j); SBAR(); } } while (0)
#define STEP(C0, C1, P0, P1, t, GK, GV, GL) do { SBAR(); \
    const lds_cptr vp_ = vp0 + sl_prev; \
    VRD(0); SBAR(); float sacc = (P0[0] + P0[1]); \
    GAPA(C0 = __builtin_amdgcn_mfma_f32_32x32x16_bf16(kf[0], qr[0], zacc, 0, 0, 0), P0[2], P0[3], P0[4], P0[5],     pw0[0] = PKW(P0, 0), pw0[1] = PKW(P0, 2), pw0); \
    VRD(4); SBAR(); GAPA(C1 = __builtin_amdgcn_mfma_f32_32x32x16_bf16(kf[1], qr[0], zacc, 0, 0, 0), P0[6], P0[7], P0[8], P0[9],     pw0[2] = PKW(P0, 4), pw0[3] = PKW(P0, 6), pw0); \
    VRD(1); SBAR(); GAPA(C0 = __builtin_amdgcn_mfma_f32_32x32x16_bf16(kf[2], qr[1], C0, 0, 0, 0),   P0[10], P0[11], P0[12], P0[13], pw1[0] = PKW(P0, 8), pw1[1] = PKW(P0, 10), pw1); \
    VRD(5); SBAR(); GAPA(C1 = __builtin_amdgcn_mfma_f32_32x32x16_bf16(kf[3], qr[1], C1, 0, 0, 0),   P0[14], P0[15], P1[0], P1[1],   pw1[2] = PKW(P0, 12), pw1[3] = PKW(P0, 14), pw1); \
    VRD(2); SBAR(); GAPA(C0 = __builtin_amdgcn_mfma_f32_32x32x16_bf16(kf[4], qr[2], C0, 0, 0, 0),   P1[2], P1[3], P1[4], P1[5],     pw2[0] = PKW(P1, 0), pw2[1] = PKW(P1, 2), pw2); \
    VRD(6); SBAR(); GAPA(C1 = __builtin_amdgcn_mfma_f32_32x32x16_bf16(kf[5], qr[2], C1, 0, 0, 0),   P1[6], P1[7], P1[8], P1[9],     pw2[2] = PKW(P1, 4), pw2[3] = PKW(P1, 6), pw2); \
    VRD(3); SBAR(); GAPA(C0 = __builtin_amdgcn_mfma_f32_32x32x16_bf16(kf[6], qr[3], C0, 0, 0, 0),   P1[10], P1[11], P1[12], P1[13], pw3[0] = PKW(P1, 8), pw3[1] = PKW(P1, 10), pw3); \
    VRD(7); SBAR(); GAPA(C1 = __builtin_amdgcn_mfma_f32_32x32x16_bf16(kf[7], qr[3], C1, 0, 0, 0),   P1[14], P1[15], 0.f, 0.f,       pw3[2] = PKW(P1, 12), pw3[3] = PKW(P1, 14), pw3); \
    l_reg += sacc; \
    if (GK) { DMA_K((t) + 3, sl_cur); } if (GV) { DMA_V((t) + 1, sl_next); } \
    if (MODE == 1) { _Pragma("unroll") for (int r = 0; r < 16; ++r) { C0[r] -= mhat; C1[r] -= mhat; } } \
    CMASK(C0, C1, t); \
    { float a = MX3(C0[0], C0[1], C1[0]), b = MX3(C0[2], C0[3], C1[1]); a = MX3(a, C1[2], C1[3]); \
      _Pragma("unroll") for (int r = 4; r < 16; r += 4) { a = MX3(a, C0[r], C0[r + 1]); b = MX3(b, C0[r + 2], C0[r + 3]); a = MX3(a, C1[r], C1[r + 1]); b = MX3(b, C1[r + 2], C1[r + 3]); } \
      float rm = __builtin_fmaxf(a, b); { auto rr = __builtin_amdgcn_permlane32_swap(__float_as_uint(rm), __float_as_uint(rm), false, false); rm = __builtin_fmaxf(__uint_as_float(rr[0]), __uint_as_float(rr[1])); } \
      resc = false; \
      if (__builtin_expect(__any(rm > (float)THRL), 0)) { const float dl = __builtin_fmaxf(rm, 0.f); mhat += dl; \
        _Pragma("unroll") for (int r = 0; r < 16; ++r) { C0[r] -= dl; C1[r] -= dl; } \
        if (MODE == 0) { _Pragma("unroll") for (int r = 0; r < 16; ++r) zacc[r] = -mhat; asm volatile("" : "+v"(zacc)); } \
        const float f = __builtin_amdgcn_exp2f(-dl); l_reg *= f; if (hi == 0) wsf[r32] = f; resc = true; } } \
    SBAR(); \
    GAPB(o[0] = __builtin_amdgcn_mfma_f32_32x32x16_bf16(PAF(0), VFR(0), o[0], 0, 0, 0), C0, 0); \
    GAPB(o[1] = __builtin_amdgcn_mfma_f32_32x32x16_bf16(PAF(0), VFR(4), o[1], 0, 0, 0), C0, 4); \
    KRD(GL, 0); GAPB(o[0] = __builtin_amdgcn_mfma_f32_32x32x16_bf16(PAF(1), VFR(1), o[0], 0, 0, 0), C0, 8); \
    KRD(GL, 1); GAPB(o[1] = __builtin_amdgcn_mfma_f32_32x32x16_bf16(PAF(1), VFR(5), o[1], 0, 0, 0), C0, 12); \
    KRD(GL, 2); GAPB(o[0] = __builtin_amdgcn_mfma_f32_32x32x16_bf16(PAF(2), VFR(2), o[0], 0, 0, 0), C1, 0); \
    KRD(GL, 3); GAPB(o[1] = __builtin_amdgcn_mfma_f32_32x32x16_bf16(PAF(2), VFR(6), o[1], 0, 0, 0), C1, 4); \
    GAPB(o[0] = __builtin_amdgcn_mfma_f32_32x32x16_bf16(PAF(3), VFR(3), o[0], 0, 0, 0), C1, 8); \
    GAPB(o[1] = __builtin_amdgcn_mfma_f32_32x32x16_bf16(PAF(3), VFR(7), o[1], 0, 0, 0), C1, 12); \
    } while (0)
  int t = 1;
  for (; t + 5 < NT; t += 2) {
    STEP(pB0, pB1, pA0, pA1, t, true, true, true);     WAIT_BAR(2); RESC(); ROT();
    STEP(pA0, pA1, pB0, pB1, t + 1, true, true, true); WAIT_BAR(2); RESC(); ROT();
  }
#define ENDW(tt) do { if ((tt) + 3 < NT) { WAIT_BAR(2); } else if ((tt) + 2 < NT) { WAIT_BAR(1); } else { WAIT_BAR(0); } } while (0)
  for (; t + 1 < NT; t += 2) {
    STEP(pB0, pB1, pA0, pA1, t, (t + 3 < NT), (t + 1 < NT), (t + 1 < NT));         ENDW(t);     RESC(); ROT();
    STEP(pA0, pA1, pB0, pB1, t + 1, (t + 4 < NT), (t + 2 < NT), (t + 2 < NT));     ENDW(t + 1); RESC(); ROT();
  }
  STEP(pB0, pB1, pA0, pA1, NT - 1, false, false, false); RESC();
  { float sacc = pB0[0] + pB0[1]; _Pragma("unroll") for (int r = 2; r < 16; ++r) sacc += pB0[r]; _Pragma("unroll") for (int r = 0; r < 16; ++r) sacc += pB1[r]; l_reg += sacc;
    pw0 = (u32x4){PKW(pB0, 0), PKW(pB0, 2), PKW(pB0, 4), PKW(pB0, 6)}; pw1 = (u32x4){PKW(pB0, 8), PKW(pB0, 10), PKW(pB0, 12), PKW(pB0, 14)}; pw2 = (u32x4){PKW(pB1, 0), PKW(pB1, 2), PKW(pB1, 4), PKW(pB1, 6)}; pw3 = (u32x4){PKW(pB1, 8), PKW(pB1, 10), PKW(pB1, 12), PKW(pB1, 14)};
    SBAR(); pv(o, vb0 + sl_cur, PAF(0), PAF(1), PAF(2), PAF(3)); }
#undef PKW
#undef PAF
#undef VFR
#undef PIN
#undef MX3
#undef GAPA
#undef GAPB
#undef EX
#undef VRD
#undef KRD
#undef STEP
#undef ENDW
  { auto rr = __builtin_amdgcn_permlane32_swap(__float_as_uint(l_reg), __float_as_uint(l_reg), false, false); l_reg = __uint_as_float(rr[0]) + __uint_as_float(rr[1]); }
  if (hi == 0) wsf[32 + r32] = l_reg; asm volatile("s_waitcnt lgkmcnt(0)" ::: "memory");
  float rli[16];
#pragma unroll
  for (int r = 0; r < 16; ++r) rli[r] = __builtin_amdgcn_rcpf(wsf[32 + crow(r, hi)]);
  bf16_t* Ow = Ow0 + (long)(wid * QBLK) * OP;
  { __hip_bfloat16* stg = (__hip_bfloat16*)(shm + LDS_OST) + wid * 2048;
#pragma unroll
    for (int r = 0; r < 16; ++r) { const int orow = crow(r, hi);
#pragma unroll
      for (int d0 = 0; d0 < 2; ++d0) stg[orow * 64 + d0 * 32 + r32] = __float2bfloat16(o[d0][r] * rli[r]); }
    asm volatile("s_waitcnt lgkmcnt(0)" ::: "memory");
#pragma unroll
    for (int i = 0; i < 4; ++i) { const int row = i * 8 + (lane >> 3), ch = lane & 7; const u32x4 v = *(const u32x4*)(stg + row * 64 + ch * 8); *(u32x4*)(Ow + (long)row * OP + ch * 8) = v; } }
  asm volatile("s_waitcnt lgkmcnt(0)\n\ts_barrier" ::: "memory");
#undef DMA_K
#undef DMA_V
#undef TROW
#undef CMASK
#undef START
#undef RESC
#undef ROT
}
#undef SBAR
#undef WAIT_BAR
}

struct Args {
  const float* in[33];
  float* out; unsigned char* ws;
  int ph_lo, ph_hi;
};
enum { I_X = 0, I_C, I_CTX, I_CCTX, I_ADAW, I_ADAB, I_NMIXPRE, I_NMIXPOST, I_NFFNPRE, I_NFFNPOST, I_WIN, I_CONVA, I_NABIAS, I_QNORM, I_KNORM,
       I_MU, I_W0, I_W2, I_A0, I_A2, I_KK, I_KA, I_RK, I_G2, I_LNW, I_LNB, I_WBR, I_WGATE, I_BGATE, I_WO, I_FUP, I_FCONV, I_FDN };

DI void transpose_item(const float* W, int N, bf16_t* WT, int ld, int koff, int mode, LAS float* scr, int item, int lane) {
  const int nblk = N / 32, kb = item / nblk, nb = item % nblk, k0 = 64 * kb, n0 = 32 * nb;
#pragma unroll 8
  for (int i = 0; i < 32; ++i) { const int kk = 2 * i + (lane >> 5); scr[kk * 33 + (lane & 31)] = W[(size_t)(k0 + kk) * N + n0 + (lane & 31)]; }
  asm volatile("s_waitcnt lgkmcnt(0)" ::: "memory");
  const int c = lane & 7;
#pragma unroll
  for (int j = 0; j < 4; ++j) { const int n = (lane >> 3) + 8 * j; const LAS float* s = scr + (8 * c) * 33 + n;
    int nn = n0 + n;
    if (mode == 1) nn = (nn < DFF) ? (256 * (nn >> 7) + (nn & 127)) : (256 * ((nn - DFF) >> 7) + 128 + ((nn - DFF) & 127));
    if (mode == 2) { const int i = nn >> 10, cc = nn & 1023, c64 = cc & 63;
      nn = ((cc >> 6) * 256) + 128 * (i >> 1) + 32 * (c64 >> 4) + 8 * ((c64 >> 2) & 3) + 4 * (i & 1) + (c64 & 3); }
    u32x4 o; o.x = cvtpk(s[0 * 33], s[1 * 33]); o.y = cvtpk(s[2 * 33], s[3 * 33]); o.z = cvtpk(s[4 * 33], s[5 * 33]); o.w = cvtpk(s[6 * 33], s[7 * 33]);
    *(u32x4*)(WT + (size_t)nn * ld + koff + k0 + 8 * c) = o; }
  asm volatile("s_waitcnt lgkmcnt(0)" ::: "memory");
}
DI void convert_weights(const CAS4 Args& A, int l, LAS unsigned char* lds, int gw, int NGW, int wave, int lane) {
  LAS float* scr = (LAS float*)(lds + wave * 8704);
  unsigned char* wb = A.ws + WS_W;
  constexpr int I_IN_ = 16 * 96, I_G = 16 * 128, I_B = 4 * 4 * 32, I_O_ = 16 * 32, I_U = 16 * 176, I_D = 44 * 32;
  constexpr int NIT = I_IN_ + I_G + I_B + I_O_ + I_U + I_D;
  for (int it = gw; it < NIT; it += NGW) {
    int r = it;
    if (r < I_IN_) { transpose_item(A.in[I_WIN] + (size_t)l * 1024 * 3072, 3072, (bf16_t*)(wb + W_IN), 1024, 0, 0, scr, r, lane); continue; } r -= I_IN_;
    if (r < I_G) { transpose_item(A.in[I_WGATE] + (size_t)l * 1024 * 4096, 4096, (bf16_t*)(wb + W_GATE), 1024, 0, 2, scr, r, lane); continue; } r -= I_G;
    if (r < I_B) { const int br = r / 128; transpose_item(A.in[I_WBR] + ((size_t)l * 4 + br) * 256 * 1024, 1024, (bf16_t*)(wb + W_BR), 1024, br * 256, 0, scr, r % 128, lane); continue; } r -= I_B;
    if (r < I_O_) { transpose_item(A.in[I_WO] + (size_t)l * 1024 * 1024, 1024, (bf16_t*)(wb + W_O), 1024, 0, 0, scr, r, lane); continue; } r -= I_O_;
    if (r < I_U) { transpose_item(A.in[I_FUP] + (size_t)l * 1024 * 5632, 5632, (bf16_t*)(wb + W_UP), 1024, 0, 1, scr, r, lane); continue; } r -= I_U;
    transpose_item(A.in[I_FDN] + (size_t)l * 2816 * 1024, 1024, (bf16_t*)(wb + W_DN), 2816, 0, 0, scr, r, lane);
  }
}

DI void row_phase(const float* xold, float* xdst, const bf16_t* src, const float* gate, const float* gpost,
                  bf16_t* hout, const float* gnext, const float* sh, const float* sc, int lane) {
  f32x4 v[4];
#pragma unroll
  for (int j = 0; j < 4; ++j) v[j] = ((const f32x4*)xold)[lane + 64 * j];
  if (src) {
    f32x4 s[4]; float ss = 0.f;
#pragma unroll
    for (int j = 0; j < 4; ++j) { const uint2 w = ((const uint2*)src)[lane + 64 * j];
      s[j] = (f32x4){__uint_as_float(w.x << 16), __uint_as_float(w.x & 0xffff0000u), __uint_as_float(w.y << 16), __uint_as_float(w.y & 0xffff0000u)};
      ss += (s[j].x * s[j].x + s[j].y * s[j].y) + (s[j].z * s[j].z + s[j].w * s[j].w); }
    const float rs = __builtin_amdgcn_rsqf(wave_sum(ss, lane) * (1.f / 1024.f) + 1e-6f);
#pragma unroll
    for (int j = 0; j < 4; ++j) { const f32x4 g = ((const f32x4*)gate)[lane + 64 * j], p = ((const f32x4*)gpost)[lane + 64 * j];
      v[j] = v[j] + g * (s[j] * rs * p); ((f32x4*)xdst)[lane + 64 * j] = v[j]; }
  }
  if (hout) {
    float ss = 0.f;
#pragma unroll
    for (int j = 0; j < 4; ++j) ss += (v[j].x * v[j].x + v[j].y * v[j].y) + (v[j].z * v[j].z + v[j].w * v[j].w);
    const float rs = __builtin_amdgcn_rsqf(wave_sum(ss, lane) * (1.f / 1024.f) + 1e-6f);
#pragma unroll
    for (int j = 0; j < 4; ++j) { const f32x4 g = ((const f32x4*)gnext)[lane + 64 * j], a = ((const f32x4*)sh)[lane + 64 * j], b = ((const f32x4*)sc)[lane + 64 * j];
      const f32x4 h = (v[j] * rs * g) * (b + 1.f) + a;
      uint2 w; w.x = cvtpk(h.x, h.y); w.y = cvtpk(h.z, h.w); ((uint2*)hout)[lane + 64 * j] = w; }
  }
}

DI void row_phase_blk(const float* xlat_in, const float* xctx_in, float* xlat_out, float* xctx_out, const bf16_t* srcb,
                      const float* modl, int gate_off, const float* gpost, bf16_t* hb, const float* gnext, const float* modn, int sh_off, int sc_off,
                      int bx, int wave, int lane) {
  const int R0 = bx * 130;
  f32x4 gpv[4], gnv[4], gav[4], shv[4], scv[4];
#pragma unroll
  for (int j = 0; j < 4; ++j) { gpv[j] = ((const f32x4*)gpost)[lane + 64 * j]; gnv[j] = hb ? ((const f32x4*)gnext)[lane + 64 * j] : (f32x4){0.f, 0.f, 0.f, 0.f}; }
  int cur_s = -1;
  f32x4 xv[4], xn[4]; uint2 sv[4], sn[4];
  int row = R0 + wave;
  { const float* xo = (row < NLAT) ? xlat_in + (size_t)row * 1024 : xctx_in + (size_t)(row - NLAT) * 1024;
#pragma unroll
    for (int j = 0; j < 4; ++j) { xv[j] = ((const f32x4*)xo)[lane + 64 * j]; sv[j] = ((const uint2*)(srcb + (size_t)row * 1024))[lane + 64 * j]; } }
  for (; row < R0 + 130; row += 8) {
    const int nrow = row + 8; const bool hn = nrow < R0 + 130;
    if (hn) { const float* xo = (nrow < NLAT) ? xlat_in + (size_t)nrow * 1024 : xctx_in + (size_t)(nrow - NLAT) * 1024;
#pragma unroll
      for (int j = 0; j < 4; ++j) { xn[j] = ((const f32x4*)xo)[lane + 64 * j]; sn[j] = ((const uint2*)(srcb + (size_t)nrow * 1024))[lane + 64 * j]; } }
    const int s = (row < NLAT) ? (row >> 14) : 2;
    if (s != cur_s) { cur_s = s; const float* md = modl + (size_t)s * 6144; const float* mn = modn + (size_t)s * 6144;
#pragma unroll
      for (int j = 0; j < 4; ++j) { gav[j] = ((const f32x4*)(md + gate_off))[lane + 64 * j];
        shv[j] = hb ? ((const f32x4*)(mn + sh_off))[lane + 64 * j] : (f32x4){0.f, 0.f, 0.f, 0.f}; scv[j] = hb ? ((const f32x4*)(mn + sc_off))[lane + 64 * j] : (f32x4){0.f, 0.f, 0.f, 0.f}; } }
    f32x4 sf[4]; float ss = 0.f;
#pragma unroll
    for (int j = 0; j < 4; ++j) { const uint2 w = sv[j];
      sf[j] = (f32x4){__uint_as_float(w.x << 16), __uint_as_float(w.x & 0xffff0000u), __uint_as_float(w.y << 16), __uint_as_float(w.y & 0xffff0000u)};
      ss += (sf[j].x * sf[j].x + sf[j].y * sf[j].y) + (sf[j].z * sf[j].z + sf[j].w * sf[j].w); }
    const float rs = __builtin_amdgcn_rsqf(wave_sum(ss, lane) * (1.f / 1024.f) + 1e-6f);
    float* xd = (row < NLAT) ? xlat_out + (size_t)row * 1024 : xctx_out + (size_t)(row - NLAT) * 1024;
    float s2 = 0.f;
#pragma unroll
    for (int j = 0; j < 4; ++j) { xv[j] = xv[j] + gav[j] * (sf[j] * rs * gpv[j]); ((f32x4*)xd)[lane + 64 * j] = xv[j];
      s2 += (xv[j].x * xv[j].x + xv[j].y * xv[j].y) + (xv[j].z * xv[j].z + xv[j].w * xv[j].w); }
    if (hb) {
      const float r2 = __builtin_amdgcn_rsqf(wave_sum(s2, lane) * (1.f / 1024.f) + 1e-6f);
#pragma unroll
      for (int j = 0; j < 4; ++j) { const f32x4 h = (xv[j] * r2 * gnv[j]) * (scv[j] + 1.f) + shv[j];
        uint2 w; w.x = cvtpk(h.x, h.y); w.y = cvtpk(h.z, h.w); ((uint2*)(hb + (size_t)row * 1024))[lane + 64 * j] = w; }
    }
#pragma unroll
    for (int j = 0; j < 4; ++j) { xv[j] = xn[j]; sv[j] = sn[j]; }
  }
}

__global__ void __launch_bounds__(NTHREADS, 2) fwd_megakernel(Args A_) {
  extern __shared__ __attribute__((aligned(16))) unsigned char lds_raw[];
  LAS unsigned char* lds = (LAS unsigned char*)lds_raw;
  const int wave0_ = __builtin_amdgcn_readfirstlane((int)threadIdx.x >> 6);
  const int G = gridDim.x, bx = blockIdx.x;
  const int NGW = G * 8;
  const int lo = A_.ph_lo, hi = A_.ph_hi;
  if (hi < 0) cg::this_grid().sync();
  int ph = 0, nbar_ = 0;
#ifndef NBARX
#define NBARX 1
#endif
#ifndef SKIPMASK
#define SKIPMASK 0
#endif
#ifndef REPMASK
#define REPMASK 0
#endif
#define PHASE_BEGIN(id) if (ph >= lo && ph < hi && !((SKIPMASK >> (id)) & 1)) for (int rep_ = 0; rep_ < ((((REPMASK) >> (id)) & 1) ? 2 : 1); ++rep_) { const CAS4 Args* Ap_ = (const CAS4 Args*)__builtin_amdgcn_kernarg_segment_ptr(); asm volatile("" : "+s"(Ap_)); const CAS4 Args& A = *Ap_; \
  unsigned char* ws = A.ws; unsigned* ctl = (unsigned*)(ws + WS_CTL); float* MOD = (float*)(ws + WS_MOD); float* XC = (float*)(ws + WS_XC); float* BONUS = (float*)(ws + WS_BONUS); \
  bf16_t* H = (bf16_t*)(ws + WS_H); bf16_t* Z = (bf16_t*)(ws + WS_Z); bf16_t* YS = (bf16_t*)(ws + WS_YS); bf16_t* WAE = (bf16_t*)(ws + WS_WA); bf16_t* WAA = WAE + (size_t)2 * NROW * 256; float* YSC = (float*)(ws + WS_YSC); \
  (void)ctl; (void)MOD; (void)XC; (void)BONUS; (void)H; (void)Z; (void)YS; (void)WAE; (void)WAA; (void)YSC; \
  int tid; asm volatile("v_mbcnt_lo_u32_b32 %0, -1, 0\n\tv_mbcnt_hi_u32_b32 %0, -1, %0" : "=v"(tid)); tid += wave0_ * 64; const int lane = tid & 63, wave = __builtin_amdgcn_readfirstlane(tid >> 6); const int gw = bx * 8 + wave; (void)lane; (void)gw;
#define FRESH_TID(v) int v; asm volatile("v_mbcnt_lo_u32_b32 %0, -1, 0\n\tv_mbcnt_hi_u32_b32 %0, -1, %0" : "=v"(v)); v += wave0_ * 64;
#define PHASE_END } if (ph >= lo && ph + 1 < hi) { FRESH_TID(tb_) const CAS4 Args* Ab_ = (const CAS4 Args*)__builtin_amdgcn_kernarg_segment_ptr(); asm volatile("" : "+s"(Ab_)); for (int bi_ = 0; bi_ < NBARX; ++bi_) { ++nbar_; grid_barrier((unsigned*)(Ab_->ws + WS_CTL), (unsigned)nbar_ * (unsigned)G, tb_); } } ++ph;

  PHASE_BEGIN(0)
    {
      LAS float* sl = (LAS float*)(lds + 72 * 1024);
      for (int i = tid; i < 3 * 1024; i += NTHREADS) { const int s = i >> 10, k = i & 1023;
        const float c = (s < 2) ? A.in[I_C][s * 1024 + k] : A.in[I_CCTX][k]; sl[i] = c * sigmoidf_(c); }
      __syncthreads();
      LAS float* red = (LAS float*)(lds + 88 * 1024);
      for (int it = bx; it < NLAYER * 96; it += G) {
        const int l = it / 96, c0 = (it % 96) * 64;
        const float* wp = A.in[I_ADAW] + (size_t)l * 1024 * 6144 + c0 + lane;
        float a0 = 0.f, a1 = 0.f, a2 = 0.f;
        for (int k = wave * 128; k < wave * 128 + 128; ++k) { const float w = wp[(size_t)k * 6144]; a0 += sl[k] * w; a1 += sl[1024 + k] * w; a2 += sl[2048 + k] * w; }
        red[(wave * 3 + 0) * 64 + lane] = a0; red[(wave * 3 + 1) * 64 + lane] = a1; red[(wave * 3 + 2) * 64 + lane] = a2;
        __syncthreads();
        if (tid < 192) { const int s = tid >> 6, ln = tid & 63; float r = A.in[I_ADAB][l * 6144 + c0 + ln];
          for (int w = 0; w < 8; ++w) r += red[(w * 3 + s) * 64 + ln];
          MOD[((size_t)(l * 3 + s)) * 6144 + c0 + ln] = r; }
        __syncthreads();
      }
    }
    convert_weights(A, 0, lds, gw, NGW, wave, lane);
  PHASE_END

  PHASE_BEGIN(1)
    for (int row = gw; row < NROW; row += NGW) {
      const int s = (row < NLAT) ? (row >> 14) : 2;
      const float* xo = (row < NLAT) ? A.in[I_X] + (size_t)row * 1024 : A.in[I_CTX] + (size_t)(row - NLAT) * 1024;
      const float* md = MOD + (size_t)(0 * 3 + s) * 6144;
      row_phase(xo, nullptr, nullptr, nullptr, nullptr, H + (size_t)row * 1024, A.in[I_NMIXPRE], md, md + 1024, lane);
    }
  PHASE_END

  for (int l = 0; l < NLAYER; ++l) {
    PHASE_BEGIN(2)
      pg8::Gemm g{(const char*)ws, 1024, 1024};
      pg8::SchedPlain S{130, 5, G, bx, 16, (long)WS_H, (long)(WS_W + W_IN), 1024, 1024, 7};
      pg8::EpiStore E{Z, DIN};
      pg8::gemm_phase<pg8::EpiStore, pg8::SchedPlain, false>(lds, g, S, E, tid);
    PHASE_END

    PHASE_BEGIN(3)
      {
        FRESH_TID(tid)
        const int ln = tid & 63, wv = __builtin_amdgcn_readfirstlane(tid >> 6), d = wv >> 2, nq = wv & 3, r32 = ln & 31, hi = ln >> 5;
        LAS unsigned char* AT = lds;
        const float* mu = A.in[I_MU] + (size_t)l * 2 * 896;
        bf16x8 Bf[2][2][4]; float bias0[2], bias1[2];
#pragma unroll
        for (int nt = 0; nt < 2; ++nt) {
          const int c = 64 * nq + 32 * nt + r32;
          bias0[nt] = A.in[I_W0][(l * 2 + d) * 256 + c]; bias1[nt] = A.in[I_A0][(l * 2 + d) * 256 + c];
#pragma unroll
          for (int ks = 0; ks < 4; ++ks) { float f0[8], f1[8];
#pragma unroll
            for (int i = 0; i < 8; ++i) { const size_t o = ((size_t)(l * 2 + d) * 64 + 16 * ks + 8 * hi + i) * 256 + c; f0[i] = A.in[I_W2][o]; f1[i] = A.in[I_A2][o]; }
            Bf[0][nt][ks] = __builtin_bit_cast(bf16x8, pack8(f0)); Bf[1][nt][ks] = __builtin_bit_cast(bf16x8, pack8(f1)); }
        }
        for (int tile = bx; tile < 520; tile += G) {
          const int R0 = tile * 64;
          __syncthreads();
          for (int i = tid; i < 2 * 64 * 16; i += NTHREADS) {
            const int dd = i >> 10, rem = i & 1023, r = rem >> 4, j8 = (rem & 15) * 8, row = R0 + r; int t, len; row_seq(row, t, len);
            const int nb = dd ? t + 1 : t - 1; const bool nv = (nb >= 0) && (nb < len);
            float zc[8], zn[8];
            unpack8(*(const u32x4*)(Z + (size_t)row * DIN + C_LW + j8), zc);
            if (nv) unpack8(*(const u32x4*)(Z + (size_t)(row + (dd ? 1 : -1)) * DIN + C_LW + j8), zn);
            else {
#pragma unroll
              for (int e = 0; e < 8; ++e) zn[e] = 0.f; }
            const f32x4 m0 = *(const f32x4*)(mu + dd * 896 + 768 + j8), m1 = *(const f32x4*)(mu + dd * 896 + 768 + j8 + 4);
            float v[8];
#pragma unroll
            for (int e = 0; e < 8; ++e) { v[e] = zc[e] + (e < 4 ? m0[e] : m1[e - 4]) * (zn[e] - zc[e]); if (j8 < 64) v[e] = 1.f - 2.f * __builtin_amdgcn_rcpf(__builtin_amdgcn_exp2f(2.8853900817779268f * v[e]) + 1.f); }
            *(LAS u32x4*)(AT + ((dd * 2 + (j8 >> 6)) * 64 + r) * 144 + (j8 & 63) * 2) = pack8(v);
          }
          __syncthreads();
          f32x16 acc[2][2][2];
#pragma unroll
          for (int m = 0; m < 2; ++m)
#pragma unroll
            for (int mt = 0; mt < 2; ++mt)
#pragma unroll
              for (int nt = 0; nt < 2; ++nt) acc[m][mt][nt] = f32x16{};
#pragma unroll
          for (int m = 0; m < 2; ++m)
#pragma unroll
            for (int mt = 0; mt < 2; ++mt)
#pragma unroll
              for (int ks = 0; ks < 4; ++ks) {
                const bf16x8 af = *(const LAS bf16x8*)(AT + ((d * 2 + m) * 64 + 32 * mt + r32) * 144 + (16 * ks + 8 * hi) * 2);
#pragma unroll
                for (int nt = 0; nt < 2; ++nt) acc[m][mt][nt] = __builtin_amdgcn_mfma_f32_32x32x16_bf16(af, Bf[m][nt][ks], acc[m][mt][nt], 0, 0, 0);
              }
#pragma unroll
          for (int mt = 0; mt < 2; ++mt)
#pragma unroll
            for (int nt = 0; nt < 2; ++nt) {
              const int c = 64 * nq + 32 * nt + r32;
#pragma unroll
              for (int r = 0; r < 16; ++r) {
                const int row = R0 + 32 * mt + (r & 3) + 8 * (r >> 2) + 4 * hi;
                const float aw = acc[0][mt][nt][r] + bias0[nt], aa = acc[1][mt][nt][r] + bias1[nt];
                const float xx = -aw; const float sp = fmaxf(xx, 0.f) + __logf(1.f + __expf(-fabsf(xx)));
                const float e = -__expf(-sp - 0.5f);
                const float av = sigmoidf_(aa);
                const size_t o = ((size_t)d * NROW + row) * 256 + c;
                WAE[o] = (bf16_t)(cvtpk(e, 0.f) & 0xffffu); WAA[o] = (bf16_t)(cvtpk(av, 0.f) & 0xffffu);
              }
            }
        }
        __syncthreads();
      }
    PHASE_END

    PHASE_BEGIN(4)
#ifndef NO_SCAN
#ifndef REP_SCAN
#define REP_SCAN 1
#endif
#ifndef REP_ATTN
#define REP_ATTN 1
#endif
      if (bx < 64 && (rep_ == 0 || REP_SCAN)) {
        const int sb = bx, s = sb >> 2, qd = sb & 3, d = s >> 3, b = (s >> 2) & 1, hh = s & 3;
        LAS float* buf = (LAS float*)lds;
        float muR[8], muK[8], muV[8], kkc[8], kac[8], rkc[8];
        const int ptid = tid & 255, ts = (ptid >> 3) & 31, cgp = ptid & 7, ch0 = hh * 64 + 8 * cgp;
        {
#pragma unroll
          for (int i = 0; i < 8; ++i) { const float* mu = A.in[I_MU] + (size_t)(l * 2 + d) * 896;
            muR[i] = mu[ch0 + i]; muK[i] = mu[256 + ch0 + i]; muV[i] = mu[512 + ch0 + i];
            kkc[i] = A.in[I_KK][l * 256 + ch0 + i]; kac[i] = A.in[I_KA][l * 256 + ch0 + i]; rkc[i] = A.in[I_RK][l * 256 + ch0 + i]; }
        }
        const int rsub = lane >> 4, kg = lane & 15, vrow = 16 * qd + 4 * (wave & 3) + rsub;
#define SCAN_RLO(cc) (((cc) < 8) ? (NLAT + b * CTXL + (d ? 224 - 32 * (cc) : 32 * (cc))) : (b * TLAT + (d ? 16352 - 32 * ((cc) - 8) : 32 * ((cc) - 8))))
        const unsigned ro = (unsigned)(d ? 31 - ts : ts);
        const unsigned offz = ro * DIN + ch0, offw = ro * 256 + ch0;
        const unsigned roy = (unsigned)(d ? 31 - (ptid >> 3) : (ptid >> 3)), offy = roy * 256 + hh * 64 + 16 * qd + (ptid & 7) * 2;
#define SCAN_LOAD(cc, X) do { const int rlo_ = SCAN_RLO(cc); const bool nv = !((((cc) == 0) || ((cc) == 8)) && ts == 0); \
          const bf16_t* zb = Z + (size_t)rlo_ * DIN; const bf16_t* znb = zb + (d ? DIN : -DIN); const u32x4 z4 = (u32x4){0u, 0u, 0u, 0u}; \
          X[0] = *(const u32x4*)(zb + (offz + C_RR)); X[1] = *(const u32x4*)(zb + (offz + C_RK)); X[2] = *(const u32x4*)(zb + (offz + C_RV)); \
          X[3] = nv ? *(const u32x4*)(znb + (offz + C_RR)) : z4; X[4] = nv ? *(const u32x4*)(znb + (offz + C_RK)) : z4; X[5] = nv ? *(const u32x4*)(znb + (offz + C_RV)) : z4; \
          const bf16_t* wb_ = WAE + ((size_t)d * NROW + rlo_) * 256; const bf16_t* ab_ = WAA + ((size_t)d * NROW + rlo_) * 256; \
          X[6] = *(const u32x4*)(wb_ + offw); X[7] = *(const u32x4*)(ab_ + offw); } while (0)
#define SCAN_PREP(cc, X) do { const int rlo_ = SCAN_RLO(cc); \
          float r8[8], k8[8], v8[8], rn[8], kn[8], vn[8], e8[8], a8[8]; \
          unpack8(X[0], r8); unpack8(X[1], k8); unpack8(X[2], v8); unpack8(X[3], rn); unpack8(X[4], kn); unpack8(X[5], vn); unpack8(X[6], e8); unpack8(X[7], a8); \
          float kkv[8], ssq = 0.f, bsum = 0.f; \
          _Pragma("unroll") for (int i = 0; i < 8; ++i) { r8[i] += muR[i] * (rn[i] - r8[i]); k8[i] += muK[i] * (kn[i] - k8[i]); v8[i] += muV[i] * (vn[i] - v8[i]); \
            kkv[i] = k8[i] * kkc[i]; ssq += kkv[i] * kkv[i]; } \
          ssq = red8(ssq); \
          const float inv = __builtin_amdgcn_rsqf(fmaxf(ssq, 1e-24f)); \
          float wv[8], bb[8], kp[8]; \
          _Pragma("unroll") for (int i = 0; i < 8; ++i) { kkv[i] *= inv; kp[i] = k8[i] * (1.f + (a8[i] - 1.f) * kac[i]); bb[i] = kkv[i] * a8[i]; wv[i] = __expf(e8[i]); bsum += r8[i] * kp[i] * rkc[i]; } \
          bsum = red8(bsum); \
          if (qd == 0 && cgp == 0) (BONUS + ((size_t)d * NROW + rlo_) * 4)[ro * 4 + hh] = bsum; \
          LAS float* db = buf + ((cc) & 1) * (6 * 32 * 64) + ts * 64 + 8 * cgp; \
          *(LAS f32x4*)(db + 0 * 2048) = (f32x4){wv[0], wv[1], wv[2], wv[3]}; *(LAS f32x4*)(db + 0 * 2048 + 4) = (f32x4){wv[4], wv[5], wv[6], wv[7]}; \
          *(LAS f32x4*)(db + 1 * 2048) = (f32x4){kkv[0], kkv[1], kkv[2], kkv[3]}; *(LAS f32x4*)(db + 1 * 2048 + 4) = (f32x4){kkv[4], kkv[5], kkv[6], kkv[7]}; \
          *(LAS f32x4*)(db + 2 * 2048) = (f32x4){bb[0], bb[1], bb[2], bb[3]}; *(LAS f32x4*)(db + 2 * 2048 + 4) = (f32x4){bb[4], bb[5], bb[6], bb[7]}; \
          *(LAS f32x4*)(db + 3 * 2048) = (f32x4){kp[0], kp[1], kp[2], kp[3]}; *(LAS f32x4*)(db + 3 * 2048 + 4) = (f32x4){kp[4], kp[5], kp[6], kp[7]}; \
          *(LAS f32x4*)(db + 4 * 2048) = (f32x4){r8[0], r8[1], r8[2], r8[3]}; *(LAS f32x4*)(db + 4 * 2048 + 4) = (f32x4){r8[4], r8[5], r8[6], r8[7]}; \
          *(LAS f32x4*)(db + 5 * 2048) = (f32x4){v8[0], v8[1], v8[2], v8[3]}; *(LAS f32x4*)(db + 5 * 2048 + 4) = (f32x4){v8[4], v8[5], v8[6], v8[7]}; \
        } while (0)
#define SCAN_YOUT(cc) do { const int rlo_ = SCAN_RLO(cc); const int step_ = ptid >> 3, r2_ = (ptid & 7) * 2; \
          const LAS f32x4* yp_ = (const LAS f32x4*)(ybuf + ((cc) & 1) * 2048 + step_ * 64 + r2_ * 4); const f32x4 y0_ = yp_[0], y1_ = yp_[1]; \
          const f32x2 yv = (f32x2){(y0_[0] + y0_[1]) + (y0_[2] + y0_[3]), (y1_[0] + y1_[1]) + (y1_[2] + y1_[3])}; \
          *(f32x2*)(YSC + ((size_t)d * NROW + rlo_) * 256 + offy) = yv; } while (0)
        LAS float* ybuf = buf + 2 * 6 * 32 * 64;
        u32x4 RA[8], RB[8];
        __syncthreads();
        SCAN_LOAD(0, RA);
        if (wave >= 4) SCAN_PREP(0, RA);
        SCAN_LOAD(1, RA);
#pragma unroll
        for (int i = 0; i < 8; ++i) RB[i] = RA[i];
        __syncthreads();
        f32x2 Sa = (f32x2){0.f, 0.f}, Sb = (f32x2){0.f, 0.f};
        for (int cc = 0; cc < 520; ++cc) {
          if (wave >= 4) {
            if (cc + 2 < 520) SCAN_LOAD(cc + 2, RB);
            if (cc + 1 < 520) SCAN_PREP(cc + 1, RA);
            if (cc > 0) SCAN_YOUT(cc - 1);
#pragma unroll
            for (int i = 0; i < 8; ++i) RA[i] = RB[i];
          } else {
            const LAS float* sbuf = buf + (cc & 1) * (6 * 32 * 64) + 4 * kg;
            LAS float* yb = ybuf + (cc & 1) * 2048 + (4 * wave + rsub) * 4 + (kg >> 2);
            f32x4 W4 = *(const LAS f32x4*)(sbuf + 0 * 2048), K4 = *(const LAS f32x4*)(sbuf + 1 * 2048), B4 = *(const LAS f32x4*)(sbuf + 2 * 2048),
                  P4 = *(const LAS f32x4*)(sbuf + 3 * 2048), R4 = *(const LAS f32x4*)(sbuf + 4 * 2048);
            float vv = sbuf[5 * 2048 - 4 * kg + vrow];
            f32x4 Rp = R4;
#pragma unroll
            for (int st = 0; st < 32; ++st) {
              const int sn = (st + 1) & 31;
              const LAS float* sp = sbuf + sn * 64;
              const f32x4 W4n = *(const LAS f32x4*)(sp + 0 * 2048), K4n = *(const LAS f32x4*)(sp + 1 * 2048), B4n = *(const LAS f32x4*)(sp + 2 * 2048),
                          P4n = *(const LAS f32x4*)(sp + 3 * 2048), R4n = *(const LAS f32x4*)(sp + 4 * 2048);
              const float vvn = sp[5 * 2048 - 4 * kg + vrow];
              f32x2 p = Sa * (f32x2){K4[0], K4[1]}; p = __builtin_elementwise_fma(Sb, (f32x2){K4[2], K4[3]}, p);
              float sa = p[0] + p[1];
              if (st > 0) {
                f32x2 q = Sa * (f32x2){Rp[0], Rp[1]}; q = __builtin_elementwise_fma(Sb, (f32x2){Rp[2], Rp[3]}, q);
                float yq = q[0] + q[1]; yq += DPPF(yq, 0xB1); yq += DPPF(yq, 0x4E);
                yb[(st - 1) * 64] = yq;
              }
              sa = allreduce16(sa);
              const f32x2 vv2 = (f32x2){vv, vv}, nsa = (f32x2){-sa, -sa};
              f32x2 ta = __builtin_elementwise_fma(nsa, (f32x2){B4[0], B4[1]}, vv2 * (f32x2){P4[0], P4[1]});
              f32x2 tb = __builtin_elementwise_fma(nsa, (f32x2){B4[2], B4[3]}, vv2 * (f32x2){P4[2], P4[3]});
              Sa = __builtin_elementwise_fma(Sa, (f32x2){W4[0], W4[1]}, ta);
              Sb = __builtin_elementwise_fma(Sb, (f32x2){W4[2], W4[3]}, tb);
              Rp = R4;
              W4 = W4n; K4 = K4n; B4 = B4n; P4 = P4n; R4 = R4n; vv = vvn;
            }
            { f32x2 q = Sa * (f32x2){Rp[0], Rp[1]}; q = __builtin_elementwise_fma(Sb, (f32x2){Rp[2], Rp[3]}, q);
              float yq = q[0] + q[1]; yq += DPPF(yq, 0xB1); yq += DPPF(yq, 0x4E);
              yb[31 * 64] = yq; }
          }
          __syncthreads();
        }
        if (wave >= 4) SCAN_YOUT(519);
        __syncthreads();
#undef SCAN_LOAD
#undef SCAN_YOUT
#undef SCAN_PREP
#undef SCAN_RLO
      }
#endif
#ifndef NO_ATTN
      if (bx >= 64) {
        {
          FRESH_TID(tid)
          pg8::Gemm g{(const char*)ws, 1024, 1024};
          pg8::SchedPlain S{130, 7, 192, bx - 64, 16, (long)WS_H, (long)(WS_W + W_IN), 1024, 1024, 0};
          pg8::EpiStore E{Z, DIN};
          pg8::gemm_phase<pg8::EpiStore, pg8::SchedPlain, false>(lds, g, S, E, tid);
        }
        { FRESH_TID(tb1_) grid_barrier(ctl + 16, 192u * (unsigned)(2 * l + 1), tb1_); }
      {
        const float* qn = A.in[I_QNORM] + l * 64; const float* kn = A.in[I_KNORM] + l * 64;
        for (long idx = (long)(bx - 64) * NTHREADS + tid; idx < (long)NROW * 48; idx += (long)192 * NTHREADS) {
          const int part = (int)(idx & 7), h6 = (int)((idx >> 3) % 6), row = (int)(idx / 48);
          bf16_t* p = Z + (size_t)row * DIN + C_GQ + 64 * h6 + 8 * part;
          float f[8]; unpack8(*(const u32x4*)p, f);
          float ss = 0.f;
#pragma unroll
          for (int i = 0; i < 8; ++i) ss += f[i] * f[i];
          ss = red8(ss);
          const float rs = __builtin_amdgcn_rsqf(ss * (1.f / 64.f) + 1e-6f);
          const bool isq = h6 < 4; const float* nw = isq ? qn : kn; const float scl = isq ? C2 : 1.f;
#pragma unroll
          for (int i = 0; i < 8; ++i) f[i] = f[i] * rs * nw[8 * part + i] * scl;
          if (row < NLAT) {
            const int t = row & (TLAT - 1); const float gr = (float)(t >> 6), gc = (float)(t & 63);
#pragma unroll
            for (int pp = 0; pp < 4; ++pp) { const int pi = 4 * part + pp;
              const float invf = exp2f(-(float)(pi & 15) * (13.287712379549449f / 16.f));
              const float ang = (pi < 16 ? gr : gc) * invf; const float cs = __cosf(ang), sn = __sinf(ang);
              const float x1 = f[2 * pp], x2 = f[2 * pp + 1]; f[2 * pp] = x1 * cs - x2 * sn; f[2 * pp + 1] = x1 * sn + x2 * cs; }
          }
          *(u32x4*)p = pack8(f);
        }
      }
      {
        FRESH_TID(tid)
        const float* cw = A.in[I_CONVA] + l * 3 * 256;
        for (long idx = (long)(bx - 64) * NTHREADS + tid; idx < (long)NROW * 32; idx += (long)192 * NTHREADS) {
          const int g8 = (int)(idx & 31), row = (int)(idx >> 5); int t, len; row_seq(row, t, len);
          const bf16_t* zr = Z + (size_t)row * DIN;
          { bf16_t* qp = Z + (size_t)row * DIN + C_NAQ + 8 * g8; float f[8]; unpack8(*(const u32x4*)qp, f);
#pragma unroll
            for (int i = 0; i < 8; ++i) f[i] *= C2;
            *(u32x4*)qp = pack8(f); }
          float bg[8], c0[8], x0[8], c1[8], x1[8], c2[8], x2[8];
          unpack8(*(const u32x4*)(zr + 8 * g8), bg);
          unpack8(*(const u32x4*)(zr + 256 + 8 * g8), c1); unpack8(*(const u32x4*)(zr + 512 + 8 * g8), x1);
          if (t > 0) { unpack8(*(const u32x4*)(zr - DIN + 256 + 8 * g8), c0); unpack8(*(const u32x4*)(zr - DIN + 512 + 8 * g8), x0); }
          else {
#pragma unroll
            for (int i = 0; i < 8; ++i) { c0[i] = 0.f; x0[i] = 0.f; } }
          if (t < len - 1) { unpack8(*(const u32x4*)(zr + DIN + 256 + 8 * g8), c2); unpack8(*(const u32x4*)(zr + DIN + 512 + 8 * g8), x2); }
          else {
#pragma unroll
            for (int i = 0; i < 8; ++i) { c2[i] = 0.f; x2[i] = 0.f; } }
          float o[8];
#pragma unroll
          for (int i = 0; i < 8; ++i) { const int c = 8 * g8 + i; o[i] = bg[i] * (cw[c] * (c0[i] * x0[i]) + cw[256 + c] * (c1[i] * x1[i]) + cw[512 + c] * (c2[i] * x2[i])); }
          *(u32x4*)(YS + (size_t)row * 1024 + 8 * g8) = pack8(o);
        }
      }
        { FRESH_TID(tb2_) grid_barrier(ctl + 16, 192u * (unsigned)(2 * l + 2), tb2_); }
      } else {
        FRESH_TID(tw_)
        if (tw_ == 0) { while (__hip_atomic_load(ctl + 16, __ATOMIC_RELAXED, __HIP_MEMORY_SCOPE_AGENT) < 192u * (unsigned)(2 * l + 2)) __builtin_amdgcn_s_sleep(2);
          __builtin_amdgcn_fence(__ATOMIC_ACQUIRE, "agent"); asm volatile("s_waitcnt vmcnt(0)" ::: "memory"); }
        __syncthreads();
      }
      if (rep_ == 0 || REP_ATTN) {
        FRESH_TID(tid)
        volatile LAS unsigned* misc = (volatile LAS unsigned*)(lds + 92 * 1024);
        const float* nab = A.in[I_NABIAS] + (size_t)l * 4 * 465;
        for (;;) {
          __syncthreads();
          if (tid == 0) misc[0] = atomicAdd(ctl + 64 + 64 * l + 32 * rep_, 1u);
          __syncthreads();
          int u = (int)misc[0];
          if (l == NLAYER - 1 && u >= 1024) u += 16;
          if (u >= 1296) break;
          if (u >= 1040) {
            LAS float* SG = (LAS float*)lds;
            const int R0 = (u - 1040) * 130;
            for (int i = tid; i < 130 * 16; i += NTHREADS) { const int r = i >> 4, j8 = (i & 15) * 8; float f[8];
              unpack8(*(const u32x4*)(Z + (size_t)(R0 + r) * DIN + C_LG + j8), f);
#pragma unroll
              for (int e = 0; e < 8; ++e) f[e] = sigmoidf_(f[e]);
              *(LAS f32x4*)(SG + r * 128 + j8) = (f32x4){f[0], f[1], f[2], f[3]}; *(LAS f32x4*)(SG + r * 128 + j8 + 4) = (f32x4){f[4], f[5], f[6], f[7]}; }
            const int half = tid >> 8, c = tid & 255;
            float g2c[128];
#pragma unroll
            for (int j = 0; j < 128; ++j) g2c[j] = A.in[I_G2][((size_t)l * 128 + j) * 256 + c];
            __syncthreads();
            for (int r = half; r < 130; r += 2) {
              const LAS f32x4* sp = (const LAS f32x4*)(SG + r * 128);
              float gate = 0.f;
#pragma unroll
              for (int j4 = 0; j4 < 32; ++j4) { const f32x4 x = sp[j4]; gate += x[0] * g2c[4 * j4] + x[1] * g2c[4 * j4 + 1] + x[2] * g2c[4 * j4 + 2] + x[3] * g2c[4 * j4 + 3]; }
              YS[(size_t)(R0 + r) * 1024 + 768 + c] = (bf16_t)(cvtpk(gate, 0.f) & 0xffffu);
            }
            continue;
          }
          attn_body::TileMap tm; attn_body::NaInfo na{0, 0};
          const bf16_t *Qp, *Kp, *Vp; bf16_t* Op; int mode = 0;
          if (u < 512) {
            const int qb = u & 63, g2 = (u >> 6) & 1, kvh = (u >> 7) & 1, b = u >> 8, h = kvh * 2 + g2;
            tm = {256, b * TLAT, NLAT + b * CTXL, 260};
            const size_t q0 = (size_t)b * TLAT + qb * 256;
            Qp = Z + q0 * DIN + C_GQ + 64 * h; Kp = Z + C_GK + 64 * kvh; Vp = Z + C_GV + 64 * kvh; Op = YS + q0 * 1024 + 512 + 64 * h;
          } else if (u < 1024) {
            const int v = u - 512, ig = v & 63, h = (v >> 6) & 3, b = v >> 8, i0 = 4 * ig;
            int rmin = min(max(i0 - 4, 0), 248), rmax = min(max(i0 + 3 - 4, 0), 248) + 7;
            if (((rmax - rmin + 1) & 1) != 0) { if (rmax < 255) ++rmax; else --rmin; }
            tm = {4, NLAT + b * CTXL, b * TLAT + 64 * rmin, 4 + (rmax - rmin + 1)};
            na = {i0, rmin}; mode = 1;
            if (tid < 512) ((LAS float*)(lds + attn_body::LDS_BIAS))[tid] = (tid < 465) ? nab[h * 465 + tid] * LOG2E : 0.f;
            const size_t q0 = (size_t)b * TLAT + i0 * 64;
            Qp = Z + q0 * DIN + C_NAQ + 64 * h; Kp = Z + C_NAK + 64 * h; Vp = Z + C_NAV + 64 * h; Op = YS + q0 * 1024 + 256 + 64 * h;
          } else {
            const int v = u - 1024, isna = v >> 3, h = v & 3, b = (v >> 2) & 1;
            const size_t q0 = (size_t)NLAT + b * CTXL;
            tm = {4, NLAT + b * CTXL, 0, 4};
            if (isna) { Qp = Z + q0 * DIN + C_NAQ + 64 * h; Kp = Z + C_NAK + 64 * h; Vp = Z + C_NAV + 64 * h; Op = YS + q0 * 1024 + 256 + 64 * h; }
            else { Qp = Z + q0 * DIN + C_GQ + 64 * h; Kp = Z + C_GK + 64 * (h >> 1); Vp = Z + C_GV + 64 * (h >> 1); Op = YS + q0 * 1024 + 512 + 64 * h; }
          }
#ifndef NO_M1
          if (mode) { FRESH_TID(t1_) attn_body::attn_unit<1, 8>(Qp, Kp, Vp, Op, tm, na, (char*)lds_raw, t1_); }
#endif
#ifndef NO_M0
          if (!mode) { FRESH_TID(t0_) attn_body::attn_unit<0, 8>(Qp, Kp, Vp, Op, tm, na, (char*)lds_raw, t0_); }
#endif
        }
      }
#endif
    PHASE_END

    PHASE_BEGIN(5)
      {
        const int half = tid >> 8, c = tid & 255, hh = c >> 6;
        const float lnw = A.in[I_LNW][l * 256 + c], lnb = A.in[I_LNB][l * 256 + c];
        const float mv0 = A.in[I_MU][(size_t)(l * 2 + 0) * 896 + 512 + c], mv1 = A.in[I_MU][(size_t)(l * 2 + 1) * 896 + 512 + c];
        for (int tile = bx; tile < 256; tile += G) {
          const int R0 = tile * 130;
#pragma unroll 2
          for (int r = half; r < 130; r += 2) {
            const int row = R0 + r; int t, len; row_seq(row, t, len);
            const float y = YSC[((size_t)0 * NROW + row) * 256 + c] + YSC[((size_t)1 * NROW + row) * 256 + c];
            const bf16_t* zr = Z + (size_t)row * DIN + C_RV + c;
            const float zv = bf2f(zr[0]), zp = (t > 0) ? bf2f(zr[-DIN]) : 0.f, zq = (t < len - 1) ? bf2f(zr[DIN]) : 0.f;
            const float b0 = BONUS[((size_t)0 * NROW + row) * 4 + hh], b1 = BONUS[((size_t)1 * NROW + row) * 4 + hh];
            const float gate = bf2f(YS[(size_t)row * 1024 + 768 + c]);
            const float mean = wave_sum(y, lane) * (1.f / 64.f); const float dv = y - mean; const float var = wave_sum(dv * dv, lane) * (1.f / 64.f);
            const float yn = dv * __builtin_amdgcn_rsqf(var + 64e-5f) * lnw + lnb;
            const float v0 = zv + mv0 * (zp - zv), v1 = zv + mv1 * (zq - zv);
            const float bon = b0 * v0 + b1 * v1;
            YS[(size_t)row * 1024 + 768 + c] = (bf16_t)(cvtpk((yn + bon) * gate, 0.f) & 0xffffu);
          }
        }
      }
    PHASE_END

    PHASE_BEGIN(6)
      pg8::Gemm g{(const char*)ws, 1024, 1024};
      pg8::SchedMerge S{G, bx, (l == NLAYER - 1) ? 128 : 130};
      pg8::EpiMerge E{ws + WS_PSCR, A.in[I_BGATE] + (size_t)l * 4096, (bf16_t*)(ws + WS_ACCM)};
      pg8::gemm_phase<pg8::EpiMerge, pg8::SchedMerge, false>(lds, g, S, E, tid);
    PHASE_END

    PHASE_BEGIN(7)
      pg8::Gemm g{(const char*)ws, 1024, 1024};
      pg8::SchedPlain S{(l == NLAYER - 1) ? 128 : 130, 4, G, bx, 16, (long)WS_ACCM, (long)(WS_W + W_O), 1024, 1024, 0};
      pg8::EpiStore E{(bf16_t*)(ws + WS_MBUF), 1024};
      pg8::gemm_phase<pg8::EpiStore, pg8::SchedPlain, false>(lds, g, S, E, tid);
    PHASE_END

    PHASE_BEGIN(8)
      for (int vb_ = bx; vb_ < 256; vb_ += G)
      row_phase_blk((l == 0) ? A.in[I_X] : (const float*)A.out, (l == 0) ? A.in[I_CTX] : (const float*)XC, A.out, XC, (const bf16_t*)(ws + WS_MBUF),
                    MOD + (size_t)l * 3 * 6144, 2 * 1024, A.in[I_NMIXPOST] + l * 1024, H, A.in[I_NFFNPRE] + l * 1024, MOD + (size_t)l * 3 * 6144, 3 * 1024, 4 * 1024, vb_, wave, lane);
    PHASE_END

    PHASE_BEGIN(9)
      pg8::Gemm g{(const char*)ws, 1024, 1024};
      pg8::SchedUp S{G, bx, (l == NLAYER - 1) ? 134 : 138};
      pg8::EpiConvGlu E{(bf16_t*)(ws + WS_G), A.in[I_FCONV] + (size_t)l * 3 * 5632};
      pg8::gemm_phase<pg8::EpiConvGlu, pg8::SchedUp, true>(lds, g, S, E, tid);
    PHASE_END

    PHASE_BEGIN(10)
      pg8::Gemm g{(const char*)ws, DFF, DFF};
      pg8::SchedPlain S{(l == NLAYER - 1) ? 128 : 130, 4, G, bx, 44, (long)WS_G, (long)(WS_W + W_DN), DFF, DFF, 0};
      pg8::EpiStore E{(bf16_t*)(ws + WS_F), 1024};
      pg8::gemm_phase<pg8::EpiStore, pg8::SchedPlain, false>(lds, g, S, E, tid);
    PHASE_END

    PHASE_BEGIN(11)
      for (int vb_ = bx; vb_ < 256; vb_ += G)
      row_phase_blk((const float*)A.out, (const float*)XC, A.out, XC, (const bf16_t*)(ws + WS_F),
                    MOD + (size_t)l * 3 * 6144, 5 * 1024, A.in[I_NFFNPOST] + l * 1024, (l < NLAYER - 1) ? H : (bf16_t*)nullptr, A.in[I_NMIXPRE] + ((l + 1) & 3) * 1024,
                    MOD + (size_t)((l + 1) & 3) * 3 * 6144, 0, 1024, vb_, wave, lane);
      if (l < NLAYER - 1) convert_weights(A, l + 1, lds, gw, NGW, wave, lane);
    PHASE_END
  }
}

constexpr int LDS_BYTES = 147456;
constexpr int NPHASES = 2 + NLAYER * 10;
extern "C" void kernel_launch(void* const* d_in, const int* in_sizes, int n_in, void* d_out, int out_size, void* d_ws, size_t ws_size, hipStream_t stream) {
  static int grid = 0;
  if (grid == 0) {
    int dev = 0, cus = 0, per_cu = 0;
    hipGetDevice(&dev);
    hipDeviceGetAttribute(&cus, hipDeviceAttributeMultiprocessorCount, dev);
    if (hipFuncSetAttribute((const void*)fwd_megakernel, hipFuncAttributeMaxDynamicSharedMemorySize, LDS_BYTES) != hipSuccess) fprintf(stderr, "kernel_launch: hipFuncSetAttribute failed\n");
    hipOccupancyMaxActiveBlocksPerMultiprocessor(&per_cu, (const void*)fwd_megakernel, NTHREADS, LDS_BYTES);
    (void)hipGetLastError();
    if (per_cu < 1) per_cu = 1;
    grid = cus;
    if (n_in != 33 || ws_size < WS_END) fprintf(stderr, "kernel_launch: unexpected n_in %d or ws %zu\n", n_in, ws_size);
  }
  (void)hipMemsetAsync((char*)d_ws + WS_CTL, 0, 4096, stream);
  Args a{};
  for (int i = 0; i < 33; ++i) a.in[i] = (const float*)d_in[i];
  a.out = (float*)d_out; a.ws = (unsigned char*)d_ws; a.ph_lo = 0; a.ph_hi = NPHASES;
  void* args[] = {&a};
  hipError_t e = hipLaunchCooperativeKernel((const void*)fwd_megakernel, dim3(grid), dim3(NTHREADS), args, LDS_BYTES, stream);
  if (e != hipSuccess) fprintf(stderr, "cooperative launch failed: %s (grid %d)\n", hipGetErrorString(e), grid);
}
```

```cpp
#include <hip/hip_runtime.h>
#include <hip/hip_cooperative_groups.h>
#include <hip/hip_bf16.h>
#include <cstdio>
#include <cstdint>
#include <cmath>
namespace cg = cooperative_groups;

#define DI __device__ __forceinline__
#define LAS __attribute__((address_space(3)))
#define CAS4 __attribute__((address_space(4)))
typedef unsigned short bf16_t;
typedef short bf16x8 __attribute__((ext_vector_type(8)));
typedef float f32x4 __attribute__((ext_vector_type(4)));
typedef float f32x2 __attribute__((ext_vector_type(2)));
typedef float f32x16 __attribute__((ext_vector_type(16)));
typedef unsigned u32x4 __attribute__((ext_vector_type(4)));
typedef short s16x4 __attribute__((ext_vector_type(4)));
typedef __bf16 bf16x2_t __attribute__((ext_vector_type(2)));

constexpr int DM = 1024, TLAT = 16384, NLAT = 32768, CTXL = 256, NROW = 33280, NLAYER = 4;
constexpr int DIN = 3072, DFF = 2816;
constexpr int C_NAQ = 768, C_NAK = 1024, C_NAV = 1280, C_GQ = 1536, C_GK = 1792, C_GV = 1920;
constexpr int C_RR = 2048, C_RK = 2304, C_RV = 2560, C_LW = 2816, C_LA = 2880, C_LG = 2944;
constexpr float C2 = 0.125f * 1.4426950408889634f;
constexpr float LOG2E = 1.4426950408889634f;
constexpr int NTHREADS = 512;

constexpr size_t MiB = 1u << 20;
constexpr size_t WS_CTL = 0, WS_MOD = 1 * MiB, WS_XC = 2 * MiB, WS_BONUS = 4 * MiB, WS_W = 6 * MiB;
constexpr size_t W_IN = 0, W_GATE = W_IN + (size_t)3072 * 1024 * 2, W_BR = W_GATE + (size_t)4096 * 1024 * 2, W_O = W_BR + (size_t)1024 * 1024 * 2,
                 W_UP = W_O + (size_t)1024 * 1024 * 2, W_DN = W_UP + (size_t)5632 * 1024 * 2, W_END = W_DN + (size_t)1024 * 2816 * 2;
static_assert(WS_W + W_END <= 42 * MiB, "weights");
constexpr size_t WS_H = 42 * MiB + 65536, WS_Z = 108 * MiB, WS_YS = 304 * MiB, WS_WA = 370 * MiB, WS_YSC = 436 * MiB, WS_END = 501 * MiB;
constexpr size_t WS_ACCM = WS_Z, WS_MBUF = WS_Z + 70 * MiB, WS_G = WS_Z, WS_F = WS_YS, WS_PSCR = WS_WA, WS_ASCR = WS_YSC;
constexpr size_t ROWB = (size_t)NROW * 1024 * 2;

DI float bf2f(unsigned u16) { return __uint_as_float(u16 << 16); }
DI unsigned cvtpk(float lo, float hi) { f32x2 v = {lo, hi}; bf16x2_t b = __builtin_convertvector(v, bf16x2_t); return __builtin_bit_cast(unsigned, b); }
DI void unpack8(const u32x4 w, float* f) {
#pragma unroll
  for (int i = 0; i < 4; ++i) { f[2 * i] = __uint_as_float(w[i] << 16); f[2 * i + 1] = __uint_as_float(w[i] & 0xffff0000u); }
}
DI u32x4 pack8(const float* f) { u32x4 w; w.x = cvtpk(f[0], f[1]); w.y = cvtpk(f[2], f[3]); w.z = cvtpk(f[4], f[5]); w.w = cvtpk(f[6], f[7]); return w; }
DI float sigmoidf_(float x) { return __builtin_amdgcn_rcpf(1.f + __builtin_amdgcn_exp2f(-1.4426950408889634f * x)); }
DI float dppf(float x, const int ctrl_dummy);
#define DPPF(x, CTRL) __int_as_float(__builtin_amdgcn_update_dpp(0, __float_as_int(x), (CTRL), 0xf, 0xf, false))
DI float allreduce16(float x) { x += DPPF(x, 0xB1); x += DPPF(x, 0x4E); x += DPPF(x, 0x141); x += DPPF(x, 0x140); return x; }
DI float red8(float x) { x += DPPF(x, 0xB1); x += DPPF(x, 0x4E); x += DPPF(x, 0x141); return x; }
DI float bperm(float v, int src_lane) { return __int_as_float(__builtin_amdgcn_ds_bpermute(src_lane << 2, __float_as_int(v))); }
DI float wave_sum(float v, int lane) { v = allreduce16(v); v += bperm(v, lane ^ 16); v += bperm(v, lane ^ 32); return v; }

DI void grid_barrier(unsigned* ctr, unsigned target, int tid) {
  __syncthreads();
  if (tid == 0) {
    __builtin_amdgcn_fence(__ATOMIC_RELEASE, "agent");
    __hip_atomic_fetch_add(ctr, 1u, __ATOMIC_RELAXED, __HIP_MEMORY_SCOPE_AGENT);
    while (__hip_atomic_load(ctr, __ATOMIC_RELAXED, __HIP_MEMORY_SCOPE_AGENT) < target) __builtin_amdgcn_s_sleep(1);
    __builtin_amdgcn_fence(__ATOMIC_ACQUIRE, "agent");
    asm volatile("s_waitcnt vmcnt(0)" ::: "memory");
  }
  __syncthreads();
}
DI void grid_barrier2(unsigned* ctl, unsigned k, int G, int bx, int tid) {
  __syncthreads();
  if (tid == 0) {
    __builtin_amdgcn_fence(__ATOMIC_RELEASE, "agent");
    const unsigned g = (unsigned)bx & 7u, gsize = ((unsigned)G - g + 7u) >> 3, ng = (G < 8) ? (unsigned)G : 8u;
    unsigned* grp = ctl + 512 + 64 * g; unsigned* top = ctl + 512 + 64 * 8; unsigned* gen = ctl + 512 + 64 * (9 + g);
    const unsigned old = __hip_atomic_fetch_add(grp, 1u, __ATOMIC_RELAXED, __HIP_MEMORY_SCOPE_AGENT);
    if (old + 1u == k * gsize) {
      const unsigned ot = __hip_atomic_fetch_add(top, 1u, __ATOMIC_RELAXED, __HIP_MEMORY_SCOPE_AGENT);
      if (ot + 1u == k * ng) { for (unsigned j = 0; j < ng; ++j) __hip_atomic_fetch_add(ctl + 512 + 64 * (9 + j), 1u, __ATOMIC_RELAXED, __HIP_MEMORY_SCOPE_AGENT); }
    }
    while (__hip_atomic_load(gen, __ATOMIC_RELAXED, __HIP_MEMORY_SCOPE_AGENT) < k) __builtin_amdgcn_s_sleep(1);
    __builtin_amdgcn_fence(__ATOMIC_ACQUIRE, "agent");
    asm volatile("s_waitcnt vmcnt(0)" ::: "memory");
  }
  __syncthreads();
}
DI void row_seq(int row, int& t, int& len) { if (row < NLAT) { t = row & (TLAT - 1); len = TLAT; } else { t = (row - NLAT) & (CTXL - 1); len = CTXL; } }

namespace pg8 {
constexpr int BM = 256, BK = 64, HALF = 128, HTB = HALF * BK * 2, STAGE_BYTES = 8 * HTB;
DI int lds_byte(int r, int c) { const int st = (r >> 4) * 2 + (c >> 5), rr = r & 15, cc = c & 31, ob = rr * 64 + cc * 2; return st * 1024 + (ob ^ (((ob >> 9) & 1) << 5)); }
DI void stage_rc(int b, int& R, int& C) { const int st = b / 1024, sb = b % 1024, swz = sb ^ (((sb >> 9) & 1) << 5); R = (st >> 1) * 16 + swz / 64; C = (st & 1) * 32 + (swz % 64) / 2; }
DI int perm32(int rho) { const int n = rho >> 4, i = rho & 15; return 8 * (i >> 2) + 4 * n + (i & 3); }

struct Unit { int pm, pn, nt, kind; };
struct Gemm { const char* base; int lda, ldb; };

template <class Epi, class Sched, bool CONV>
DI void gemm_phase(LAS unsigned char* lds, const Gemm g, const Sched& S, const Epi& E, int tid) {
    const int wid = __builtin_amdgcn_readfirstlane(tid >> 6), lane = tid & 63, wr = wid >> 2, wc = wid & 3, fr = lane & 15, fq = lane >> 4;
    unsigned voffA[2], voffB[2];
#pragma unroll
    for (int i = 0; i < 2; ++i) { int R, C; stage_rc(tid * 16 + i * 8192, R, C); const int Rb = (R & ~31) + perm32(R & 31);
        const int Ra = CONV ? (62 * (R >> 6) + (R & 63)) : R;
        voffA[i] = (unsigned)(Ra * g.lda + C) * 2u; voffB[i] = (unsigned)(Rb * g.ldb + C) * 2u; }
    constexpr int kstep = BK * 2;
    const int hstepA = (CONV ? 124 : HALF) * g.lda * 2, hstepB = HALF * g.ldb * 2;
    const unsigned ldsw = (unsigned)wid * 1024u;
    const int aoff = lds_byte(wr * 64 + fr, fq * 8), boff = lds_byte(wc * 32 + fr, fq * 8);
#define PG8_SA(b, h) (((b) * 2 + (h)) * HTB)
#define PG8_SB(b, h) ((4 + (b) * 2 + (h)) * HTB)
#define PG8_STAGE(bufoff, gbase, voff) do { _Pragma("unroll") for (int _i = 0; _i < 2; ++_i) \
        __builtin_amdgcn_global_load_lds((const unsigned*)((const char*)(gbase) + (voff)[_i]), (LAS unsigned*)(lds + (bufoff) + ldsw + _i * 8192), 16, 0, 0); } while (0)
#define PG8_LDA(dst, b, h) do { _Pragma("unroll") for (int m = 0; m < 4; ++m) _Pragma("unroll") for (int k = 0; k < 2; ++k) dst[m][k] = *(const LAS bf16x8*)(lds + PG8_SA(b, h) + aoff + m * 2048 + k * 1024); } while (0)
#define PG8_LDB(dst, b, h) do { _Pragma("unroll") for (int n = 0; n < 2; ++n) _Pragma("unroll") for (int k = 0; k < 2; ++k) dst[n][k] = *(const LAS bf16x8*)(lds + PG8_SB(b, h) + boff + n * 2048 + k * 1024); } while (0)
#define PG8_MMA(ai, bj, At, Bt) do { __builtin_amdgcn_s_setprio(1); _Pragma("unroll") for (int m = 0; m < 4; ++m) _Pragma("unroll") for (int n = 0; n < 2; ++n) _Pragma("unroll") for (int k = 0; k < 2; ++k) \
        acc[ai][bj][m][n] = __builtin_amdgcn_mfma_f32_16x16x32_bf16(Bt[n][k], At[m][k], acc[ai][bj][m][n], 0, 0, 0); __builtin_amdgcn_s_setprio(0); } while (0)
#define PG8_WAIT_V(n) asm volatile("s_waitcnt vmcnt(" #n ")" ::: "memory")
#define PG8_WAIT_L(n) asm volatile("s_waitcnt lgkmcnt(" #n ")" ::: "memory")
#define PG8_BAR __builtin_amdgcn_s_barrier()
#define PG8_SCHED __builtin_amdgcn_sched_barrier(0)
    Unit cur, nxt; int ui = 0; long ao_, bo_;
    if (!S.next(0, cur, ao_, bo_)) return;
    f32x4 acc[2][2][4][2];
#pragma unroll
    for (int a = 0; a < 2; ++a)
#pragma unroll
        for (int b = 0; b < 2; ++b)
#pragma unroll
            for (int m = 0; m < 4; ++m)
#pragma unroll
                for (int n = 0; n < 2; ++n) acc[a][b][m][n] = (f32x4){0.f, 0.f, 0.f, 0.f};
    bf16x8 At[4][2], B0[2][2], B1[2][2];
    const char* cA = g.base + ao_; const char* cB = g.base + bo_;
    PG8_STAGE(PG8_SB(0, 0), cB, voffB); PG8_STAGE(PG8_SB(0, 1), cB + hstepB, voffB); PG8_STAGE(PG8_SA(0, 0), cA, voffA); PG8_STAGE(PG8_SA(0, 1), cA + hstepA, voffA);
    if (wr == 1) PG8_BAR;
    PG8_WAIT_V(2); PG8_BAR;
    PG8_STAGE(PG8_SB(1, 0), cB + kstep, voffB); PG8_STAGE(PG8_SA(1, 0), cA + kstep, voffA); PG8_STAGE(PG8_SB(1, 1), cB + hstepB + kstep, voffB);
    PG8_WAIT_V(6); PG8_BAR;
    for (;;) {
        const bool has_next = S.next(ui + 1, nxt, ao_, bo_);
        const char* nA = has_next ? g.base + ao_ : cA; const char* nB = has_next ? g.base + bo_ : cB;
        const int nt = cur.nt;
        for (int t = 0; t < nt; t += 2) {
            const bool last = (t == nt - 2);
            const char* a1 = cA + (size_t)(t + 1) * kstep;
            const char* a2 = last ? nA : cA + (size_t)(t + 2) * kstep; const char* b2 = last ? nB : cB + (size_t)(t + 2) * kstep;
            const char* a3 = a2 + kstep; const char* b3 = b2 + kstep;
            PG8_LDB(B0, 0, 0); PG8_LDB(B1, 0, 1); PG8_SCHED; PG8_LDA(At, 0, 0); PG8_STAGE(PG8_SA(1, 1), a1 + hstepA, voffA);
            PG8_WAIT_V(8); PG8_WAIT_L(0); PG8_BAR; PG8_MMA(0, 0, At, B0); PG8_MMA(0, 1, At, B1); PG8_BAR; PG8_SCHED;
            PG8_LDA(At, 0, 1); PG8_STAGE(PG8_SB(0, 0), b2, voffB); PG8_STAGE(PG8_SB(0, 1), b2 + hstepB, voffB); PG8_STAGE(PG8_SA(0, 0), a2, voffA);
            PG8_WAIT_V(8); PG8_WAIT_L(0); PG8_BAR; PG8_MMA(1, 0, At, B0); PG8_MMA(1, 1, At, B1); PG8_BAR; PG8_SCHED;
            PG8_LDB(B0, 1, 0); PG8_LDB(B1, 1, 1); PG8_SCHED; PG8_LDA(At, 1, 0); PG8_STAGE(PG8_SA(0, 1), a2 + hstepA, voffA);
            PG8_WAIT_V(8); PG8_WAIT_L(0); PG8_BAR; PG8_MMA(0, 0, At, B0); PG8_MMA(0, 1, At, B1); PG8_BAR; PG8_SCHED;
            PG8_LDA(At, 1, 1); PG8_STAGE(PG8_SB(1, 0), b3, voffB); PG8_STAGE(PG8_SB(1, 1), b3 + hstepB, voffB); PG8_STAGE(PG8_SA(1, 0), a3, voffA);
            PG8_WAIT_V(8); PG8_WAIT_L(0); PG8_BAR; PG8_MMA(1, 0, At, B0); PG8_MMA(1, 1, At, B1); PG8_BAR; PG8_SCHED;
        }
        if (wr == 0) PG8_BAR;
        E(acc, cur, wr, wc, fr, fq);
        if (!has_next) break;
#pragma unroll
        for (int a = 0; a < 2; ++a)
#pragma unroll
            for (int b = 0; b < 2; ++b)
#pragma unroll
                for (int m = 0; m < 4; ++m)
#pragma unroll
                    for (int n = 0; n < 2; ++n) acc[a][b][m][n] = (f32x4){0.f, 0.f, 0.f, 0.f};
        cur = nxt; cA = nA; cB = nB; ++ui;
        if (wr == 1) PG8_BAR;
    }
    PG8_WAIT_V(0);
    PG8_BAR;
#undef PG8_SA
#undef PG8_SB
#undef PG8_STAGE
#undef PG8_LDA
#undef PG8_LDB
#undef PG8_MMA
#undef PG8_WAIT_V
#undef PG8_WAIT_L
#undef PG8_BAR
#undef PG8_SCHED
}

DI void xcd_tile(int L, int nM, int nN, int& pm, int& pn) {
    const int nwg = nM * nN; int wgid = L; { const int q = nwg / 8, r = nwg % 8, xcd = wgid % 8, off = wgid / 8; wgid = (xcd < r ? xcd * (q + 1) : r * (q + 1) + (xcd - r) * q) + off; }
    const int nig = 8 * nN, gid = wgid / nig, fm = gid * 8, gsz = (nM - fm) < 8 ? (nM - fm) : 8;
    pm = fm + ((wgid % nig) % gsz); pn = (wgid % nig) / gsz;
}
struct SchedPlain {
    int nM, nN, G, c, nt; long a0, b0; int lda, ldb, pn0;
    DI bool next(int i, Unit& u, long& a_off, long& b_off) const {
        const int L = i * G + c; if (L >= nM * nN) return false;
        xcd_tile(L, nM, nN, u.pm, u.pn); u.pn += pn0; a_off = a0 + (long)u.pm * 256 * lda * 2; b_off = b0 + (long)u.pn * 256 * ldb * 2; u.nt = nt; u.kind = 0; return true; }
};
struct SchedMerge {
    int G, c, nrt;
    DI bool next(int i, Unit& u, long& a_off, long& b_off) const {
        const int nr = (c < 512) ? (512 - c + G - 1) / G : 0;
        int sub;
        if (i < 8 * nr) { const int L = (i >> 3) * G + c; xcd_tile(L, 128, 4, u.pm, u.pn); sub = i & 7; }
        else { if (nrt != 130) return false;
            const int ii = i - 8 * nr, k = ii / 5, j = ii - 5 * k, qid = c + k * G; if (qid >= 32) return false;
            const int tq = qid >> 2, q = qid & 3; u.pm = 128 + (tq >> 2); u.pn = tq & 3; sub = (j < 4) ? j : 12 + q; }
        u.kind = sub;
        if (sub < 4) { a_off = (long)WS_YS + ((long)u.pm * 256 * 1024 + sub * 256) * 2; b_off = (long)(WS_W + W_BR) + ((long)u.pn * 256 * 1024 + sub * 256) * 2; u.nt = 4; }
        else { a_off = (long)WS_H + (long)u.pm * 256 * 1024 * 2; b_off = (long)(WS_W + W_GATE) + ((long)((u.pn * 4 + ((sub - 4) & 3)) * 256) * 1024) * 2; u.nt = 16; }
        return true; }
};
struct SchedUp {
    int G, c, ntm;
    DI static void tile_seq(int tm, int& base, int& len, int& j) {
        if (tm < 67) { base = 0; len = TLAT; j = tm; } else if (tm < 134) { base = TLAT; len = TLAT; j = tm - 67; }
        else { const int x = tm - 134; base = NLAT + (x >> 1) * CTXL; len = CTXL; j = x & 1; } }
    DI bool next(int i, Unit& u, long& a_off, long& b_off) const {
        const int L = i * G + c; if (L >= ntm * 22) return false;
        xcd_tile(L, ntm, 22, u.pm, u.pn); int base, len, j; tile_seq(u.pm, base, len, j);
        a_off = (long)WS_H + ((long)(base + 248 * j - 1) * 1024) * 2; b_off = (long)(WS_W + W_UP) + (long)u.pn * 256 * 1024 * 2; u.nt = 16; u.kind = 0; return true; }
};

struct EpiStore {
    bf16_t* O; int ldc;
    DI void operator()(const f32x4 (&acc)[2][2][4][2], const Unit& u, int wr, int wc, int fr_in, int fq_in) const {
        int ln_; asm volatile("v_mbcnt_lo_u32_b32 %0, -1, 0\n\tv_mbcnt_hi_u32_b32 %0, -1, %0" : "=v"(ln_)); const int fr = ln_ & 15, fq = ln_ >> 4; (void)fr_in; (void)fq_in;
        const int row0 = u.pm * 256 + wr * 64 + fr, col0 = u.pn * 256 + wc * 32 + 8 * fq;
#pragma unroll
        for (int ai = 0; ai < 2; ++ai)
#pragma unroll
            for (int m = 0; m < 4; ++m) { bf16_t* rowp = O + (size_t)(row0 + ai * 128 + m * 16) * ldc + col0;
#pragma unroll
                for (int bj = 0; bj < 2; ++bj) { const f32x4 v0 = acc[ai][bj][m][0], v1 = acc[ai][bj][m][1];
                    u32x4 w; w.x = cvtpk(v0[0], v0[1]); w.y = cvtpk(v0[2], v0[3]); w.z = cvtpk(v1[0], v1[1]); w.w = cvtpk(v1[2], v1[3]);
                    *(u32x4*)(rowp + bj * 128) = w; } }
    }
};
struct EpiMerge {
    unsigned char* stash; const float* bgate; bf16_t* O;
    DI void operator()(const f32x4 (&acc)[2][2][4][2], const Unit& u, int wr, int wc, int fr_in, int fq_in) const {
        int ln_; asm volatile("v_mbcnt_lo_u32_b32 %0, -1, 0\n\tv_mbcnt_hi_u32_b32 %0, -1, %0" : "=v"(ln_)); const int fr = ln_ & 15, fq = ln_ >> 4; (void)fr_in; (void)fq_in;
        unsigned char* st = stash + (size_t)blockIdx.x * 524288;
        if (u.kind < 4) {
            unsigned char* pb = st + (size_t)u.kind * 131072 + (size_t)(wr * 64 + fr) * 512 + (wc * 32 + 8 * fq) * 2;
#pragma unroll
            for (int ai = 0; ai < 2; ++ai)
#pragma unroll
                for (int m = 0; m < 4; ++m)
#pragma unroll
                    for (int bj = 0; bj < 2; ++bj) { const f32x4 v0 = acc[ai][bj][m][0], v1 = acc[ai][bj][m][1];
                        u32x4 w; w.x = cvtpk(v0[0], v0[1]); w.y = cvtpk(v0[2], v0[3]); w.z = cvtpk(v1[0], v1[1]); w.w = cvtpk(v1[2], v1[3]);
                        *(u32x4*)(pb + (size_t)(ai * 128 + m * 16) * 512 + bj * 256) = w; }
            if (u.kind == 3) asm volatile("s_waitcnt vmcnt(0)" ::: "memory");
        } else {
            if (u.kind == 4 || u.kind >= 12) { __builtin_amdgcn_fence(__ATOMIC_ACQUIRE, "agent"); asm volatile("s_waitcnt vmcnt(0)" ::: "memory"); }
            const int q = (u.kind - 4) & 3, cq = 64 * q + 16 * wc + 4 * fq, col = u.pn * 256 + cq;
            f32x4 bg[4];
#pragma unroll
            for (int i = 0; i < 4; ++i) bg[i] = *(const f32x4*)(bgate + i * 1024 + col);
            const unsigned char* pb = st + (size_t)(wr * 64 + fr) * 512 + cq * 2;
            bf16_t* ob = O + (size_t)(u.pm * 256 + wr * 64 + fr) * 1024 + col;
#pragma unroll
            for (int ai = 0; ai < 2; ++ai)
#pragma unroll
                for (int m = 0; m < 4; ++m) {
                    f32x4 o = (f32x4){0.f, 0.f, 0.f, 0.f};
#pragma unroll
                    for (int bj = 0; bj < 2; ++bj)
#pragma unroll
                        for (int n = 0; n < 2; ++n) { const int i = 2 * bj + n;
                            const uint2 pw = *(const uint2*)(pb + (size_t)i * 131072 + (size_t)(ai * 128 + m * 16) * 512);
                            const f32x4 p = (f32x4){__uint_as_float(pw.x << 16), __uint_as_float(pw.x & 0xffff0000u), __uint_as_float(pw.y << 16), __uint_as_float(pw.y & 0xffff0000u)};
                            const f32x4 gv = acc[ai][bj][m][n] + bg[i];
#pragma unroll
                            for (int e = 0; e < 4; ++e) o[e] += sigmoidf_(gv[e]) * p[e]; }
                    uint2 w; w.x = cvtpk(o[0], o[1]); w.y = cvtpk(o[2], o[3]);
                    *(uint2*)(ob + (size_t)(ai * 128 + m * 16) * 1024) = w;
                }
        }
    }
};
struct EpiConvGlu {
    bf16_t* Gout; const float* cw;
    DI void operator()(const f32x4 (&acc)[2][2][4][2], const Unit& u, int wr, int wc, int fr_in, int fq_in) const {
        int ln_; asm volatile("v_mbcnt_lo_u32_b32 %0, -1, 0\n\tv_mbcnt_hi_u32_b32 %0, -1, %0" : "=v"(ln_)); const int fr = ln_ & 15, fq = ln_ >> 4; (void)fr_in; (void)fq_in;
        int base, len, j; SchedUp::tile_seq(u.pm, base, len, j);
        const bool f0 = (fr == 0), f15 = (fr == 15);
#pragma unroll
        for (int n = 0; n < 2; ++n) {
            const int colv = u.pn * 128 + wc * 32 + 8 * fq + 4 * n;
            f32x4 wv[3], wg[3];
#pragma unroll
            for (int k = 0; k < 3; ++k) { wv[k] = *(const f32x4*)(cw + k * 5632 + colv); wg[k] = *(const f32x4*)(cw + k * 5632 + 2816 + colv); }
#pragma unroll
            for (int ai = 0; ai < 2; ++ai) {
#pragma unroll
                for (int m = 0; m < 4; ++m) {
                    const int rho = 16 * m + fr;
                    const int tl = 248 * j + 62 * (2 * ai + wr) - 1 + rho;
                    const bool valid = (rho >= 1) && (rho <= 62) && (tl >= 0) && (tl < len);
                    const bool lz = (tl <= 0), rz = (tl >= len - 1);
                    float outv[4];
#pragma unroll
                    for (int e = 0; e < 4; ++e) {
                        float cvv[2];
#pragma unroll
                        for (int bj = 0; bj < 2; ++bj) {
                            const float xc = acc[ai][bj][m][n][e];
                            const float xm1 = (m > 0) ? acc[ai][bj][m - 1][n][e] : xc, xp1 = (m < 3) ? acc[ai][bj][m + 1][n][e] : xc;
                            const float tl_ = f15 ? xm1 : xc, tr_ = f0 ? xp1 : xc;
                            const float lraw = DPPF(tl_, 0x121); const float left = lz ? 0.f : lraw;
                            const float rraw = DPPF(tr_, 0x12F); const float right = rz ? 0.f : rraw;
                            cvv[bj] = bj ? (left * wg[0][e] + xc * wg[1][e] + right * wg[2][e]) : (left * wv[0][e] + xc * wv[1][e] + right * wv[2][e]);
                        }
                        outv[e] = cvv[0] * cvv[1] * sigmoidf_(cvv[1]);
                    }
                    if (valid) { uint2 w; w.x = cvtpk(outv[0], outv[1]); w.y = cvtpk(outv[2], outv[3]); *(uint2*)(Gout + (size_t)(base + tl) * DFF + colv) = w; }
                }
            }
        }
    }
};
}

namespace attn_body {
constexpr int QP = DIN, OP = 1024;
constexpr int NW = 8, QBLK = 32, KVBLK = 64;
DI int crow(int r, int hi) { return (r & 3) + 8 * (r >> 2) + 4 * hi; }
#define SBAR() __builtin_amdgcn_sched_barrier(0)
constexpr int NSLOT = 3, SLOTB = 8192;
constexpr int LDS_K = 0, LDS_V = NSLOT * SLOTB, LDS_WS = 2 * NSLOT * SLOTB, LDS_OST = LDS_WS + NW * 64 * 4, LDS_BYTES = LDS_OST + NW * 4096;
constexpr int LDS_BIAS = 86016;
DI void glds16(const void* gsrc, unsigned lds_dst) { unsigned keep;
  asm volatile("s_mov_b32 %0, m0\n\ts_mov_b32 m0, %2\n\ts_nop 0\n\tglobal_load_lds_dwordx4 %1, off\n\ts_mov_b32 m0, %0" : "=&s"(keep) : "v"(gsrc), "s"(lds_dst) : "memory"); }
DI float max3f(float a, float b, float c) { float r; asm("v_max3_f32 %0, %1, %2, %3" : "=v"(r) : "v"(a), "v"(b), "v"(c)); return r; }
DI float max2f(float a, float b) { float r; asm("v_max_f32_e32 %0, %1, %2" : "=v"(r) : "v"(a), "v"(b)); return r; }
DI float fadd_s(float a, float b) { float r; asm("v_add_f32_e32 %0, %1, %2" : "=v"(r) : "v"(a), "v"(b)); return r; }
DI float fsub_s(float a, float b) { float r; asm("v_sub_f32_e32 %0, %1, %2" : "=v"(r) : "v"(a), "v"(b)); return r; }
DI unsigned cvtpk_s(float lo, float hi) { return cvtpk(lo, hi); }
#define WAIT_BAR(N) asm volatile("s_waitcnt vmcnt(" #N ") lgkmcnt(0)\n\ts_barrier" ::: "memory")

DI void qkt(f32x16& p0, f32x16& p1, const char* Kslot, const bf16x8* qr, int r32, int hi) {
  const f32x16 zz = f32x16{};
  const char* kb = Kslot + hi * 1024 + r32 * 16;
#pragma unroll
  for (int d0 = 0; d0 < 4; ++d0) {
    const bf16x8 b0 = *reinterpret_cast<const bf16x8*>(kb + d0 * 2048);
    const bf16x8 b1 = *reinterpret_cast<const bf16x8*>(kb + d0 * 2048 + 512);
    if (d0 == 0) { p0 = __builtin_amdgcn_mfma_f32_32x32x16_bf16(b0, qr[0], zz, 0, 0, 0); p1 = __builtin_amdgcn_mfma_f32_32x32x16_bf16(b1, qr[0], zz, 0, 0, 0); }
    else { p0 = __builtin_amdgcn_mfma_f32_32x32x16_bf16(b0, qr[d0], p0, 0, 0, 0); p1 = __builtin_amdgcn_mfma_f32_32x32x16_bf16(b1, qr[d0], p1, 0, 0, 0); } }
}
typedef __attribute__((address_space(3))) const char* lds_cptr;
typedef short v4i16_t __attribute__((ext_vector_type(4)));
DI void kload8(bf16x8* kf, lds_cptr kp) {
  kf[0] = *(const LAS bf16x8*)(kp);        kf[1] = *(const LAS bf16x8*)(kp + 512);
  kf[2] = *(const LAS bf16x8*)(kp + 2048); kf[3] = *(const LAS bf16x8*)(kp + 2560);
  kf[4] = *(const LAS bf16x8*)(kp + 4096); kf[5] = *(const LAS bf16x8*)(kp + 4608);
  kf[6] = *(const LAS bf16x8*)(kp + 6144); kf[7] = *(const LAS bf16x8*)(kp + 6656);
}
DI void kload2(bf16x8* kf, lds_cptr kp, int j) { kf[2 * j] = *(const LAS bf16x8*)(kp + j * 2048); kf[2 * j + 1] = *(const LAS bf16x8*)(kp + j * 2048 + 512); }
DI s16x4 vtr(lds_cptr p) { return __builtin_bit_cast(s16x4, __builtin_amdgcn_ds_read_tr16_b64_v4i16((LAS v4i16_t*)p)); }
DI float rowmax(const f32x16& p0, const f32x16& p1) {
  float a = max3f(p0[0], p0[1], p1[0]), b = max3f(p0[2], p0[3], p1[1]); a = max3f(a, p1[2], p1[3]);
#pragma unroll
  for (int r = 4; r < 16; r += 4) { a = max3f(a, p0[r], p0[r + 1]); b = max3f(b, p0[r + 2], p0[r + 3]); a = max3f(a, p1[r], p1[r + 1]); b = max3f(b, p1[r + 2], p1[r + 3]); }
  const float m = max2f(a, b);
  auto rr = __builtin_amdgcn_permlane32_swap(__float_as_uint(m), __float_as_uint(m), false, false);
  return max2f(__uint_as_float(rr[0]), __uint_as_float(rr[1]));
}
DI void pv(f32x16* o, int vb, bf16x8 pa0, bf16x8 pa1, bf16x8 pa2, bf16x8 pa3) {
#pragma unroll
  for (int d0 = 0; d0 < 2; ++d0) { s16x4 lo[4], hi[4];
#pragma unroll
    for (int ks = 0; ks < 4; ++ks) {
      asm volatile("ds_read_b64_tr_b16 %0,%1 offset:%c2" : "=&v"(lo[ks]) : "v"(vb), "i"(d0 * 4096 + ks * 1024) : "memory");
      asm volatile("ds_read_b64_tr_b16 %0,%1 offset:%c2" : "=&v"(hi[ks]) : "v"(vb), "i"(d0 * 4096 + ks * 1024 + 512) : "memory"); }
    asm volatile("s_waitcnt lgkmcnt(0)" ::: "memory"); SBAR();
#define PK(k) (bf16x8){lo[k][0], lo[k][1], lo[k][2], lo[k][3], hi[k][0], hi[k][1], hi[k][2], hi[k][3]}
    o[d0] = __builtin_amdgcn_mfma_f32_32x32x16_bf16(pa0, PK(0), o[d0], 0, 0, 0);
    o[d0] = __builtin_amdgcn_mfma_f32_32x32x16_bf16(pa1, PK(1), o[d0], 0, 0, 0);
    o[d0] = __builtin_amdgcn_mfma_f32_32x32x16_bf16(pa2, PK(2), o[d0], 0, 0, 0);
    o[d0] = __builtin_amdgcn_mfma_f32_32x32x16_bf16(pa3, PK(3), o[d0], 0, 0, 0);
#undef PK
  }
}
struct TileMap { int n1, base1, base2, NT; };
struct NaInfo { int i0, rmin; };

template <int MODE, int THRL>
DI void attn_unit(const bf16_t* Qw0, const bf16_t* __restrict__ Kh, const bf16_t* __restrict__ Vh, bf16_t* Ow0, const TileMap tm, const NaInfo na, char* shm, int tid) {
  const int lane = tid & 63, r32 = lane & 31, hi = lane >> 5; const int wid = __builtin_amdgcn_readfirstlane(tid >> 6);
  const bf16_t* Qw = Qw0 + (long)(wid * QBLK) * QP;
  const unsigned lds0 = (unsigned)(uintptr_t)shm;
  float* wsf = (float*)(shm + LDS_WS) + wid * 64;
  const bf16_t* ksrc = Kh + (long)lane * QP + wid * 8;
  const bf16_t* vsrc = Vh + (long)(16 * (wid & 3) + (lane >> 2)) * QP + (wid >> 2) * 32 + (lane & 3) * 8;
  const unsigned kdst = lds0 + LDS_K + wid * 1024, vdst = lds0 + LDS_V + wid * 1024;
#define TROW(t) ((long)(((t) < tm.n1) ? (tm.base1 + 64 * (t)) : (tm.base2 + 64 * ((t) - tm.n1))))
#define DMA_K(t, slot) glds16(ksrc + TROW(t) * QP, (unsigned)__builtin_amdgcn_readfirstlane(kdst + (slot)))
#define DMA_V(t, slot) glds16(vsrc + TROW(t) * QP, (unsigned)__builtin_amdgcn_readfirstlane(vdst + (slot)))
  const int vb0 = (int)(lds0 + LDS_V) + ((lane >> 4) & 1) * 32 + (lane & 3) * 8 + (4 * hi + ((lane & 15) >> 2)) * 64;
  const char* Kbase = shm + LDS_K; bf16x8 kf[8];
  const lds_cptr shm3 = (lds_cptr)shm; const lds_cptr kp0 = shm3 + LDS_K + hi * 1024 + r32 * 16; const lds_cptr vp0 = shm3 + LDS_V + ((lane >> 4) & 1) * 32 + (lane & 3) * 8 + (4 * hi + ((lane & 15) >> 2)) * 64;
  const int NT = tm.NT;
  DMA_K(0, 0); DMA_V(0, 0); DMA_K(1, SLOTB);
  bf16x8 qr[4];
#pragma unroll
  for (int d0 = 0; d0 < 4; ++d0) qr[d0] = *reinterpret_cast<const bf16x8*>(&Qw[(long)r32 * QP + d0 * 16 + hi * 8]);
  float mhat = 0.f, l_reg = 0.f; f32x16 o[2]; o[0] = f32x16{}; o[1] = f32x16{}; f32x16 zacc = f32x16{}; if (MODE == 0) asm volatile("" : "+v"(zacc));
#define CMASK(P0, P1, t) do { if (MODE == 1) { const int t_ = (t); const bool ctx_ = t_ < 4; \
      int lane_ = lane; asm volatile("" : "+v"(lane_)); const int r32_ = lane_ & 31, hi_ = lane_ >> 5; \
      const int qi_ = na.i0 + (wid >> 1), qj_ = (wid & 1) * 32 + r32_; const int rs_ = min(max(qi_ - 4, 0), 248), cs_ = min(max(qj_ - 8, 0), 48); \
      const int kr = na.rmin + t_ - 4; const bool rowok = (unsigned)(kr - rs_) < 8u; \
      const int bb = ctx_ ? 480 : ((kr - qi_ + 7) * 31 + 15 - qj_ + 4 * hi_); const int lo_ = ctx_ ? -4096 : ((rowok ? cs_ : 4096) - 4 * hi_); const unsigned wd_ = ctx_ ? 8192u : 16u; const int mul_ = ctx_ ? 0 : 1; \
      const LAS float* btab = (const LAS float*)((lds_cptr)shm + LDS_BIAS); \
      _Pragma("unroll") for (int g_ = 0; g_ < 8; ++g_) { \
        _Pragma("unroll") for (int q_ = 0; q_ < 2; ++q_) { const int r = 2 * g_ + q_; const int kc0 = (r & 3) + 8 * (r >> 2); \
          const int d0_ = kc0 - lo_; \
          const int i0_ = ((unsigned)d0_ < wd_) ? bb + kc0 * mul_ : -1, i1_ = ((unsigned)(d0_ + 32) < wd_) ? bb + (kc0 + 32) * mul_ : -1; \
          const float b0_ = btab[max(i0_, 0)], b1_ = btab[max(i1_, 0)]; \
          P0[r] = (i0_ >= 0) ? P0[r] + b0_ : -INFINITY; P1[r] = (i1_ >= 0) ? P1[r] + b1_ : -INFINITY; } \
        SBAR(); } } } while (0)
  bool resc = false;
#define START(P0, P1) do { const float rm = rowmax(P0, P1); resc = false; \
    { const float dl = rm; mhat = fadd_s(mhat, dl); \
      _Pragma("unroll") for (int r = 0; r < 16; ++r) { P0[r] = fsub_s(P0[r], dl); P1[r] = fsub_s(P1[r], dl); } \
      if (MODE == 0) { _Pragma("unroll") for (int r = 0; r < 16; ++r) zacc[r] = -mhat; asm volatile("" : "+v"(zacc)); } } \
    _Pragma("unroll") for (int r = 0; r < 16; ++r) P0[r] = __builtin_amdgcn_exp2f(P0[r]); } while (0)
#define RESC() do { if (resc) { asm volatile("s_waitcnt lgkmcnt(0)" ::: "memory"); \
      _Pragma("unroll") for (int d_ = 0; d_ < 2; ++d_) _Pragma("unroll") for (int r = 0; r < 16; ++r) o[d_][r] *= wsf[crow(r, hi)]; } } while (0)
  f32x16 pA0, pA1, pB0, pB1;
  int sl_prev = 0, sl_cur = 0, sl_next = SLOTB;
#define ROT() do { sl_prev = sl_cur; sl_cur = sl_next; sl_next = (sl_next == (NSLOT - 1) * SLOTB) ? 0 : sl_next + SLOTB; } while (0)
  DMA_K(2, 2 * SLOTB);
  WAIT_BAR(3);
  qkt(pA0, pA1, Kbase, qr, r32, hi); asm volatile("s_nop 15\n\ts_nop 7" : "+v"(pA0), "+v"(pA1)); CMASK(pA0, pA1, 0);
  START(pA0, pA1);
  _Pragma("unroll") for (int r = 0; r < 16; ++r) pA1[r] = __builtin_amdgcn_exp2f(pA1[r]);
  WAIT_BAR(0);
  DMA_K(3, 0); DMA_V(1, SLOTB);
  ROT();
  kload8(kf, kp0 + sl_cur);
  WAIT_BAR(2);
  s16x4 vlo[8], vhi[8]; u32x4 pw0, pw1, pw2, pw3;
#define PKW(P, B) cvtpk_s(P[B], P[B + 1])
#define PAF(k) __builtin_bit_cast(bf16x8, pw##k)
#define VFR(i) (bf16x8){vlo[i][0], vlo[i][1], vlo[i][2], vlo[i][3], vhi[i][0], vhi[i][1], vhi[i][2], vhi[i][3]}
#define PIN(x) asm volatile("" : "+v"(x))
#define MX3(a, b, c) __builtin_fmaxf(__builtin_fmaxf((a), (b)), (c))
#define GAPA(MF, A0, A1, A2, A3, W0, W1, PW) do { MF; sacc += A0; sacc += A1; sacc += A2; sacc += A3; PIN(sacc); W0; W1; PIN(PW); SBAR(); } while (0)
#define EX(v) __builtin_amdgcn_exp2f(v)
#define GAPB(MF, X, B) do { MF; X[B] = EX(X[B]); X[B + 1] = EX(X[B + 1]); X[B + 2] = EX(X[B + 2]); X[B + 3] = EX(X[B + 3]); PIN(X); SBAR(); } while (0)
#define VRD(i) do { vlo[i] = vtr(vp_ + (((i) >> 2) * 4096 + ((i) & 3) * 1024)); vhi[i] = vtr(vp_ + (((i) >> 2) * 4096 + ((i) & 3) * 1024 + 512)); } while (0)
#define KRD(G, j) do { if (G) { kload2(kf, kp0 + sl_next, j); SBAR(); } } while (0)
#define STEP(C0, C1, P0, P1, t, GK, GV, GL) do { SBAR(); \
    const lds_cptr vp_ = vp0 + sl_prev; \
    VRD(0); SBAR(); float sacc = (P0[0] + P0[1]); \
    GAPA(C0 = __builtin_amdgcn_mfma_f32_32x32x16_bf16(kf[0], qr[0], zacc, 0, 0, 0), P0[2], P0[3], P0[4], P0[5],     pw0[0] = PKW(P0, 0), pw0[1] = PKW(P0, 2), pw0); \
    VRD(4); SBAR(); GAPA(C1 = __builtin_amdgcn_mfma_f32_32x32x16_bf16(kf[1], qr[0], zacc, 0, 0, 0), P0[6], P0[7], P0[8], P0[9],     pw0[2] = PKW(P0, 4), pw0[3] = PKW(P0, 6), pw0); \
    VRD(1); SBAR(); GAPA(C0 = __builtin_amdgcn_mfma_f32_32x32x16_bf16(kf[2], qr[1], C0, 0, 0, 0),   P0[10], P0[11], P0[12], P0[13], pw1[0] = PKW(P0, 8), pw1[1] = PKW(P0, 10), pw1); \
    VRD(5); SBAR(); GAPA(C1 = __builtin_amdgcn_mfma_f32_32x32x16_bf16(kf[3], qr[1], C1, 0, 0, 0),   P0[14], P0[15], P1[0], P1[1],   pw1[2] = PKW(P0, 12), pw1[3] = PKW(P0, 14), pw1); \
    VRD(2); SBAR(); GAPA(C0 = __builtin_amdgcn_mfma_f32_32x32x16_bf16(kf[4], qr[2], C0, 0, 0, 0),   P1[2], P1[3], P1[4], P1[5],     pw2[0] = PKW(P1, 0), pw2[1] = PKW(P1, 2), pw2); \
    VRD(6); SBAR(); GAPA(C1 = __builtin_amdgcn_mfma_f32_32x32x16_bf16(kf[5], qr[2], C1, 0, 0, 0),   P1[6], P1[7], P1[8], P1[9],     pw2[2] = PKW(P1, 4), pw2[3] = PKW(P1, 6), pw2); \
    VRD(3); SBAR(); GAPA(C0 = __builtin_amdgcn_mfma_f32_32x32x16_bf16(kf[6], qr[3], C0, 0, 0, 0),   P1[10], P1[11], P1[12], P1[13], pw3[0] = PKW(P1, 8), pw3[1] = PKW(P1, 10), pw3); \
    VRD(7); SBAR(); GAPA(C1 = __builtin_amdgcn_mfma_f32_32x32x16_bf16(kf[7], qr[3], C1, 0, 0, 0),   P1[14], P1[15], 0.f, 0.f,       pw3[2] = PKW(P1, 12), pw3[3] = PKW(P1, 14), pw3); \
    l_reg += sacc; \
    if (GK) { DMA_K((t) + 3, sl_cur); } if (GV) { DMA_V((t) + 1, sl_next); } \
    if (MODE == 1) { _Pragma("unroll") for (int r = 0; r < 16; ++r) { C0[r] -= mhat; C1[r] -= mhat; } } \
    CMASK(C0, C1, t); \
    { float a = MX3(C0[0], C0[1], C1[0]), b = MX3(C0[2], C0[3], C1[1]); a = MX3(a, C1[2], C1[3]); \
      _Pragma("unroll") for (int r = 4; r < 16; r += 4) { a = MX3(a, C0[r], C0[r + 1]); b = MX3(b, C0[r + 2], C0[r + 3]); a = MX3(a, C1[r], C1[r + 1]); b = MX3(b, C1[r + 2], C1[r + 3]); } \
      float rm = __builtin_fmaxf(a, b); { auto rr = __builtin_amdgcn_permlane32_swap(__float_as_uint(rm), __float_as_uint(rm), false, false); rm = __builtin_fmaxf(__uint_as_float(rr[0]), __uint_as_float(rr[1])); } \
      resc = false; \
      if (__builtin_expect(__any(rm > (float)THRL), 0)) { const float dl = __builtin_fmaxf(rm, 0.f); mhat += dl; \
        _Pragma("unroll") for (int r = 0; r < 16; ++r) { C0[r] -= dl; C1[r] -= dl; } \
        if (MODE == 0) { _Pragma("unroll") for (int r = 0; r < 16; ++r) zacc[r] = -mhat; asm volatile("" : "+v"(zacc)); } \
        const float f = __builtin_amdgcn_exp2f(-dl); l_reg *= f; if (hi == 0) wsf[r32] = f; resc = true; } } \
    SBAR(); \
    GAPB(o[0] = __builtin_amdgcn_mfma_f32_32x32x16_bf16(PAF(0), VFR(0), o[0], 0, 0, 0), C0, 0); \
    GAPB(o[1] = __builtin_amdgcn_mfma_f32_32x32x16_bf16(PAF(0), VFR(4), o[1], 0, 0, 0), C0, 4); \
    KRD(GL, 0); GAPB(o[0] = __builtin_amdgcn_mfma_f32_32x32x16_bf16(PAF(1), VFR(1), o[0], 0, 0, 0), C0, 8); \
    KRD(GL, 1); GAPB(o[1] = __builtin_amdgcn_mfma_f32_32x32x16_bf16(PAF(1), VFR(5), o[1], 0, 0, 0), C0, 12); \
    KRD(GL, 2); GAPB(o[0] = __builtin_amdgcn_mfma_f32_32x32x16_bf16(PAF(2), VFR(2), o[0], 0, 0, 0), C1, 0); \
    KRD(GL, 3); GAPB(o[1] = __builtin_amdgcn_mfma_f32_32x32x16_bf16(PAF(2), VFR(6), o[1], 0, 0, 0), C1, 4); \
    GAPB(o[0] = __builtin_amdgcn_mfma_f32_32x32x16_bf16(PAF(3), VFR(3), o[0], 0, 0, 0), C1, 8); \
    GAPB(o[1] = __builtin_amdgcn_mfma_f32_32x32x16_bf16(PAF(3), VFR(7), o[1], 0, 0, 0), C1, 12); \
    } while (0)
  int t = 1;
  for (; t + 5 < NT; t += 2) {
    STEP(pB0, pB1, pA0, pA1, t, true, true, true);     WAIT_BAR(2); RESC(); ROT();
    STEP(pA0, pA1, pB0, pB1, t + 1, true, true, true); WAIT_BAR(2); RESC(); ROT();
  }
#define ENDW(tt) do { if ((tt) + 3 < NT) { WAIT_BAR(2); } else if ((tt) + 2 < NT) { WAIT_BAR(1); } else { WAIT_BAR(0); } } while (0)
  for (; t + 1 < NT; t += 2) {
    STEP(pB0, pB1, pA0, pA1, t, (t + 3 < NT), (t + 1 < NT), (t + 1 < NT));         ENDW(t);     RESC(); ROT();
    STEP(pA0, pA1, pB0, pB1, t + 1, (t + 4 < NT), (t + 2 < NT), (t + 2 < NT));     ENDW(t + 1); RESC(); ROT();
  }
  STEP(pB0, pB1, pA0, pA1, NT - 1, false, false, false); RESC();
  { float sacc = pB0[0] + pB0[1]; _Pragma("unroll") for (int r = 2; r < 16; ++r) sacc += pB0[r]; _Pragma("unroll") for (int r = 0; r < 16; ++r) sacc += pB1[r]; l_reg += sacc;
    pw0 = (u32x4){PKW(pB0, 0), PKW(pB0, 2), PKW(pB0, 4), PKW(pB0, 6)}; pw1 = (u32x4){PKW(pB0, 8), PKW(pB0, 10), PKW(pB0, 12), PKW(pB0, 14)}; pw2 = (u32x4){PKW(pB1, 0), PKW(pB1, 2), PKW(pB1, 4), PKW(pB1, 6)}; pw3 = (u32x4){PKW(pB1, 8), PKW(pB1, 10), PKW(pB1, 12), PKW(pB1, 14)};
    SBAR(); pv(o, vb0 + sl_cur, PAF(0), PAF(1), PAF(2), PAF(3)); }
#undef PKW
#undef PAF
#undef VFR
#undef PIN
#undef MX3
#undef GAPA
#undef GAPB
#undef EX
#undef VRD
#undef KRD
#undef STEP
#undef ENDW
  { auto rr = __builtin_amdgcn_permlane32_swap(__float_as_uint(l_reg), __float_as_uint(l_reg), false, false); l_reg = __uint_as_float(rr[0]) + __uint_as_float(rr[1]); }
  if (hi == 0) wsf[32 + r32] = l_reg; asm volatile("s_waitcnt lgkmcnt(0)" ::: "memory");
  float rli[16];
#pragma unroll
  for (int r = 0; r < 16; ++r) rli[r] = __builtin_amdgcn_rcpf(wsf[32 + crow(r, hi)]);
  bf16_t* Ow = Ow0 + (long)(wid * QBLK) * OP;
  { __hip_bfloat16* stg = (__hip_bfloat16*)(shm + LDS_OST) + wid * 2048;
#pragma unroll
    for (int r = 0; r < 16; ++r) { const int orow = crow(r, hi);
#pragma unroll
      for (int d0 = 0; d0 < 2; ++d0) stg[orow * 64 + d0 * 32 + r32] = __float2bfloat16(o[d0][r] * rli[r]); }
    asm volatile("s_waitcnt lgkmcnt(0)" ::: "memory");
#pragma unroll
    for (int i = 0; i < 4; ++i) { const int row = i * 8 + (lane >> 3), ch = lane & 7; const u32x4 v = *(const u32x4*)(stg + row * 64 + ch * 8); *(u32x4*)(Ow + (long)row * OP + ch * 8) = v; } }
  asm volatile("s_waitcnt lgkmcnt(0)\n\ts_barrier" ::: "memory");
#undef DMA_K
#undef DMA_V
#undef TROW
#undef CMASK
#undef START
#undef RESC
#undef ROT
}
#undef SBAR
#undef WAIT_BAR
}

struct Args {
  const float* in[33];
  float* out; unsigned char* ws;
  int ph_lo, ph_hi;
};
enum { I_X = 0, I_C, I_CTX, I_CCTX, I_ADAW, I_ADAB, I_NMIXPRE, I_NMIXPOST, I_NFFNPRE, I_NFFNPOST, I_WIN, I_CONVA, I_NABIAS, I_QNORM, I_KNORM,
       I_MU, I_W0, I_W2, I_A0, I_A2, I_KK, I_KA, I_RK, I_G2, I_LNW, I_LNB, I_WBR, I_WGATE, I_BGATE, I_WO, I_FUP, I_FCONV, I_FDN };

DI void transpose_item(const float* W, int N, bf16_t* WT, int ld, int koff, int mode, LAS float* scr, int item, int lane) {
  const int nblk = N / 32, kb = item / nblk, nb = item % nblk, k0 = 64 * kb, n0 = 32 * nb;
#pragma unroll 8
  for (int i = 0; i < 32; ++i) { const int kk = 2 * i + (lane >> 5); scr[kk * 33 + (lane & 31)] = W[(size_t)(k0 + kk) * N + n0 + (lane & 31)]; }
  asm volatile("s_waitcnt lgkmcnt(0)" ::: "memory");
  const int c = lane & 7;
#pragma unroll
  for (int j = 0; j < 4; ++j) { const int n = (lane >> 3) + 8 * j; const LAS float* s = scr + (8 * c) * 33 + n;
    int nn = n0 + n;
    if (mode == 1) nn = (nn < DFF) ? (256 * (nn >> 7) + (nn & 127)) : (256 * ((nn - DFF) >> 7) + 128 + ((nn - DFF) & 127));
    if (mode == 2) { const int i = nn >> 10, cc = nn & 1023, c64 = cc & 63;
      nn = ((cc >> 6) * 256) + 128 * (i >> 1) + 32 * (c64 >> 4) + 8 * ((c64 >> 2) & 3) + 4 * (i & 1) + (c64 & 3); }
    u32x4 o; o.x = cvtpk(s[0 * 33], s[1 * 33]); o.y = cvtpk(s[2 * 33], s[3 * 33]); o.z = cvtpk(s[4 * 33], s[5 * 33]); o.w = cvtpk(s[6 * 33], s[7 * 33]);
    *(u32x4*)(WT + (size_t)nn * ld + koff + k0 + 8 * c) = o; }
  asm volatile("s_waitcnt lgkmcnt(0)" ::: "memory");
}
DI void convert_weights(const CAS4 Args& A, int l, LAS unsigned char* lds, int gw, int NGW, int wave, int lane) {
  LAS float* scr = (LAS float*)(lds + wave * 8704);
  unsigned char* wb = A.ws + WS_W;
  constexpr int I_IN_ = 16 * 96, I_G = 16 * 128, I_B = 4 * 4 * 32, I_O_ = 16 * 32, I_U = 16 * 176, I_D = 44 * 32;
  constexpr int NIT = I_IN_ + I_G + I_B + I_O_ + I_U + I_D;
  for (int it = gw; it < NIT; it += NGW) {
    int r = it;
    if (r < I_IN_) { transpose_item(A.in[I_WIN] + (size_t)l * 1024 * 3072, 3072, (bf16_t*)(wb + W_IN), 1024, 0, 0, scr, r, lane); continue; } r -= I_IN_;
    if (r < I_G) { transpose_item(A.in[I_WGATE] + (size_t)l * 1024 * 4096, 4096, (bf16_t*)(wb + W_GATE), 1024, 0, 2, scr, r, lane); continue; } r -= I_G;
    if (r < I_B) { const int br = r / 128; transpose_item(A.in[I_WBR] + ((size_t)l * 4 + br) * 256 * 1024, 1024, (bf16_t*)(wb + W_BR), 1024, br * 256, 0, scr, r % 128, lane); continue; } r -= I_B;
    if (r < I_O_) { transpose_item(A.in[I_WO] + (size_t)l * 1024 * 1024, 1024, (bf16_t*)(wb + W_O), 1024, 0, 0, scr, r, lane); continue; } r -= I_O_;
    if (r < I_U) { transpose_item(A.in[I_FUP] + (size_t)l * 1024 * 5632, 5632, (bf16_t*)(wb + W_UP), 1024, 0, 1, scr, r, lane); continue; } r -= I_U;
    transpose_item(A.in[I_FDN] + (size_t)l * 2816 * 1024, 1024, (bf16_t*)(wb + W_DN), 2816, 0, 0, scr, r, lane);
  }
}

DI void row_phase(const float* xold, float* xdst, const bf16_t* src, const float* gate, const float* gpost,
                  bf16_t* hout, const float* gnext, const float* sh, const float* sc, int lane) {
  f32x4 v[4];
#pragma unroll
  for (int j = 0; j < 4; ++j) v[j] = ((const f32x4*)xold)[lane + 64 * j];
  if (src) {
    f32x4 s[4]; float ss = 0.f;
#pragma unroll
    for (int j = 0; j < 4; ++j) { const uint2 w = ((const uint2*)src)[lane + 64 * j];
      s[j] = (f32x4){__uint_as_float(w.x << 16), __uint_as_float(w.x & 0xffff0000u), __uint_as_float(w.y << 16), __uint_as_float(w.y & 0xffff0000u)};
      ss += (s[j].x * s[j].x + s[j].y * s[j].y) + (s[j].z * s[j].z + s[j].w * s[j].w); }
    const float rs = __builtin_amdgcn_rsqf(wave_sum(ss, lane) * (1.f / 1024.f) + 1e-6f);
#pragma unroll
    for (int j = 0; j < 4; ++j) { const f32x4 g = ((const f32x4*)gate)[lane + 64 * j], p = ((const f32x4*)gpost)[lane + 64 * j];
      v[j] = v[j] + g * (s[j] * rs * p); ((f32x4*)xdst)[lane + 64 * j] = v[j]; }
  }
  if (hout) {
    float ss = 0.f;
#pragma unroll
    for (int j = 0; j < 4; ++j) ss += (v[j].x * v[j].x + v[j].y * v[j].y) + (v[j].z * v[j].z + v[j].w * v[j].w);
    const float rs = __builtin_amdgcn_rsqf(wave_sum(ss, lane) * (1.f / 1024.f) + 1e-6f);
#pragma unroll
    for (int j = 0; j < 4; ++j) { const f32x4 g = ((const f32x4*)gnext)[lane + 64 * j], a = ((const f32x4*)sh)[lane + 64 * j], b = ((const f32x4*)sc)[lane + 64 * j];
      const f32x4 h = (v[j] * rs * g) * (b + 1.f) + a;
      uint2 w; w.x = cvtpk(h.x, h.y); w.y = cvtpk(h.z, h.w); ((uint2*)hout)[lane + 64 * j] = w; }
  }
}

DI void row_phase_blk(const float* xlat_in, const float* xctx_in, float* xlat_out, float* xctx_out, const bf16_t* srcb,
                      const float* modl, int gate_off, const float* gpost, bf16_t* hb, const float* gnext, const float* modn, int sh_off, int sc_off,
                      int bx, int wave, int lane) {
  const int R0 = bx * 130;
  f32x4 gpv[4], gnv[4], gav[4], shv[4], scv[4];
#pragma unroll
  for (int j = 0; j < 4; ++j) { gpv[j] = ((const f32x4*)gpost)[lane + 64 * j]; gnv[j] = hb ? ((const f32x4*)gnext)[lane + 64 * j] : (f32x4){0.f, 0.f, 0.f, 0.f}; }
  int cur_s = -1;
  f32x4 xv[4], xn[4]; uint2 sv[4], sn[4];
  int row = R0 + wave;
  { const float* xo = (row < NLAT) ? xlat_in + (size_t)row * 1024 : xctx_in + (size_t)(row - NLAT) * 1024;
#pragma unroll
    for (int j = 0; j < 4; ++j) { xv[j] = ((const f32x4*)xo)[lane + 64 * j]; sv[j] = ((const uint2*)(srcb + (size_t)row * 1024))[lane + 64 * j]; } }
  for (; row < R0 + 130; row += 8) {
    const int nrow = row + 8; const bool hn = nrow < R0 + 130;
    if (hn) { const float* xo = (nrow < NLAT) ? xlat_in + (size_t)nrow * 1024 : xctx_in + (size_t)(nrow - NLAT) * 1024;
#pragma unroll
      for (int j = 0; j < 4; ++j) { xn[j] = ((const f32x4*)xo)[lane + 64 * j]; sn[j] = ((const uint2*)(srcb + (size_t)nrow * 1024))[lane + 64 * j]; } }
    const int s = (row < NLAT) ? (row >> 14) : 2;
    if (s != cur_s) { cur_s = s; const float* md = modl + (size_t)s * 6144; const float* mn = modn + (size_t)s * 6144;
#pragma unroll
      for (int j = 0; j < 4; ++j) { gav[j] = ((const f32x4*)(md + gate_off))[lane + 64 * j];
        shv[j] = hb ? ((const f32x4*)(mn + sh_off))[lane + 64 * j] : (f32x4){0.f, 0.f, 0.f, 0.f}; scv[j] = hb ? ((const f32x4*)(mn + sc_off))[lane + 64 * j] : (f32x4){0.f, 0.f, 0.f, 0.f}; } }
    f32x4 sf[4]; float ss = 0.f;
#pragma unroll
    for (int j = 0; j < 4; ++j) { const uint2 w = sv[j];
      sf[j] = (f32x4){__uint_as_float(w.x << 16), __uint_as_float(w.x & 0xffff0000u), __uint_as_float(w.y << 16), __uint_as_float(w.y & 0xffff0000u)};
      ss += (sf[j].x * sf[j].x + sf[j].y * sf[j].y) + (sf[j].z * sf[j].z + sf[j].w * sf[j].w); }
    const float rs = __builtin_amdgcn_rsqf(wave_sum(ss, lane) * (1.f / 1024.f) + 1e-6f);
    float* xd = (row < NLAT) ? xlat_out + (size_t)row * 1024 : xctx_out + (size_t)(row - NLAT) * 1024;
    float s2 = 0.f;
#pragma unroll
    for (int j = 0; j < 4; ++j) { xv[j] = xv[j] + gav[j] * (sf[j] * rs * gpv[j]); ((f32x4*)xd)[lane + 64 * j] = xv[j];
      s2 += (xv[j].x * xv[j].x + xv[j].y * xv[j].y) + (xv[j].z * xv[j].z + xv[j].w * xv[j].w); }
    if (hb) {
      const float r2 = __builtin_amdgcn_rsqf(wave_sum(s2, lane) * (1.f / 1024.f) + 1e-6f);
#pragma unroll
      for (int j = 0; j < 4; ++j) { const f32x4 h = (xv[j] * r2 * gnv[j]) * (scv[j] + 1.f) + shv[j];
        uint2 w; w.x = cvtpk(h.x, h.y); w.y = cvtpk(h.z, h.w); ((uint2*)(hb + (size_t)row * 1024))[lane + 64 * j] = w; }
    }
#pragma unroll
    for (int j = 0; j < 4; ++j) { xv[j] = xn[j]; sv[j] = sn[j]; }
  }
}

__global__ void __launch_bounds__(NTHREADS, 2) fwd_megakernel(Args A_) {
  extern __shared__ __attribute__((aligned(16))) unsigned char lds_raw[];
  LAS unsigned char* lds = (LAS unsigned char*)lds_raw;
  const int wave0_ = __builtin_amdgcn_readfirstlane((int)threadIdx.x >> 6);
  const int G = gridDim.x, bx = blockIdx.x;
  const int NGW = G * 8;
  const int lo = A_.ph_lo, hi = A_.ph_hi;
  if (hi < 0) cg::this_grid().sync();
  int ph = 0, nbar_ = 0;
#ifndef NBARX
#define NBARX 1
#endif
#ifndef SKIPMASK
#define SKIPMASK 0
#endif
#ifndef REPMASK
#define REPMASK 0
#endif
#define PHASE_BEGIN(id) if (ph >= lo && ph < hi && !((SKIPMASK >> (id)) & 1)) for (int rep_ = 0; rep_ < ((((REPMASK) >> (id)) & 1) ? 2 : 1); ++rep_) { const CAS4 Args* Ap_ = (const CAS4 Args*)__builtin_amdgcn_kernarg_segment_ptr(); asm volatile("" : "+s"(Ap_)); const CAS4 Args& A = *Ap_; \
  unsigned char* ws = A.ws; unsigned* ctl = (unsigned*)(ws + WS_CTL); float* MOD = (float*)(ws + WS_MOD); float* XC = (float*)(ws + WS_XC); float* BONUS = (float*)(ws + WS_BONUS); \
  bf16_t* H = (bf16_t*)(ws + WS_H); bf16_t* Z = (bf16_t*)(ws + WS_Z); bf16_t* YS = (bf16_t*)(ws + WS_YS); bf16_t* WAE = (bf16_t*)(ws + WS_WA); bf16_t* WAA = WAE + (size_t)2 * NROW * 256; float* YSC = (float*)(ws + WS_YSC); \
  (void)ctl; (void)MOD; (void)XC; (void)BONUS; (void)H; (void)Z; (void)YS; (void)WAE; (void)WAA; (void)YSC; \
  int tid; asm volatile("v_mbcnt_lo_u32_b32 %0, -1, 0\n\tv_mbcnt_hi_u32_b32 %0, -1, %0" : "=v"(tid)); tid += wave0_ * 64; const int lane = tid & 63, wave = __builtin_amdgcn_readfirstlane(tid >> 6); const int gw = bx * 8 + wave; (void)lane; (void)gw;
#define FRESH_TID(v) int v; asm volatile("v_mbcnt_lo_u32_b32 %0, -1, 0\n\tv_mbcnt_hi_u32_b32 %0, -1, %0" : "=v"(v)); v += wave0_ * 64;
#define PHASE_END } if (ph >= lo && ph + 1 < hi) { FRESH_TID(tb_) const CAS4 Args* Ab_ = (const CAS4 Args*)__builtin_amdgcn_kernarg_segment_ptr(); asm volatile("" : "+s"(Ab_)); for (int bi_ = 0; bi_ < NBARX; ++bi_) { ++nbar_; grid_barrier2((unsigned*)(Ab_->ws + WS_CTL), (unsigned)nbar_, G, bx, tb_); } } ++ph;

  PHASE_BEGIN(0)
    {
      LAS float* sl = (LAS float*)(lds + 72 * 1024);
      for (int i = tid; i < 3 * 1024; i += NTHREADS) { const int s = i >> 10, k = i & 1023;
        const float c = (s < 2) ? A.in[I_C][s * 1024 + k] : A.in[I_CCTX][k]; sl[i] = c * sigmoidf_(c); }
      __syncthreads();
      LAS float* red = (LAS float*)(lds + 88 * 1024);
      for (int it = bx; it < NLAYER * 96; it += G) {
        const int l = it / 96, c0 = (it % 96) * 64;
        const float* wp = A.in[I_ADAW] + (size_t)l * 1024 * 6144 + c0 + lane;
        float a0 = 0.f, a1 = 0.f, a2 = 0.f;
        for (int k = wave * 128; k < wave * 128 + 128; ++k) { const float w = wp[(size_t)k * 6144]; a0 += sl[k] * w; a1 += sl[1024 + k] * w; a2 += sl[2048 + k] * w; }
        red[(wave * 3 + 0) * 64 + lane] = a0; red[(wave * 3 + 1) * 64 + lane] = a1; red[(wave * 3 + 2) * 64 + lane] = a2;
        __syncthreads();
        if (tid < 192) { const int s = tid >> 6, ln = tid & 63; float r = A.in[I_ADAB][l * 6144 + c0 + ln];
          for (int w = 0; w < 8; ++w) r += red[(w * 3 + s) * 64 + ln];
          MOD[((size_t)(l * 3 + s)) * 6144 + c0 + ln] = r; }
        __syncthreads();
      }
    }
    convert_weights(A, 0, lds, gw, NGW, wave, lane);
  PHASE_END

  PHASE_BEGIN(1)
    for (int row = gw; row < NROW; row += NGW) {
      const int s = (row < NLAT) ? (row >> 14) : 2;
      const float* xo = (row < NLAT) ? A.in[I_X] + (size_t)row * 1024 : A.in[I_CTX] + (size_t)(row - NLAT) * 1024;
      const float* md = MOD + (size_t)(0 * 3 + s) * 6144;
      row_phase(xo, nullptr, nullptr, nullptr, nullptr, H + (size_t)row * 1024, A.in[I_NMIXPRE], md, md + 1024, lane);
    }
  PHASE_END

  for (int l = 0; l < NLAYER; ++l) {
    PHASE_BEGIN(2)
      pg8::Gemm g{(const char*)ws, 1024, 1024};
      pg8::SchedPlain S{130, 5, G, bx, 16, (long)WS_H, (long)(WS_W + W_IN), 1024, 1024, 7};
      pg8::EpiStore E{Z, DIN};
      pg8::gemm_phase<pg8::EpiStore, pg8::SchedPlain, false>(lds, g, S, E, tid);
    PHASE_END

    PHASE_BEGIN(3)
      {
        FRESH_TID(tid)
        const int ln = tid & 63, wv = __builtin_amdgcn_readfirstlane(tid >> 6), d = wv >> 2, nq = wv & 3, r32 = ln & 31, hi = ln >> 5;
        LAS unsigned char* AT = lds;
        const float* mu = A.in[I_MU] + (size_t)l * 2 * 896;
        bf16x8 Bf[2][2][4]; float bias0[2], bias1[2];
#pragma unroll
        for (int nt = 0; nt < 2; ++nt) {
          const int c = 64 * nq + 32 * nt + r32;
          bias0[nt] = A.in[I_W0][(l * 2 + d) * 256 + c]; bias1[nt] = A.in[I_A0][(l * 2 + d) * 256 + c];
#pragma unroll
          for (int ks = 0; ks < 4; ++ks) { float f0[8], f1[8];
#pragma unroll
            for (int i = 0; i < 8; ++i) { const size_t o = ((size_t)(l * 2 + d) * 64 + 16 * ks + 8 * hi + i) * 256 + c; f0[i] = A.in[I_W2][o]; f1[i] = A.in[I_A2][o]; }
            Bf[0][nt][ks] = __builtin_bit_cast(bf16x8, pack8(f0)); Bf[1][nt][ks] = __builtin_bit_cast(bf16x8, pack8(f1)); }
        }
        for (int tile = bx; tile < 520; tile += G) {
          const int R0 = tile * 64;
          __syncthreads();
          for (int i = tid; i < 2 * 64 * 16; i += NTHREADS) {
            const int dd = i >> 10, rem = i & 1023, r = rem >> 4, j8 = (rem & 15) * 8, row = R0 + r; int t, len; row_seq(row, t, len);
            const int nb = dd ? t + 1 : t - 1; const bool nv = (nb >= 0) && (nb < len);
            float zc[8], zn[8];
            unpack8(*(const u32x4*)(Z + (size_t)row * DIN + C_LW + j8), zc);
            if (nv) unpack8(*(const u32x4*)(Z + (size_t)(row + (dd ? 1 : -1)) * DIN + C_LW + j8), zn);
            else {
#pragma unroll
              for (int e = 0; e < 8; ++e) zn[e] = 0.f; }
            const f32x4 m0 = *(const f32x4*)(mu + dd * 896 + 768 + j8), m1 = *(const f32x4*)(mu + dd * 896 + 768 + j8 + 4);
            float v[8];
#pragma unroll
            for (int e = 0; e < 8; ++e) { v[e] = zc[e] + (e < 4 ? m0[e] : m1[e - 4]) * (zn[e] - zc[e]); if (j8 < 64) v[e] = 1.f - 2.f * __builtin_amdgcn_rcpf(__builtin_amdgcn_exp2f(2.8853900817779268f * v[e]) + 1.f); }
            *(LAS u32x4*)(AT + ((dd * 2 + (j8 >> 6)) * 64 + r) * 144 + (j8 & 63) * 2) = pack8(v);
          }
          __syncthreads();
          f32x16 acc[2][2][2];
#pragma unroll
          for (int m = 0; m < 2; ++m)
#pragma unroll
            for (int mt = 0; mt < 2; ++mt)
#pragma unroll
              for (int nt = 0; nt < 2; ++nt) acc[m][mt][nt] = f32x16{};
#pragma unroll
          for (int m = 0; m < 2; ++m)
#pragma unroll
            for (int mt = 0; mt < 2; ++mt)
#pragma unroll
              for (int ks = 0; ks < 4; ++ks) {
                const bf16x8 af = *(const LAS bf16x8*)(AT + ((d * 2 + m) * 64 + 32 * mt + r32) * 144 + (16 * ks + 8 * hi) * 2);
#pragma unroll
                for (int nt = 0; nt < 2; ++nt) acc[m][mt][nt] = __builtin_amdgcn_mfma_f32_32x32x16_bf16(af, Bf[m][nt][ks], acc[m][mt][nt], 0, 0, 0);
              }
#pragma unroll
          for (int mt = 0; mt < 2; ++mt)
#pragma unroll
            for (int nt = 0; nt < 2; ++nt) {
              const int c = 64 * nq + 32 * nt + r32;
#pragma unroll
              for (int r = 0; r < 16; ++r) {
                const int row = R0 + 32 * mt + (r & 3) + 8 * (r >> 2) + 4 * hi;
                const float aw = acc[0][mt][nt][r] + bias0[nt], aa = acc[1][mt][nt][r] + bias1[nt];
                const float xx = -aw; const float sp = fmaxf(xx, 0.f) + __logf(1.f + __expf(-fabsf(xx)));
                const float e = -__expf(-sp - 0.5f);
                const float av = sigmoidf_(aa);
                const size_t o = ((size_t)d * NROW + row) * 256 + c;
                WAE[o] = (bf16_t)(cvtpk(e, 0.f) & 0xffffu); WAA[o] = (bf16_t)(cvtpk(av, 0.f) & 0xffffu);
              }
            }
        }
        __syncthreads();
      }
    PHASE_END

    PHASE_BEGIN(4)
#ifndef NO_SCAN
#ifndef REP_SCAN
#define REP_SCAN 1
#endif
#ifndef REP_ATTN
#define REP_ATTN 1
#endif
      if (bx < 64 && (rep_ == 0 || REP_SCAN)) {
        const int sb = bx, s = sb >> 2, qd = sb & 3, d = s >> 3, b = (s >> 2) & 1, hh = s & 3;
        LAS float* buf = (LAS float*)lds;
        float muR[8], muK[8], muV[8], kkc[8], kac[8], rkc[8];
        const int ptid = tid & 255, ts = (ptid >> 3) & 31, cgp = ptid & 7, ch0 = hh * 64 + 8 * cgp;
        {
#pragma unroll
          for (int i = 0; i < 8; ++i) { const float* mu = A.in[I_MU] + (size_t)(l * 2 + d) * 896;
            muR[i] = mu[ch0 + i]; muK[i] = mu[256 + ch0 + i]; muV[i] = mu[512 + ch0 + i];
            kkc[i] = A.in[I_KK][l * 256 + ch0 + i]; kac[i] = A.in[I_KA][l * 256 + ch0 + i]; rkc[i] = A.in[I_RK][l * 256 + ch0 + i]; }
        }
        const int rsub = lane >> 4, kg = lane & 15, vrow = 16 * qd + 4 * (wave & 3) + rsub;
#define SCAN_RLO(cc) (((cc) < 8) ? (NLAT + b * CTXL + (d ? 224 - 32 * (cc) : 32 * (cc))) : (b * TLAT + (d ? 16352 - 32 * ((cc) - 8) : 32 * ((cc) - 8))))
        const unsigned ro = (unsigned)(d ? 31 - ts : ts);
        const unsigned offz = ro * DIN + ch0, offw = ro * 256 + ch0;
        const unsigned roy = (unsigned)(d ? 31 - (ptid >> 3) : (ptid >> 3)), offy = roy * 256 + hh * 64 + 16 * qd + (ptid & 7) * 2;
#define SCAN_LOAD(cc, X) do { const int rlo_ = SCAN_RLO(cc); const bool nv = !((((cc) == 0) || ((cc) == 8)) && ts == 0); \
          const bf16_t* zb = Z + (size_t)rlo_ * DIN; const bf16_t* znb = zb + (d ? DIN : -DIN); const u32x4 z4 = (u32x4){0u, 0u, 0u, 0u}; \
          X[0] = *(const u32x4*)(zb + (offz + C_RR)); X[1] = *(const u32x4*)(zb + (offz + C_RK)); X[2] = *(const u32x4*)(zb + (offz + C_RV)); \
          X[3] = nv ? *(const u32x4*)(znb + (offz + C_RR)) : z4; X[4] = nv ? *(const u32x4*)(znb + (offz + C_RK)) : z4; X[5] = nv ? *(const u32x4*)(znb + (offz + C_RV)) : z4; \
          const bf16_t* wb_ = WAE + ((size_t)d * NROW + rlo_) * 256; const bf16_t* ab_ = WAA + ((size_t)d * NROW + rlo_) * 256; \
          X[6] = *(const u32x4*)(wb_ + offw); X[7] = *(const u32x4*)(ab_ + offw); } while (0)
#define SCAN_PREP(cc, X) do { const int rlo_ = SCAN_RLO(cc); \
          float r8[8], k8[8], v8[8], rn[8], kn[8], vn[8], e8[8], a8[8]; \
          unpack8(X[0], r8); unpack8(X[1], k8); unpack8(X[2], v8); unpack8(X[3], rn); unpack8(X[4], kn); unpack8(X[5], vn); unpack8(X[6], e8); unpack8(X[7], a8); \
          float kkv[8], ssq = 0.f, bsum = 0.f; \
          _Pragma("unroll") for (int i = 0; i < 8; ++i) { r8[i] += muR[i] * (rn[i] - r8[i]); k8[i] += muK[i] * (kn[i] - k8[i]); v8[i] += muV[i] * (vn[i] - v8[i]); \
            kkv[i] = k8[i] * kkc[i]; ssq += kkv[i] * kkv[i]; } \
          ssq = red8(ssq); \
          const float inv = __builtin_amdgcn_rsqf(fmaxf(ssq, 1e-24f)); \
          float wv[8], bb[8], kp[8]; \
          _Pragma("unroll") for (int i = 0; i < 8; ++i) { kkv[i] *= inv; kp[i] = k8[i] * (1.f + (a8[i] - 1.f) * kac[i]); bb[i] = kkv[i] * a8[i]; wv[i] = __expf(e8[i]); bsum += r8[i] * kp[i] * rkc[i]; } \
          bsum = red8(bsum); \
          if (qd == 0 && cgp == 0) (BONUS + ((size_t)d * NROW + rlo_) * 4)[ro * 4 + hh] = bsum; \
          LAS float* db = buf + ((cc) & 1) * (6 * 32 * 64) + ts * 64 + 8 * cgp; \
          *(LAS f32x4*)(db + 0 * 2048) = (f32x4){wv[0], wv[1], wv[2], wv[3]}; *(LAS f32x4*)(db + 0 * 2048 + 4) = (f32x4){wv[4], wv[5], wv[6], wv[7]}; \
          *(LAS f32x4*)(db + 1 * 2048) = (f32x4){kkv[0], kkv[1], kkv[2], kkv[3]}; *(LAS f32x4*)(db + 1 * 2048 + 4) = (f32x4){kkv[4], kkv[5], kkv[6], kkv[7]}; \
          *(LAS f32x4*)(db + 2 * 2048) = (f32x4){bb[0], bb[1], bb[2], bb[3]}; *(LAS f32x4*)(db + 2 * 2048 + 4) = (f32x4){bb[4], bb[5], bb[6], bb[7]}; \
          *(LAS f32x4*)(db + 3 * 2048) = (f32x4){kp[0], kp[1], kp[2], kp[3]}; *(LAS f32x4*)(db + 3 * 2048 + 4) = (f32x4){kp[4], kp[5], kp[6], kp[7]}; \
          *(LAS f32x4*)(db + 4 * 2048) = (f32x4){r8[0], r8[1], r8[2], r8[3]}; *(LAS f32x4*)(db + 4 * 2048 + 4) = (f32x4){r8[4], r8[5], r8[6], r8[7]}; \
          *(LAS f32x4*)(db + 5 * 2048) = (f32x4){v8[0], v8[1], v8[2], v8[3]}; *(LAS f32x4*)(db + 5 * 2048 + 4) = (f32x4){v8[4], v8[5], v8[6], v8[7]}; \
        } while (0)
#define SCAN_YOUT(cc) do { const int rlo_ = SCAN_RLO(cc); const int step_ = ptid >> 3, r2_ = (ptid & 7) * 2; \
          const LAS f32x4* yp_ = (const LAS f32x4*)(ybuf + ((cc) & 1) * 2048 + step_ * 64 + r2_ * 4); const f32x4 y0_ = yp_[0], y1_ = yp_[1]; \
          const f32x2 yv = (f32x2){(y0_[0] + y0_[1]) + (y0_[2] + y0_[3]), (y1_[0] + y1_[1]) + (y1_[2] + y1_[3])}; \
          *(f32x2*)(YSC + ((size_t)d * NROW + rlo_) * 256 + offy) = yv; } while (0)
        LAS float* ybuf = buf + 2 * 6 * 32 * 64;
        u32x4 RA[8], RB[8];
        __syncthreads();
        SCAN_LOAD(0, RA);
        if (wave >= 4) SCAN_PREP(0, RA);
        SCAN_LOAD(1, RA);
#pragma unroll
        for (int i = 0; i < 8; ++i) RB[i] = RA[i];
        __syncthreads();
        f32x2 Sa = (f32x2){0.f, 0.f}, Sb = (f32x2){0.f, 0.f};
        for (int cc = 0; cc < 520; ++cc) {
          if (wave >= 4) {
            if (cc + 2 < 520) SCAN_LOAD(cc + 2, RB);
            if (cc + 1 < 520) SCAN_PREP(cc + 1, RA);
            if (cc > 0) SCAN_YOUT(cc - 1);
#pragma unroll
            for (int i = 0; i < 8; ++i) RA[i] = RB[i];
          } else {
            const LAS float* sbuf = buf + (cc & 1) * (6 * 32 * 64) + 4 * kg;
            LAS float* yb = ybuf + (cc & 1) * 2048 + (4 * wave + rsub) * 4 + (kg >> 2);
            f32x4 W4 = *(const LAS f32x4*)(sbuf + 0 * 2048), K4 = *(const LAS f32x4*)(sbuf + 1 * 2048), B4 = *(const LAS f32x4*)(sbuf + 2 * 2048),
                  P4 = *(const LAS f32x4*)(sbuf + 3 * 2048), R4 = *(const LAS f32x4*)(sbuf + 4 * 2048);
            float vv = sbuf[5 * 2048 - 4 * kg + vrow];
            f32x4 Rp = R4;
#pragma unroll
            for (int st = 0; st < 32; ++st) {
              const int sn = (st + 1) & 31;
              const LAS float* sp = sbuf + sn * 64;
              const f32x4 W4n = *(const LAS f32x4*)(sp + 0 * 2048), K4n = *(const LAS f32x4*)(sp + 1 * 2048), B4n = *(const LAS f32x4*)(sp + 2 * 2048),
                          P4n = *(const LAS f32x4*)(sp + 3 * 2048), R4n = *(const LAS f32x4*)(sp + 4 * 2048);
              const float vvn = sp[5 * 2048 - 4 * kg + vrow];
              f32x2 p = Sa * (f32x2){K4[0], K4[1]}; p = __builtin_elementwise_fma(Sb, (f32x2){K4[2], K4[3]}, p);
              float sa = p[0] + p[1];
              if (st > 0) {
                f32x2 q = Sa * (f32x2){Rp[0], Rp[1]}; q = __builtin_elementwise_fma(Sb, (f32x2){Rp[2], Rp[3]}, q);
                float yq = q[0] + q[1]; yq += DPPF(yq, 0xB1); yq += DPPF(yq, 0x4E);
                yb[(st - 1) * 64] = yq;
              }
              sa = allreduce16(sa);
              const f32x2 vv2 = (f32x2){vv, vv}, nsa = (f32x2){-sa, -sa};
              f32x2 ta = __builtin_elementwise_fma(nsa, (f32x2){B4[0], B4[1]}, vv2 * (f32x2){P4[0], P4[1]});
              f32x2 tb = __builtin_elementwise_fma(nsa, (f32x2){B4[2], B4[3]}, vv2 * (f32x2){P4[2], P4[3]});
              Sa = __builtin_elementwise_fma(Sa, (f32x2){W4[0], W4[1]}, ta);
              Sb = __builtin_elementwise_fma(Sb, (f32x2){W4[2], W4[3]}, tb);
              Rp = R4;
              W4 = W4n; K4 = K4n; B4 = B4n; P4 = P4n; R4 = R4n; vv = vvn;
            }
            { f32x2 q = Sa * (f32x2){Rp[0], Rp[1]}; q = __builtin_elementwise_fma(Sb, (f32x2){Rp[2], Rp[3]}, q);
              float yq = q[0] + q[1]; yq += DPPF(yq, 0xB1); yq += DPPF(yq, 0x4E);
              yb[31 * 64] = yq; }
          }
          __syncthreads();
        }
        if (wave >= 4) SCAN_YOUT(519);
        __syncthreads();
#undef SCAN_LOAD
#undef SCAN_YOUT
#undef SCAN_PREP
#undef SCAN_RLO
      }
#endif
#ifndef NO_ATTN
      if (bx >= 64) {
        {
          FRESH_TID(tid)
          pg8::Gemm g{(const char*)ws, 1024, 1024};
          pg8::SchedPlain S{130, 7, 192, bx - 64, 16, (long)WS_H, (long)(WS_W + W_IN), 1024, 1024, 0};
          pg8::EpiStore E{Z, DIN};
          pg8::gemm_phase<pg8::EpiStore, pg8::SchedPlain, false>(lds, g, S, E, tid);
        }
        { FRESH_TID(tb1_) grid_barrier(ctl + 16, 192u * (unsigned)(2 * l + 1), tb1_); }
      {
        const float* qn = A.in[I_QNORM] + l * 64; const float* kn = A.in[I_KNORM] + l * 64;
        for (long idx = (long)(bx - 64) * NTHREADS + tid; idx < (long)NROW * 48; idx += (long)192 * NTHREADS) {
          const int part = (int)(idx & 7), h6 = (int)((idx >> 3) % 6), row = (int)(idx / 48);
          bf16_t* p = Z + (size_t)row * DIN + C_GQ + 64 * h6 + 8 * part;
          float f[8]; unpack8(*(const u32x4*)p, f);
          float ss = 0.f;
#pragma unroll
          for (int i = 0; i < 8; ++i) ss += f[i] * f[i];
          ss = red8(ss);
          const float rs = __builtin_amdgcn_rsqf(ss * (1.f / 64.f) + 1e-6f);
          const bool isq = h6 < 4; const float* nw = isq ? qn : kn; const float scl = isq ? C2 : 1.f;
#pragma unroll
          for (int i = 0; i < 8; ++i) f[i] = f[i] * rs * nw[8 * part + i] * scl;
          if (row < NLAT) {
            const int t = row & (TLAT - 1); const float gr = (float)(t >> 6), gc = (float)(t & 63);
#pragma unroll
            for (int pp = 0; pp < 4; ++pp) { const int pi = 4 * part + pp;
              const float invf = exp2f(-(float)(pi & 15) * (13.287712379549449f / 16.f));
              const float ang = (pi < 16 ? gr : gc) * invf; const float cs = __cosf(ang), sn = __sinf(ang);
              const float x1 = f[2 * pp], x2 = f[2 * pp + 1]; f[2 * pp] = x1 * cs - x2 * sn; f[2 * pp + 1] = x1 * sn + x2 * cs; }
          }
          *(u32x4*)p = pack8(f);
        }
      }
      {
        FRESH_TID(tid)
        const float* cw = A.in[I_CONVA] + l * 3 * 256;
        for (long idx = (long)(bx - 64) * NTHREADS + tid; idx < (long)NROW * 32; idx += (long)192 * NTHREADS) {
          const int g8 = (int)(idx & 31), row = (int)(idx >> 5); int t, len; row_seq(row, t, len);
          const bf16_t* zr = Z + (size_t)row * DIN;
          { bf16_t* qp = Z + (size_t)row * DIN + C_NAQ + 8 * g8; float f[8]; unpack8(*(const u32x4*)qp, f);
#pragma unroll
            for (int i = 0; i < 8; ++i) f[i] *= C2;
            *(u32x4*)qp = pack8(f); }
          float bg[8], c0[8], x0[8], c1[8], x1[8], c2[8], x2[8];
          unpack8(*(const u32x4*)(zr + 8 * g8), bg);
          unpack8(*(const u32x4*)(zr + 256 + 8 * g8), c1); unpack8(*(const u32x4*)(zr + 512 + 8 * g8), x1);
          if (t > 0) { unpack8(*(const u32x4*)(zr - DIN + 256 + 8 * g8), c0); unpack8(*(const u32x4*)(zr - DIN + 512 + 8 * g8), x0); }
          else {
#pragma unroll
            for (int i = 0; i < 8; ++i) { c0[i] = 0.f; x0[i] = 0.f; } }
          if (t < len - 1) { unpack8(*(const u32x4*)(zr + DIN + 256 + 8 * g8), c2); unpack8(*(const u32x4*)(zr + DIN + 512 + 8 * g8), x2); }
          else {
#pragma unroll
            for (int i = 0; i < 8; ++i) { c2[i] = 0.f; x2[i] = 0.f; } }
          float o[8];
#pragma unroll
          for (int i = 0; i < 8; ++i) { const int c = 8 * g8 + i; o[i] = bg[i] * (cw[c] * (c0[i] * x0[i]) + cw[256 + c] * (c1[i] * x1[i]) + cw[512 + c] * (c2[i] * x2[i])); }
          *(u32x4*)(YS + (size_t)row * 1024 + 8 * g8) = pack8(o);
        }
      }
        { FRESH_TID(tb2_) grid_barrier(ctl + 16, 192u * (unsigned)(2 * l + 2), tb2_); }
      } else {
        FRESH_TID(tw_)
        if (tw_ == 0) { while (__hip_atomic_load(ctl + 16, __ATOMIC_RELAXED, __HIP_MEMORY_SCOPE_AGENT) < 192u * (unsigned)(2 * l + 2)) __builtin_amdgcn_s_sleep(2);
          __builtin_amdgcn_fence(__ATOMIC_ACQUIRE, "agent"); asm volatile("s_waitcnt vmcnt(0)" ::: "memory"); }
        __syncthreads();
      }
      if (rep_ == 0 || REP_ATTN) {
        FRESH_TID(tid)
        volatile LAS unsigned* misc = (volatile LAS unsigned*)(lds + 92 * 1024);
        const float* nab = A.in[I_NABIAS] + (size_t)l * 4 * 465;
        for (;;) {
          __syncthreads();
          if (tid == 0) misc[0] = atomicAdd(ctl + 64 + 64 * l + 32 * rep_, 1u);
          __syncthreads();
          int u = (int)misc[0];
          if (l == NLAYER - 1 && u >= 1024) u += 16;
          if (u >= 1296) break;
          if (u >= 1040) {
            LAS float* SG = (LAS float*)lds;
            const int R0 = (u - 1040) * 130;
            for (int i = tid; i < 130 * 16; i += NTHREADS) { const int r = i >> 4, j8 = (i & 15) * 8; float f[8];
              unpack8(*(const u32x4*)(Z + (size_t)(R0 + r) * DIN + C_LG + j8), f);
#pragma unroll
              for (int e = 0; e < 8; ++e) f[e] = sigmoidf_(f[e]);
              *(LAS f32x4*)(SG + r * 128 + j8) = (f32x4){f[0], f[1], f[2], f[3]}; *(LAS f32x4*)(SG + r * 128 + j8 + 4) = (f32x4){f[4], f[5], f[6], f[7]}; }
            const int half = tid >> 8, c = tid & 255;
            float g2c[128];
#pragma unroll
            for (int j = 0; j < 128; ++j) g2c[j] = A.in[I_G2][((size_t)l * 128 + j) * 256 + c];
            __syncthreads();
            for (int r = half; r < 130; r += 2) {
              const LAS f32x4* sp = (const LAS f32x4*)(SG + r * 128);
              float gate = 0.f;
#pragma unroll
              for (int j4 = 0; j4 < 32; ++j4) { const f32x4 x = sp[j4]; gate += x[0] * g2c[4 * j4] + x[1] * g2c[4 * j4 + 1] + x[2] * g2c[4 * j4 + 2] + x[3] * g2c[4 * j4 + 3]; }
              YS[(size_t)(R0 + r) * 1024 + 768 + c] = (bf16_t)(cvtpk(gate, 0.f) & 0xffffu);
            }
            continue;
          }
          attn_body::TileMap tm; attn_body::NaInfo na{0, 0};
          const bf16_t *Qp, *Kp, *Vp; bf16_t* Op; int mode = 0;
          if (u < 512) {
            const int qb = u & 63, g2 = (u >> 6) & 1, kvh = (u >> 7) & 1, b = u >> 8, h = kvh * 2 + g2;
            tm = {256, b * TLAT, NLAT + b * CTXL, 260};
            const size_t q0 = (size_t)b * TLAT + qb * 256;
            Qp = Z + q0 * DIN + C_GQ + 64 * h; Kp = Z + C_GK + 64 * kvh; Vp = Z + C_GV + 64 * kvh; Op = YS + q0 * 1024 + 512 + 64 * h;
          } else if (u < 1024) {
            const int v = u - 512, ig = v & 63, h = (v >> 6) & 3, b = v >> 8, i0 = 4 * ig;
            int rmin = min(max(i0 - 4, 0), 248), rmax = min(max(i0 + 3 - 4, 0), 248) + 7;
            if (((rmax - rmin + 1) & 1) != 0) { if (rmax < 255) ++rmax; else --rmin; }
            tm = {4, NLAT + b * CTXL, b * TLAT + 64 * rmin, 4 + (rmax - rmin + 1)};
            na = {i0, rmin}; mode = 1;
            if (tid < 512) ((LAS float*)(lds + attn_body::LDS_BIAS))[tid] = (tid < 465) ? nab[h * 465 + tid] * LOG2E : 0.f;
            const size_t q0 = (size_t)b * TLAT + i0 * 64;
            Qp = Z + q0 * DIN + C_NAQ + 64 * h; Kp = Z + C_NAK + 64 * h; Vp = Z + C_NAV + 64 * h; Op = YS + q0 * 1024 + 256 + 64 * h;
          } else {
            const int v = u - 1024, isna = v >> 3, h = v & 3, b = (v >> 2) & 1;
            const size_t q0 = (size_t)NLAT + b * CTXL;
            tm = {4, NLAT + b * CTXL, 0, 4};
            if (isna) { Qp = Z + q0 * DIN + C_NAQ + 64 * h; Kp = Z + C_NAK + 64 * h; Vp = Z + C_NAV + 64 * h; Op = YS + q0 * 1024 + 256 + 64 * h; }
            else { Qp = Z + q0 * DIN + C_GQ + 64 * h; Kp = Z + C_GK + 64 * (h >> 1); Vp = Z + C_GV + 64 * (h >> 1); Op = YS + q0 * 1024 + 512 + 64 * h; }
          }
#ifndef NO_M1
          if (mode) { FRESH_TID(t1_) attn_body::attn_unit<1, 8>(Qp, Kp, Vp, Op, tm, na, (char*)lds_raw, t1_); }
#endif
#ifndef NO_M0
          if (!mode) { FRESH_TID(t0_) attn_body::attn_unit<0, 8>(Qp, Kp, Vp, Op, tm, na, (char*)lds_raw, t0_); }
#endif
        }
      }
#endif
    PHASE_END

    PHASE_BEGIN(5)
      {
        const int half = tid >> 8, c = tid & 255, hh = c >> 6;
        const float lnw = A.in[I_LNW][l * 256 + c], lnb = A.in[I_LNB][l * 256 + c];
        const float mv0 = A.in[I_MU][(size_t)(l * 2 + 0) * 896 + 512 + c], mv1 = A.in[I_MU][(size_t)(l * 2 + 1) * 896 + 512 + c];
        for (int tile = bx; tile < 256; tile += G) {
          const int R0 = tile * 130;
#pragma unroll 2
          for (int r = half; r < 130; r += 2) {
            const int row = R0 + r; int t, len; row_seq(row, t, len);
            const float y = YSC[((size_t)0 * NROW + row) * 256 + c] + YSC[((size_t)1 * NROW + row) * 256 + c];
            const bf16_t* zr = Z + (size_t)row * DIN + C_RV + c;
            const float zv = bf2f(zr[0]), zp = (t > 0) ? bf2f(zr[-DIN]) : 0.f, zq = (t < len - 1) ? bf2f(zr[DIN]) : 0.f;
            const float b0 = BONUS[((size_t)0 * NROW + row) * 4 + hh], b1 = BONUS[((size_t)1 * NROW + row) * 4 + hh];
            const float gate = bf2f(YS[(size_t)row * 1024 + 768 + c]);
            const float mean = wave_sum(y, lane) * (1.f / 64.f); const float dv = y - mean; const float var = wave_sum(dv * dv, lane) * (1.f / 64.f);
            const float yn = dv * __builtin_amdgcn_rsqf(var + 64e-5f) * lnw + lnb;
            const float v0 = zv + mv0 * (zp - zv), v1 = zv + mv1 * (zq - zv);
            const float bon = b0 * v0 + b1 * v1;
            YS[(size_t)row * 1024 + 768 + c] = (bf16_t)(cvtpk((yn + bon) * gate, 0.f) & 0xffffu);
          }
        }
      }
    PHASE_END

    PHASE_BEGIN(6)
      pg8::Gemm g{(const char*)ws, 1024, 1024};
      pg8::SchedMerge S{G, bx, (l == NLAYER - 1) ? 128 : 130};
      pg8::EpiMerge E{ws + WS_PSCR, A.in[I_BGATE] + (size_t)l * 4096, (bf16_t*)(ws + WS_ACCM)};
      pg8::gemm_phase<pg8::EpiMerge, pg8::SchedMerge, false>(lds, g, S, E, tid);
    PHASE_END

    PHASE_BEGIN(7)
      pg8::Gemm g{(const char*)ws, 1024, 1024};
      pg8::SchedPlain S{(l == NLAYER - 1) ? 128 : 130, 4, G, bx, 16, (long)WS_ACCM, (long)(WS_W + W_O), 1024, 1024, 0};
      pg8::EpiStore E{(bf16_t*)(ws + WS_MBUF), 1024};
      pg8::gemm_phase<pg8::EpiStore, pg8::SchedPlain, false>(lds, g, S, E, tid);
    PHASE_END

    PHASE_BEGIN(8)
      for (int vb_ = bx; vb_ < 256; vb_ += G)
      row_phase_blk((l == 0) ? A.in[I_X] : (const float*)A.out, (l == 0) ? A.in[I_CTX] : (const float*)XC, A.out, XC, (const bf16_t*)(ws + WS_MBUF),
                    MOD + (size_t)l * 3 * 6144, 2 * 1024, A.in[I_NMIXPOST] + l * 1024, H, A.in[I_NFFNPRE] + l * 1024, MOD + (size_t)l * 3 * 6144, 3 * 1024, 4 * 1024, vb_, wave, lane);
    PHASE_END

    PHASE_BEGIN(9)
      pg8::Gemm g{(const char*)ws, 1024, 1024};
      pg8::SchedUp S{G, bx, (l == NLAYER - 1) ? 134 : 138};
      pg8::EpiConvGlu E{(bf16_t*)(ws + WS_G), A.in[I_FCONV] + (size_t)l * 3 * 5632};
      pg8::gemm_phase<pg8::EpiConvGlu, pg8::SchedUp, true>(lds, g, S, E, tid);
    PHASE_END

    PHASE_BEGIN(10)
      pg8::Gemm g{(const char*)ws, DFF, DFF};
      pg8::SchedPlain S{(l == NLAYER - 1) ? 128 : 130, 4, G, bx, 44, (long)WS_G, (long)(WS_W + W_DN), DFF, DFF, 0};
      pg8::EpiStore E{(bf16_t*)(ws + WS_F), 1024};
      pg8::gemm_phase<pg8::EpiStore, pg8::SchedPlain, false>(lds, g, S, E, tid);
    PHASE_END

    PHASE_BEGIN(11)
      for (int vb_ = bx; vb_ < 256; vb_ += G)
      row_phase_blk((const float*)A.out, (const float*)XC, A.out, XC, (const bf16_t*)(ws + WS_F),
                    MOD + (size_t)l * 3 * 6144, 5 * 1024, A.in[I_NFFNPOST] + l * 1024, (l < NLAYER - 1) ? H : (bf16_t*)nullptr, A.in[I_NMIXPRE] + ((l + 1) & 3) * 1024,
                    MOD + (size_t)((l + 1) & 3) * 3 * 6144, 0, 1024, vb_, wave, lane);
      if (l < NLAYER - 1) convert_weights(A, l + 1, lds, gw, NGW, wave, lane);
    PHASE_END
  }
}

constexpr int LDS_BYTES = 147456;
constexpr int NPHASES = 2 + NLAYER * 10;
extern "C" void kernel_launch(void* const* d_in, const int* in_sizes, int n_in, void* d_out, int out_size, void* d_ws, size_t ws_size, hipStream_t stream) {
  static int grid = 0;
  if (grid == 0) {
    int dev = 0, cus = 0, per_cu = 0;
    hipGetDevice(&dev);
    hipDeviceGetAttribute(&cus, hipDeviceAttributeMultiprocessorCount, dev);
    if (hipFuncSetAttribute((const void*)fwd_megakernel, hipFuncAttributeMaxDynamicSharedMemorySize, LDS_BYTES) != hipSuccess) fprintf(stderr, "kernel_launch: hipFuncSetAttribute failed\n");
    hipOccupancyMaxActiveBlocksPerMultiprocessor(&per_cu, (const void*)fwd_megakernel, NTHREADS, LDS_BYTES);
    (void)hipGetLastError();
    if (per_cu < 1) per_cu = 1;
    grid = cus;
    if (n_in != 33 || ws_size < WS_END) fprintf(stderr, "kernel_launch: unexpected n_in %d or ws %zu\n", n_in, ws_size);
  }
  (void)hipMemsetAsync((char*)d_ws + WS_CTL, 0, 8192, stream);
  Args a{};
  for (int i = 0; i < 33; ++i) a.in[i] = (const float*)d_in[i];
  a.out = (float*)d_out; a.ws = (unsigned char*)d_ws; a.ph_lo = 0; a.ph_hi = NPHASES;
  void* args[] = {&a};
  hipError_t e = hipLaunchCooperativeKernel((const void*)fwd_megakernel, dim3(grid), dim3(NTHREADS), args, LDS_BYTES, stream);
  if (e != hipSuccess) fprintf(stderr, "cooperative launch failed: %s (grid %d)\n", hipGetErrorString(e), grid);
}
```

```cpp
#include <hip/hip_runtime.h>
#include <hip/hip_cooperative_groups.h>
#include <hip/hip_bf16.h>
#include <cstdio>
#include <cstdint>
#include <cmath>
namespace cg = cooperative_groups;

#define DI __device__ __forceinline__
#define LAS __attribute__((address_space(3)))
#define CAS4 __attribute__((address_space(4)))
typedef unsigned short bf16_t;
typedef short bf16x8 __attribute__((ext_vector_type(8)));
typedef float f32x4 __attribute__((ext_vector_type(4)));
typedef float f32x2 __attribute__((ext_vector_type(2)));
typedef float f32x16 __attribute__((ext_vector_type(16)));
typedef unsigned u32x4 __attribute__((ext_vector_type(4)));
typedef short s16x4 __attribute__((ext_vector_type(4)));
typedef __bf16 bf16x2_t __attribute__((ext_vector_type(2)));

constexpr int DM = 1024, TLAT = 16384, NLAT = 32768, CTXL = 256, NROW = 33280, NLAYER = 4;
constexpr int DIN = 3072, DFF = 2816;
constexpr int C_NAQ = 768, C_NAK = 1024, C_NAV = 1280, C_GQ = 1536, C_GK = 1792, C_GV = 1920;
constexpr int C_RR = 2048, C_RK = 2304, C_RV = 2560, C_LW = 2816, C_LA = 2880, C_LG = 2944;
constexpr float C2 = 0.125f * 1.4426950408889634f;
constexpr float LOG2E = 1.4426950408889634f;
constexpr int NTHREADS = 512;

constexpr size_t MiB = 1u << 20;
constexpr size_t WS_CTL = 0, WS_MOD = 1 * MiB, WS_XC = 2 * MiB, WS_BONUS = 4 * MiB, WS_W = 6 * MiB;
constexpr size_t W_IN = 0, W_GATE = W_IN + (size_t)3072 * 1024 * 2, W_BR = W_GATE + (size_t)4096 * 1024 * 2, W_O = W_BR + (size_t)1024 * 1024 * 2,
                 W_UP = W_O + (size_t)1024 * 1024 * 2, W_DN = W_UP + (size_t)5632 * 1024 * 2, W_END = W_DN + (size_t)1024 * 2816 * 2;
static_assert(WS_W + W_END <= 42 * MiB, "weights");
constexpr size_t WS_H = 42 * MiB + 65536, WS_Z = 108 * MiB, WS_YS = 304 * MiB, WS_WA = 370 * MiB, WS_YSC = 436 * MiB, WS_END = 501 * MiB;
constexpr size_t WS_ACCM = WS_Z, WS_MBUF = WS_Z + 70 * MiB, WS_G = WS_Z, WS_F = WS_YS, WS_PSCR = WS_WA, WS_ASCR = WS_YSC;
constexpr size_t ROWB = (size_t)NROW * 1024 * 2;

DI float bf2f(unsigned u16) { return __uint_as_float(u16 << 16); }
DI unsigned cvtpk(float lo, float hi) { f32x2 v = {lo, hi}; bf16x2_t b = __builtin_convertvector(v, bf16x2_t); return __builtin_bit_cast(unsigned, b); }
DI void unpack8(const u32x4 w, float* f) {
#pragma unroll
  for (int i = 0; i < 4; ++i) { f[2 * i] = __uint_as_float(w[i] << 16); f[2 * i + 1] = __uint_as_float(w[i] & 0xffff0000u); }
}
DI u32x4 pack8(const float* f) { u32x4 w; w.x = cvtpk(f[0], f[1]); w.y = cvtpk(f[2], f[3]); w.z = cvtpk(f[4], f[5]); w.w = cvtpk(f[6], f[7]); return w; }
DI float sigmoidf_(float x) { return __builtin_amdgcn_rcpf(1.f + __builtin_amdgcn_exp2f(-1.4426950408889634f * x)); }
DI float dppf(float x, const int ctrl_dummy);
#define DPPF(x, CTRL) __int_as_float(__builtin_amdgcn_update_dpp(0, __float_as_int(x), (CTRL), 0xf, 0xf, false))
DI float allreduce16(float x) { x += DPPF(x, 0xB1); x += DPPF(x, 0x4E); x += DPPF(x, 0x141); x += DPPF(x, 0x140); return x; }
DI float red8(float x) { x += DPPF(x, 0xB1); x += DPPF(x, 0x4E); x += DPPF(x, 0x141); return x; }
DI float bperm(float v, int src_lane) { return __int_as_float(__builtin_amdgcn_ds_bpermute(src_lane << 2, __float_as_int(v))); }
DI float wave_sum(float v, int lane) { v = allreduce16(v); v += bperm(v, lane ^ 16); v += bperm(v, lane ^ 32); return v; }

DI void grid_barrier(unsigned* ctr, unsigned target, int tid) {
  __syncthreads();
  if (tid == 0) {
    __builtin_amdgcn_fence(__ATOMIC_RELEASE, "agent");
    __hip_atomic_fetch_add(ctr, 1u, __ATOMIC_RELAXED, __HIP_MEMORY_SCOPE_AGENT);
    while (__hip_atomic_load(ctr, __ATOMIC_RELAXED, __HIP_MEMORY_SCOPE_AGENT) < target) __builtin_amdgcn_s_sleep(1);
    __builtin_amdgcn_fence(__ATOMIC_ACQUIRE, "agent");
    asm volatile("s_waitcnt vmcnt(0)" ::: "memory");
  }
  __syncthreads();
}
DI void grid_barrier2(unsigned* ctl, unsigned k, int G, int bx, int tid) {
  __syncthreads();
  if (tid == 0) {
    __builtin_amdgcn_fence(__ATOMIC_RELEASE, "agent");
    const unsigned g = (unsigned)bx & 7u, gsize = ((unsigned)G - g + 7u) >> 3, ng = (G < 8) ? (unsigned)G : 8u;
    unsigned* grp = ctl + 512 + 64 * g; unsigned* top = ctl + 512 + 64 * 8; unsigned* gen = ctl + 512 + 64 * (9 + g);
    const unsigned old = __hip_atomic_fetch_add(grp, 1u, __ATOMIC_RELAXED, __HIP_MEMORY_SCOPE_AGENT);
    if (old + 1u == k * gsize) {
      const unsigned ot = __hip_atomic_fetch_add(top, 1u, __ATOMIC_RELAXED, __HIP_MEMORY_SCOPE_AGENT);
      if (ot + 1u == k * ng) { for (unsigned j = 0; j < ng; ++j) __hip_atomic_fetch_add(ctl + 512 + 64 * (9 + j), 1u, __ATOMIC_RELAXED, __HIP_MEMORY_SCOPE_AGENT); }
    }
    while (__hip_atomic_load(gen, __ATOMIC_RELAXED, __HIP_MEMORY_SCOPE_AGENT) < k) __builtin_amdgcn_s_sleep(1);
    __builtin_amdgcn_fence(__ATOMIC_ACQUIRE, "agent");
    asm volatile("s_waitcnt vmcnt(0)" ::: "memory");
  }
  __syncthreads();
}
DI void row_seq(int row, int& t, int& len) { if (row < NLAT) { t = row & (TLAT - 1); len = TLAT; } else { t = (row - NLAT) & (CTXL - 1); len = CTXL; } }

namespace pg8 {
constexpr int BM = 256, BK = 64, HALF = 128, HTB = HALF * BK * 2, STAGE_BYTES = 8 * HTB;
DI int lds_byte(int r, int c) { const int st = (r >> 4) * 2 + (c >> 5), rr = r & 15, cc = c & 31, ob = rr * 64 + cc * 2; return st * 1024 + (ob ^ (((ob >> 9) & 1) << 5)); }
DI void stage_rc(int b, int& R, int& C) { const int st = b / 1024, sb = b % 1024, swz = sb ^ (((sb >> 9) & 1) << 5); R = (st >> 1) * 16 + swz / 64; C = (st & 1) * 32 + (swz % 64) / 2; }
DI int perm32(int rho) { const int n = rho >> 4, i = rho & 15; return 8 * (i >> 2) + 4 * n + (i & 3); }

struct Unit { int pm, pn, nt, kind; };
struct Gemm { const char* base; int lda, ldb; };

template <class Epi, class Sched, bool CONV>
DI void gemm_phase(LAS unsigned char* lds, const Gemm g, const Sched& S, const Epi& E, int tid) {
    const int wid = __builtin_amdgcn_readfirstlane(tid >> 6), lane = tid & 63, wr = wid >> 2, wc = wid & 3, fr = lane & 15, fq = lane >> 4;
    unsigned voffA[2], voffB[2];
#pragma unroll
    for (int i = 0; i < 2; ++i) { int R, C; stage_rc(tid * 16 + i * 8192, R, C); const int Rb = (R & ~31) + perm32(R & 31);
        const int Ra = CONV ? (62 * (R >> 6) + (R & 63)) : R;
        voffA[i] = (unsigned)(Ra * g.lda + C) * 2u; voffB[i] = (unsigned)(Rb * g.ldb + C) * 2u; }
    constexpr int kstep = BK * 2;
    const int hstepA = (CONV ? 124 : HALF) * g.lda * 2, hstepB = HALF * g.ldb * 2;
    const unsigned ldsw = (unsigned)wid * 1024u;
    const int aoff = lds_byte(wr * 64 + fr, fq * 8), boff = lds_byte(wc * 32 + fr, fq * 8);
#define PG8_SA(b, h) (((b) * 2 + (h)) * HTB)
#define PG8_SB(b, h) ((4 + (b) * 2 + (h)) * HTB)
#define PG8_STAGE(bufoff, gbase, voff) do { _Pragma("unroll") for (int _i = 0; _i < 2; ++_i) \
        __builtin_amdgcn_global_load_lds((const unsigned*)((const char*)(gbase) + (voff)[_i]), (LAS unsigned*)(lds + (bufoff) + ldsw + _i * 8192), 16, 0, 0); } while (0)
#define PG8_LDA(dst, b, h) do { _Pragma("unroll") for (int m = 0; m < 4; ++m) _Pragma("unroll") for (int k = 0; k < 2; ++k) dst[m][k] = *(const LAS bf16x8*)(lds + PG8_SA(b, h) + aoff + m * 2048 + k * 1024); } while (0)
#define PG8_LDB(dst, b, h) do { _Pragma("unroll") for (int n = 0; n < 2; ++n) _Pragma("unroll") for (int k = 0; k < 2; ++k) dst[n][k] = *(const LAS bf16x8*)(lds + PG8_SB(b, h) + boff + n * 2048 + k * 1024); } while (0)
#define PG8_MMA(ai, bj, At, Bt) do { __builtin_amdgcn_s_setprio(1); _Pragma("unroll") for (int m = 0; m < 4; ++m) _Pragma("unroll") for (int n = 0; n < 2; ++n) _Pragma("unroll") for (int k = 0; k < 2; ++k) \
        acc[ai][bj][m][n] = __builtin_amdgcn_mfma_f32_16x16x32_bf16(Bt[n][k], At[m][k], acc[ai][bj][m][n], 0, 0, 0); __builtin_amdgcn_s_setprio(0); } while (0)
#define PG8_WAIT_V(n) asm volatile("s_waitcnt vmcnt(" #n ")" ::: "memory")
#define PG8_WAIT_L(n) asm volatile("s_waitcnt lgkmcnt(" #n ")" ::: "memory")
#define PG8_BAR __builtin_amdgcn_s_barrier()
#define PG8_SCHED __builtin_amdgcn_sched_barrier(0)
    Unit cur, nxt; int ui = 0; long ao_, bo_;
    if (!S.next(0, cur, ao_, bo_)) return;
    f32x4 acc[2][2][4][2];
#pragma unroll
    for (int a = 0; a < 2; ++a)
#pragma unroll
        for (int b = 0; b < 2; ++b)
#pragma unroll
            for (int m = 0; m < 4; ++m)
#pragma unroll
                for (int n = 0; n < 2; ++n) acc[a][b][m][n] = (f32x4){0.f, 0.f, 0.f, 0.f};
    bf16x8 At[4][2], B0[2][2], B1[2][2];
    const char* cA = g.base + ao_; const char* cB = g.base + bo_;
    PG8_STAGE(PG8_SB(0, 0), cB, voffB); PG8_STAGE(PG8_SB(0, 1), cB + hstepB, voffB); PG8_STAGE(PG8_SA(0, 0), cA, voffA); PG8_STAGE(PG8_SA(0, 1), cA + hstepA, voffA);
    if (wr == 1) PG8_BAR;
    PG8_WAIT_V(2); PG8_BAR;
    PG8_STAGE(PG8_SB(1, 0), cB + kstep, voffB); PG8_STAGE(PG8_SA(1, 0), cA + kstep, voffA); PG8_STAGE(PG8_SB(1, 1), cB + hstepB + kstep, voffB);
    PG8_WAIT_V(6); PG8_BAR;
    for (;;) {
        const bool has_next = S.next(ui + 1, nxt, ao_, bo_);
        const char* nA = has_next ? g.base + ao_ : cA; const char* nB = has_next ? g.base + bo_ : cB;
        const int nt = cur.nt;
        for (int t = 0; t < nt; t += 2) {
            const bool last = (t == nt - 2);
            const char* a1 = cA + (size_t)(t + 1) * kstep;
            const char* a2 = last ? nA : cA + (size_t)(t + 2) * kstep; const char* b2 = last ? nB : cB + (size_t)(t + 2) * kstep;
            const char* a3 = a2 + kstep; const char* b3 = b2 + kstep;
            PG8_LDB(B0, 0, 0); PG8_LDB(B1, 0, 1); PG8_SCHED; PG8_LDA(At, 0, 0); PG8_STAGE(PG8_SA(1, 1), a1 + hstepA, voffA);
            PG8_WAIT_V(8); PG8_WAIT_L(0); PG8_BAR; PG8_MMA(0, 0, At, B0); PG8_MMA(0, 1, At, B1); PG8_BAR; PG8_SCHED;
            PG8_LDA(At, 0, 1); PG8_STAGE(PG8_SB(0, 0), b2, voffB); PG8_STAGE(PG8_SB(0, 1), b2 + hstepB, voffB); PG8_STAGE(PG8_SA(0, 0), a2, voffA);
            PG8_WAIT_V(8); PG8_WAIT_L(0); PG8_BAR; PG8_MMA(1, 0, At, B0); PG8_MMA(1, 1, At, B1); PG8_BAR; PG8_SCHED;
            PG8_LDB(B0, 1, 0); PG8_LDB(B1, 1, 1); PG8_SCHED; PG8_LDA(At, 1, 0); PG8_STAGE(PG8_SA(0, 1), a2 + hstepA, voffA);
            PG8_WAIT_V(8); PG8_WAIT_L(0); PG8_BAR; PG8_MMA(0, 0, At, B0); PG8_MMA(0, 1, At, B1); PG8_BAR; PG8_SCHED;
            PG8_LDA(At, 1, 1); PG8_STAGE(PG8_SB(1, 0), b3, voffB); PG8_STAGE(PG8_SB(1, 1), b3 + hstepB, voffB); PG8_STAGE(PG8_SA(1, 0), a3, voffA);
            PG8_WAIT_V(8); PG8_WAIT_L(0); PG8_BAR; PG8_MMA(1, 0, At, B0); PG8_MMA(1, 1, At, B1); PG8_BAR; PG8_SCHED;
        }
        if (wr == 0) PG8_BAR;
        E(acc, cur, wr, wc, fr, fq);
        if (!has_next) break;
#pragma unroll
        for (int a = 0; a < 2; ++a)
#pragma unroll
            for (int b = 0; b < 2; ++b)
#pragma unroll
                for (int m = 0; m < 4; ++m)
#pragma unroll
                    for (int n = 0; n < 2; ++n) acc[a][b][m][n] = (f32x4){0.f, 0.f, 0.f, 0.f};
        cur = nxt; cA = nA; cB = nB; ++ui;
        if (wr == 1) PG8_BAR;
    }
    PG8_WAIT_V(0);
    PG8_BAR;
#undef PG8_SA
#undef PG8_SB
#undef PG8_STAGE
#undef PG8_LDA
#undef PG8_LDB
#undef PG8_MMA
#undef PG8_WAIT_V
#undef PG8_WAIT_L
#undef PG8_BAR
#undef PG8_SCHED
}

DI void xcd_tile(int L, int nM, int nN, int& pm, int& pn) {
    const int nwg = nM * nN; int wgid = L; { const int q = nwg / 8, r = nwg % 8, xcd = wgid % 8, off = wgid / 8; wgid = (xcd < r ? xcd * (q + 1) : r * (q + 1) + (xcd - r) * q) + off; }
    const int nig = 8 * nN, gid = wgid / nig, fm = gid * 8, gsz = (nM - fm) < 8 ? (nM - fm) : 8;
    pm = fm + ((wgid % nig) % gsz); pn = (wgid % nig) / gsz;
}
struct SchedPlain {
    int nM, nN, G, c, nt; long a0, b0; int lda, ldb, pn0;
    DI bool next(int i, Unit& u, long& a_off, long& b_off) const {
        const int L = i * G + c; if (L >= nM * nN) return false;
        xcd_tile(L, nM, nN, u.pm, u.pn); u.pn += pn0; a_off = a0 + (long)u.pm * 256 * lda * 2; b_off = b0 + (long)u.pn * 256 * ldb * 2; u.nt = nt; u.kind = 0; return true; }
};
struct SchedMerge {
    int G, c, nrt;
    DI bool next(int i, Unit& u, long& a_off, long& b_off) const {
        const int nr = (c < 512) ? (512 - c + G - 1) / G : 0;
        int sub;
        if (i < 8 * nr) { const int L = (i >> 3) * G + c; xcd_tile(L, 128, 4, u.pm, u.pn); sub = i & 7; }
        else { if (nrt != 130) return false;
            const int ii = i - 8 * nr, k = ii / 5, j = ii - 5 * k, qid = c + k * G; if (qid >= 32) return false;
            const int tq = qid >> 2, q = qid & 3; u.pm = 128 + (tq >> 2); u.pn = tq & 3; sub = (j < 4) ? j : 12 + q; }
        u.kind = sub;
        if (sub < 4) { a_off = (long)WS_YS + ((long)u.pm * 256 * 1024 + sub * 256) * 2; b_off = (long)(WS_W + W_BR) + ((long)u.pn * 256 * 1024 + sub * 256) * 2; u.nt = 4; }
        else { a_off = (long)WS_H + (long)u.pm * 256 * 1024 * 2; b_off = (long)(WS_W + W_GATE) + ((long)((u.pn * 4 + ((sub - 4) & 3)) * 256) * 1024) * 2; u.nt = 16; }
        return true; }
};
struct SchedUp {
    int G, c, ntm;
    DI static void tile_seq(int tm, int& base, int& len, int& j) {
        if (tm < 67) { base = 0; len = TLAT; j = tm; } else if (tm < 134) { base = TLAT; len = TLAT; j = tm - 67; }
        else { const int x = tm - 134; base = NLAT + (x >> 1) * CTXL; len = CTXL; j = x & 1; } }
    DI bool next(int i, Unit& u, long& a_off, long& b_off) const {
        const int L = i * G + c; if (L >= ntm * 22) return false;
        xcd_tile(L, ntm, 22, u.pm, u.pn); int base, len, j; tile_seq(u.pm, base, len, j);
        a_off = (long)WS_H + ((long)(base + 248 * j - 1) * 1024) * 2; b_off = (long)(WS_W + W_UP) + (long)u.pn * 256 * 1024 * 2; u.nt = 16; u.kind = 0; return true; }
};

struct EpiStore {
    bf16_t* O; int ldc;
    DI void operator()(const f32x4 (&acc)[2][2][4][2], const Unit& u, int wr, int wc, int fr_in, int fq_in) const {
        int ln_; asm volatile("v_mbcnt_lo_u32_b32 %0, -1, 0\n\tv_mbcnt_hi_u32_b32 %0, -1, %0" : "=v"(ln_)); const int fr = ln_ & 15, fq = ln_ >> 4; (void)fr_in; (void)fq_in;
        const int row0 = u.pm * 256 + wr * 64 + fr, col0 = u.pn * 256 + wc * 32 + 8 * fq;
#pragma unroll
        for (int ai = 0; ai < 2; ++ai)
#pragma unroll
            for (int m = 0; m < 4; ++m) { bf16_t* rowp = O + (size_t)(row0 + ai * 128 + m * 16) * ldc + col0;
#pragma unroll
                for (int bj = 0; bj < 2; ++bj) { const f32x4 v0 = acc[ai][bj][m][0], v1 = acc[ai][bj][m][1];
                    u32x4 w; w.x = cvtpk(v0[0], v0[1]); w.y = cvtpk(v0[2], v0[3]); w.z = cvtpk(v1[0], v1[1]); w.w = cvtpk(v1[2], v1[3]);
                    *(u32x4*)(rowp + bj * 128) = w; } }
    }
};
struct EpiMerge {
    unsigned char* stash; const float* bgate; bf16_t* O;
    DI void operator()(const f32x4 (&acc)[2][2][4][2], const Unit& u, int wr, int wc, int fr_in, int fq_in) const {
        int ln_; asm volatile("v_mbcnt_lo_u32_b32 %0, -1, 0\n\tv_mbcnt_hi_u32_b32 %0, -1, %0" : "=v"(ln_)); const int fr = ln_ & 15, fq = ln_ >> 4; (void)fr_in; (void)fq_in;
        unsigned char* st = stash + (size_t)blockIdx.x * 524288;
        if (u.kind < 4) {
            unsigned char* pb = st + (size_t)u.kind * 131072 + (size_t)(wr * 64 + fr) * 512 + (wc * 32 + 8 * fq) * 2;
#pragma unroll
            for (int ai = 0; ai < 2; ++ai)
#pragma unroll
                for (int m = 0; m < 4; ++m)
#pragma unroll
                    for (int bj = 0; bj < 2; ++bj) { const f32x4 v0 = acc[ai][bj][m][0], v1 = acc[ai][bj][m][1];
                        u32x4 w; w.x = cvtpk(v0[0], v0[1]); w.y = cvtpk(v0[2], v0[3]); w.z = cvtpk(v1[0], v1[1]); w.w = cvtpk(v1[2], v1[3]);
                        *(u32x4*)(pb + (size_t)(ai * 128 + m * 16) * 512 + bj * 256) = w; }
            if (u.kind == 3) asm volatile("s_waitcnt vmcnt(0)" ::: "memory");
        } else {
            if (u.kind == 4 || u.kind >= 12) { __builtin_amdgcn_fence(__ATOMIC_ACQUIRE, "agent"); asm volatile("s_waitcnt vmcnt(0)" ::: "memory"); }
            const int q = (u.kind - 4) & 3, cq = 64 * q + 16 * wc + 4 * fq, col = u.pn * 256 + cq;
            f32x4 bg[4];
#pragma unroll
            for (int i = 0; i < 4; ++i) bg[i] = *(const f32x4*)(bgate + i * 1024 + col);
            const unsigned char* pb = st + (size_t)(wr * 64 + fr) * 512 + cq * 2;
            bf16_t* ob = O + (size_t)(u.pm * 256 + wr * 64 + fr) * 1024 + col;
#pragma unroll
            for (int ai = 0; ai < 2; ++ai)
#pragma unroll
                for (int m = 0; m < 4; ++m) {
                    f32x4 o = (f32x4){0.f, 0.f, 0.f, 0.f};
#pragma unroll
                    for (int bj = 0; bj < 2; ++bj)
#pragma unroll
                        for (int n = 0; n < 2; ++n) { const int i = 2 * bj + n;
                            const uint2 pw = *(const uint2*)(pb + (size_t)i * 131072 + (size_t)(ai * 128 + m * 16) * 512);
                            const f32x4 p = (f32x4){__uint_as_float(pw.x << 16), __uint_as_float(pw.x & 0xffff0000u), __uint_as_float(pw.y << 16), __uint_as_float(pw.y & 0xffff0000u)};
                            const f32x4 gv = acc[ai][bj][m][n] + bg[i];
#pragma unroll
                            for (int e = 0; e < 4; ++e) o[e] += sigmoidf_(gv[e]) * p[e]; }
                    uint2 w; w.x = cvtpk(o[0], o[1]); w.y = cvtpk(o[2], o[3]);
                    *(uint2*)(ob + (size_t)(ai * 128 + m * 16) * 1024) = w;
                }
        }
    }
};
struct EpiConvGlu {
    bf16_t* Gout; const float* cw;
    DI void operator()(const f32x4 (&acc)[2][2][4][2], const Unit& u, int wr, int wc, int fr_in, int fq_in) const {
        int ln_; asm volatile("v_mbcnt_lo_u32_b32 %0, -1, 0\n\tv_mbcnt_hi_u32_b32 %0, -1, %0" : "=v"(ln_)); const int fr = ln_ & 15, fq = ln_ >> 4; (void)fr_in; (void)fq_in;
        int base, len, j; SchedUp::tile_seq(u.pm, base, len, j);
        const bool f0 = (fr == 0), f15 = (fr == 15);
#pragma unroll
        for (int n = 0; n < 2; ++n) {
            const int colv = u.pn * 128 + wc * 32 + 8 * fq + 4 * n;
            f32x4 wv[3], wg[3];
#pragma unroll
            for (int k = 0; k < 3; ++k) { wv[k] = *(const f32x4*)(cw + k * 5632 + colv); wg[k] = *(const f32x4*)(cw + k * 5632 + 2816 + colv); }
#pragma unroll
            for (int ai = 0; ai < 2; ++ai) {
#pragma unroll
                for (int m = 0; m < 4; ++m) {
                    const int rho = 16 * m + fr;
                    const int tl = 248 * j + 62 * (2 * ai + wr) - 1 + rho;
                    const bool valid = (rho >= 1) && (rho <= 62) && (tl >= 0) && (tl < len);
                    const bool lz = (tl <= 0), rz = (tl >= len - 1);
                    float outv[4];
#pragma unroll
                    for (int e = 0; e < 4; ++e) {
                        float cvv[2];
#pragma unroll
                        for (int bj = 0; bj < 2; ++bj) {
                            const float xc = acc[ai][bj][m][n][e];
                            const float xm1 = (m > 0) ? acc[ai][bj][m - 1][n][e] : xc, xp1 = (m < 3) ? acc[ai][bj][m + 1][n][e] : xc;
                            const float tl_ = f15 ? xm1 : xc, tr_ = f0 ? xp1 : xc;
                            const float lraw = DPPF(tl_, 0x121); const float left = lz ? 0.f : lraw;
                            const float rraw = DPPF(tr_, 0x12F); const float right = rz ? 0.f : rraw;
                            cvv[bj] = bj ? (left * wg[0][e] + xc * wg[1][e] + right * wg[2][e]) : (left * wv[0][e] + xc * wv[1][e] + right * wv[2][e]);
                        }
                        outv[e] = cvv[0] * cvv[1] * sigmoidf_(cvv[1]);
                    }
                    if (valid) { uint2 w; w.x = cvtpk(outv[0], outv[1]); w.y = cvtpk(outv[2], outv[3]); *(uint2*)(Gout + (size_t)(base + tl) * DFF + colv) = w; }
                }
            }
        }
    }
};
}

namespace attn_body {
constexpr int QP = DIN, OP = 1024;
constexpr int NW = 8, QBLK = 32, KVBLK = 64;
DI int crow(int r, int hi) { return (r & 3) + 8 * (r >> 2) + 4 * hi; }
#define SBAR() __builtin_amdgcn_sched_barrier(0)
constexpr int NSLOT = 3, SLOTB = 8192;
constexpr int LDS_K = 0, LDS_V = NSLOT * SLOTB, LDS_WS = 2 * NSLOT * SLOTB, LDS_OST = LDS_WS + NW * 64 * 4, LDS_BYTES = LDS_OST + NW * 4096;
constexpr int LDS_BIAS = 86016;
DI void glds16(const void* gsrc, unsigned lds_dst) { unsigned keep;
  asm volatile("s_mov_b32 %0, m0\n\ts_mov_b32 m0, %2\n\ts_nop 0\n\tglobal_load_lds_dwordx4 %1, off\n\ts_mov_b32 m0, %0" : "=&s"(keep) : "v"(gsrc), "s"(lds_dst) : "memory"); }
DI float max3f(float a, float b, float c) { float r; asm("v_max3_f32 %0, %1, %2, %3" : "=v"(r) : "v"(a), "v"(b), "v"(c)); return r; }
DI float max2f(float a, float b) { float r; asm("v_max_f32_e32 %0, %1, %2" : "=v"(r) : "v"(a), "v"(b)); return r; }
DI float fadd_s(float a, float b) { float r; asm("v_add_f32_e32 %0, %1, %2" : "=v"(r) : "v"(a), "v"(b)); return r; }
DI float fsub_s(float a, float b) { float r; asm("v_sub_f32_e32 %0, %1, %2" : "=v"(r) : "v"(a), "v"(b)); return r; }
DI unsigned cvtpk_s(float lo, float hi) { return cvtpk(lo, hi); }
#define WAIT_BAR(N) asm volatile("s_waitcnt vmcnt(" #N ") lgkmcnt(0)\n\ts_barrier" ::: "memory")

DI void qkt(f32x16& p0, f32x16& p1, const char* Kslot, const bf16x8* qr, int r32, int hi) {
  const f32x16 zz = f32x16{};
  const char* kb = Kslot + hi * 1024 + r32 * 16;
#pragma unroll
  for (int d0 = 0; d0 < 4; ++d0) {
    const bf16x8 b0 = *reinterpret_cast<const bf16x8*>(kb + d0 * 2048);
    const bf16x8 b1 = *reinterpret_cast<const bf16x8*>(kb + d0 * 2048 + 512);
    if (d0 == 0) { p0 = __builtin_amdgcn_mfma_f32_32x32x16_bf16(b0, qr[0], zz, 0, 0, 0); p1 = __builtin_amdgcn_mfma_f32_32x32x16_bf16(b1, qr[0], zz, 0, 0, 0); }
    else { p0 = __builtin_amdgcn_mfma_f32_32x32x16_bf16(b0, qr[d0], p0, 0, 0, 0); p1 = __builtin_amdgcn_mfma_f32_32x32x16_bf16(b1, qr[d0], p1, 0, 0, 0); } }
}
typedef __attribute__((address_space(3))) const char* lds_cptr;
typedef short v4i16_t __attribute__((ext_vector_type(4)));
DI void kload8(bf16x8* kf, lds_cptr kp) {
  kf[0] = *(const LAS bf16x8*)(kp);        kf[1] = *(const LAS bf16x8*)(kp + 512);
  kf[2] = *(const LAS bf16x8*)(kp + 2048); kf[3] = *(const LAS bf16x8*)(kp + 2560);
  kf[4] = *(const LAS bf16x8*)(kp + 4096); kf[5] = *(const LAS bf16x8*)(kp + 4608);
  kf[6] = *(const LAS bf16x8*)(kp + 6144); kf[7] = *(const LAS bf16x8*)(kp + 6656);
}
DI void kload2(bf16x8* kf, lds_cptr kp, int j) { kf[2 * j] = *(const LAS bf16x8*)(kp + j * 2048); kf[2 * j + 1] = *(const LAS bf16x8*)(kp + j * 2048 + 512); }
DI s16x4 vtr(lds_cptr p) { return __builtin_bit_cast(s16x4, __builtin_amdgcn_ds_read_tr16_b64_v4i16((LAS v4i16_t*)p)); }
DI float rowmax(const f32x16& p0, const f32x16& p1) {
  float a = max3f(p0[0], p0[1], p1[0]), b = max3f(p0[2], p0[3], p1[1]); a = max3f(a, p1[2], p1[3]);
#pragma unroll
  for (int r = 4; r < 16; r += 4) { a = max3f(a, p0[r], p0[r + 1]); b = max3f(b, p0[r + 2], p0[r + 3]); a = max3f(a, p1[r], p1[r + 1]); b = max3f(b, p1[r + 2], p1[r + 3]); }
  const float m = max2f(a, b);
  auto rr = __builtin_amdgcn_permlane32_swap(__float_as_uint(m), __float_as_uint(m), false, false);
  return max2f(__uint_as_float(rr[0]), __uint_as_float(rr[1]));
}
DI void pv(f32x16* o, int vb, bf16x8 pa0, bf16x8 pa1, bf16x8 pa2, bf16x8 pa3) {
#pragma unroll
  for (int d0 = 0; d0 < 2; ++d0) { s16x4 lo[4], hi[4];
#pragma unroll
    for (int ks = 0; ks < 4; ++ks) {
      asm volatile("ds_read_b64_tr_b16 %0,%1 offset:%c2" : "=&v"(lo[ks]) : "v"(vb), "i"(d0 * 4096 + ks * 1024) : "memory");
      asm volatile("ds_read_b64_tr_b16 %0,%1 offset:%c2" : "=&v"(hi[ks]) : "v"(vb), "i"(d0 * 4096 + ks * 1024 + 512) : "memory"); }
    asm volatile("s_waitcnt lgkmcnt(0)" ::: "memory"); SBAR();
#define PK(k) (bf16x8){lo[k][0], lo[k][1], lo[k][2], lo[k][3], hi[k][0], hi[k][1], hi[k][2], hi[k][3]}
    o[d0] = __builtin_amdgcn_mfma_f32_32x32x16_bf16(pa0, PK(0), o[d0], 0, 0, 0);
    o[d0] = __builtin_amdgcn_mfma_f32_32x32x16_bf16(pa1, PK(1), o[d0], 0, 0, 0);
    o[d0] = __builtin_amdgcn_mfma_f32_32x32x16_bf16(pa2, PK(2), o[d0], 0, 0, 0);
    o[d0] = __builtin_amdgcn_mfma_f32_32x32x16_bf16(pa3, PK(3), o[d0], 0, 0, 0);
#undef PK
  }
}
struct TileMap { int n1, base1, base2, NT; };
struct NaInfo { int i0, rmin; };

template <int MODE, int THRL>
DI void attn_unit(const bf16_t* Qw0, const bf16_t* __restrict__ Kh, const bf16_t* __restrict__ Vh, bf16_t* Ow0, const TileMap tm, const NaInfo na, char* shm, int tid) {
  const int lane = tid & 63, r32 = lane & 31, hi = lane >> 5; const int wid = __builtin_amdgcn_readfirstlane(tid >> 6);
  const bf16_t* Qw = Qw0 + (long)(wid * QBLK) * QP;
  const unsigned lds0 = (unsigned)(uintptr_t)shm;
  float* wsf = (float*)(shm + LDS_WS) + wid * 64;
  const bf16_t* ksrc = Kh + (long)lane * QP + wid * 8;
  const bf16_t* vsrc = Vh + (long)(16 * (wid & 3) + (lane >> 2)) * QP + (wid >> 2) * 32 + (lane & 3) * 8;
  const unsigned kdst = lds0 + LDS_K + wid * 1024, vdst = lds0 + LDS_V + wid * 1024;
#define TROW(t) ((long)(((t) < tm.n1) ? (tm.base1 + 64 * (t)) : (tm.base2 + 64 * ((t) - tm.n1))))
#define DMA_K(t, slot) glds16(ksrc + TROW(t) * QP, (unsigned)__builtin_amdgcn_readfirstlane(kdst + (slot)))
#define DMA_V(t, slot) glds16(vsrc + TROW(t) * QP, (unsigned)__builtin_amdgcn_readfirstlane(vdst + (slot)))
  const int vb0 = (int)(lds0 + LDS_V) + ((lane >> 4) & 1) * 32 + (lane & 3) * 8 + (4 * hi + ((lane & 15) >> 2)) * 64;
  const char* Kbase = shm + LDS_K; bf16x8 kf[8];
  const lds_cptr shm3 = (lds_cptr)shm; const lds_cptr kp0 = shm3 + LDS_K + hi * 1024 + r32 * 16; const lds_cptr vp0 = shm3 + LDS_V + ((lane >> 4) & 1) * 32 + (lane & 3) * 8 + (4 * hi + ((lane & 15) >> 2)) * 64;
  const int NT = tm.NT;
  DMA_K(0, 0); DMA_V(0, 0); DMA_K(1, SLOTB);
  bf16x8 qr[4];
#pragma unroll
  for (int d0 = 0; d0 < 4; ++d0) qr[d0] = *reinterpret_cast<const bf16x8*>(&Qw[(long)r32 * QP + d0 * 16 + hi * 8]);
  float mhat = 0.f, l_reg = 0.f; f32x16 o[2]; o[0] = f32x16{}; o[1] = f32x16{}; f32x16 zacc = f32x16{}; if (MODE == 0) asm volatile("" : "+v"(zacc));
#define CMASK(P0, P1, t) do { if (MODE == 1) { const int t_ = (t); const bool ctx_ = t_ < 4; \
      int lane_ = lane; asm volatile("" : "+v"(lane_)); const int r32_ = lane_ & 31, hi_ = lane_ >> 5; \
      const int qi_ = na.i0 + (wid >> 1), qj_ = (wid & 1) * 32 + r32_; const int rs_ = min(max(qi_ - 4, 0), 248), cs_ = min(max(qj_ - 8, 0), 48); \
      const int kr = na.rmin + t_ - 4; const bool rowok = (unsigned)(kr - rs_) < 8u; \
      const int bb = ctx_ ? 480 : ((kr - qi_ + 7) * 31 + 15 - qj_ + 4 * hi_); const int lo_ = ctx_ ? -4096 : ((rowok ? cs_ : 4096) - 4 * hi_); const unsigned wd_ = ctx_ ? 8192u : 16u; const int mul_ = ctx_ ? 0 : 1; \
      const LAS float* btab = (const LAS float*)((lds_cptr)shm + LDS_BIAS); \
      _Pragma("unroll") for (int g_ = 0; g_ < 8; ++g_) { \
        _Pragma("unroll") for (int q_ = 0; q_ < 2; ++q_) { const int r = 2 * g_ + q_; const int kc0 = (r & 3) + 8 * (r >> 2); \
          const int d0_ = kc0 - lo_; \
          const int i0_ = ((unsigned)d0_ < wd_) ? bb + kc0 * mul_ : -1, i1_ = ((unsigned)(d0_ + 32) < wd_) ? bb + (kc0 + 32) * mul_ : -1; \
          const float b0_ = btab[max(i0_, 0)], b1_ = btab[max(i1_, 0)]; \
          P0[r] = (i0_ >= 0) ? P0[r] + b0_ : -INFINITY; P1[r] = (i1_ >= 0) ? P1[r] + b1_ : -INFINITY; } \
        SBAR(); } } } while (0)
  bool resc = false;
#define START(P0, P1) do { const float rm = rowmax(P0, P1); resc = false; \
    { const float dl = rm; mhat = fadd_s(mhat, dl); \
      _Pragma("unroll") for (int r = 0; r < 16; ++r) { P0[r] = fsub_s(P0[r], dl); P1[r] = fsub_s(P1[r], dl); } \
      if (MODE == 0) { _Pragma("unroll") for (int r = 0; r < 16; ++r) zacc[r] = -mhat; asm volatile("" : "+v"(zacc)); } } \
    _Pragma("unroll") for (int r = 0; r < 16; ++r) P0[r] = __builtin_amdgcn_exp2f(P0[r]); } while (0)
#define RESC() do { if (resc) { asm volatile("s_waitcnt lgkmcnt(0)" ::: "memory"); \
      _Pragma("unroll") for (int d_ = 0; d_ < 2; ++d_) _Pragma("unroll") for (int r = 0; r < 16; ++r) o[d_][r] *= wsf[crow(r, hi)]; } } while (0)
  f32x16 pA0, pA1, pB0, pB1;
  int sl_prev = 0, sl_cur = 0, sl_next = SLOTB;
#define ROT() do { sl_prev = sl_cur; sl_cur = sl_next; sl_next = (sl_next == (NSLOT - 1) * SLOTB) ? 0 : sl_next + SLOTB; } while (0)
  DMA_K(2, 2 * SLOTB);
  WAIT_BAR(3);
  qkt(pA0, pA1, Kbase, qr, r32, hi); asm volatile("s_nop 15\n\ts_nop 7" : "+v"(pA0), "+v"(pA1)); CMASK(pA0, pA1, 0);
  START(pA0, pA1);
  _Pragma("unroll") for (int r = 0; r < 16; ++r) pA1[r] = __builtin_amdgcn_exp2f(pA1[r]);
  WAIT_BAR(0);
  DMA_K(3, 0); DMA_V(1, SLOTB);
  ROT();
  kload8(kf, kp0 + sl_cur);
  WAIT_BAR(2);
  s16x4 vlo[8], vhi[8]; u32x4 pw0, pw1, pw2, pw3;
#define PKW(P, B) cvtpk_s(P[B], P[B + 1])
#define PAF(k) __builtin_bit_cast(bf16x8, pw##k)
#define VFR(i) (bf16x8){vlo[i][0], vlo[i][1], vlo[i][2], vlo[i][3], vhi[i][0], vhi[i][1], vhi[i][2], vhi[i][3]}
#define PIN(x) asm volatile("" : "+v"(x))
#define MX3(a, b, c) __builtin_fmaxf(__builtin_fmaxf((a), (b)), (c))
#define GAPA(MF, A0, A1, A2, A3, W0, W1, PW) do { MF; sacc += A0; sacc += A1; sacc += A2; sacc += A3; PIN(sacc); W0; W1; PIN(PW); SBAR(); } while (0)
#define EX(v) __builtin_amdgcn_exp2f(v)
#define GAPB(MF, X, B) do { MF; X[B] = EX(X[B]); X[B + 1] = EX(X[B + 1]); X[B + 2] = EX(X[B + 2]); X[B + 3] = EX(X[B + 3]); PIN(X); SBAR(); } while (0)
#define VRD(i) do { vlo[i] = vtr(vp_ + (((i) >> 2) * 4096 + ((i) & 3) * 1024)); vhi[i] = vtr(vp_ + (((i) >> 2) * 4096 + ((i) & 3) * 1024 + 512)); } while (0)
#define KRD(G, j) do { if (G) { kload2(kf, kp0 + sl_next, j); SBAR(); } } while (0)
#define STEP(C0, C1, P0, P1, t, GK, GV, GL) do { SBAR(); \
    const lds_cptr vp_ = vp0 + sl_prev; \
    VRD(0); SBAR(); float sacc = (P0[0] + P0[1]); \
    GAPA(C0 = __builtin_amdgcn_mfma_f32_32x32x16_bf16(kf[0], qr[0], zacc, 0, 0, 0), P0[2], P0[3], P0[4], P0[5],     pw0[0] = PKW(P0, 0), pw0[1] = PKW(P0, 2), pw0); \
    VRD(4); SBAR(); GAPA(C1 = __builtin_amdgcn_mfma_f32_32x32x16_bf16(kf[1], qr[0], zacc, 0, 0, 0), P0[6], P0[7], P0[8], P0[9],     pw0[2] = PKW(P0, 4), pw0[3] = PKW(P0, 6), pw0); \
    VRD(1); SBAR(); GAPA(C0 = __builtin_amdgcn_mfma_f32_32x32x16_bf16(kf[2], qr[1], C0, 0, 0, 0),   P0[10], P0[11], P0[12], P0[13], pw1[0] = PKW(P0, 8), pw1[1] = PKW(P0, 10), pw1); \
    VRD(5); SBAR(); GAPA(C1 = __builtin_amdgcn_mfma_f32_32x32x16_bf16(kf[3], qr[1], C1, 0, 0, 0),   P0[14], P0[15], P1[0], P1[1],   pw1[2] = PKW(P0, 12), pw1[3] = PKW(P0, 14), pw1); \
    VRD(2); SBAR(); GAPA(C0 = __builtin_amdgcn_mfma_f32_32x32x16_bf16(kf[4], qr[2], C0, 0, 0, 0),   P1[2], P1[3], P1[4], P1[5],     pw2[0] = PKW(P1, 0), pw2[1] = PKW(P1, 2), pw2); \
    VRD(6); SBAR(); GAPA(C1 = __builtin_amdgcn_mfma_f32_32x32x16_bf16(kf[5], qr[2], C1, 0, 0, 0),   P1[6], P1[7], P1[8], P1[9],     pw2[2] = PKW(P1, 4), pw2[3] = PKW(P1, 6), pw2); \
    VRD(3); SBAR(); GAPA(C0 = __builtin_amdgcn_mfma_f32_32x32x16_bf16(kf[6], qr[3], C0, 0, 0, 0),   P1[10], P1[11], P1[12], P1[13], pw3[0] = PKW(P1, 8), pw3[1] = PKW(P1, 10), pw3); \
    VRD(7); SBAR(); GAPA(C1 = __builtin_amdgcn_mfma_f32_32x32x16_bf16(kf[7], qr[3], C1, 0, 0, 0),   P1[14], P1[15], 0.f, 0.f,       pw3[2] = PKW(P1, 12), pw3[3] = PKW(P1, 14), pw3); \
    l_reg += sacc; \
    if (GK) { DMA_K((t) + 3, sl_cur); } if (GV) { DMA_V((t) + 1, sl_next); } \
    if (MODE == 1) { _Pragma("unroll") for (int r = 0; r < 16; ++r) { C0[r] -= mhat; C1[r] -= mhat; } } \
    CMASK(C0, C1, t); \
    { float a = MX3(C0[0], C0[1], C1[0]), b = MX3(C0[2], C0[3], C1[1]); a = MX3(a, C1[2], C1[3]); \
      _Pragma("unroll") for (int r = 4; r < 16; r += 4) { a = MX3(a, C0[r], C0[r + 1]); b = MX3(b, C0[r + 2], C0[r + 3]); a = MX3(a, C1[r], C1[r + 1]); b = MX3(b, C1[r + 2], C1[r + 3]); } \
      float rm = __builtin_fmaxf(a, b); { auto rr = __builtin_amdgcn_permlane32_swap(__float_as_uint(rm), __float_as_uint(rm), false, false); rm = __builtin_fmaxf(__uint_as_float(rr[0]), __uint_as_float(rr[1])); } \
      resc = false; \
      if (__builtin_expect(__any(rm > (float)THRL), 0)) { const float dl = __builtin_fmaxf(rm, 0.f); mhat += dl; \
        _Pragma("unroll") for (int r = 0; r < 16; ++r) { C0[r] -= dl; C1[r] -= dl; } \
        if (MODE == 0) { _Pragma("unroll") for (int r = 0; r < 16; ++r) zacc[r] = -mhat; asm volatile("" : "+v"(zacc)); } \
        const float f = __builtin_amdgcn_exp2f(-dl); l_reg *= f; if (hi == 0) wsf[r32] = f; resc = true; } } \
    SBAR(); \
    GAPB(o[0] = __builtin_amdgcn_mfma_f32_32x32x16_bf16(PAF(0), VFR(0), o[0], 0, 0, 0), C0, 0); \
    GAPB(o[1] = __builtin_amdgcn_mfma_f32_32x32x16_bf16(PAF(0), VFR(4), o[1], 0, 0, 0), C0, 4); \
    KRD(GL, 0); GAPB(o[0] = __builtin_amdgcn_mfma_f32_32x32x16_bf16(PAF(1), VFR(1), o[0], 0, 0, 0), C0, 8); \
    KRD(GL, 1); GAPB(o[1] = __builtin_amdgcn_mfma_f32_32x32x16_bf16(PAF(1), VFR(5), o[1], 0, 0, 0), C0, 12); \
    KRD(GL, 2); GAPB(o[0] = __builtin_amdgcn_mfma_f32_32x32x16_bf16(PAF(2), VFR(2), o[0], 0, 0, 0), C1, 0); \
    KRD(GL, 3); GAPB(o[1] = __builtin_amdgcn_mfma_f32_32x32x16_bf16(PAF(2), VFR(6), o[1], 0, 0, 0), C1, 4); \
    GAPB(o[0] = __builtin_amdgcn_mfma_f32_32x32x16_bf16(PAF(3), VFR(3), o[0], 0, 0, 0), C1, 8); \
    GAPB(o[1] = __builtin_amdgcn_mfma_f32_32x32x16_bf16(PAF(3), VFR(7), o[1], 0, 0, 0), C1, 12); \
    } while (0)
  int t = 1;
  for (; t + 5 < NT; t += 2) {
    STEP(pB0, pB1, pA0, pA1, t, true, true, true);     WAIT_BAR(2); RESC(); ROT();
    STEP(pA0, pA1, pB0, pB1, t + 1, true, true, true); WAIT_BAR(2); RESC(); ROT();
  }
#define ENDW(tt) do { if ((tt) + 3 < NT) { WAIT_BAR(2); } else if ((tt) + 2 < NT) { WAIT_BAR(1); } else { WAIT_BAR(0); } } while (0)
  for (; t + 1 < NT; t += 2) {
    STEP(pB0, pB1, pA0, pA1, t, (t + 3 < NT), (t + 1 < NT), (t + 1 < NT));         ENDW(t);     RESC(); ROT();
    STEP(pA0, pA1, pB0, pB1, t + 1, (t + 4 < NT), (t + 2 < NT), (t + 2 < NT));     ENDW(t + 1); RESC(); ROT();
  }
  STEP(pB0, pB1, pA0, pA1, NT - 1, false, false, false); RESC();
  { float sacc = pB0[0] + pB0[1]; _Pragma("unroll") for (int r = 2; r < 16; ++r) sacc += pB0[r]; _Pragma("unroll") for (int r = 0; r < 16; ++r) sacc += pB1[r]; l_reg += sacc;
    pw0 = (u32x4){PKW(pB0, 0), PKW(pB0, 2), PKW(pB0, 4), PKW(pB0, 6)}; pw1 = (u32x4){PKW(pB0, 8), PKW(pB0, 10), PKW(pB0, 12), PKW(pB0, 14)}; pw2 = (u32x4){PKW(pB1, 0), PKW(pB1, 2), PKW(pB1, 4), PKW(pB1, 6)}; pw3 = (u32x4){PKW(pB1, 8), PKW(pB1, 10), PKW(pB1, 12), PKW(pB1, 14)};
    SBAR(); pv(o, vb0 + sl_cur, PAF(0), PAF(1), PAF(2), PAF(3)); }
#undef PKW
#undef PAF
#undef VFR
#undef PIN
#undef MX3
#undef GAPA
#undef GAPB
#undef EX
#undef VRD
#undef KRD
#undef STEP
#undef ENDW
  { auto rr = __builtin_amdgcn_permlane32_swap(__float_as_uint(l_reg), __float_as_uint(l_reg), false, false); l_reg = __uint_as_float(rr[0]) + __uint_as_float(rr[1]); }
  if (hi == 0) wsf[32 + r32] = l_reg; asm volatile("s_waitcnt lgkmcnt(0)" ::: "memory");
  float rli[16];
#pragma unroll
  for (int r = 0; r < 16; ++r) rli[r] = __builtin_amdgcn_rcpf(wsf[32 + crow(r, hi)]);
  bf16_t* Ow = Ow0 + (long)(wid * QBLK) * OP;
  { __hip_bfloat16* stg = (__hip_bfloat16*)(shm + LDS_OST) + wid * 2048;
#pragma unroll
    for (int r = 0; r < 16; ++r) { const int orow = crow(r, hi);
#pragma unroll
      for (int d0 = 0; d0 < 2; ++d0) stg[orow * 64 + d0 * 32 + r32] = __float2bfloat16(o[d0][r] * rli[r]); }
    asm volatile("s_waitcnt lgkmcnt(0)" ::: "memory");
#pragma unroll
    for (int i = 0; i < 4; ++i) { const int row = i * 8 + (lane >> 3), ch = lane & 7; const u32x4 v = *(const u32x4*)(stg + row * 64 + ch * 8); *(u32x4*)(Ow + (long)row * OP + ch * 8) = v; } }
  asm volatile("s_waitcnt lgkmcnt(0)\n\ts_barrier" ::: "memory");
#undef DMA_K
#undef DMA_V
#undef TROW
#undef CMASK
#undef START
#undef RESC
#undef ROT
}
#undef SBAR
#undef WAIT_BAR
}

struct Args {
  const float* in[33];
  float* out; unsigned char* ws;
  int ph_lo, ph_hi;
};
enum { I_X = 0, I_C, I_CTX, I_CCTX, I_ADAW, I_ADAB, I_NMIXPRE, I_NMIXPOST, I_NFFNPRE, I_NFFNPOST, I_WIN, I_CONVA, I_NABIAS, I_QNORM, I_KNORM,
       I_MU, I_W0, I_W2, I_A0, I_A2, I_KK, I_KA, I_RK, I_G2, I_LNW, I_LNB, I_WBR, I_WGATE, I_BGATE, I_WO, I_FUP, I_FCONV, I_FDN };

DI void transpose_item(const float* W, int N, bf16_t* WT, int ld, int koff, int mode, LAS float* scr, int item, int lane) {
  const int nblk = N / 32, kb = item / nblk, nb = item % nblk, k0 = 64 * kb, n0 = 32 * nb;
  { f32x4 wv_[8];
#pragma unroll
    for (int i = 0; i < 8; ++i) wv_[i] = *(const f32x4*)(W + (size_t)(k0 + 8 * i + (lane >> 3)) * N + n0 + 4 * (lane & 7));
#pragma unroll
    for (int i = 0; i < 8; ++i) { LAS float* d_ = scr + (8 * i + (lane >> 3)) * 33 + 4 * (lane & 7); d_[0] = wv_[i][0]; d_[1] = wv_[i][1]; d_[2] = wv_[i][2]; d_[3] = wv_[i][3]; } }
  asm volatile("s_waitcnt lgkmcnt(0)" ::: "memory");
  const int c = lane & 7;
#pragma unroll
  for (int j = 0; j < 4; ++j) { const int n = (lane >> 3) + 8 * j; const LAS float* s = scr + (8 * c) * 33 + n;
    int nn = n0 + n;
    if (mode == 1) nn = (nn < DFF) ? (256 * (nn >> 7) + (nn & 127)) : (256 * ((nn - DFF) >> 7) + 128 + ((nn - DFF) & 127));
    if (mode == 2) { const int i = nn >> 10, cc = nn & 1023, c64 = cc & 63;
      nn = ((cc >> 6) * 256) + 128 * (i >> 1) + 32 * (c64 >> 4) + 8 * ((c64 >> 2) & 3) + 4 * (i & 1) + (c64 & 3); }
    u32x4 o; o.x = cvtpk(s[0 * 33], s[1 * 33]); o.y = cvtpk(s[2 * 33], s[3 * 33]); o.z = cvtpk(s[4 * 33], s[5 * 33]); o.w = cvtpk(s[6 * 33], s[7 * 33]);
    *(u32x4*)(WT + (size_t)nn * ld + koff + k0 + 8 * c) = o; }
  asm volatile("s_waitcnt lgkmcnt(0)" ::: "memory");
}
DI void convert_weights(const CAS4 Args& A, int l, LAS unsigned char* lds, int gw, int NGW, int wave, int lane) {
  LAS float* scr = (LAS float*)(lds + wave * 8704);
  unsigned char* wb = A.ws + WS_W;
  constexpr int I_IN_ = 16 * 96, I_G = 16 * 128, I_B = 4 * 4 * 32, I_O_ = 16 * 32, I_U = 16 * 176, I_D = 44 * 32;
  constexpr int NIT = I_IN_ + I_G + I_B + I_O_ + I_U + I_D;
  for (int it = gw; it < NIT; it += NGW) {
    int r = it;
    if (r < I_IN_) { transpose_item(A.in[I_WIN] + (size_t)l * 1024 * 3072, 3072, (bf16_t*)(wb + W_IN), 1024, 0, 0, scr, r, lane); continue; } r -= I_IN_;
    if (r < I_G) { transpose_item(A.in[I_WGATE] + (size_t)l * 1024 * 4096, 4096, (bf16_t*)(wb + W_GATE), 1024, 0, 2, scr, r, lane); continue; } r -= I_G;
    if (r < I_B) { const int br = r / 128; transpose_item(A.in[I_WBR] + ((size_t)l * 4 + br) * 256 * 1024, 1024, (bf16_t*)(wb + W_BR), 1024, br * 256, 0, scr, r % 128, lane); continue; } r -= I_B;
    if (r < I_O_) { transpose_item(A.in[I_WO] + (size_t)l * 1024 * 1024, 1024, (bf16_t*)(wb + W_O), 1024, 0, 0, scr, r, lane); continue; } r -= I_O_;
    if (r < I_U) { transpose_item(A.in[I_FUP] + (size_t)l * 1024 * 5632, 5632, (bf16_t*)(wb + W_UP), 1024, 0, 1, scr, r, lane); continue; } r -= I_U;
    transpose_item(A.in[I_FDN] + (size_t)l * 2816 * 1024, 1024, (bf16_t*)(wb + W_DN), 2816, 0, 0, scr, r, lane);
  }
}

DI void row_phase(const float* xold, float* xdst, const bf16_t* src, const float* gate, const float* gpost,
                  bf16_t* hout, const float* gnext, const float* sh, const float* sc, int lane) {
  f32x4 v[4];
#pragma unroll
  for (int j = 0; j < 4; ++j) v[j] = ((const f32x4*)xold)[lane + 64 * j];
  if (src) {
    f32x4 s[4]; float ss = 0.f;
#pragma unroll
    for (int j = 0; j < 4; ++j) { const uint2 w = ((const uint2*)src)[lane + 64 * j];
      s[j] = (f32x4){__uint_as_float(w.x << 16), __uint_as_float(w.x & 0xffff0000u), __uint_as_float(w.y << 16), __uint_as_float(w.y & 0xffff0000u)};
      ss += (s[j].x * s[j].x + s[j].y * s[j].y) + (s[j].z * s[j].z + s[j].w * s[j].w); }
    const float rs = __builtin_amdgcn_rsqf(wave_sum(ss, lane) * (1.f / 1024.f) + 1e-6f);
#pragma unroll
    for (int j = 0; j < 4; ++j) { const f32x4 g = ((const f32x4*)gate)[lane + 64 * j], p = ((const f32x4*)gpost)[lane + 64 * j];
      v[j] = v[j] + g * (s[j] * rs * p); ((f32x4*)xdst)[lane + 64 * j] = v[j]; }
  }
  if (hout) {
    float ss = 0.f;
#pragma unroll
    for (int j = 0; j < 4; ++j) ss += (v[j].x * v[j].x + v[j].y * v[j].y) + (v[j].z * v[j].z + v[j].w * v[j].w);
    const float rs = __builtin_amdgcn_rsqf(wave_sum(ss, lane) * (1.f / 1024.f) + 1e-6f);
#pragma unroll
    for (int j = 0; j < 4; ++j) { const f32x4 g = ((const f32x4*)gnext)[lane + 64 * j], a = ((const f32x4*)sh)[lane + 64 * j], b = ((const f32x4*)sc)[lane + 64 * j];
      const f32x4 h = (v[j] * rs * g) * (b + 1.f) + a;
      uint2 w; w.x = cvtpk(h.x, h.y); w.y = cvtpk(h.z, h.w); ((uint2*)hout)[lane + 64 * j] = w; }
  }
}

DI void row_phase_blk(const float* xlat_in, const float* xctx_in, float* xlat_out, float* xctx_out, const bf16_t* srcb,
                      const float* modl, int gate_off, const float* gpost, bf16_t* hb, const float* gnext, const float* modn, int sh_off, int sc_off,
                      int bx, int wave, int lane) {
  const int R0 = bx * 130;
  f32x4 gpv[4], gnv[4], gav[4], shv[4], scv[4];
#pragma unroll
  for (int j = 0; j < 4; ++j) { gpv[j] = ((const f32x4*)gpost)[lane + 64 * j]; gnv[j] = hb ? ((const f32x4*)gnext)[lane + 64 * j] : (f32x4){0.f, 0.f, 0.f, 0.f}; }
  int cur_s = -1;
  f32x4 xv[4], xn[4]; uint2 sv[4], sn[4];
  int row = R0 + wave;
  { const float* xo = (row < NLAT) ? xlat_in + (size_t)row * 1024 : xctx_in + (size_t)(row - NLAT) * 1024;
#pragma unroll
    for (int j = 0; j < 4; ++j) { xv[j] = ((const f32x4*)xo)[lane + 64 * j]; sv[j] = ((const uint2*)(srcb + (size_t)row * 1024))[lane + 64 * j]; } }
  for (; row < R0 + 130; row += 8) {
    const int nrow = row + 8; const bool hn = nrow < R0 + 130;
    if (hn) { const float* xo = (nrow < NLAT) ? xlat_in + (size_t)nrow * 1024 : xctx_in + (size_t)(nrow - NLAT) * 1024;
#pragma unroll
      for (int j = 0; j < 4; ++j) { xn[j] = ((const f32x4*)xo)[lane + 64 * j]; sn[j] = ((const uint2*)(srcb + (size_t)nrow * 1024))[lane + 64 * j]; } }
    const int s = (row < NLAT) ? (row >> 14) : 2;
    if (s != cur_s) { cur_s = s; const float* md = modl + (size_t)s * 6144; const float* mn = modn + (size_t)s * 6144;
#pragma unroll
      for (int j = 0; j < 4; ++j) { gav[j] = ((const f32x4*)(md + gate_off))[lane + 64 * j];
        shv[j] = hb ? ((const f32x4*)(mn + sh_off))[lane + 64 * j] : (f32x4){0.f, 0.f, 0.f, 0.f}; scv[j] = hb ? ((const f32x4*)(mn + sc_off))[lane + 64 * j] : (f32x4){0.f, 0.f, 0.f, 0.f}; } }
    f32x4 sf[4]; float ss = 0.f;
#pragma unroll
    for (int j = 0; j < 4; ++j) { const uint2 w = sv[j];
      sf[j] = (f32x4){__uint_as_float(w.x << 16), __uint_as_float(w.x & 0xffff0000u), __uint_as_float(w.y << 16), __uint_as_float(w.y & 0xffff0000u)};
      ss += (sf[j].x * sf[j].x + sf[j].y * sf[j].y) + (sf[j].z * sf[j].z + sf[j].w * sf[j].w); }
    const float rs = __builtin_amdgcn_rsqf(wave_sum(ss, lane) * (1.f / 1024.f) + 1e-6f);
    float* xd = (row < NLAT) ? xlat_out + (size_t)row * 1024 : xctx_out + (size_t)(row - NLAT) * 1024;
    float s2 = 0.f;
#pragma unroll
    for (int j = 0; j < 4; ++j) { xv[j] = xv[j] + gav[j] * (sf[j] * rs * gpv[j]); ((f32x4*)xd)[lane + 64 * j] = xv[j];
      s2 += (xv[j].x * xv[j].x + xv[j].y * xv[j].y) + (xv[j].z * xv[j].z + xv[j].w * xv[j].w); }
    if (hb) {
      const float r2 = __builtin_amdgcn_rsqf(wave_sum(s2, lane) * (1.f / 1024.f) + 1e-6f);
#pragma unroll
      for (int j = 0; j < 4; ++j) { const f32x4 h = (xv[j] * r2 * gnv[j]) * (scv[j] + 1.f) + shv[j];
        uint2 w; w.x = cvtpk(h.x, h.y); w.y = cvtpk(h.z, h.w); ((uint2*)(hb + (size_t)row * 1024))[lane + 64 * j] = w; }
    }
#pragma unroll
    for (int j = 0; j < 4; ++j) { xv[j] = xn[j]; sv[j] = sn[j]; }
  }
}

__global__ void __launch_bounds__(NTHREADS, 2) fwd_megakernel(Args A_) {
  extern __shared__ __attribute__((aligned(16))) unsigned char lds_raw[];
  LAS unsigned char* lds = (LAS unsigned char*)lds_raw;
  const int wave0_ = __builtin_amdgcn_readfirstlane((int)threadIdx.x >> 6);
  const int G = gridDim.x, bx = blockIdx.x;
  const int NGW = G * 8;
  const int lo = A_.ph_lo, hi = A_.ph_hi;
  if (hi < 0) cg::this_grid().sync();
  int ph = 0, nbar_ = 0;
#ifndef NBARX
#define NBARX 1
#endif
#ifndef SKIPMASK
#define SKIPMASK 0
#endif
#ifndef REPMASK
#define REPMASK 0
#endif
#define PHASE_BEGIN(id) if (ph >= lo && ph < hi && !((SKIPMASK >> (id)) & 1)) for (int rep_ = 0; rep_ < ((((REPMASK) >> (id)) & 1) ? 2 : 1); ++rep_) { const CAS4 Args* Ap_ = (const CAS4 Args*)__builtin_amdgcn_kernarg_segment_ptr(); asm volatile("" : "+s"(Ap_)); const CAS4 Args& A = *Ap_; \
  unsigned char* ws = A.ws; unsigned* ctl = (unsigned*)(ws + WS_CTL); float* MOD = (float*)(ws + WS_MOD); float* XC = (float*)(ws + WS_XC); float* BONUS = (float*)(ws + WS_BONUS); \
  bf16_t* H = (bf16_t*)(ws + WS_H); bf16_t* Z = (bf16_t*)(ws + WS_Z); bf16_t* YS = (bf16_t*)(ws + WS_YS); bf16_t* WAE = (bf16_t*)(ws + WS_WA); bf16_t* WAA = WAE + (size_t)2 * NROW * 256; float* YSC = (float*)(ws + WS_YSC); \
  (void)ctl; (void)MOD; (void)XC; (void)BONUS; (void)H; (void)Z; (void)YS; (void)WAE; (void)WAA; (void)YSC; \
  int tid; asm volatile("v_mbcnt_lo_u32_b32 %0, -1, 0\n\tv_mbcnt_hi_u32_b32 %0, -1, %0" : "=v"(tid)); tid += wave0_ * 64; const int lane = tid & 63, wave = __builtin_amdgcn_readfirstlane(tid >> 6); const int gw = bx * 8 + wave; (void)lane; (void)gw;
#define FRESH_TID(v) int v; asm volatile("v_mbcnt_lo_u32_b32 %0, -1, 0\n\tv_mbcnt_hi_u32_b32 %0, -1, %0" : "=v"(v)); v += wave0_ * 64;
#define PHASE_END } if (ph >= lo && ph + 1 < hi) { FRESH_TID(tb_) const CAS4 Args* Ab_ = (const CAS4 Args*)__builtin_amdgcn_kernarg_segment_ptr(); asm volatile("" : "+s"(Ab_)); for (int bi_ = 0; bi_ < NBARX; ++bi_) { ++nbar_; grid_barrier2((unsigned*)(Ab_->ws + WS_CTL), (unsigned)nbar_, G, bx, tb_); } } ++ph;

  PHASE_BEGIN(0)
    {
      LAS float* sl = (LAS float*)(lds + 72 * 1024);
      for (int i = tid; i < 3 * 1024; i += NTHREADS) { const int s = i >> 10, k = i & 1023;
        const float c = (s < 2) ? A.in[I_C][s * 1024 + k] : A.in[I_CCTX][k]; sl[i] = c * sigmoidf_(c); }
      __syncthreads();
      LAS float* red = (LAS float*)(lds + 88 * 1024);
      for (int it = bx; it < NLAYER * 96; it += G) {
        const int l = it / 96, c0 = (it % 96) * 64;
        const float* wp = A.in[I_ADAW] + (size_t)l * 1024 * 6144 + c0 + lane;
        float a0 = 0.f, a1 = 0.f, a2 = 0.f;
        for (int k = wave * 128; k < wave * 128 + 128; ++k) { const float w = wp[(size_t)k * 6144]; a0 += sl[k] * w; a1 += sl[1024 + k] * w; a2 += sl[2048 + k] * w; }
        red[(wave * 3 + 0) * 64 + lane] = a0; red[(wave * 3 + 1) * 64 + lane] = a1; red[(wave * 3 + 2) * 64 + lane] = a2;
        __syncthreads();
        if (tid < 192) { const int s = tid >> 6, ln = tid & 63; float r = A.in[I_ADAB][l * 6144 + c0 + ln];
          for (int w = 0; w < 8; ++w) r += red[(w * 3 + s) * 64 + ln];
          MOD[((size_t)(l * 3 + s)) * 6144 + c0 + ln] = r; }
        __syncthreads();
      }
    }
    convert_weights(A, 0, lds, gw, NGW, wave, lane);
  PHASE_END

  PHASE_BEGIN(1)
    for (int row = gw; row < NROW; row += NGW) {
      const int s = (row < NLAT) ? (row >> 14) : 2;
      const float* xo = (row < NLAT) ? A.in[I_X] + (size_t)row * 1024 : A.in[I_CTX] + (size_t)(row - NLAT) * 1024;
      const float* md = MOD + (size_t)(0 * 3 + s) * 6144;
      row_phase(xo, nullptr, nullptr, nullptr, nullptr, H + (size_t)row * 1024, A.in[I_NMIXPRE], md, md + 1024, lane);
    }
  PHASE_END

  for (int l = 0; l < NLAYER; ++l) {
    PHASE_BEGIN(2)
      pg8::Gemm g{(const char*)ws, 1024, 1024};
      pg8::SchedPlain S{130, 5, G, bx, 16, (long)WS_H, (long)(WS_W + W_IN), 1024, 1024, 7};
      pg8::EpiStore E{Z, DIN};
      pg8::gemm_phase<pg8::EpiStore, pg8::SchedPlain, false>(lds, g, S, E, tid);
    PHASE_END

    PHASE_BEGIN(3)
      {
        FRESH_TID(tid)
        const int ln = tid & 63, wv = __builtin_amdgcn_readfirstlane(tid >> 6), d = wv >> 2, nq = wv & 3, r32 = ln & 31, hi = ln >> 5;
        LAS unsigned char* AT = lds;
        const float* mu = A.in[I_MU] + (size_t)l * 2 * 896;
        bf16x8 Bf[2][2][4]; float bias0[2], bias1[2];
#pragma unroll
        for (int nt = 0; nt < 2; ++nt) {
          const int c = 64 * nq + 32 * nt + r32;
          bias0[nt] = A.in[I_W0][(l * 2 + d) * 256 + c]; bias1[nt] = A.in[I_A0][(l * 2 + d) * 256 + c];
#pragma unroll
          for (int ks = 0; ks < 4; ++ks) { float f0[8], f1[8];
#pragma unroll
            for (int i = 0; i < 8; ++i) { const size_t o = ((size_t)(l * 2 + d) * 64 + 16 * ks + 8 * hi + i) * 256 + c; f0[i] = A.in[I_W2][o]; f1[i] = A.in[I_A2][o]; }
            Bf[0][nt][ks] = __builtin_bit_cast(bf16x8, pack8(f0)); Bf[1][nt][ks] = __builtin_bit_cast(bf16x8, pack8(f1)); }
        }
        for (int tile = bx; tile < 520; tile += G) {
          const int R0 = tile * 64;
          __syncthreads();
          for (int i = tid; i < 2 * 64 * 16; i += NTHREADS) {
            const int dd = i >> 10, rem = i & 1023, r = rem >> 4, j8 = (rem & 15) * 8, row = R0 + r; int t, len; row_seq(row, t, len);
            const int nb = dd ? t + 1 : t - 1; const bool nv = (nb >= 0) && (nb < len);
            float zc[8], zn[8];
            unpack8(*(const u32x4*)(Z + (size_t)row * DIN + C_LW + j8), zc);
            if (nv) unpack8(*(const u32x4*)(Z + (size_t)(row + (dd ? 1 : -1)) * DIN + C_LW + j8), zn);
            else {
#pragma unroll
              for (int e = 0; e < 8; ++e) zn[e] = 0.f; }
            const f32x4 m0 = *(const f32x4*)(mu + dd * 896 + 768 + j8), m1 = *(const f32x4*)(mu + dd * 896 + 768 + j8 + 4);
            float v[8];
#pragma unroll
            for (int e = 0; e < 8; ++e) { v[e] = zc[e] + (e < 4 ? m0[e] : m1[e - 4]) * (zn[e] - zc[e]); if (j8 < 64) v[e] = 1.f - 2.f * __builtin_amdgcn_rcpf(__builtin_amdgcn_exp2f(2.8853900817779268f * v[e]) + 1.f); }
            *(LAS u32x4*)(AT + ((dd * 2 + (j8 >> 6)) * 64 + r) * 144 + (j8 & 63) * 2) = pack8(v);
          }
          __syncthreads();
          f32x16 acc[2][2][2];
#pragma unroll
          for (int m = 0; m < 2; ++m)
#pragma unroll
            for (int mt = 0; mt < 2; ++mt)
#pragma unroll
              for (int nt = 0; nt < 2; ++nt) acc[m][mt][nt] = f32x16{};
#pragma unroll
          for (int m = 0; m < 2; ++m)
#pragma unroll
            for (int mt = 0; mt < 2; ++mt)
#pragma unroll
              for (int ks = 0; ks < 4; ++ks) {
                const bf16x8 af = *(const LAS bf16x8*)(AT + ((d * 2 + m) * 64 + 32 * mt + r32) * 144 + (16 * ks + 8 * hi) * 2);
#pragma unroll
                for (int nt = 0; nt < 2; ++nt) acc[m][mt][nt] = __builtin_amdgcn_mfma_f32_32x32x16_bf16(af, Bf[m][nt][ks], acc[m][mt][nt], 0, 0, 0);
              }
#pragma unroll
          for (int mt = 0; mt < 2; ++mt)
#pragma unroll
            for (int nt = 0; nt < 2; ++nt) {
              const int c = 64 * nq + 32 * nt + r32;
#pragma unroll
              for (int r = 0; r < 16; ++r) {
                const int row = R0 + 32 * mt + (r & 3) + 8 * (r >> 2) + 4 * hi;
                const float aw = acc[0][mt][nt][r] + bias0[nt], aa = acc[1][mt][nt][r] + bias1[nt];
                const float xx = -aw; const float sp = fmaxf(xx, 0.f) + __logf(1.f + __expf(-fabsf(xx)));
                const float e = -__expf(-sp - 0.5f);
                const float av = sigmoidf_(aa);
                const size_t o = ((size_t)d * NROW + row) * 256 + c;
                WAE[o] = (bf16_t)(cvtpk(e, 0.f) & 0xffffu); WAA[o] = (bf16_t)(cvtpk(av, 0.f) & 0xffffu);
              }
            }
        }
        __syncthreads();
      }
    PHASE_END

    PHASE_BEGIN(4)
#ifndef NO_SCAN
#ifndef REP_SCAN
#define REP_SCAN 1
#endif
#ifndef REP_ATTN
#define REP_ATTN 1
#endif
      if (bx < 64 && (rep_ == 0 || REP_SCAN)) {
        const int sb = bx, s = sb >> 2, qd = sb & 3, d = s >> 3, b = (s >> 2) & 1, hh = s & 3;
        LAS float* buf = (LAS float*)lds;
        float muR[8], muK[8], muV[8], kkc[8], kac[8], rkc[8];
        const int ptid = tid & 255, ts = (ptid >> 3) & 31, cgp = ptid & 7, ch0 = hh * 64 + 8 * cgp;
        {
#pragma unroll
          for (int i = 0; i < 8; ++i) { const float* mu = A.in[I_MU] + (size_t)(l * 2 + d) * 896;
            muR[i] = mu[ch0 + i]; muK[i] = mu[256 + ch0 + i]; muV[i] = mu[512 + ch0 + i];
            kkc[i] = A.in[I_KK][l * 256 + ch0 + i]; kac[i] = A.in[I_KA][l * 256 + ch0 + i]; rkc[i] = A.in[I_RK][l * 256 + ch0 + i]; }
        }
        const int rsub = lane >> 4, kg = lane & 15, vrow = 16 * qd + 4 * (wave & 3) + rsub;
#define SCAN_RLO(cc) (((cc) < 8) ? (NLAT + b * CTXL + (d ? 224 - 32 * (cc) : 32 * (cc))) : (b * TLAT + (d ? 16352 - 32 * ((cc) - 8) : 32 * ((cc) - 8))))
        const unsigned ro = (unsigned)(d ? 31 - ts : ts);
        const unsigned offz = ro * DIN + ch0, offw = ro * 256 + ch0;
        const unsigned roy = (unsigned)(d ? 31 - (ptid >> 3) : (ptid >> 3)), offy = roy * 256 + hh * 64 + 16 * qd + (ptid & 7) * 2;
#define SCAN_LOAD(cc, X) do { const int rlo_ = SCAN_RLO(cc); const bool nv = !((((cc) == 0) || ((cc) == 8)) && ts == 0); \
          const bf16_t* zb = Z + (size_t)rlo_ * DIN; const bf16_t* znb = zb + (d ? DIN : -DIN); const u32x4 z4 = (u32x4){0u, 0u, 0u, 0u}; \
          X[0] = *(const u32x4*)(zb + (offz + C_RR)); X[1] = *(const u32x4*)(zb + (offz + C_RK)); X[2] = *(const u32x4*)(zb + (offz + C_RV)); \
          X[3] = nv ? *(const u32x4*)(znb + (offz + C_RR)) : z4; X[4] = nv ? *(const u32x4*)(znb + (offz + C_RK)) : z4; X[5] = nv ? *(const u32x4*)(znb + (offz + C_RV)) : z4; \
          const bf16_t* wb_ = WAE + ((size_t)d * NROW + rlo_) * 256; const bf16_t* ab_ = WAA + ((size_t)d * NROW + rlo_) * 256; \
          X[6] = *(const u32x4*)(wb_ + offw); X[7] = *(const u32x4*)(ab_ + offw); } while (0)
#define SCAN_PREP(cc, X) do { const int rlo_ = SCAN_RLO(cc); \
          float r8[8], k8[8], v8[8], rn[8], kn[8], vn[8], e8[8], a8[8]; \
          unpack8(X[0], r8); unpack8(X[1], k8); unpack8(X[2], v8); unpack8(X[3], rn); unpack8(X[4], kn); unpack8(X[5], vn); unpack8(X[6], e8); unpack8(X[7], a8); \
          float kkv[8], ssq = 0.f, bsum = 0.f; \
          _Pragma("unroll") for (int i = 0; i < 8; ++i) { r8[i] += muR[i] * (rn[i] - r8[i]); k8[i] += muK[i] * (kn[i] - k8[i]); v8[i] += muV[i] * (vn[i] - v8[i]); \
            kkv[i] = k8[i] * kkc[i]; ssq += kkv[i] * kkv[i]; } \
          ssq = red8(ssq); \
          const float inv = __builtin_amdgcn_rsqf(fmaxf(ssq, 1e-24f)); \
          float wv[8], bb[8], kp[8]; \
          _Pragma("unroll") for (int i = 0; i < 8; ++i) { kkv[i] *= inv; kp[i] = k8[i] * (1.f + (a8[i] - 1.f) * kac[i]); bb[i] = kkv[i] * a8[i]; wv[i] = __expf(e8[i]); bsum += r8[i] * kp[i] * rkc[i]; } \
          bsum = red8(bsum); \
          if (qd == 0 && cgp == 0) (BONUS + ((size_t)d * NROW + rlo_) * 4)[ro * 4 + hh] = bsum; \
          LAS float* db = buf + ((cc) & 1) * (6 * 32 * 64) + ts * 64 + 8 * cgp; \
          *(LAS f32x4*)(db + 0 * 2048) = (f32x4){wv[0], wv[1], wv[2], wv[3]}; *(LAS f32x4*)(db + 0 * 2048 + 4) = (f32x4){wv[4], wv[5], wv[6], wv[7]}; \
          *(LAS f32x4*)(db + 1 * 2048) = (f32x4){kkv[0], kkv[1], kkv[2], kkv[3]}; *(LAS f32x4*)(db + 1 * 2048 + 4) = (f32x4){kkv[4], kkv[5], kkv[6], kkv[7]}; \
          *(LAS f32x4*)(db + 2 * 2048) = (f32x4){bb[0], bb[1], bb[2], bb[3]}; *(LAS f32x4*)(db + 2 * 2048 + 4) = (f32x4){bb[4], bb[5], bb[6], bb[7]}; \
          *(LAS f32x4*)(db + 3 * 2048) = (f32x4){kp[0], kp[1], kp[2], kp[3]}; *(LAS f32x4*)(db + 3 * 2048 + 4) = (f32x4){kp[4], kp[5], kp[6], kp[7]}; \
          *(LAS f32x4*)(db + 4 * 2048) = (f32x4){r8[0], r8[1], r8[2], r8[3]}; *(LAS f32x4*)(db + 4 * 2048 + 4) = (f32x4){r8[4], r8[5], r8[6], r8[7]}; \
          *(LAS f32x4*)(db + 5 * 2048) = (f32x4){v8[0], v8[1], v8[2], v8[3]}; *(LAS f32x4*)(db + 5 * 2048 + 4) = (f32x4){v8[4], v8[5], v8[6], v8[7]}; \
        } while (0)
#define SCAN_YOUT(cc) do { const int rlo_ = SCAN_RLO(cc); const int step_ = ptid >> 3, r2_ = (ptid & 7) * 2; \
          const LAS f32x4* yp_ = (const LAS f32x4*)(ybuf + ((cc) & 1) * 2048 + step_ * 64 + r2_ * 4); const f32x4 y0_ = yp_[0], y1_ = yp_[1]; \
          const f32x2 yv = (f32x2){(y0_[0] + y0_[1]) + (y0_[2] + y0_[3]), (y1_[0] + y1_[1]) + (y1_[2] + y1_[3])}; \
          *(f32x2*)(YSC + ((size_t)d * NROW + rlo_) * 256 + offy) = yv; } while (0)
        LAS float* ybuf = buf + 2 * 6 * 32 * 64;
        u32x4 RA[8], RB[8];
        __syncthreads();
        SCAN_LOAD(0, RA);
        if (wave >= 4) SCAN_PREP(0, RA);
        SCAN_LOAD(1, RA);
#pragma unroll
        for (int i = 0; i < 8; ++i) RB[i] = RA[i];
        __syncthreads();
        f32x2 Sa = (f32x2){0.f, 0.f}, Sb = (f32x2){0.f, 0.f};
        for (int cc = 0; cc < 520; ++cc) {
          if (wave >= 4) {
            if (cc + 2 < 520) SCAN_LOAD(cc + 2, RB);
            if (cc + 1 < 520) SCAN_PREP(cc + 1, RA);
            if (cc > 0) SCAN_YOUT(cc - 1);
#pragma unroll
            for (int i = 0; i < 8; ++i) RA[i] = RB[i];
          } else {
            const LAS float* sbuf = buf + (cc & 1) * (6 * 32 * 64) + 4 * kg;
            LAS float* yb = ybuf + (cc & 1) * 2048 + (4 * wave + rsub) * 4 + (kg >> 2);
            f32x4 W4 = *(const LAS f32x4*)(sbuf + 0 * 2048), K4 = *(const LAS f32x4*)(sbuf + 1 * 2048), B4 = *(const LAS f32x4*)(sbuf + 2 * 2048),
                  P4 = *(const LAS f32x4*)(sbuf + 3 * 2048), R4 = *(const LAS f32x4*)(sbuf + 4 * 2048);
            float vv = sbuf[5 * 2048 - 4 * kg + vrow];
            f32x4 Rp = R4;
#pragma unroll
            for (int st = 0; st < 32; ++st) {
              const int sn = (st + 1) & 31;
              const LAS float* sp = sbuf + sn * 64;
              const f32x4 W4n = *(const LAS f32x4*)(sp + 0 * 2048), K4n = *(const LAS f32x4*)(sp + 1 * 2048), B4n = *(const LAS f32x4*)(sp + 2 * 2048),
                          P4n = *(const LAS f32x4*)(sp + 3 * 2048), R4n = *(const LAS f32x4*)(sp + 4 * 2048);
              const float vvn = sp[5 * 2048 - 4 * kg + vrow];
              f32x2 p = Sa * (f32x2){K4[0], K4[1]}; p = __builtin_elementwise_fma(Sb, (f32x2){K4[2], K4[3]}, p);
              float sa = p[0] + p[1];
              if (st > 0) {
                f32x2 q = Sa * (f32x2){Rp[0], Rp[1]}; q = __builtin_elementwise_fma(Sb, (f32x2){Rp[2], Rp[3]}, q);
                float yq = q[0] + q[1]; yq += DPPF(yq, 0xB1); yq += DPPF(yq, 0x4E);
                yb[(st - 1) * 64] = yq;
              }
              sa = allreduce16(sa);
              const f32x2 vv2 = (f32x2){vv, vv}, nsa = (f32x2){-sa, -sa};
              f32x2 ta = __builtin_elementwise_fma(nsa, (f32x2){B4[0], B4[1]}, vv2 * (f32x2){P4[0], P4[1]});
              f32x2 tb = __builtin_elementwise_fma(nsa, (f32x2){B4[2], B4[3]}, vv2 * (f32x2){P4[2], P4[3]});
              Sa = __builtin_elementwise_fma(Sa, (f32x2){W4[0], W4[1]}, ta);
              Sb = __builtin_elementwise_fma(Sb, (f32x2){W4[2], W4[3]}, tb);
              Rp = R4;
              W4 = W4n; K4 = K4n; B4 = B4n; P4 = P4n; R4 = R4n; vv = vvn;
            }
            { f32x2 q = Sa * (f32x2){Rp[0], Rp[1]}; q = __builtin_elementwise_fma(Sb, (f32x2){Rp[2], Rp[3]}, q);
              float yq = q[0] + q[1]; yq += DPPF(yq, 0xB1); yq += DPPF(yq, 0x4E);
              yb[31 * 64] = yq; }
          }
          __syncthreads();
        }
        if (wave >= 4) SCAN_YOUT(519);
        __syncthreads();
#undef SCAN_LOAD
#undef SCAN_YOUT
#undef SCAN_PREP
#undef SCAN_RLO
      }
#endif
#ifndef NO_ATTN
      if (bx >= 64) {
        {
          FRESH_TID(tid)
          pg8::Gemm g{(const char*)ws, 1024, 1024};
          pg8::SchedPlain S{130, 7, 192, bx - 64, 16, (long)WS_H, (long)(WS_W + W_IN), 1024, 1024, 0};
          pg8::EpiStore E{Z, DIN};
          pg8::gemm_phase<pg8::EpiStore, pg8::SchedPlain, false>(lds, g, S, E, tid);
        }
        { FRESH_TID(tb1_) grid_barrier(ctl + 16, 192u * (unsigned)(2 * l + 1), tb1_); }
      {
        const float* qn = A.in[I_QNORM] + l * 64; const float* kn = A.in[I_KNORM] + l * 64;
        for (long idx = (long)(bx - 64) * NTHREADS + tid; idx < (long)NROW * 48; idx += (long)192 * NTHREADS) {
          const int part = (int)(idx & 7), h6 = (int)((idx >> 3) % 6), row = (int)(idx / 48);
          bf16_t* p = Z + (size_t)row * DIN + C_GQ + 64 * h6 + 8 * part;
          float f[8]; unpack8(*(const u32x4*)p, f);
          float ss = 0.f;
#pragma unroll
          for (int i = 0; i < 8; ++i) ss += f[i] * f[i];
          ss = red8(ss);
          const float rs = __builtin_amdgcn_rsqf(ss * (1.f / 64.f) + 1e-6f);
          const bool isq = h6 < 4; const float* nw = isq ? qn : kn; const float scl = isq ? C2 : 1.f;
#pragma unroll
          for (int i = 0; i < 8; ++i) f[i] = f[i] * rs * nw[8 * part + i] * scl;
          if (row < NLAT) {
            const int t = row & (TLAT - 1); const float gr = (float)(t >> 6), gc = (float)(t & 63);
#pragma unroll
            for (int pp = 0; pp < 4; ++pp) { const int pi = 4 * part + pp;
              const float invf = exp2f(-(float)(pi & 15) * (13.287712379549449f / 16.f));
              const float ang = (pi < 16 ? gr : gc) * invf; const float cs = __cosf(ang), sn = __sinf(ang);
              const float x1 = f[2 * pp], x2 = f[2 * pp + 1]; f[2 * pp] = x1 * cs - x2 * sn; f[2 * pp + 1] = x1 * sn + x2 * cs; }
          }
          *(u32x4*)p = pack8(f);
        }
      }
      {
        FRESH_TID(tid)
        const float* cw = A.in[I_CONVA] + l * 3 * 256;
        for (long idx = (long)(bx - 64) * NTHREADS + tid; idx < (long)NROW * 32; idx += (long)192 * NTHREADS) {
          const int g8 = (int)(idx & 31), row = (int)(idx >> 5); int t, len; row_seq(row, t, len);
          const bf16_t* zr = Z + (size_t)row * DIN;
          { bf16_t* qp = Z + (size_t)row * DIN + C_NAQ + 8 * g8; float f[8]; unpack8(*(const u32x4*)qp, f);
#pragma unroll
            for (int i = 0; i < 8; ++i) f[i] *= C2;
            *(u32x4*)qp = pack8(f); }
          float bg[8], c0[8], x0[8], c1[8], x1[8], c2[8], x2[8];
          unpack8(*(const u32x4*)(zr + 8 * g8), bg);
          unpack8(*(const u32x4*)(zr + 256 + 8 * g8), c1); unpack8(*(const u32x4*)(zr + 512 + 8 * g8), x1);
          if (t > 0) { unpack8(*(const u32x4*)(zr - DIN + 256 + 8 * g8), c0); unpack8(*(const u32x4*)(zr - DIN + 512 + 8 * g8), x0); }
          else {
#pragma unroll
            for (int i = 0; i < 8; ++i) { c0[i] = 0.f; x0[i] = 0.f; } }
          if (t < len - 1) { unpack8(*(const u32x4*)(zr + DIN + 256 + 8 * g8), c2); unpack8(*(const u32x4*)(zr + DIN + 512 + 8 * g8), x2); }
          else {
#pragma unroll
            for (int i = 0; i < 8; ++i) { c2[i] = 0.f; x2[i] = 0.f; } }
          float o[8];
#pragma unroll
          for (int i = 0; i < 8; ++i) { const int c = 8 * g8 + i; o[i] = bg[i] * (cw[c] * (c0[i] * x0[i]) + cw[256 + c] * (c1[i] * x1[i]) + cw[512 + c] * (c2[i] * x2[i])); }
          *(u32x4*)(YS + (size_t)row * 1024 + 8 * g8) = pack8(o);
        }
      }
        { FRESH_TID(tb2_) grid_barrier(ctl + 16, 192u * (unsigned)(2 * l + 2), tb2_); }
      } else {
        FRESH_TID(tw_)
        if (tw_ == 0) { while (__hip_atomic_load(ctl + 16, __ATOMIC_RELAXED, __HIP_MEMORY_SCOPE_AGENT) < 192u * (unsigned)(2 * l + 2)) __builtin_amdgcn_s_sleep(2);
          __builtin_amdgcn_fence(__ATOMIC_ACQUIRE, "agent"); asm volatile("s_waitcnt vmcnt(0)" ::: "memory"); }
        __syncthreads();
      }
      if (rep_ == 0 || REP_ATTN) {
        FRESH_TID(tid)
        volatile LAS unsigned* misc = (volatile LAS unsigned*)(lds + 92 * 1024);
        const float* nab = A.in[I_NABIAS] + (size_t)l * 4 * 465;
        for (;;) {
          __syncthreads();
          if (tid == 0) misc[0] = atomicAdd(ctl + 64 + 64 * l + 32 * rep_, 1u);
          __syncthreads();
          int u = (int)misc[0];
          if (l == NLAYER - 1 && u >= 1024) u += 16;
          if (u >= 1296) break;
          if (u >= 1040) {
            LAS float* SG = (LAS float*)lds;
            const int R0 = (u - 1040) * 130;
            for (int i = tid; i < 130 * 16; i += NTHREADS) { const int r = i >> 4, j8 = (i & 15) * 8; float f[8];
              unpack8(*(const u32x4*)(Z + (size_t)(R0 + r) * DIN + C_LG + j8), f);
#pragma unroll
              for (int e = 0; e < 8; ++e) f[e] = sigmoidf_(f[e]);
              *(LAS f32x4*)(SG + r * 128 + j8) = (f32x4){f[0], f[1], f[2], f[3]}; *(LAS f32x4*)(SG + r * 128 + j8 + 4) = (f32x4){f[4], f[5], f[6], f[7]}; }
            const int half = tid >> 8, c = tid & 255;
            float g2c[128];
#pragma unroll
            for (int j = 0; j < 128; ++j) g2c[j] = A.in[I_G2][((size_t)l * 128 + j) * 256 + c];
            __syncthreads();
            for (int r = half; r < 130; r += 2) {
              const LAS f32x4* sp = (const LAS f32x4*)(SG + r * 128);
              float gate = 0.f;
#pragma unroll
              for (int j4 = 0; j4 < 32; ++j4) { const f32x4 x = sp[j4]; gate += x[0] * g2c[4 * j4] + x[1] * g2c[4 * j4 + 1] + x[2] * g2c[4 * j4 + 2] + x[3] * g2c[4 * j4 + 3]; }
              YS[(size_t)(R0 + r) * 1024 + 768 + c] = (bf16_t)(cvtpk(gate, 0.f) & 0xffffu);
            }
            continue;
          }
          attn_body::TileMap tm; attn_body::NaInfo na{0, 0};
          const bf16_t *Qp, *Kp, *Vp; bf16_t* Op; int mode = 0;
          if (u < 512) {
            const int qb = u & 63, g2 = (u >> 6) & 1, kvh = (u >> 7) & 1, b = u >> 8, h = kvh * 2 + g2;
            tm = {256, b * TLAT, NLAT + b * CTXL, 260};
            const size_t q0 = (size_t)b * TLAT + qb * 256;
            Qp = Z + q0 * DIN + C_GQ + 64 * h; Kp = Z + C_GK + 64 * kvh; Vp = Z + C_GV + 64 * kvh; Op = YS + q0 * 1024 + 512 + 64 * h;
          } else if (u < 1024) {
            const int v = u - 512, ig = v & 63, h = (v >> 6) & 3, b = v >> 8, i0 = 4 * ig;
            int rmin = min(max(i0 - 4, 0), 248), rmax = min(max(i0 + 3 - 4, 0), 248) + 7;
            if (((rmax - rmin + 1) & 1) != 0) { if (rmax < 255) ++rmax; else --rmin; }
            tm = {4, NLAT + b * CTXL, b * TLAT + 64 * rmin, 4 + (rmax - rmin + 1)};
            na = {i0, rmin}; mode = 1;
            if (tid < 512) ((LAS float*)(lds + attn_body::LDS_BIAS))[tid] = (tid < 465) ? nab[h * 465 + tid] * LOG2E : 0.f;
            const size_t q0 = (size_t)b * TLAT + i0 * 64;
            Qp = Z + q0 * DIN + C_NAQ + 64 * h; Kp = Z + C_NAK + 64 * h; Vp = Z + C_NAV + 64 * h; Op = YS + q0 * 1024 + 256 + 64 * h;
          } else {
            const int v = u - 1024, isna = v >> 3, h = v & 3, b = (v >> 2) & 1;
            const size_t q0 = (size_t)NLAT + b * CTXL;
            tm = {4, NLAT + b * CTXL, 0, 4};
            if (isna) { Qp = Z + q0 * DIN + C_NAQ + 64 * h; Kp = Z + C_NAK + 64 * h; Vp = Z + C_NAV + 64 * h; Op = YS + q0 * 1024 + 256 + 64 * h; }
            else { Qp = Z + q0 * DIN + C_GQ + 64 * h; Kp = Z + C_GK + 64 * (h >> 1); Vp = Z + C_GV + 64 * (h >> 1); Op = YS + q0 * 1024 + 512 + 64 * h; }
          }
#ifndef NO_M1
          if (mode) { FRESH_TID(t1_) attn_body::attn_unit<1, 8>(Qp, Kp, Vp, Op, tm, na, (char*)lds_raw, t1_); }
#endif
#ifndef NO_M0
          if (!mode) { FRESH_TID(t0_) attn_body::attn_unit<0, 8>(Qp, Kp, Vp, Op, tm, na, (char*)lds_raw, t0_); }
#endif
        }
      }
#endif
    PHASE_END

    PHASE_BEGIN(5)
      {
        const int half = tid >> 8, c = tid & 255, hh = c >> 6;
        const float lnw = A.in[I_LNW][l * 256 + c], lnb = A.in[I_LNB][l * 256 + c];
        const float mv0 = A.in[I_MU][(size_t)(l * 2 + 0) * 896 + 512 + c], mv1 = A.in[I_MU][(size_t)(l * 2 + 1) * 896 + 512 + c];
        for (int tile = bx; tile < 256; tile += G) {
          const int R0 = tile * 130;
#pragma unroll 2
          for (int r = half; r < 130; r += 2) {
            const int row = R0 + r; int t, len; row_seq(row, t, len);
            const float y = YSC[((size_t)0 * NROW + row) * 256 + c] + YSC[((size_t)1 * NROW + row) * 256 + c];
            const bf16_t* zr = Z + (size_t)row * DIN + C_RV + c;
            const float zv = bf2f(zr[0]), zp = (t > 0) ? bf2f(zr[-DIN]) : 0.f, zq = (t < len - 1) ? bf2f(zr[DIN]) : 0.f;
            const float b0 = BONUS[((size_t)0 * NROW + row) * 4 + hh], b1 = BONUS[((size_t)1 * NROW + row) * 4 + hh];
            const float gate = bf2f(YS[(size_t)row * 1024 + 768 + c]);
            const float mean = wave_sum(y, lane) * (1.f / 64.f); const float dv = y - mean; const float var = wave_sum(dv * dv, lane) * (1.f / 64.f);
            const float yn = dv * __builtin_amdgcn_rsqf(var + 64e-5f) * lnw + lnb;
            const float v0 = zv + mv0 * (zp - zv), v1 = zv + mv1 * (zq - zv);
            const float bon = b0 * v0 + b1 * v1;
            YS[(size_t)row * 1024 + 768 + c] = (bf16_t)(cvtpk((yn + bon) * gate, 0.f) & 0xffffu);
          }
        }
      }
    PHASE_END

    PHASE_BEGIN(6)
      pg8::Gemm g{(const char*)ws, 1024, 1024};
      pg8::SchedMerge S{G, bx, (l == NLAYER - 1) ? 128 : 130};
      pg8::EpiMerge E{ws + WS_PSCR, A.in[I_BGATE] + (size_t)l * 4096, (bf16_t*)(ws + WS_ACCM)};
      pg8::gemm_phase<pg8::EpiMerge, pg8::SchedMerge, false>(lds, g, S, E, tid);
    PHASE_END

    PHASE_BEGIN(7)
      pg8::Gemm g{(const char*)ws, 1024, 1024};
      pg8::SchedPlain S{(l == NLAYER - 1) ? 128 : 130, 4, G, bx, 16, (long)WS_ACCM, (long)(WS_W + W_O), 1024, 1024, 0};
      pg8::EpiStore E{(bf16_t*)(ws + WS_MBUF), 1024};
      pg8::gemm_phase<pg8::EpiStore, pg8::SchedPlain, false>(lds, g, S, E, tid);
    PHASE_END

    PHASE_BEGIN(8)
      for (int vb_ = bx; vb_ < 256; vb_ += G)
      row_phase_blk((l == 0) ? A.in[I_X] : (const float*)A.out, (l == 0) ? A.in[I_CTX] : (const float*)XC, A.out, XC, (const bf16_t*)(ws + WS_MBUF),
                    MOD + (size_t)l * 3 * 6144, 2 * 1024, A.in[I_NMIXPOST] + l * 1024, H, A.in[I_NFFNPRE] + l * 1024, MOD + (size_t)l * 3 * 6144, 3 * 1024, 4 * 1024, vb_, wave, lane);
    PHASE_END

    PHASE_BEGIN(9)
      pg8::Gemm g{(const char*)ws, 1024, 1024};
      pg8::SchedUp S{G, bx, (l == NLAYER - 1) ? 134 : 138};
      pg8::EpiConvGlu E{(bf16_t*)(ws + WS_G), A.in[I_FCONV] + (size_t)l * 3 * 5632};
      pg8::gemm_phase<pg8::EpiConvGlu, pg8::SchedUp, true>(lds, g, S, E, tid);
    PHASE_END

    PHASE_BEGIN(10)
      pg8::Gemm g{(const char*)ws, DFF, DFF};
      pg8::SchedPlain S{(l == NLAYER - 1) ? 128 : 130, 4, G, bx, 44, (long)WS_G, (long)(WS_W + W_DN), DFF, DFF, 0};
      pg8::EpiStore E{(bf16_t*)(ws + WS_F), 1024};
      pg8::gemm_phase<pg8::EpiStore, pg8::SchedPlain, false>(lds, g, S, E, tid);
    PHASE_END

    PHASE_BEGIN(11)
      for (int vb_ = bx; vb_ < 256; vb_ += G)
      row_phase_blk((const float*)A.out, (const float*)XC, A.out, XC, (const bf16_t*)(ws + WS_F),
                    MOD + (size_t)l * 3 * 6144, 5 * 1024, A.in[I_NFFNPOST] + l * 1024, (l < NLAYER - 1) ? H : (bf16_t*)nullptr, A.in[I_NMIXPRE] + ((l + 1) & 3) * 1024,
                    MOD + (size_t)((l + 1) & 3) * 3 * 6144, 0, 1024, vb_, wave, lane);
      if (l < NLAYER - 1) convert_weights(A, l + 1, lds, gw, NGW, wave, lane);
    PHASE_END
  }
}

constexpr int LDS_BYTES = 147456;
constexpr int NPHASES = 2 + NLAYER * 10;
extern "C" void kernel_launch(void* const* d_in, const int* in_sizes, int n_in, void* d_out, int out_size, void* d_ws, size_t ws_size, hipStream_t stream) {
  static int grid = 0;
  if (grid == 0) {
    int dev = 0, cus = 0, per_cu = 0;
    hipGetDevice(&dev);
    hipDeviceGetAttribute(&cus, hipDeviceAttributeMultiprocessorCount, dev);
    if (hipFuncSetAttribute((const void*)fwd_megakernel, hipFuncAttributeMaxDynamicSharedMemorySize, LDS_BYTES) != hipSuccess) fprintf(stderr, "kernel_launch: hipFuncSetAttribute failed\n");
    hipOccupancyMaxActiveBlocksPerMultiprocessor(&per_cu, (const void*)fwd_megakernel, NTHREADS, LDS_BYTES);
    (void)hipGetLastError();
    if (per_cu < 1) per_cu = 1;
    grid = cus;
    if (n_in != 33 || ws_size < WS_END) fprintf(stderr, "kernel_launch: unexpected n_in %d or ws %zu\n", n_in, ws_size);
  }
  (void)hipMemsetAsync((char*)d_ws + WS_CTL, 0, 8192, stream);
  Args a{};
  for (int i = 0; i < 33; ++i) a.in[i] = (const float*)d_in[i];
  a.out = (float*)d_out; a.ws = (unsigned char*)d_ws; a.ph_lo = 0; a.ph_hi = NPHASES;
  void* args[] = {&a};
  hipError_t e = hipLaunchCooperativeKernel((const void*)fwd_megakernel, dim3(grid), dim3(NTHREADS), args, LDS_BYTES, stream);
  if (e != hipSuccess) fprintf(stderr, "cooperative launch failed: %s (grid %d)\n", hipGetErrorString(e), grid);
}
```

```cpp
#include <hip/hip_runtime.h>
#include <hip/hip_cooperative_groups.h>
#include <hip/hip_bf16.h>
#include <cstdio>
#include <cstdint>
#include <cmath>
namespace cg = cooperative_groups;

#define DI __device__ __forceinline__
#define LAS __attribute__((address_space(3)))
#define CAS4 __attribute__((address_space(4)))
typedef unsigned short bf16_t;
typedef short bf16x8 __attribute__((ext_vector_type(8)));
typedef float f32x4 __attribute__((ext_vector_type(4)));
typedef float f32x2 __attribute__((ext_vector_type(2)));
typedef float f32x16 __attribute__((ext_vector_type(16)));
typedef unsigned u32x4 __attribute__((ext_vector_type(4)));
typedef short s16x4 __attribute__((ext_vector_type(4)));
typedef __bf16 bf16x2_t __attribute__((ext_vector_type(2)));

constexpr int DM = 1024, TLAT = 16384, NLAT = 32768, CTXL = 256, NROW = 33280, NLAYER = 4;
constexpr int DIN = 3072, DFF = 2816;
constexpr int C_NAQ = 768, C_NAK = 1024, C_NAV = 1280, C_GQ = 1536, C_GK = 1792, C_GV = 1920;
constexpr int C_RR = 2048, C_RK = 2304, C_RV = 2560, C_LW = 2816, C_LA = 2880, C_LG = 2944;
constexpr float C2 = 0.125f * 1.4426950408889634f;
constexpr float LOG2E = 1.4426950408889634f;
constexpr int NTHREADS = 512;

constexpr size_t MiB = 1u << 20;
constexpr size_t WS_CTL = 0, WS_MOD = 1 * MiB, WS_XC = 2 * MiB, WS_BONUS = 4 * MiB, WS_W = 6 * MiB;
constexpr size_t W_IN = 0, W_GATE = W_IN + (size_t)3072 * 1024 * 2, W_BR = W_GATE + (size_t)4096 * 1024 * 2, W_O = W_BR + (size_t)1024 * 1024 * 2,
                 W_UP = W_O + (size_t)1024 * 1024 * 2, W_DN = W_UP + (size_t)5632 * 1024 * 2, W_END = W_DN + (size_t)1024 * 2816 * 2;
static_assert(WS_W + W_END <= 42 * MiB, "weights");
constexpr size_t WS_H = 42 * MiB + 65536, WS_Z = 108 * MiB, WS_YS = 304 * MiB, WS_WA = 370 * MiB, WS_YSC = 436 * MiB, WS_END = 501 * MiB;
constexpr size_t WS_ACCM = WS_Z, WS_MBUF = WS_Z + 70 * MiB, WS_G = WS_Z, WS_F = WS_YS, WS_PSCR = WS_WA, WS_ASCR = WS_YSC;
constexpr size_t ROWB = (size_t)NROW * 1024 * 2;

DI float bf2f(unsigned u16) { return __uint_as_float(u16 << 16); }
DI unsigned cvtpk(float lo, float hi) { f32x2 v = {lo, hi}; bf16x2_t b = __builtin_convertvector(v, bf16x2_t); return __builtin_bit_cast(unsigned, b); }
DI void unpack8(const u32x4 w, float* f) {
#pragma unroll
  for (int i = 0; i < 4; ++i) { f[2 * i] = __uint_as_float(w[i] << 16); f[2 * i + 1] = __uint_as_float(w[i] & 0xffff0000u); }
}
DI u32x4 pack8(const float* f) { u32x4 w; w.x = cvtpk(f[0], f[1]); w.y = cvtpk(f[2], f[3]); w.z = cvtpk(f[4], f[5]); w.w = cvtpk(f[6], f[7]); return w; }
DI float sigmoidf_(float x) { return __builtin_amdgcn_rcpf(1.f + __builtin_amdgcn_exp2f(-1.4426950408889634f * x)); }
DI float dppf(float x, const int ctrl_dummy);
#define DPPF(x, CTRL) __int_as_float(__builtin_amdgcn_update_dpp(0, __float_as_int(x), (CTRL), 0xf, 0xf, false))
DI float allreduce16(float x) { x += DPPF(x, 0xB1); x += DPPF(x, 0x4E); x += DPPF(x, 0x141); x += DPPF(x, 0x140); return x; }
DI float red8(float x) { x += DPPF(x, 0xB1); x += DPPF(x, 0x4E); x += DPPF(x, 0x141); return x; }
DI float bperm(float v, int src_lane) { return __int_as_float(__builtin_amdgcn_ds_bpermute(src_lane << 2, __float_as_int(v))); }
DI float wave_sum(float v, int lane) { v = allreduce16(v); v += bperm(v, lane ^ 16); v += bperm(v, lane ^ 32); return v; }

DI void grid_barrier(unsigned* ctr, unsigned target, int tid) {
  __syncthreads();
  if (tid == 0) {
    __builtin_amdgcn_fence(__ATOMIC_RELEASE, "agent");
    __hip_atomic_fetch_add(ctr, 1u, __ATOMIC_RELAXED, __HIP_MEMORY_SCOPE_AGENT);
    while (__hip_atomic_load(ctr, __ATOMIC_RELAXED, __HIP_MEMORY_SCOPE_AGENT) < target) __builtin_amdgcn_s_sleep(1);
    __builtin_amdgcn_fence(__ATOMIC_ACQUIRE, "agent");
    asm volatile("s_waitcnt vmcnt(0)" ::: "memory");
  }
  __syncthreads();
}
DI void grid_barrier2(unsigned* ctl, unsigned k, int G, int bx, int tid) {
  __syncthreads();
  if (tid == 0) {
    __builtin_amdgcn_fence(__ATOMIC_RELEASE, "agent");
    const unsigned g = (unsigned)bx & 7u, gsize = ((unsigned)G - g + 7u) >> 3, ng = (G < 8) ? (unsigned)G : 8u;
    unsigned* grp = ctl + 512 + 64 * g; unsigned* top = ctl + 512 + 64 * 8; unsigned* gen = ctl + 512 + 64 * (9 + g);
    const unsigned old = __hip_atomic_fetch_add(grp, 1u, __ATOMIC_RELAXED, __HIP_MEMORY_SCOPE_AGENT);
    if (old + 1u == k * gsize) {
      const unsigned ot = __hip_atomic_fetch_add(top, 1u, __ATOMIC_RELAXED, __HIP_MEMORY_SCOPE_AGENT);
      if (ot + 1u == k * ng) { for (unsigned j = 0; j < ng; ++j) __hip_atomic_fetch_add(ctl + 512 + 64 * (9 + j), 1u, __ATOMIC_RELAXED, __HIP_MEMORY_SCOPE_AGENT); }
    }
    while (__hip_atomic_load(gen, __ATOMIC_RELAXED, __HIP_MEMORY_SCOPE_AGENT) < k) __builtin_amdgcn_s_sleep(1);
    __builtin_amdgcn_fence(__ATOMIC_ACQUIRE, "agent");
    asm volatile("s_waitcnt vmcnt(0)" ::: "memory");
  }
  __syncthreads();
}
DI void row_seq(int row, int& t, int& len) { if (row < NLAT) { t = row & (TLAT - 1); len = TLAT; } else { t = (row - NLAT) & (CTXL - 1); len = CTXL; } }

namespace pg8 {
constexpr int BM = 256, BK = 64, HALF = 128, HTB = HALF * BK * 2, STAGE_BYTES = 8 * HTB;
DI int lds_byte(int r, int c) { const int st = (r >> 4) * 2 + (c >> 5), rr = r & 15, cc = c & 31, ob = rr * 64 + cc * 2; return st * 1024 + (ob ^ (((ob >> 9) & 1) << 5)); }
DI void stage_rc(int b, int& R, int& C) { const int st = b / 1024, sb = b % 1024, swz = sb ^ (((sb >> 9) & 1) << 5); R = (st >> 1) * 16 + swz / 64; C = (st & 1) * 32 + (swz % 64) / 2; }
DI int perm32(int rho) { const int n = rho >> 4, i = rho & 15; return 8 * (i >> 2) + 4 * n + (i & 3); }

struct Unit { int pm, pn, nt, kind; };
struct Gemm { const char* base; int lda, ldb; };

template <class Epi, class Sched, bool CONV>
DI void gemm_phase(LAS unsigned char* lds, const Gemm g, const Sched& S, const Epi& E, int tid) {
    const int wid = __builtin_amdgcn_readfirstlane(tid >> 6), lane = tid & 63, wr = wid >> 2, wc = wid & 3, fr = lane & 15, fq = lane >> 4;
    unsigned voffA[2], voffB[2];
#pragma unroll
    for (int i = 0; i < 2; ++i) { int R, C; stage_rc(tid * 16 + i * 8192, R, C); const int Rb = (R & ~31) + perm32(R & 31);
        const int Ra = CONV ? (62 * (R >> 6) + (R & 63)) : R;
        voffA[i] = (unsigned)(Ra * g.lda + C) * 2u; voffB[i] = (unsigned)(Rb * g.ldb + C) * 2u; }
    constexpr int kstep = BK * 2;
    const int hstepA = (CONV ? 124 : HALF) * g.lda * 2, hstepB = HALF * g.ldb * 2;
    const unsigned ldsw = (unsigned)wid * 1024u;
    const int aoff = lds_byte(wr * 64 + fr, fq * 8), boff = lds_byte(wc * 32 + fr, fq * 8);
#define PG8_SA(b, h) (((b) * 2 + (h)) * HTB)
#define PG8_SB(b, h) ((4 + (b) * 2 + (h)) * HTB)
#define PG8_STAGE(bufoff, gbase, voff) do { _Pragma("unroll") for (int _i = 0; _i < 2; ++_i) \
        __builtin_amdgcn_global_load_lds((const unsigned*)((const char*)(gbase) + (voff)[_i]), (LAS unsigned*)(lds + (bufoff) + ldsw + _i * 8192), 16, 0, 0); } while (0)
#define PG8_LDA(dst, b, h) do { _Pragma("unroll") for (int m = 0; m < 4; ++m) _Pragma("unroll") for (int k = 0; k < 2; ++k) dst[m][k] = *(const LAS bf16x8*)(lds + PG8_SA(b, h) + aoff + m * 2048 + k * 1024); } while (0)
#define PG8_LDB(dst, b, h) do { _Pragma("unroll") for (int n = 0; n < 2; ++n) _Pragma("unroll") for (int k = 0; k < 2; ++k) dst[n][k] = *(const LAS bf16x8*)(lds + PG8_SB(b, h) + boff + n * 2048 + k * 1024); } while (0)
#define PG8_MMA(ai, bj, At, Bt) do { __builtin_amdgcn_s_setprio(1); _Pragma("unroll") for (int m = 0; m < 4; ++m) _Pragma("unroll") for (int n = 0; n < 2; ++n) _Pragma("unroll") for (int k = 0; k < 2; ++k) \
        acc[ai][bj][m][n] = __builtin_amdgcn_mfma_f32_16x16x32_bf16(Bt[n][k], At[m][k], acc[ai][bj][m][n], 0, 0, 0); __builtin_amdgcn_s_setprio(0); } while (0)
#define PG8_WAIT_V(n) asm volatile("s_waitcnt vmcnt(" #n ")" ::: "memory")
#define PG8_WAIT_L(n) asm volatile("s_waitcnt lgkmcnt(" #n ")" ::: "memory")
#define PG8_BAR __builtin_amdgcn_s_barrier()
#define PG8_SCHED __builtin_amdgcn_sched_barrier(0)
    Unit cur, nxt; int ui = 0; long ao_, bo_;
    if (!S.next(0, cur, ao_, bo_)) return;
    f32x4 acc[2][2][4][2];
#pragma unroll
    for (int a = 0; a < 2; ++a)
#pragma unroll
        for (int b = 0; b < 2; ++b)
#pragma unroll
            for (int m = 0; m < 4; ++m)
#pragma unroll
                for (int n = 0; n < 2; ++n) acc[a][b][m][n] = (f32x4){0.f, 0.f, 0.f, 0.f};
    bf16x8 At[4][2], B0[2][2], B1[2][2];
    const char* cA = g.base + ao_; const char* cB = g.base + bo_;
    PG8_STAGE(PG8_SB(0, 0), cB, voffB); PG8_STAGE(PG8_SB(0, 1), cB + hstepB, voffB); PG8_STAGE(PG8_SA(0, 0), cA, voffA); PG8_STAGE(PG8_SA(0, 1), cA + hstepA, voffA);
    if (wr == 1) PG8_BAR;
    PG8_WAIT_V(2); PG8_BAR;
    PG8_STAGE(PG8_SB(1, 0), cB + kstep, voffB); PG8_STAGE(PG8_SA(1, 0), cA + kstep, voffA); PG8_STAGE(PG8_SB(1, 1), cB + hstepB + kstep, voffB);
    PG8_WAIT_V(6); PG8_BAR;
    for (;;) {
        const bool has_next = S.next(ui + 1, nxt, ao_, bo_);
        const char* nA = has_next ? g.base + ao_ : cA; const char* nB = has_next ? g.base + bo_ : cB;
        const int nt = cur.nt;
        for (int t = 0; t < nt; t += 2) {
            const bool last = (t == nt - 2);
            const char* a1 = cA + (size_t)(t + 1) * kstep;
            const char* a2 = last ? nA : cA + (size_t)(t + 2) * kstep; const char* b2 = last ? nB : cB + (size_t)(t + 2) * kstep;
            const char* a3 = a2 + kstep; const char* b3 = b2 + kstep;
            PG8_LDB(B0, 0, 0); PG8_LDB(B1, 0, 1); PG8_SCHED; PG8_LDA(At, 0, 0); PG8_STAGE(PG8_SA(1, 1), a1 + hstepA, voffA);
            PG8_WAIT_V(8); PG8_WAIT_L(0); PG8_BAR; PG8_MMA(0, 0, At, B0); PG8_MMA(0, 1, At, B1); PG8_BAR; PG8_SCHED;
            PG8_LDA(At, 0, 1); PG8_STAGE(PG8_SB(0, 0), b2, voffB); PG8_STAGE(PG8_SB(0, 1), b2 + hstepB, voffB); PG8_STAGE(PG8_SA(0, 0), a2, voffA);
            PG8_WAIT_V(8); PG8_WAIT_L(0); PG8_BAR; PG8_MMA(1, 0, At, B0); PG8_MMA(1, 1, At, B1); PG8_BAR; PG8_SCHED;
            PG8_LDB(B0, 1, 0); PG8_LDB(B1, 1, 1); PG8_SCHED; PG8_LDA(At, 1, 0); PG8_STAGE(PG8_SA(0, 1), a2 + hstepA, voffA);
            PG8_WAIT_V(8); PG8_WAIT_L(0); PG8_BAR; PG8_MMA(0, 0, At, B0); PG8_MMA(0, 1, At, B1); PG8_BAR; PG8_SCHED;
            PG8_LDA(At, 1, 1); PG8_STAGE(PG8_SB(1, 0), b3, voffB); PG8_STAGE(PG8_SB(1, 1), b3 + hstepB, voffB); PG8_STAGE(PG8_SA(1, 0), a3, voffA);
            PG8_WAIT_V(8); PG8_WAIT_L(0); PG8_BAR; PG8_MMA(1, 0, At, B0); PG8_MMA(1, 1, At, B1); PG8_BAR; PG8_SCHED;
        }
        if (wr == 0) PG8_BAR;
        E(acc, cur, wr, wc, fr, fq);
        if (!has_next) break;
#pragma unroll
        for (int a = 0; a < 2; ++a)
#pragma unroll
            for (int b = 0; b < 2; ++b)
#pragma unroll
                for (int m = 0; m < 4; ++m)
#pragma unroll
                    for (int n = 0; n < 2; ++n) acc[a][b][m][n] = (f32x4){0.f, 0.f, 0.f, 0.f};
        cur = nxt; cA = nA; cB = nB; ++ui;
        if (wr == 1) PG8_BAR;
    }
    PG8_WAIT_V(0);
    PG8_BAR;
#undef PG8_SA
#undef PG8_SB
#undef PG8_STAGE
#undef PG8_LDA
#undef PG8_LDB
#undef PG8_MMA
#undef PG8_WAIT_V
#undef PG8_WAIT_L
#undef PG8_BAR
#undef PG8_SCHED
}

DI void xcd_tile(int L, int nM, int nN, int& pm, int& pn) {
    const int nwg = nM * nN; int wgid = L; { const int q = nwg / 8, r = nwg % 8, xcd = wgid % 8, off = wgid / 8; wgid = (xcd < r ? xcd * (q + 1) : r * (q + 1) + (xcd - r) * q) + off; }
    const int nig = 8 * nN, gid = wgid / nig, fm = gid * 8, gsz = (nM - fm) < 8 ? (nM - fm) : 8;
    pm = fm + ((wgid % nig) % gsz); pn = (wgid % nig) / gsz;
}
struct SchedPlain {
    int nM, nN, G, c, nt; long a0, b0; int lda, ldb, pn0;
    DI bool next(int i, Unit& u, long& a_off, long& b_off) const {
        const int L = i * G + c; if (L >= nM * nN) return false;
        xcd_tile(L, nM, nN, u.pm, u.pn); u.pn += pn0; a_off = a0 + (long)u.pm * 256 * lda * 2; b_off = b0 + (long)u.pn * 256 * ldb * 2; u.nt = nt; u.kind = 0; return true; }
};
struct SchedMerge {
    int G, c, nrt;
    DI bool next(int i, Unit& u, long& a_off, long& b_off) const {
        const int nr = (c < 512) ? (512 - c + G - 1) / G : 0;
        int sub;
        if (i < 8 * nr) { const int L = (i >> 3) * G + c; xcd_tile(L, 128, 4, u.pm, u.pn); sub = i & 7; }
        else { if (nrt != 130) return false;
            const int ii = i - 8 * nr, k = ii / 5, j = ii - 5 * k, qid = c + k * G; if (qid >= 32) return false;
            const int tq = qid >> 2, q = qid & 3; u.pm = 128 + (tq >> 2); u.pn = tq & 3; sub = (j < 4) ? j : 12 + q; }
        u.kind = sub;
        if (sub < 4) { a_off = (long)WS_YS + ((long)u.pm * 256 * 1024 + sub * 256) * 2; b_off = (long)(WS_W + W_BR) + ((long)u.pn * 256 * 1024 + sub * 256) * 2; u.nt = 4; }
        else { a_off = (long)WS_H + (long)u.pm * 256 * 1024 * 2; b_off = (long)(WS_W + W_GATE) + ((long)((u.pn * 4 + ((sub - 4) & 3)) * 256) * 1024) * 2; u.nt = 16; }
        return true; }
};
struct SchedUp {
    int G, c, ntm;
    DI static void tile_seq(int tm, int& base, int& len, int& j) {
        if (tm < 67) { base = 0; len = TLAT; j = tm; } else if (tm < 134) { base = TLAT; len = TLAT; j = tm - 67; }
        else { const int x = tm - 134; base = NLAT + (x >> 1) * CTXL; len = CTXL; j = x & 1; } }
    DI bool next(int i, Unit& u, long& a_off, long& b_off) const {
        const int L = i * G + c; if (L >= ntm * 22) return false;
        xcd_tile(L, ntm, 22, u.pm, u.pn); int base, len, j; tile_seq(u.pm, base, len, j);
        a_off = (long)WS_H + ((long)(base + 248 * j - 1) * 1024) * 2; b_off = (long)(WS_W + W_UP) + (long)u.pn * 256 * 1024 * 2; u.nt = 16; u.kind = 0; return true; }
};

struct EpiStore {
    bf16_t* O; int ldc;
    DI void operator()(const f32x4 (&acc)[2][2][4][2], const Unit& u, int wr, int wc, int fr_in, int fq_in) const {
        int ln_; asm volatile("v_mbcnt_lo_u32_b32 %0, -1, 0\n\tv_mbcnt_hi_u32_b32 %0, -1, %0" : "=v"(ln_)); const int fr = ln_ & 15, fq = ln_ >> 4; (void)fr_in; (void)fq_in;
        const int row0 = u.pm * 256 + wr * 64 + fr, col0 = u.pn * 256 + wc * 32 + 8 * fq;
#pragma unroll
        for (int ai = 0; ai < 2; ++ai)
#pragma unroll
            for (int m = 0; m < 4; ++m) { bf16_t* rowp = O + (size_t)(row0 + ai * 128 + m * 16) * ldc + col0;
#pragma unroll
                for (int bj = 0; bj < 2; ++bj) { const f32x4 v0 = acc[ai][bj][m][0], v1 = acc[ai][bj][m][1];
                    u32x4 w; w.x = cvtpk(v0[0], v0[1]); w.y = cvtpk(v0[2], v0[3]); w.z = cvtpk(v1[0], v1[1]); w.w = cvtpk(v1[2], v1[3]);
                    *(u32x4*)(rowp + bj * 128) = w; } }
    }
};
struct EpiMerge {
    unsigned char* stash; const float* bgate; bf16_t* O;
    DI void operator()(const f32x4 (&acc)[2][2][4][2], const Unit& u, int wr, int wc, int fr_in, int fq_in) const {
        int ln_; asm volatile("v_mbcnt_lo_u32_b32 %0, -1, 0\n\tv_mbcnt_hi_u32_b32 %0, -1, %0" : "=v"(ln_)); const int fr = ln_ & 15, fq = ln_ >> 4; (void)fr_in; (void)fq_in;
        unsigned char* st = stash + (size_t)blockIdx.x * 524288;
        if (u.kind < 4) {
            unsigned char* pb = st + (size_t)u.kind * 131072 + (size_t)(wr * 64 + fr) * 512 + (wc * 32 + 8 * fq) * 2;
#pragma unroll
            for (int ai = 0; ai < 2; ++ai)
#pragma unroll
                for (int m = 0; m < 4; ++m)
#pragma unroll
                    for (int bj = 0; bj < 2; ++bj) { const f32x4 v0 = acc[ai][bj][m][0], v1 = acc[ai][bj][m][1];
                        u32x4 w; w.x = cvtpk(v0[0], v0[1]); w.y = cvtpk(v0[2], v0[3]); w.z = cvtpk(v1[0], v1[1]); w.w = cvtpk(v1[2], v1[3]);
                        *(u32x4*)(pb + (size_t)(ai * 128 + m * 16) * 512 + bj * 256) = w; }
            if (u.kind == 3) asm volatile("s_waitcnt vmcnt(0)" ::: "memory");
        } else {
            if (u.kind == 4 || u.kind >= 12) { __builtin_amdgcn_fence(__ATOMIC_ACQUIRE, "agent"); asm volatile("s_waitcnt vmcnt(0)" ::: "memory"); }
            const int q = (u.kind - 4) & 3, cq = 64 * q + 16 * wc + 4 * fq, col = u.pn * 256 + cq;
            f32x4 bg[4];
#pragma unroll
            for (int i = 0; i < 4; ++i) bg[i] = *(const f32x4*)(bgate + i * 1024 + col);
            const unsigned char* pb = st + (size_t)(wr * 64 + fr) * 512 + cq * 2;
            bf16_t* ob = O + (size_t)(u.pm * 256 + wr * 64 + fr) * 1024 + col;
#pragma unroll
            for (int ai = 0; ai < 2; ++ai)
#pragma unroll
                for (int m = 0; m < 4; ++m) {
                    f32x4 o = (f32x4){0.f, 0.f, 0.f, 0.f};
#pragma unroll
                    for (int bj = 0; bj < 2; ++bj)
#pragma unroll
                        for (int n = 0; n < 2; ++n) { const int i = 2 * bj + n;
                            const uint2 pw = *(const uint2*)(pb + (size_t)i * 131072 + (size_t)(ai * 128 + m * 16) * 512);
                            const f32x4 p = (f32x4){__uint_as_float(pw.x << 16), __uint_as_float(pw.x & 0xffff0000u), __uint_as_float(pw.y << 16), __uint_as_float(pw.y & 0xffff0000u)};
                            const f32x4 gv = acc[ai][bj][m][n] + bg[i];
#pragma unroll
                            for (int e = 0; e < 4; ++e) o[e] += sigmoidf_(gv[e]) * p[e]; }
                    uint2 w; w.x = cvtpk(o[0], o[1]); w.y = cvtpk(o[2], o[3]);
                    *(uint2*)(ob + (size_t)(ai * 128 + m * 16) * 1024) = w;
                }
        }
    }
};
struct EpiConvGlu {
    bf16_t* Gout; const float* cw;
    DI void operator()(const f32x4 (&acc)[2][2][4][2], const Unit& u, int wr, int wc, int fr_in, int fq_in) const {
        int ln_; asm volatile("v_mbcnt_lo_u32_b32 %0, -1, 0\n\tv_mbcnt_hi_u32_b32 %0, -1, %0" : "=v"(ln_)); const int fr = ln_ & 15, fq = ln_ >> 4; (void)fr_in; (void)fq_in;
        int base, len, j; SchedUp::tile_seq(u.pm, base, len, j);
        const bool f0 = (fr == 0), f15 = (fr == 15);
#pragma unroll
        for (int n = 0; n < 2; ++n) {
            const int colv = u.pn * 128 + wc * 32 + 8 * fq + 4 * n;
            f32x4 wv[3], wg[3];
#pragma unroll
            for (int k = 0; k < 3; ++k) { wv[k] = *(const f32x4*)(cw + k * 5632 + colv); wg[k] = *(const f32x4*)(cw + k * 5632 + 2816 + colv); }
#pragma unroll
            for (int ai = 0; ai < 2; ++ai) {
#pragma unroll
                for (int m = 0; m < 4; ++m) {
                    const int rho = 16 * m + fr;
                    const int tl = 248 * j + 62 * (2 * ai + wr) - 1 + rho;
                    const bool valid = (rho >= 1) && (rho <= 62) && (tl >= 0) && (tl < len);
                    const bool lz = (tl <= 0), rz = (tl >= len - 1);
                    float outv[4];
#pragma unroll
                    for (int e = 0; e < 4; ++e) {
                        float cvv[2];
#pragma unroll
                        for (int bj = 0; bj < 2; ++bj) {
                            const float xc = acc[ai][bj][m][n][e];
                            const float xm1 = (m > 0) ? acc[ai][bj][m - 1][n][e] : xc, xp1 = (m < 3) ? acc[ai][bj][m + 1][n][e] : xc;
                            const float tl_ = f15 ? xm1 : xc, tr_ = f0 ? xp1 : xc;
                            const float lraw = DPPF(tl_, 0x121); const float left = lz ? 0.f : lraw;
                            const float rraw = DPPF(tr_, 0x12F); const float right = rz ? 0.f : rraw;
                            cvv[bj] = bj ? (left * wg[0][e] + xc * wg[1][e] + right * wg[2][e]) : (left * wv[0][e] + xc * wv[1][e] + right * wv[2][e]);
                        }
                        outv[e] = cvv[0] * cvv[1] * sigmoidf_(cvv[1]);
                    }
                    if (valid) { uint2 w; w.x = cvtpk(outv[0], outv[1]); w.y = cvtpk(outv[2], outv[3]); *(uint2*)(Gout + (size_t)(base + tl) * DFF + colv) = w; }
                }
            }
        }
    }
};
}

namespace attn_body {
constexpr int QP = DIN, OP = 1024;
constexpr int NW = 8, QBLK = 32, KVBLK = 64;
DI int crow(int r, int hi) { return (r & 3) + 8 * (r >> 2) + 4 * hi; }
#define SBAR() __builtin_amdgcn_sched_barrier(0)
constexpr int NSLOT = 3, SLOTB = 8192;
constexpr int LDS_K = 0, LDS_V = NSLOT * SLOTB, LDS_WS = 2 * NSLOT * SLOTB, LDS_OST = LDS_WS + NW * 64 * 4, LDS_BYTES = LDS_OST + NW * 4096;
constexpr int LDS_BIAS = 86016;
DI void glds16(const void* gsrc, unsigned lds_dst) { unsigned keep;
  asm volatile("s_mov_b32 %0, m0\n\ts_mov_b32 m0, %2\n\ts_nop 0\n\tglobal_load_lds_dwordx4 %1, off\n\ts_mov_b32 m0, %0" : "=&s"(keep) : "v"(gsrc), "s"(lds_dst) : "memory"); }
DI float max3f(float a, float b, float c) { float r; asm("v_max3_f32 %0, %1, %2, %3" : "=v"(r) : "v"(a), "v"(b), "v"(c)); return r; }
DI float max2f(float a, float b) { float r; asm("v_max_f32_e32 %0, %1, %2" : "=v"(r) : "v"(a), "v"(b)); return r; }
DI float fadd_s(float a, float b) { float r; asm("v_add_f32_e32 %0, %1, %2" : "=v"(r) : "v"(a), "v"(b)); return r; }
DI float fsub_s(float a, float b) { float r; asm("v_sub_f32_e32 %0, %1, %2" : "=v"(r) : "v"(a), "v"(b)); return r; }
DI unsigned cvtpk_s(float lo, float hi) { return cvtpk(lo, hi); }
#define WAIT_BAR(N) asm volatile("s_waitcnt vmcnt(" #N ") lgkmcnt(0)\n\ts_barrier" ::: "memory")

DI void qkt(f32x16& p0, f32x16& p1, const char* Kslot, const bf16x8* qr, int r32, int hi) {
  const f32x16 zz = f32x16{};
  const char* kb = Kslot + hi * 1024 + r32 * 16;
#pragma unroll
  for (int d0 = 0; d0 < 4; ++d0) {
    const bf16x8 b0 = *reinterpret_cast<const bf16x8*>(kb + d0 * 2048);
    const bf16x8 b1 = *reinterpret_cast<const bf16x8*>(kb + d0 * 2048 + 512);
    if (d0 == 0) { p0 = __builtin_amdgcn_mfma_f32_32x32x16_bf16(b0, qr[0], zz, 0, 0, 0); p1 = __builtin_amdgcn_mfma_f32_32x32x16_bf16(b1, qr[0], zz, 0, 0, 0); }
    else { p0 = __builtin_amdgcn_mfma_f32_32x32x16_bf16(b0, qr[d0], p0, 0, 0, 0); p1 = __builtin_amdgcn_mfma_f32_32x32x16_bf16(b1, qr[d0], p1, 0, 0, 0); } }
}
typedef __attribute__((address_space(3))) const char* lds_cptr;
typedef short v4i16_t __attribute__((ext_vector_type(4)));
DI void kload8(bf16x8* kf, lds_cptr kp) {
  kf[0] = *(const LAS bf16x8*)(kp);        kf[1] = *(const LAS bf16x8*)(kp + 512);
  kf[2] = *(const LAS bf16x8*)(kp + 2048); kf[3] = *(const LAS bf16x8*)(kp + 2560);
  kf[4] = *(const LAS bf16x8*)(kp + 4096); kf[5] = *(const LAS bf16x8*)(kp + 4608);
  kf[6] = *(const LAS bf16x8*)(kp + 6144); kf[7] = *(const LAS bf16x8*)(kp + 6656);
}
DI void kload2(bf16x8* kf, lds_cptr kp, int j) { kf[2 * j] = *(const LAS bf16x8*)(kp + j * 2048); kf[2 * j + 1] = *(const LAS bf16x8*)(kp + j * 2048 + 512); }
DI s16x4 vtr(lds_cptr p) { return __builtin_bit_cast(s16x4, __builtin_amdgcn_ds_read_tr16_b64_v4i16((LAS v4i16_t*)p)); }
DI float rowmax(const f32x16& p0, const f32x16& p1) {
  float a = max3f(p0[0], p0[1], p1[0]), b = max3f(p0[2], p0[3], p1[1]); a = max3f(a, p1[2], p1[3]);
#pragma unroll
  for (int r = 4; r < 16; r += 4) { a = max3f(a, p0[r], p0[r + 1]); b = max3f(b, p0[r + 2], p0[r + 3]); a = max3f(a, p1[r], p1[r + 1]); b = max3f(b, p1[r + 2], p1[r + 3]); }
  const float m = max2f(a, b);
  auto rr = __builtin_amdgcn_permlane32_swap(__float_as_uint(m), __float_as_uint(m), false, false);
  return max2f(__uint_as_float(rr[0]), __uint_as_float(rr[1]));
}
DI void pv(f32x16* o, int vb, bf16x8 pa0, bf16x8 pa1, bf16x8 pa2, bf16x8 pa3) {
#pragma unroll
  for (int d0 = 0; d0 < 2; ++d0) { s16x4 lo[4], hi[4];
#pragma unroll
    for (int ks = 0; ks < 4; ++ks) {
      asm volatile("ds_read_b64_tr_b16 %0,%1 offset:%c2" : "=&v"(lo[ks]) : "v"(vb), "i"(d0 * 4096 + ks * 1024) : "memory");
      asm volatile("ds_read_b64_tr_b16 %0,%1 offset:%c2" : "=&v"(hi[ks]) : "v"(vb), "i"(d0 * 4096 + ks * 1024 + 512) : "memory"); }
    asm volatile("s_waitcnt lgkmcnt(0)" ::: "memory"); SBAR();
#define PK(k) (bf16x8){lo[k][0], lo[k][1], lo[k][2], lo[k][3], hi[k][0], hi[k][1], hi[k][2], hi[k][3]}
    o[d0] = __builtin_amdgcn_mfma_f32_32x32x16_bf16(pa0, PK(0), o[d0], 0, 0, 0);
    o[d0] = __builtin_amdgcn_mfma_f32_32x32x16_bf16(pa1, PK(1), o[d0], 0, 0, 0);
    o[d0] = __builtin_amdgcn_mfma_f32_32x32x16_bf16(pa2, PK(2), o[d0], 0, 0, 0);
    o[d0] = __builtin_amdgcn_mfma_f32_32x32x16_bf16(pa3, PK(3), o[d0], 0, 0, 0);
#undef PK
  }
}
struct TileMap { int n1, base1, base2, NT; };
struct NaInfo { int i0, rmin; };

template <int MODE, int THRL>
DI void attn_unit(const bf16_t* Qw0, const bf16_t* __restrict__ Kh, const bf16_t* __restrict__ Vh, bf16_t* Ow0, const TileMap tm, const NaInfo na, char* shm, int tid) {
  const int lane = tid & 63, r32 = lane & 31, hi = lane >> 5; const int wid = __builtin_amdgcn_readfirstlane(tid >> 6);
  const bf16_t* Qw = Qw0 + (long)(wid * QBLK) * QP;
  const unsigned lds0 = (unsigned)(uintptr_t)shm;
  float* wsf = (float*)(shm + LDS_WS) + wid * 64;
  const bf16_t* ksrc = Kh + (long)lane * QP + wid * 8;
  const bf16_t* vsrc = Vh + (long)(16 * (wid & 3) + (lane >> 2)) * QP + (wid >> 2) * 32 + (lane & 3) * 8;
  const unsigned kdst = lds0 + LDS_K + wid * 1024, vdst = lds0 + LDS_V + wid * 1024;
#define TROW(t) ((long)(((t) < tm.n1) ? (tm.base1 + 64 * (t)) : (tm.base2 + 64 * ((t) - tm.n1))))
#define DMA_K(t, slot) glds16(ksrc + TROW(t) * QP, (unsigned)__builtin_amdgcn_readfirstlane(kdst + (slot)))
#define DMA_V(t, slot) glds16(vsrc + TROW(t) * QP, (unsigned)__builtin_amdgcn_readfirstlane(vdst + (slot)))
  const int vb0 = (int)(lds0 + LDS_V) + ((lane >> 4) & 1) * 32 + (lane & 3) * 8 + (4 * hi + ((lane & 15) >> 2)) * 64;
  const char* Kbase = shm + LDS_K; bf16x8 kf[8];
  const lds_cptr shm3 = (lds_cptr)shm; const lds_cptr kp0 = shm3 + LDS_K + hi * 1024 + r32 * 16; const lds_cptr vp0 = shm3 + LDS_V + ((lane >> 4) & 1) * 32 + (lane & 3) * 8 + (4 * hi + ((lane & 15) >> 2)) * 64;
  const int NT = tm.NT;
  DMA_K(0, 0); DMA_V(0, 0); DMA_K(1, SLOTB);
  bf16x8 qr[4];
#pragma unroll
  for (int d0 = 0; d0 < 4; ++d0) qr[d0] = *reinterpret_cast<const bf16x8*>(&Qw[(long)r32 * QP + d0 * 16 + hi * 8]);
  float mhat = 0.f, l_reg = 0.f; f32x16 o[2]; o[0] = f32x16{}; o[1] = f32x16{}; f32x16 zacc = f32x16{}; if (MODE == 0) asm volatile("" : "+v"(zacc));
#define CMASK(P0, P1, t) do { if (MODE == 1) { const int t_ = (t); const bool ctx_ = t_ < 4; \
      int lane_ = lane; asm volatile("" : "+v"(lane_)); const int r32_ = lane_ & 31, hi_ = lane_ >> 5; \
      const int qi_ = na.i0 + (wid >> 1), qj_ = (wid & 1) * 32 + r32_; const int rs_ = min(max(qi_ - 4, 0), 248), cs_ = min(max(qj_ - 8, 0), 48); \
      const int kr = na.rmin + t_ - 4; const bool rowok = (unsigned)(kr - rs_) < 8u; \
      const int bb = ctx_ ? 480 : ((kr - qi_ + 7) * 31 + 15 - qj_ + 4 * hi_); const int lo_ = ctx_ ? -4096 : ((rowok ? cs_ : 4096) - 4 * hi_); const unsigned wd_ = ctx_ ? 8192u : 16u; const int mul_ = ctx_ ? 0 : 1; \
      const LAS float* btab = (const LAS float*)((lds_cptr)shm + LDS_BIAS); \
      _Pragma("unroll") for (int g_ = 0; g_ < 8; ++g_) { \
        _Pragma("unroll") for (int q_ = 0; q_ < 2; ++q_) { const int r = 2 * g_ + q_; const int kc0 = (r & 3) + 8 * (r >> 2); \
          const int d0_ = kc0 - lo_; \
          const int i0_ = ((unsigned)d0_ < wd_) ? bb + kc0 * mul_ : -1, i1_ = ((unsigned)(d0_ + 32) < wd_) ? bb + (kc0 + 32) * mul_ : -1; \
          const float b0_ = btab[max(i0_, 0)], b1_ = btab[max(i1_, 0)]; \
          P0[r] = (i0_ >= 0) ? P0[r] + b0_ : -INFINITY; P1[r] = (i1_ >= 0) ? P1[r] + b1_ : -INFINITY; } \
        SBAR(); } } } while (0)
  bool resc = false;
#define START(P0, P1) do { const float rm = rowmax(P0, P1); resc = false; \
    { const float dl = rm; mhat = fadd_s(mhat, dl); \
      _Pragma("unroll") for (int r = 0; r < 16; ++r) { P0[r] = fsub_s(P0[r], dl); P1[r] = fsub_s(P1[r], dl); } \
      if (MODE == 0) { _Pragma("unroll") for (int r = 0; r < 16; ++r) zacc[r] = -mhat; asm volatile("" : "+v"(zacc)); } } \
    _Pragma("unroll") for (int r = 0; r < 16; ++r) P0[r] = __builtin_amdgcn_exp2f(P0[r]); } while (0)
#define RESC() do { if (resc) { asm volatile("s_waitcnt lgkmcnt(0)" ::: "memory"); \
      _Pragma("unroll") for (int d_ = 0; d_ < 2; ++d_) _Pragma("unroll") for (int r = 0; r < 16; ++r) o[d_][r] *= wsf[crow(r, hi)]; } } while (0)
  f32x16 pA0, pA1, pB0, pB1;
  int sl_prev = 0, sl_cur = 0, sl_next = SLOTB;
#define ROT() do { sl_prev = sl_cur; sl_cur = sl_next; sl_next = (sl_next == (NSLOT - 1) * SLOTB) ? 0 : sl_next + SLOTB; } while (0)
  DMA_K(2, 2 * SLOTB);
  WAIT_BAR(3);
  qkt(pA0, pA1, Kbase, qr, r32, hi); asm volatile("s_nop 15\n\ts_nop 7" : "+v"(pA0), "+v"(pA1)); CMASK(pA0, pA1, 0);
  START(pA0, pA1);
  _Pragma("unroll") for (int r = 0; r < 16; ++r) pA1[r] = __builtin_amdgcn_exp2f(pA1[r]);
  WAIT_BAR(0);
  DMA_K(3, 0); DMA_V(1, SLOTB);
  ROT();
  kload8(kf, kp0 + sl_cur);
  WAIT_BAR(2);
  s16x4 vlo[8], vhi[8]; u32x4 pw0, pw1, pw2, pw3;
#define PKW(P, B) cvtpk_s(P[B], P[B + 1])
#define PAF(k) __builtin_bit_cast(bf16x8, pw##k)
#define VFR(i) (bf16x8){vlo[i][0], vlo[i][1], vlo[i][2], vlo[i][3], vhi[i][0], vhi[i][1], vhi[i][2], vhi[i][3]}
#define PIN(x) asm volatile("" : "+v"(x))
#define MX3(a, b, c) __builtin_fmaxf(__builtin_fmaxf((a), (b)), (c))
#define GAPA(MF, A0, A1, A2, A3, W0, W1, PW) do { MF; sacc += A0; sacc += A1; sacc += A2; sacc += A3; PIN(sacc); W0; W1; PIN(PW); SBAR(); } while (0)
#define EX(v) __builtin_amdgcn_exp2f(v)
#define GAPB(MF, X, B) do { MF; X[B] = EX(X[B]); X[B + 1] = EX(X[B + 1]); X[B + 2] = EX(X[B + 2]); X[B + 3] = EX(X[B + 3]); PIN(X); SBAR(); } while (0)
#define VRD(i) do { vlo[i] = vtr(vp_ + (((i) >> 2) * 4096 + ((i) & 3) * 1024)); vhi[i] = vtr(vp_ + (((i) >> 2) * 4096 + ((i) & 3) * 1024 + 512)); } while (0)
#define KRD(G, j) do { if (G) { kload2(kf, kp0 + sl_next, j); SBAR(); } } while (0)
#define STEP(C0, C1, P0, P1, t, GK, GV, GL) do { SBAR(); \
    const lds_cptr vp_ = vp0 + sl_prev; \
    VRD(0); SBAR(); float sacc = (P0[0] + P0[1]); \
    GAPA(C0 = __builtin_amdgcn_mfma_f32_32x32x16_bf16(kf[0], qr[0], zacc, 0, 0, 0), P0[2], P0[3], P0[4], P0[5],     pw0[0] = PKW(P0, 0), pw0[1] = PKW(P0, 2), pw0); \
    VRD(4); SBAR(); GAPA(C1 = __builtin_amdgcn_mfma_f32_32x32x16_bf16(kf[1], qr[0], zacc, 0, 0, 0), P0[6], P0[7], P0[8], P0[9],     pw0[2] = PKW(P0, 4), pw0[3] = PKW(P0, 6), pw0); \
    VRD(1); SBAR(); GAPA(C0 = __builtin_amdgcn_mfma_f32_32x32x16_bf16(kf[2], qr[1], C0, 0, 0, 0),   P0[10], P0[11], P0[12], P0[13], pw1[0] = PKW(P0, 8), pw1[1] = PKW(P0, 10), pw1); \
    VRD(5); SBAR(); GAPA(C1 = __builtin_amdgcn_mfma_f32_32x32x16_bf16(kf[3], qr[1], C1, 0, 0, 0),   P0[14], P0[15], P1[0], P1[1],   pw1[2] = PKW(P0, 12), pw1[3] = PKW(P0, 14), pw1); \
    VRD(2); SBAR(); GAPA(C0 = __builtin_amdgcn_mfma_f32_32x32x16_bf16(kf[4], qr[2], C0, 0, 0, 0),   P1[2], P1[3], P1[4], P1[5],     pw2[0] = PKW(P1, 0), pw2[1] = PKW(P1, 2), pw2); \
    VRD(6); SBAR(); GAPA(C1 = __builtin_amdgcn_mfma_f32_32x32x16_bf16(kf[5], qr[2], C1, 0, 0, 0),   P1[6], P1[7], P1[8], P1[9],     pw2[2] = PKW(P1, 4), pw2[3] = PKW(P1, 6), pw2); \
    VRD(3); SBAR(); GAPA(C0 = __builtin_amdgcn_mfma_f32_32x32x16_bf16(kf[6], qr[3], C0, 0, 0, 0),   P1[10], P1[11], P1[12], P1[13], pw3[0] = PKW(P1, 8), pw3[1] = PKW(P1, 10), pw3); \
    VRD(7); SBAR(); GAPA(C1 = __builtin_amdgcn_mfma_f32_32x32x16_bf16(kf[7], qr[3], C1, 0, 0, 0),   P1[14], P1[15], 0.f, 0.f,       pw3[2] = PKW(P1, 12), pw3[3] = PKW(P1, 14), pw3); \
    l_reg += sacc; \
    if (GK) { DMA_K((t) + 3, sl_cur); } if (GV) { DMA_V((t) + 1, sl_next); } \
    if (MODE == 1) { _Pragma("unroll") for (int r = 0; r < 16; ++r) { C0[r] -= mhat; C1[r] -= mhat; } } \
    CMASK(C0, C1, t); \
    { float a = MX3(C0[0], C0[1], C1[0]), b = MX3(C0[2], C0[3], C1[1]); a = MX3(a, C1[2], C1[3]); \
      _Pragma("unroll") for (int r = 4; r < 16; r += 4) { a = MX3(a, C0[r], C0[r + 1]); b = MX3(b, C0[r + 2], C0[r + 3]); a = MX3(a, C1[r], C1[r + 1]); b = MX3(b, C1[r + 2], C1[r + 3]); } \
      float rm = __builtin_fmaxf(a, b); { auto rr = __builtin_amdgcn_permlane32_swap(__float_as_uint(rm), __float_as_uint(rm), false, false); rm = __builtin_fmaxf(__uint_as_float(rr[0]), __uint_as_float(rr[1])); } \
      resc = false; \
      if (__builtin_expect(__any(rm > (float)THRL), 0)) { const float dl = __builtin_fmaxf(rm, 0.f); mhat += dl; \
        _Pragma("unroll") for (int r = 0; r < 16; ++r) { C0[r] -= dl; C1[r] -= dl; } \
        if (MODE == 0) { _Pragma("unroll") for (int r = 0; r < 16; ++r) zacc[r] = -mhat; asm volatile("" : "+v"(zacc)); } \
        const float f = __builtin_amdgcn_exp2f(-dl); l_reg *= f; if (hi == 0) wsf[r32] = f; resc = true; } } \
    SBAR(); \
    GAPB(o[0] = __builtin_amdgcn_mfma_f32_32x32x16_bf16(PAF(0), VFR(0), o[0], 0, 0, 0), C0, 0); \
    GAPB(o[1] = __builtin_amdgcn_mfma_f32_32x32x16_bf16(PAF(0), VFR(4), o[1], 0, 0, 0), C0, 4); \
    KRD(GL, 0); GAPB(o[0] = __builtin_amdgcn_mfma_f32_32x32x16_bf16(PAF(1), VFR(1), o[0], 0, 0, 0), C0, 8); \
    KRD(GL, 1); GAPB(o[1] = __builtin_amdgcn_mfma_f32_32x32x16_bf16(PAF(1), VFR(5), o[1], 0, 0, 0), C0, 12); \
    KRD(GL, 2); GAPB(o[0] = __builtin_amdgcn_mfma_f32_32x32x16_bf16(PAF(2), VFR(2), o[0], 0, 0, 0), C1, 0); \
    KRD(GL, 3); GAPB(o[1] = __builtin_amdgcn_mfma_f32_32x32x16_bf16(PAF(2), VFR(6), o[1], 0, 0, 0), C1, 4); \
    GAPB(o[0] = __builtin_amdgcn_mfma_f32_32x32x16_bf16(PAF(3), VFR(3), o[0], 0, 0, 0), C1, 8); \
    GAPB(o[1] = __builtin_amdgcn_mfma_f32_32x32x16_bf16(PAF(3), VFR(7), o[1], 0, 0, 0), C1, 12); \
    } while (0)
  int t = 1;
  for (; t + 5 < NT; t += 2) {
    STEP(pB0, pB1, pA0, pA1, t, true, true, true);     WAIT_BAR(2); RESC(); ROT();
    STEP(pA0, pA1, pB0, pB1, t + 1, true, true, true); WAIT_BAR(2); RESC(); ROT();
  }
#define ENDW(tt) do { if ((tt) + 3 < NT) { WAIT_BAR(2); } else if ((tt) + 2 < NT) { WAIT_BAR(1); } else { WAIT_BAR(0); } } while (0)
  for (; t + 1 < NT; t += 2) {
    STEP(pB0, pB1, pA0, pA1, t, (t + 3 < NT), (t + 1 < NT), (t + 1 < NT));         ENDW(t);     RESC(); ROT();
    STEP(pA0, pA1, pB0, pB1, t + 1, (t + 4 < NT), (t + 2 < NT), (t + 2 < NT));     ENDW(t + 1); RESC(); ROT();
  }
  STEP(pB0, pB1, pA0, pA1, NT - 1, false, false, false); RESC();
  { float sacc = pB0[0] + pB0[1]; _Pragma("unroll") for (int r = 2; r < 16; ++r) sacc += pB0[r]; _Pragma("unroll") for (int r = 0; r < 16; ++r) sacc += pB1[r]; l_reg += sacc;
    pw0 = (u32x4){PKW(pB0, 0), PKW(pB0, 2), PKW(pB0, 4), PKW(pB0, 6)}; pw1 = (u32x4){PKW(pB0, 8), PKW(pB0, 10), PKW(pB0, 12), PKW(pB0, 14)}; pw2 = (u32x4){PKW(pB1, 0), PKW(pB1, 2), PKW(pB1, 4), PKW(pB1, 6)}; pw3 = (u32x4){PKW(pB1, 8), PKW(pB1, 10), PKW(pB1, 12), PKW(pB1, 14)};
    SBAR(); pv(o, vb0 + sl_cur, PAF(0), PAF(1), PAF(2), PAF(3)); }
#undef PKW
#undef PAF
#undef VFR
#undef PIN
#undef MX3
#undef GAPA
#undef GAPB
#undef EX
#undef VRD
#undef KRD
#undef STEP
#undef ENDW
  { auto rr = __builtin_amdgcn_permlane32_swap(__float_as_uint(l_reg), __float_as_uint(l_reg), false, false); l_reg = __uint_as_float(rr[0]) + __uint_as_float(rr[1]); }
  if (hi == 0) wsf[32 + r32] = l_reg; asm volatile("s_waitcnt lgkmcnt(0)" ::: "memory");
  float rli[16];
#pragma unroll
  for (int r = 0; r < 16; ++r) rli[r] = __builtin_amdgcn_rcpf(wsf[32 + crow(r, hi)]);
  bf16_t* Ow = Ow0 + (long)(wid * QBLK) * OP;
  { __hip_bfloat16* stg = (__hip_bfloat16*)(shm + LDS_OST) + wid * 2048;
#pragma unroll
    for (int r = 0; r < 16; ++r) { const int orow = crow(r, hi);
#pragma unroll
      for (int d0 = 0; d0 < 2; ++d0) stg[orow * 64 + d0 * 32 + r32] = __float2bfloat16(o[d0][r] * rli[r]); }
    asm volatile("s_waitcnt lgkmcnt(0)" ::: "memory");
#pragma unroll
    for (int i = 0; i < 4; ++i) { const int row = i * 8 + (lane >> 3), ch = lane & 7; const u32x4 v = *(const u32x4*)(stg + row * 64 + ch * 8); *(u32x4*)(Ow + (long)row * OP + ch * 8) = v; } }
  asm volatile("s_waitcnt lgkmcnt(0)\n\ts_barrier" ::: "memory");
#undef DMA_K
#undef DMA_V
#undef TROW
#undef CMASK
#undef START
#undef RESC
#undef ROT
}
#undef SBAR
#undef WAIT_BAR
}

struct Args {
  const float* in[33];
  float* out; unsigned char* ws;
  int ph_lo, ph_hi;
};
enum { I_X = 0, I_C, I_CTX, I_CCTX, I_ADAW, I_ADAB, I_NMIXPRE, I_NMIXPOST, I_NFFNPRE, I_NFFNPOST, I_WIN, I_CONVA, I_NABIAS, I_QNORM, I_KNORM,
       I_MU, I_W0, I_W2, I_A0, I_A2, I_KK, I_KA, I_RK, I_G2, I_LNW, I_LNB, I_WBR, I_WGATE, I_BGATE, I_WO, I_FUP, I_FCONV, I_FDN };

DI void transpose_item(const float* W, int N, bf16_t* WT, int ld, int koff, int mode, LAS float* scr, int item, int lane) {
  const int nblk = N / 32, kb = item / nblk, nb = item % nblk, k0 = 64 * kb, n0 = 32 * nb;
  { f32x4 wv_[8];
#pragma unroll
    for (int i = 0; i < 8; ++i) wv_[i] = *(const f32x4*)(W + (size_t)(k0 + 8 * i + (lane >> 3)) * N + n0 + 4 * (lane & 7));
#pragma unroll
    for (int i = 0; i < 8; ++i) { LAS float* d_ = scr + (8 * i + (lane >> 3)) * 33 + 4 * (lane & 7); d_[0] = wv_[i][0]; d_[1] = wv_[i][1]; d_[2] = wv_[i][2]; d_[3] = wv_[i][3]; } }
  asm volatile("s_waitcnt lgkmcnt(0)" ::: "memory");
  const int c = lane & 7;
#pragma unroll
  for (int j = 0; j < 4; ++j) { const int n = (lane >> 3) + 8 * j; const LAS float* s = scr + (8 * c) * 33 + n;
    int nn = n0 + n;
    if (mode == 1) nn = (nn < DFF) ? (256 * (nn >> 7) + (nn & 127)) : (256 * ((nn - DFF) >> 7) + 128 + ((nn - DFF) & 127));
    if (mode == 2) { const int i = nn >> 10, cc = nn & 1023, c64 = cc & 63;
      nn = ((cc >> 6) * 256) + 128 * (i >> 1) + 32 * (c64 >> 4) + 8 * ((c64 >> 2) & 3) + 4 * (i & 1) + (c64 & 3); }
    u32x4 o; o.x = cvtpk(s[0 * 33], s[1 * 33]); o.y = cvtpk(s[2 * 33], s[3 * 33]); o.z = cvtpk(s[4 * 33], s[5 * 33]); o.w = cvtpk(s[6 * 33], s[7 * 33]);
    *(u32x4*)(WT + (size_t)nn * ld + koff + k0 + 8 * c) = o; }
  asm volatile("s_waitcnt lgkmcnt(0)" ::: "memory");
}
DI void convert_weights(const CAS4 Args& A, int l, LAS unsigned char* lds, int gw, int NGW, int wave, int lane) {
  LAS float* scr = (LAS float*)(lds + wave * 8704);
  unsigned char* wb = A.ws + WS_W;
  constexpr int I_IN_ = 16 * 96, I_G = 16 * 128, I_B = 4 * 4 * 32, I_O_ = 16 * 32, I_U = 16 * 176, I_D = 44 * 32;
  constexpr int NIT = I_IN_ + I_G + I_B + I_O_ + I_U + I_D;
  for (int it = gw; it < NIT; it += NGW) {
    int r = it;
    if (r < I_IN_) { transpose_item(A.in[I_WIN] + (size_t)l * 1024 * 3072, 3072, (bf16_t*)(wb + W_IN), 1024, 0, 0, scr, r, lane); continue; } r -= I_IN_;
    if (r < I_G) { transpose_item(A.in[I_WGATE] + (size_t)l * 1024 * 4096, 4096, (bf16_t*)(wb + W_GATE), 1024, 0, 2, scr, r, lane); continue; } r -= I_G;
    if (r < I_B) { const int br = r / 128; transpose_item(A.in[I_WBR] + ((size_t)l * 4 + br) * 256 * 1024, 1024, (bf16_t*)(wb + W_BR), 1024, br * 256, 0, scr, r % 128, lane); continue; } r -= I_B;
    if (r < I_O_) { transpose_item(A.in[I_WO] + (size_t)l * 1024 * 1024, 1024, (bf16_t*)(wb + W_O), 1024, 0, 0, scr, r, lane); continue; } r -= I_O_;
    if (r < I_U) { transpose_item(A.in[I_FUP] + (size_t)l * 1024 * 5632, 5632, (bf16_t*)(wb + W_UP), 1024, 0, 1, scr, r, lane); continue; } r -= I_U;
    transpose_item(A.in[I_FDN] + (size_t)l * 2816 * 1024, 1024, (bf16_t*)(wb + W_DN), 2816, 0, 0, scr, r, lane);
  }
}

DI void row_phase(const float* xold, float* xdst, const bf16_t* src, const float* gate, const float* gpost,
                  bf16_t* hout, const float* gnext, const float* sh, const float* sc, int lane) {
  f32x4 v[4];
#pragma unroll
  for (int j = 0; j < 4; ++j) v[j] = ((const f32x4*)xold)[lane + 64 * j];
  if (src) {
    f32x4 s[4]; float ss = 0.f;
#pragma unroll
    for (int j = 0; j < 4; ++j) { const uint2 w = ((const uint2*)src)[lane + 64 * j];
      s[j] = (f32x4){__uint_as_float(w.x << 16), __uint_as_float(w.x & 0xffff0000u), __uint_as_float(w.y << 16), __uint_as_float(w.y & 0xffff0000u)};
      ss += (s[j].x * s[j].x + s[j].y * s[j].y) + (s[j].z * s[j].z + s[j].w * s[j].w); }
    const float rs = __builtin_amdgcn_rsqf(wave_sum(ss, lane) * (1.f / 1024.f) + 1e-6f);
#pragma unroll
    for (int j = 0; j < 4; ++j) { const f32x4 g = ((const f32x4*)gate)[lane + 64 * j], p = ((const f32x4*)gpost)[lane + 64 * j];
      v[j] = v[j] + g * (s[j] * rs * p); ((f32x4*)xdst)[lane + 64 * j] = v[j]; }
  }
  if (hout) {
    float ss = 0.f;
#pragma unroll
    for (int j = 0; j < 4; ++j) ss += (v[j].x * v[j].x + v[j].y * v[j].y) + (v[j].z * v[j].z + v[j].w * v[j].w);
    const float rs = __builtin_amdgcn_rsqf(wave_sum(ss, lane) * (1.f / 1024.f) + 1e-6f);
#pragma unroll
    for (int j = 0; j < 4; ++j) { const f32x4 g = ((const f32x4*)gnext)[lane + 64 * j], a = ((const f32x4*)sh)[lane + 64 * j], b = ((const f32x4*)sc)[lane + 64 * j];
      const f32x4 h = (v[j] * rs * g) * (b + 1.f) + a;
      uint2 w; w.x = cvtpk(h.x, h.y); w.y = cvtpk(h.z, h.w); ((uint2*)hout)[lane + 64 * j] = w; }
  }
}

DI void row_phase_blk(const float* xlat_in, const float* xctx_in, float* xlat_out, float* xctx_out, const bf16_t* srcb,
                      const float* modl, int gate_off, const float* gpost, bf16_t* hb, const float* gnext, const float* modn, int sh_off, int sc_off,
                      int bx, int wave, int lane) {
  const int R0 = bx * 130;
  f32x4 gpv[4], gnv[4], gav[4], shv[4], scv[4];
#pragma unroll
  for (int j = 0; j < 4; ++j) { gpv[j] = ((const f32x4*)gpost)[lane + 64 * j]; gnv[j] = hb ? ((const f32x4*)gnext)[lane + 64 * j] : (f32x4){0.f, 0.f, 0.f, 0.f}; }
  int cur_s = -1;
  f32x4 xv[4], xn[4]; uint2 sv[4], sn[4];
  int row = R0 + wave;
  { const float* xo = (row < NLAT) ? xlat_in + (size_t)row * 1024 : xctx_in + (size_t)(row - NLAT) * 1024;
#pragma unroll
    for (int j = 0; j < 4; ++j) { xv[j] = ((const f32x4*)xo)[lane + 64 * j]; sv[j] = ((const uint2*)(srcb + (size_t)row * 1024))[lane + 64 * j]; } }
  for (; row < R0 + 130; row += 8) {
    const int nrow = row + 8; const bool hn = nrow < R0 + 130;
    if (hn) { const float* xo = (nrow < NLAT) ? xlat_in + (size_t)nrow * 1024 : xctx_in + (size_t)(nrow - NLAT) * 1024;
#pragma unroll
      for (int j = 0; j < 4; ++j) { xn[j] = ((const f32x4*)xo)[lane + 64 * j]; sn[j] = ((const uint2*)(srcb + (size_t)nrow * 1024))[lane + 64 * j]; } }
    const int s = (row < NLAT) ? (row >> 14) : 2;
    if (s != cur_s) { cur_s = s; const float* md = modl + (size_t)s * 6144; const float* mn = modn + (size_t)s * 6144;
#pragma unroll
      for (int j = 0; j < 4; ++j) { gav[j] = ((const f32x4*)(md + gate_off))[lane + 64 * j];
        shv[j] = hb ? ((const f32x4*)(mn + sh_off))[lane + 64 * j] : (f32x4){0.f, 0.f, 0.f, 0.f}; scv[j] = hb ? ((const f32x4*)(mn + sc_off))[lane + 64 * j] : (f32x4){0.f, 0.f, 0.f, 0.f}; } }
    f32x4 sf[4]; float ss = 0.f;
#pragma unroll
    for (int j = 0; j < 4; ++j) { const uint2 w = sv[j];
      sf[j] = (f32x4){__uint_as_float(w.x << 16), __uint_as_float(w.x & 0xffff0000u), __uint_as_float(w.y << 16), __uint_as_float(w.y & 0xffff0000u)};
      ss += (sf[j].x * sf[j].x + sf[j].y * sf[j].y) + (sf[j].z * sf[j].z + sf[j].w * sf[j].w); }
    const float rs = __builtin_amdgcn_rsqf(wave_sum(ss, lane) * (1.f / 1024.f) + 1e-6f);
    float* xd = (row < NLAT) ? xlat_out + (size_t)row * 1024 : xctx_out + (size_t)(row - NLAT) * 1024;
    float s2 = 0.f;
#pragma unroll
    for (int j = 0; j < 4; ++j) { xv[j] = xv[j] + gav[j] * (sf[j] * rs * gpv[j]); ((f32x4*)xd)[lane + 64 * j] = xv[j];
      s2 += (xv[j].x * xv[j].x + xv[j].y * xv[j].y) + (xv[j].z * xv[j].z + xv[j].w * xv[j].w); }
    if (hb) {
      const float r2 = __builtin_amdgcn_rsqf(wave_sum(s2, lane) * (1.f / 1024.f) + 1e-6f);
#pragma unroll
      for (int j = 0; j < 4; ++j) { const f32x4 h = (xv[j] * r2 * gnv[j]) * (scv[j] + 1.f) + shv[j];
        uint2 w; w.x = cvtpk(h.x, h.y); w.y = cvtpk(h.z, h.w); ((uint2*)(hb + (size_t)row * 1024))[lane + 64 * j] = w; }
    }
#pragma unroll
    for (int j = 0; j < 4; ++j) { xv[j] = xn[j]; sv[j] = sn[j]; }
  }
}

__global__ void __launch_bounds__(NTHREADS, 2) fwd_megakernel(Args A_) {
  extern __shared__ __attribute__((aligned(16))) unsigned char lds_raw[];
  LAS unsigned char* lds = (LAS unsigned char*)lds_raw;
  const int wave0_ = __builtin_amdgcn_readfirstlane((int)threadIdx.x >> 6);
  const int G = gridDim.x, bx = blockIdx.x;
  const int NGW = G * 8;
  const int lo = A_.ph_lo, hi = A_.ph_hi;
  if (hi < 0) cg::this_grid().sync();
  int ph = 0, nbar_ = 0;
#ifndef NBARX
#define NBARX 1
#endif
#ifndef SKIPMASK
#define SKIPMASK 0
#endif
#ifndef REPMASK
#define REPMASK 0
#endif
#define PHASE_BEGIN(id) if (ph >= lo && ph < hi && !((SKIPMASK >> (id)) & 1)) for (int rep_ = 0; rep_ < ((((REPMASK) >> (id)) & 1) ? 2 : 1); ++rep_) { const CAS4 Args* Ap_ = (const CAS4 Args*)__builtin_amdgcn_kernarg_segment_ptr(); asm volatile("" : "+s"(Ap_)); const CAS4 Args& A = *Ap_; \
  unsigned char* ws = A.ws; unsigned* ctl = (unsigned*)(ws + WS_CTL); float* MOD = (float*)(ws + WS_MOD); float* XC = (float*)(ws + WS_XC); float* BONUS = (float*)(ws + WS_BONUS); \
  bf16_t* H = (bf16_t*)(ws + WS_H); bf16_t* Z = (bf16_t*)(ws + WS_Z); bf16_t* YS = (bf16_t*)(ws + WS_YS); bf16_t* WAE = (bf16_t*)(ws + WS_WA); bf16_t* WAA = WAE + (size_t)2 * NROW * 256; float* YSC = (float*)(ws + WS_YSC); \
  (void)ctl; (void)MOD; (void)XC; (void)BONUS; (void)H; (void)Z; (void)YS; (void)WAE; (void)WAA; (void)YSC; \
  int tid; asm volatile("v_mbcnt_lo_u32_b32 %0, -1, 0\n\tv_mbcnt_hi_u32_b32 %0, -1, %0" : "=v"(tid)); tid += wave0_ * 64; const int lane = tid & 63, wave = __builtin_amdgcn_readfirstlane(tid >> 6); const int gw = bx * 8 + wave; (void)lane; (void)gw;
#define FRESH_TID(v) int v; asm volatile("v_mbcnt_lo_u32_b32 %0, -1, 0\n\tv_mbcnt_hi_u32_b32 %0, -1, %0" : "=v"(v)); v += wave0_ * 64;
#define PHASE_END } if (ph >= lo && ph + 1 < hi) { FRESH_TID(tb_) const CAS4 Args* Ab_ = (const CAS4 Args*)__builtin_amdgcn_kernarg_segment_ptr(); asm volatile("" : "+s"(Ab_)); for (int bi_ = 0; bi_ < NBARX; ++bi_) { ++nbar_; grid_barrier2((unsigned*)(Ab_->ws + WS_CTL), (unsigned)nbar_, G, bx, tb_); } } ++ph;

  PHASE_BEGIN(0)
    {
      LAS float* sl = (LAS float*)(lds + 72 * 1024);
      for (int i = tid; i < 3 * 1024; i += NTHREADS) { const int s = i >> 10, k = i & 1023;
        const float c = (s < 2) ? A.in[I_C][s * 1024 + k] : A.in[I_CCTX][k]; sl[i] = c * sigmoidf_(c); }
      __syncthreads();
      LAS float* red = (LAS float*)(lds + 88 * 1024);
      for (int it = bx; it < NLAYER * 96; it += G) {
        const int l = it / 96, c0 = (it % 96) * 64;
        const float* wp = A.in[I_ADAW] + (size_t)l * 1024 * 6144 + c0 + lane;
        float a0 = 0.f, a1 = 0.f, a2 = 0.f;
        for (int k = wave * 128; k < wave * 128 + 128; ++k) { const float w = wp[(size_t)k * 6144]; a0 += sl[k] * w; a1 += sl[1024 + k] * w; a2 += sl[2048 + k] * w; }
        red[(wave * 3 + 0) * 64 + lane] = a0; red[(wave * 3 + 1) * 64 + lane] = a1; red[(wave * 3 + 2) * 64 + lane] = a2;
        __syncthreads();
        if (tid < 192) { const int s = tid >> 6, ln = tid & 63; float r = A.in[I_ADAB][l * 6144 + c0 + ln];
          for (int w = 0; w < 8; ++w) r += red[(w * 3 + s) * 64 + ln];
          MOD[((size_t)(l * 3 + s)) * 6144 + c0 + ln] = r; }
        __syncthreads();
      }
    }
    convert_weights(A, 0, lds, gw, NGW, wave, lane);
  PHASE_END

  PHASE_BEGIN(1)
    for (int row = gw; row < NROW; row += NGW) {
      const int s = (row < NLAT) ? (row >> 14) : 2;
      const float* xo = (row < NLAT) ? A.in[I_X] + (size_t)row * 1024 : A.in[I_CTX] + (size_t)(row - NLAT) * 1024;
      const float* md = MOD + (size_t)(0 * 3 + s) * 6144;
      row_phase(xo, nullptr, nullptr, nullptr, nullptr, H + (size_t)row * 1024, A.in[I_NMIXPRE], md, md + 1024, lane);
    }
  PHASE_END

  for (int l = 0; l < NLAYER; ++l) {
    PHASE_BEGIN(2)
      pg8::Gemm g{(const char*)ws, 1024, 1024};
      pg8::SchedPlain S{130, 5, G, bx, 16, (long)WS_H, (long)(WS_W + W_IN), 1024, 1024, 7};
      pg8::EpiStore E{Z, DIN};
      pg8::gemm_phase<pg8::EpiStore, pg8::SchedPlain, false>(lds, g, S, E, tid);
    PHASE_END

    PHASE_BEGIN(3)
      {
        FRESH_TID(tid)
        const int ln = tid & 63, wv = __builtin_amdgcn_readfirstlane(tid >> 6), d = wv >> 2, nq = wv & 3, r32 = ln & 31, hi = ln >> 5;
        LAS unsigned char* AT = lds;
        const float* mu = A.in[I_MU] + (size_t)l * 2 * 896;
        bf16x8 Bf[2][2][4]; float bias0[2], bias1[2];
#pragma unroll
        for (int nt = 0; nt < 2; ++nt) {
          const int c = 64 * nq + 32 * nt + r32;
          bias0[nt] = A.in[I_W0][(l * 2 + d) * 256 + c]; bias1[nt] = A.in[I_A0][(l * 2 + d) * 256 + c];
#pragma unroll
          for (int ks = 0; ks < 4; ++ks) { float f0[8], f1[8];
#pragma unroll
            for (int i = 0; i < 8; ++i) { const size_t o = ((size_t)(l * 2 + d) * 64 + 16 * ks + 8 * hi + i) * 256 + c; f0[i] = A.in[I_W2][o]; f1[i] = A.in[I_A2][o]; }
            Bf[0][nt][ks] = __builtin_bit_cast(bf16x8, pack8(f0)); Bf[1][nt][ks] = __builtin_bit_cast(bf16x8, pack8(f1)); }
        }
        for (int tile = bx; tile < 520; tile += G) {
          const int R0 = tile * 64;
          __syncthreads();
          for (int i = tid; i < 2 * 64 * 16; i += NTHREADS) {
            const int dd = i >> 10, rem = i & 1023, r = rem >> 4, j8 = (rem & 15) * 8, row = R0 + r; int t, len; row_seq(row, t, len);
            const int nb = dd ? t + 1 : t - 1; const bool nv = (nb >= 0) && (nb < len);
            float zc[8], zn[8];
            unpack8(*(const u32x4*)(Z + (size_t)row * DIN + C_LW + j8), zc);
            if (nv) unpack8(*(const u32x4*)(Z + (size_t)(row + (dd ? 1 : -1)) * DIN + C_LW + j8), zn);
            else {
#pragma unroll
              for (int e = 0; e < 8; ++e) zn[e] = 0.f; }
            const f32x4 m0 = *(const f32x4*)(mu + dd * 896 + 768 + j8), m1 = *(const f32x4*)(mu + dd * 896 + 768 + j8 + 4);
            float v[8];
#pragma unroll
            for (int e = 0; e < 8; ++e) { v[e] = zc[e] + (e < 4 ? m0[e] : m1[e - 4]) * (zn[e] - zc[e]); if (j8 < 64) v[e] = 1.f - 2.f * __builtin_amdgcn_rcpf(__builtin_amdgcn_exp2f(2.8853900817779268f * v[e]) + 1.f); }
            *(LAS u32x4*)(AT + ((dd * 2 + (j8 >> 6)) * 64 + r) * 144 + (j8 & 63) * 2) = pack8(v);
          }
          __syncthreads();
          f32x16 acc[2][2][2];
#pragma unroll
          for (int m = 0; m < 2; ++m)
#pragma unroll
            for (int mt = 0; mt < 2; ++mt)
#pragma unroll
              for (int nt = 0; nt < 2; ++nt) acc[m][mt][nt] = f32x16{};
#pragma unroll
          for (int m = 0; m < 2; ++m)
#pragma unroll
            for (int mt = 0; mt < 2; ++mt)
#pragma unroll
              for (int ks = 0; ks < 4; ++ks) {
                const bf16x8 af = *(const LAS bf16x8*)(AT + ((d * 2 + m) * 64 + 32 * mt + r32) * 144 + (16 * ks + 8 * hi) * 2);
#pragma unroll
                for (int nt = 0; nt < 2; ++nt) acc[m][mt][nt] = __builtin_amdgcn_mfma_f32_32x32x16_bf16(af, Bf[m][nt][ks], acc[m][mt][nt], 0, 0, 0);
              }
#pragma unroll
          for (int mt = 0; mt < 2; ++mt)
#pragma unroll
            for (int nt = 0; nt < 2; ++nt) {
              const int c = 64 * nq + 32 * nt + r32;
#pragma unroll
              for (int r = 0; r < 16; ++r) {
                const int row = R0 + 32 * mt + (r & 3) + 8 * (r >> 2) + 4 * hi;
                const float aw = acc[0][mt][nt][r] + bias0[nt], aa = acc[1][mt][nt][r] + bias1[nt];
                const float xx = -aw; const float sp = fmaxf(xx, 0.f) + __logf(1.f + __expf(-fabsf(xx)));
                const float e = -__expf(-sp - 0.5f);
                const float av = sigmoidf_(aa);
                const size_t o = ((size_t)d * NROW + row) * 256 + c;
                WAE[o] = (bf16_t)(cvtpk(e, 0.f) & 0xffffu); WAA[o] = (bf16_t)(cvtpk(av, 0.f) & 0xffffu);
              }
            }
        }
        __syncthreads();
      }
    PHASE_END

    PHASE_BEGIN(4)
#ifndef NO_SCAN
#ifndef REP_SCAN
#define REP_SCAN 1
#endif
#ifndef REP_ATTN
#define REP_ATTN 1
#endif
      if (bx < 64 && (rep_ == 0 || REP_SCAN)) {
        const int sb = bx, s = sb >> 2, qd = sb & 3, d = s >> 3, b = (s >> 2) & 1, hh = s & 3;
        LAS float* buf = (LAS float*)lds;
        float muR[8], muK[8], muV[8], kkc[8], kac[8], rkc[8];
        const int ptid = tid & 255, ts = (ptid >> 3) & 31, cgp = ptid & 7, ch0 = hh * 64 + 8 * cgp;
        {
#pragma unroll
          for (int i = 0; i < 8; ++i) { const float* mu = A.in[I_MU] + (size_t)(l * 2 + d) * 896;
            muR[i] = mu[ch0 + i]; muK[i] = mu[256 + ch0 + i]; muV[i] = mu[512 + ch0 + i];
            kkc[i] = A.in[I_KK][l * 256 + ch0 + i]; kac[i] = A.in[I_KA][l * 256 + ch0 + i]; rkc[i] = A.in[I_RK][l * 256 + ch0 + i]; }
        }
        const int rsub = lane >> 4, kg = lane & 15, vrow = 16 * qd + 4 * (wave & 3) + rsub;
#define SCAN_RLO(cc) (((cc) < 8) ? (NLAT + b * CTXL + (d ? 224 - 32 * (cc) : 32 * (cc))) : (b * TLAT + (d ? 16352 - 32 * ((cc) - 8) : 32 * ((cc) - 8))))
        const unsigned ro = (unsigned)(d ? 31 - ts : ts);
        const unsigned offz = ro * DIN + ch0, offw = ro * 256 + ch0;
        const unsigned roy = (unsigned)(d ? 31 - (ptid >> 3) : (ptid >> 3)), offy = roy * 256 + hh * 64 + 16 * qd + (ptid & 7) * 2;
#define SCAN_LOAD(cc, X) do { const int rlo_ = SCAN_RLO(cc); const bool nv = !((((cc) == 0) || ((cc) == 8)) && ts == 0); \
          const bf16_t* zb = Z + (size_t)rlo_ * DIN; const bf16_t* znb = zb + (d ? DIN : -DIN); const u32x4 z4 = (u32x4){0u, 0u, 0u, 0u}; \
          X[0] = *(const u32x4*)(zb + (offz + C_RR)); X[1] = *(const u32x4*)(zb + (offz + C_RK)); X[2] = *(const u32x4*)(zb + (offz + C_RV)); \
          X[3] = nv ? *(const u32x4*)(znb + (offz + C_RR)) : z4; X[4] = nv ? *(const u32x4*)(znb + (offz + C_RK)) : z4; X[5] = nv ? *(const u32x4*)(znb + (offz + C_RV)) : z4; \
          const bf16_t* wb_ = WAE + ((size_t)d * NROW + rlo_) * 256; const bf16_t* ab_ = WAA + ((size_t)d * NROW + rlo_) * 256; \
          X[6] = *(const u32x4*)(wb_ + offw); X[7] = *(const u32x4*)(ab_ + offw); } while (0)
#define SCAN_PREP(cc, X) do { const int rlo_ = SCAN_RLO(cc); \
          float r8[8], k8[8], v8[8], rn[8], kn[8], vn[8], e8[8], a8[8]; \
          unpack8(X[0], r8); unpack8(X[1], k8); unpack8(X[2], v8); unpack8(X[3], rn); unpack8(X[4], kn); unpack8(X[5], vn); unpack8(X[6], e8); unpack8(X[7], a8); \
          float kkv[8], ssq = 0.f, bsum = 0.f; \
          _Pragma("unroll") for (int i = 0; i < 8; ++i) { r8[i] += muR[i] * (rn[i] - r8[i]); k8[i] += muK[i] * (kn[i] - k8[i]); v8[i] += muV[i] * (vn[i] - v8[i]); \
            kkv[i] = k8[i] * kkc[i]; ssq += kkv[i] * kkv[i]; } \
          ssq = red8(ssq); \
          const float inv = __builtin_amdgcn_rsqf(fmaxf(ssq, 1e-24f)); \
          float wv[8], bb[8], kp[8]; \
          _Pragma("unroll") for (int i = 0; i < 8; ++i) { kkv[i] *= inv; kp[i] = k8[i] * (1.f + (a8[i] - 1.f) * kac[i]); bb[i] = kkv[i] * a8[i]; wv[i] = __expf(e8[i]); bsum += r8[i] * kp[i] * rkc[i]; } \
          bsum = red8(bsum); \
          if (qd == 0 && cgp == 0) (BONUS + ((size_t)d * NROW + rlo_) * 4)[ro * 4 + hh] = bsum; \
          LAS float* db = buf + ((cc) & 1) * (6 * 32 * 64) + ts * 64 + 8 * cgp; \
          *(LAS f32x4*)(db + 0 * 2048) = (f32x4){wv[0], wv[1], wv[2], wv[3]}; *(LAS f32x4*)(db + 0 * 2048 + 4) = (f32x4){wv[4], wv[5], wv[6], wv[7]}; \
          *(LAS f32x4*)(db + 1 * 2048) = (f32x4){kkv[0], kkv[1], kkv[2], kkv[3]}; *(LAS f32x4*)(db + 1 * 2048 + 4) = (f32x4){kkv[4], kkv[5], kkv[6], kkv[7]}; \
          *(LAS f32x4*)(db + 2 * 2048) = (f32x4){bb[0], bb[1], bb[2], bb[3]}; *(LAS f32x4*)(db + 2 * 2048 + 4) = (f32x4){bb[4], bb[5], bb[6], bb[7]}; \
          *(LAS f32x4*)(db + 3 * 2048) = (f32x4){kp[0], kp[1], kp[2], kp[3]}; *(LAS f32x4*)(db + 3 * 2048 + 4) = (f32x4){kp[4], kp[5], kp[6], kp[7]}; \
          *(LAS f32x4*)(db + 4 * 2048) = (f32x4){r8[0], r8[1], r8[2], r8[3]}; *(LAS f32x4*)(db + 4 * 2048 + 4) = (f32x4){r8[4], r8[5], r8[6], r8[7]}; \
          *(LAS f32x4*)(db + 5 * 2048) = (f32x4){v8[0], v8[1], v8[2], v8[3]}; *(LAS f32x4*)(db + 5 * 2048 + 4) = (f32x4){v8[4], v8[5], v8[6], v8[7]}; \
        } while (0)
#define SCAN_YOUT(cc) do { const int rlo_ = SCAN_RLO(cc); const int step_ = ptid >> 3, r2_ = (ptid & 7) * 2; \
          const LAS f32x4* yp_ = (const LAS f32x4*)(ybuf + ((cc) & 1) * 2048 + step_ * 64 + r2_ * 4); const f32x4 y0_ = yp_[0], y1_ = yp_[1]; \
          const f32x2 yv = (f32x2){(y0_[0] + y0_[1]) + (y0_[2] + y0_[3]), (y1_[0] + y1_[1]) + (y1_[2] + y1_[3])}; \
          *(f32x2*)(YSC + ((size_t)d * NROW + rlo_) * 256 + offy) = yv; } while (0)
        LAS float* ybuf = buf + 2 * 6 * 32 * 64;
        u32x4 RA[8], RB[8];
        __syncthreads();
        SCAN_LOAD(0, RA);
        if (wave >= 4) SCAN_PREP(0, RA);
        SCAN_LOAD(1, RA);
#pragma unroll
        for (int i = 0; i < 8; ++i) RB[i] = RA[i];
        __syncthreads();
        f32x2 Sa = (f32x2){0.f, 0.f}, Sb = (f32x2){0.f, 0.f};
        for (int cc = 0; cc < 520; ++cc) {
          if (wave >= 4) {
            if (cc + 2 < 520) SCAN_LOAD(cc + 2, RB);
            if (cc + 1 < 520) SCAN_PREP(cc + 1, RA);
            if (cc > 0) SCAN_YOUT(cc - 1);
#pragma unroll
            for (int i = 0; i < 8; ++i) RA[i] = RB[i];
          } else {
            const LAS float* sbuf = buf + (cc & 1) * (6 * 32 * 64) + 4 * kg;
            LAS float* yb = ybuf + (cc & 1) * 2048 + (4 * wave + rsub) * 4 + (kg >> 2);
            f32x4 W4 = *(const LAS f32x4*)(sbuf + 0 * 2048), K4 = *(const LAS f32x4*)(sbuf + 1 * 2048), B4 = *(const LAS f32x4*)(sbuf + 2 * 2048),
                  P4 = *(const LAS f32x4*)(sbuf + 3 * 2048), R4 = *(const LAS f32x4*)(sbuf + 4 * 2048);
            float vv = sbuf[5 * 2048 - 4 * kg + vrow];
            f32x4 Rp = R4;
#pragma unroll
            for (int st = 0; st < 32; ++st) {
              const int sn = (st + 1) & 31;
              const LAS float* sp = sbuf + sn * 64;
              const f32x4 W4n = *(const LAS f32x4*)(sp + 0 * 2048), K4n = *(const LAS f32x4*)(sp + 1 * 2048), B4n = *(const LAS f32x4*)(sp + 2 * 2048),
                          P4n = *(const LAS f32x4*)(sp + 3 * 2048), R4n = *(const LAS f32x4*)(sp + 4 * 2048);
              const float vvn = sp[5 * 2048 - 4 * kg + vrow];
              f32x2 p = Sa * (f32x2){K4[0], K4[1]}; p = __builtin_elementwise_fma(Sb, (f32x2){K4[2], K4[3]}, p);
              float sa = p[0] + p[1];
              if (st > 0) {
                f32x2 q = Sa * (f32x2){Rp[0], Rp[1]}; q = __builtin_elementwise_fma(Sb, (f32x2){Rp[2], Rp[3]}, q);
                float yq = q[0] + q[1]; yq += DPPF(yq, 0xB1); yq += DPPF(yq, 0x4E);
                yb[(st - 1) * 64] = yq;
              }
              sa = allreduce16(sa);
              const f32x2 vv2 = (f32x2){vv, vv}, nsa = (f32x2){-sa, -sa};
              f32x2 ta = __builtin_elementwise_fma(nsa, (f32x2){B4[0], B4[1]}, vv2 * (f32x2){P4[0], P4[1]});
              f32x2 tb = __builtin_elementwise_fma(nsa, (f32x2){B4[2], B4[3]}, vv2 * (f32x2){P4[2], P4[3]});
              Sa = __builtin_elementwise_fma(Sa, (f32x2){W4[0], W4[1]}, ta);
              Sb = __builtin_elementwise_fma(Sb, (f32x2){W4[2], W4[3]}, tb);
              Rp = R4;
              W4 = W4n; K4 = K4n; B4 = B4n; P4 = P4n; R4 = R4n; vv = vvn;
            }
            { f32x2 q = Sa * (f32x2){Rp[0], Rp[1]}; q = __builtin_elementwise_fma(Sb, (f32x2){Rp[2], Rp[3]}, q);
              float yq = q[0] + q[1]; yq += DPPF(yq, 0xB1); yq += DPPF(yq, 0x4E);
              yb[31 * 64] = yq; }
          }
          __syncthreads();
        }
        if (wave >= 4) SCAN_YOUT(519);
        __syncthreads();
#undef SCAN_LOAD
#undef SCAN_YOUT
#undef SCAN_PREP
#undef SCAN_RLO
      }
#endif
#ifndef NO_ATTN
      if (bx >= 64) {
        {
          FRESH_TID(tid)
          pg8::Gemm g{(const char*)ws, 1024, 1024};
          pg8::SchedPlain S{130, 7, 192, bx - 64, 16, (long)WS_H, (long)(WS_W + W_IN), 1024, 1024, 0};
          pg8::EpiStore E{Z, DIN};
          pg8::gemm_phase<pg8::EpiStore, pg8::SchedPlain, false>(lds, g, S, E, tid);
        }
        { FRESH_TID(tb1_) grid_barrier(ctl + 16, 192u * (unsigned)(2 * l + 1), tb1_); }
      {
        const float* qn = A.in[I_QNORM] + l * 64; const float* kn = A.in[I_KNORM] + l * 64;
        for (long idx = (long)(bx - 64) * NTHREADS + tid; idx < (long)NROW * 48; idx += (long)192 * NTHREADS) {
          const int part = (int)(idx & 7), h6 = (int)((idx >> 3) % 6), row = (int)(idx / 48);
          bf16_t* p = Z + (size_t)row * DIN + C_GQ + 64 * h6 + 8 * part;
          float f[8]; unpack8(*(const u32x4*)p, f);
          float ss = 0.f;
#pragma unroll
          for (int i = 0; i < 8; ++i) ss += f[i] * f[i];
          ss = red8(ss);
          const float rs = __builtin_amdgcn_rsqf(ss * (1.f / 64.f) + 1e-6f);
          const bool isq = h6 < 4; const float* nw = isq ? qn : kn; const float scl = isq ? C2 : 1.f;
#pragma unroll
          for (int i = 0; i < 8; ++i) f[i] = f[i] * rs * nw[8 * part + i] * scl;
          if (row < NLAT) {
            const int t = row & (TLAT - 1); const float gr = (float)(t >> 6), gc = (float)(t & 63);
#pragma unroll
            for (int pp = 0; pp < 4; ++pp) { const int pi = 4 * part + pp;
              const float invf = exp2f(-(float)(pi & 15) * (13.287712379549449f / 16.f));
              const float ang = (pi < 16 ? gr : gc) * invf; const float cs = __cosf(ang), sn = __sinf(ang);
              const float x1 = f[2 * pp], x2 = f[2 * pp + 1]; f[2 * pp] = x1 * cs - x2 * sn; f[2 * pp + 1] = x1 * sn + x2 * cs; }
          }
          *(u32x4*)p = pack8(f);
        }
      }
      {
        FRESH_TID(tid)
        const float* cw = A.in[I_CONVA] + l * 3 * 256;
        for (long idx = (long)(bx - 64) * NTHREADS + tid; idx < (long)NROW * 32; idx += (long)192 * NTHREADS) {
          const int g8 = (int)(idx & 31), row = (int)(idx >> 5); int t, len; row_seq(row, t, len);
          const bf16_t* zr = Z + (size_t)row * DIN;
          { bf16_t* qp = Z + (size_t)row * DIN + C_NAQ + 8 * g8; float f[8]; unpack8(*(const u32x4*)qp, f);
#pragma unroll
            for (int i = 0; i < 8; ++i) f[i] *= C2;
            *(u32x4*)qp = pack8(f); }
          float bg[8], c0[8], x0[8], c1[8], x1[8], c2[8], x2[8];
          unpack8(*(const u32x4*)(zr + 8 * g8), bg);
          unpack8(*(const u32x4*)(zr + 256 + 8 * g8), c1); unpack8(*(const u32x4*)(zr + 512 + 8 * g8), x1);
          if (t > 0) { unpack8(*(const u32x4*)(zr - DIN + 256 + 8 * g8), c0); unpack8(*(const u32x4*)(zr - DIN + 512 + 8 * g8), x0); }
          else {
#pragma unroll
            for (int i = 0; i < 8; ++i) { c0[i] = 0.f; x0[i] = 0.f; } }
          if (t < len - 1) { unpack8(*(const u32x4*)(zr + DIN + 256 + 8 * g8), c2); unpack8(*(const u32x4*)(zr + DIN + 512 + 8 * g8), x2); }
          else {
#pragma unroll
            for (int i = 0; i < 8; ++i) { c2[i] = 0.f; x2[i] = 0.f; } }
          float o[8];
#pragma unroll
          for (int i = 0; i < 8; ++i) { const int c = 8 * g8 + i; o[i] = bg[i] * (cw[c] * (c0[i] * x0[i]) + cw[256 + c] * (c1[i] * x1[i]) + cw[512 + c] * (c2[i] * x2[i])); }
          *(u32x4*)(YS + (size_t)row * 1024 + 8 * g8) = pack8(o);
        }
      }
        { FRESH_TID(tb2_) grid_barrier(ctl + 16, 192u * (unsigned)(2 * l + 2), tb2_); }
      } else {
        FRESH_TID(tw_)
        if (tw_ == 0) { while (__hip_atomic_load(ctl + 16, __ATOMIC_RELAXED, __HIP_MEMORY_SCOPE_AGENT) < 192u * (unsigned)(2 * l + 2)) __builtin_amdgcn_s_sleep(2);
          __builtin_amdgcn_fence(__ATOMIC_ACQUIRE, "agent"); asm volatile("s_waitcnt vmcnt(0)" ::: "memory"); }
        __syncthreads();
      }
      if (rep_ == 0 || REP_ATTN) {
        FRESH_TID(tid)
        volatile LAS unsigned* misc = (volatile LAS unsigned*)(lds + 92 * 1024);
        const float* nab = A.in[I_NABIAS] + (size_t)l * 4 * 465;
        for (;;) {
          __syncthreads();
          if (tid == 0) misc[0] = atomicAdd(ctl + 64 + 64 * l + 32 * rep_, 1u);
          __syncthreads();
          int u = (int)misc[0];
          if (l == NLAYER - 1 && u >= 1024) u += 16;
          if (u >= 1296) break;
          if (u >= 1040) {
            LAS float* SG = (LAS float*)lds;
            const int R0 = (u - 1040) * 130;
            for (int i = tid; i < 130 * 16; i += NTHREADS) { const int r = i >> 4, j8 = (i & 15) * 8; float f[8];
              unpack8(*(const u32x4*)(Z + (size_t)(R0 + r) * DIN + C_LG + j8), f);
#pragma unroll
              for (int e = 0; e < 8; ++e) f[e] = sigmoidf_(f[e]);
              *(LAS f32x4*)(SG + r * 128 + j8) = (f32x4){f[0], f[1], f[2], f[3]}; *(LAS f32x4*)(SG + r * 128 + j8 + 4) = (f32x4){f[4], f[5], f[6], f[7]}; }
            const int half = tid >> 8, c = tid & 255;
            float g2c[128];
#pragma unroll
            for (int j = 0; j < 128; ++j) g2c[j] = A.in[I_G2][((size_t)l * 128 + j) * 256 + c];
            __syncthreads();
            for (int r = half; r < 130; r += 2) {
              const LAS f32x4* sp = (const LAS f32x4*)(SG + r * 128);
              float gate = 0.f;
#pragma unroll
              for (int j4 = 0; j4 < 32; ++j4) { const f32x4 x = sp[j4]; gate += x[0] * g2c[4 * j4] + x[1] * g2c[4 * j4 + 1] + x[2] * g2c[4 * j4 + 2] + x[3] * g2c[4 * j4 + 3]; }
              YS[(size_t)(R0 + r) * 1024 + 768 + c] = (bf16_t)(cvtpk(gate, 0.f) & 0xffffu);
            }
            continue;
          }
          attn_body::TileMap tm; attn_body::NaInfo na{0, 0};
          const bf16_t *Qp, *Kp, *Vp; bf16_t* Op; int mode = 0;
          if (u < 512) {
            const int qb = u & 63, g2 = (u >> 6) & 1, kvh = (u >> 7) & 1, b = u >> 8, h = kvh * 2 + g2;
            tm = {256, b * TLAT, NLAT + b * CTXL, 260};
            const size_t q0 = (size_t)b * TLAT + qb * 256;
            Qp = Z + q0 * DIN + C_GQ + 64 * h; Kp = Z + C_GK + 64 * kvh; Vp = Z + C_GV + 64 * kvh; Op = YS + q0 * 1024 + 512 + 64 * h;
          } else if (u < 1024) {
            const int v = u - 512, ig = v & 63, h = (v >> 6) & 3, b = v >> 8, i0 = 4 * ig;
            int rmin = min(max(i0 - 4, 0), 248), rmax = min(max(i0 + 3 - 4, 0), 248) + 7;
            if (((rmax - rmin + 1) & 1) != 0) { if (rmax < 255) ++rmax; else --rmin; }
            tm = {4, NLAT + b * CTXL, b * TLAT + 64 * rmin, 4 + (rmax - rmin + 1)};
            na = {i0, rmin}; mode = 1;
            if (tid < 512) ((LAS float*)(lds + attn_body::LDS_BIAS))[tid] = (tid < 465) ? nab[h * 465 + tid] * LOG2E : 0.f;
            const size_t q0 = (size_t)b * TLAT + i0 * 64;
            Qp = Z + q0 * DIN + C_NAQ + 64 * h; Kp = Z + C_NAK + 64 * h; Vp = Z + C_NAV + 64 * h; Op = YS + q0 * 1024 + 256 + 64 * h;
          } else {
            const int v = u - 1024, isna = v >> 3, h = v & 3, b = (v >> 2) & 1;
            const size_t q0 = (size_t)NLAT + b * CTXL;
            tm = {4, NLAT + b * CTXL, 0, 4};
            if (isna) { Qp = Z + q0 * DIN + C_NAQ + 64 * h; Kp = Z + C_NAK + 64 * h; Vp = Z + C_NAV + 64 * h; Op = YS + q0 * 1024 + 256 + 64 * h; }
            else { Qp = Z + q0 * DIN + C_GQ + 64 * h; Kp = Z + C_GK + 64 * (h >> 1); Vp = Z + C_GV + 64 * (h >> 1); Op = YS + q0 * 1024 + 512 + 64 * h; }
          }
#ifndef NO_M1
          if (mode) { FRESH_TID(t1_) attn_body::attn_unit<1, 8>(Qp, Kp, Vp, Op, tm, na, (char*)lds_raw, t1_); }
#endif
#ifndef NO_M0
          if (!mode) { FRESH_TID(t0_) attn_body::attn_unit<0, 8>(Qp, Kp, Vp, Op, tm, na, (char*)lds_raw, t0_); }
#endif
        }
      }
#endif
    PHASE_END

    PHASE_BEGIN(5)
      {
        const int half = tid >> 8, c = tid & 255, hh = c >> 6;
        const float lnw = A.in[I_LNW][l * 256 + c], lnb = A.in[I_LNB][l * 256 + c];
        const float mv0 = A.in[I_MU][(size_t)(l * 2 + 0) * 896 + 512 + c], mv1 = A.in[I_MU][(size_t)(l * 2 + 1) * 896 + 512 + c];
        for (int tile = bx; tile < 256; tile += G) {
          const int R0 = tile * 130;
          for (int r0 = half; r0 < 130; r0 += 10) {
            float y5[5], zv5[5], zp5[5], zq5[5], b05[5], b15[5], g5[5];
#pragma unroll
            for (int q = 0; q < 5; ++q) { const int row = R0 + r0 + 2 * q; int t, len; row_seq(row, t, len);
              y5[q] = YSC[((size_t)0 * NROW + row) * 256 + c] + YSC[((size_t)1 * NROW + row) * 256 + c];
              const bf16_t* zr = Z + (size_t)row * DIN + C_RV + c;
              zv5[q] = bf2f(zr[0]); zp5[q] = (t > 0) ? bf2f(zr[-DIN]) : 0.f; zq5[q] = (t < len - 1) ? bf2f(zr[DIN]) : 0.f;
              b05[q] = BONUS[((size_t)0 * NROW + row) * 4 + hh]; b15[q] = BONUS[((size_t)1 * NROW + row) * 4 + hh];
              g5[q] = bf2f(YS[(size_t)row * 1024 + 768 + c]); }
#pragma unroll
            for (int q = 0; q < 5; ++q) { const int row = R0 + r0 + 2 * q;
              const float mean = wave_sum(y5[q], lane) * (1.f / 64.f); const float dv = y5[q] - mean; const float var = wave_sum(dv * dv, lane) * (1.f / 64.f);
              const float yn = dv * __builtin_amdgcn_rsqf(var + 64e-5f) * lnw + lnb;
              const float v0 = zv5[q] + mv0 * (zp5[q] - zv5[q]), v1 = zv5[q] + mv1 * (zq5[q] - zv5[q]);
              const float bon = b05[q] * v0 + b15[q] * v1;
              YS[(size_t)row * 1024 + 768 + c] = (bf16_t)(cvtpk((yn + bon) * g5[q], 0.f) & 0xffffu); }
          }
        }
      }
    PHASE_END

    PHASE_BEGIN(6)
      pg8::Gemm g{(const char*)ws, 1024, 1024};
      pg8::SchedMerge S{G, bx, (l == NLAYER - 1) ? 128 : 130};
      pg8::EpiMerge E{ws + WS_PSCR, A.in[I_BGATE] + (size_t)l * 4096, (bf16_t*)(ws + WS_ACCM)};
      pg8::gemm_phase<pg8::EpiMerge, pg8::SchedMerge, false>(lds, g, S, E, tid);
    PHASE_END

    PHASE_BEGIN(7)
      pg8::Gemm g{(const char*)ws, 1024, 1024};
      pg8::SchedPlain S{(l == NLAYER - 1) ? 128 : 130, 4, G, bx, 16, (long)WS_ACCM, (long)(WS_W + W_O), 1024, 1024, 0};
      pg8::EpiStore E{(bf16_t*)(ws + WS_MBUF), 1024};
      pg8::gemm_phase<pg8::EpiStore, pg8::SchedPlain, false>(lds, g, S, E, tid);
    PHASE_END

    PHASE_BEGIN(8)
      for (int vb_ = bx; vb_ < 256; vb_ += G)
      row_phase_blk((l == 0) ? A.in[I_X] : (const float*)A.out, (l == 0) ? A.in[I_CTX] : (const float*)XC, A.out, XC, (const bf16_t*)(ws + WS_MBUF),
                    MOD + (size_t)l * 3 * 6144, 2 * 1024, A.in[I_NMIXPOST] + l * 1024, H, A.in[I_NFFNPRE] + l * 1024, MOD + (size_t)l * 3 * 6144, 3 * 1024, 4 * 1024, vb_, wave, lane);
    PHASE_END

    PHASE_BEGIN(9)
      pg8::Gemm g{(const char*)ws, 1024, 1024};
      pg8::SchedUp S{G, bx, (l == NLAYER - 1) ? 134 : 138};
      pg8::EpiConvGlu E{(bf16_t*)(ws + WS_G), A.in[I_FCONV] + (size_t)l * 3 * 5632};
      pg8::gemm_phase<pg8::EpiConvGlu, pg8::SchedUp, true>(lds, g, S, E, tid);
    PHASE_END

    PHASE_BEGIN(10)
      pg8::Gemm g{(const char*)ws, DFF, DFF};
      pg8::SchedPlain S{(l == NLAYER - 1) ? 128 : 130, 4, G, bx, 44, (long)WS_G, (long)(WS_W + W_DN), DFF, DFF, 0};
      pg8::EpiStore E{(bf16_t*)(ws + WS_F), 1024};
      pg8::gemm_phase<pg8::EpiStore, pg8::SchedPlain, false>(lds, g, S, E, tid);
    PHASE_END

    PHASE_BEGIN(11)
      for (int vb_ = bx; vb_ < 256; vb_ += G)
      row_phase_blk((const float*)A.out, (const float*)XC, A.out, XC, (const bf16_t*)(ws + WS_F),
                    MOD + (size_t)l * 3 * 6144, 5 * 1024, A.in[I_NFFNPOST] + l * 1024, (l < NLAYER - 1) ? H : (bf16_t*)nullptr, A.in[I_NMIXPRE] + ((l + 1) & 3) * 1024,
                    MOD + (size_t)((l + 1) & 3) * 3 * 6144, 0, 1024, vb_, wave, lane);
      if (l < NLAYER - 1) convert_weights(A, l + 1, lds, gw, NGW, wave, lane);
    PHASE_END
  }
}

constexpr int LDS_BYTES = 147456;
constexpr int NPHASES = 2 + NLAYER * 10;
extern "C" void kernel_launch(void* const* d_in, const int* in_sizes, int n_in, void* d_out, int out_size, void* d_ws, size_t ws_size, hipStream_t stream) {
  static int grid = 0;
  if (grid == 0) {
    int dev = 0, cus = 0, per_cu = 0;
    hipGetDevice(&dev);
    hipDeviceGetAttribute(&cus, hipDeviceAttributeMultiprocessorCount, dev);
    if (hipFuncSetAttribute((const void*)fwd_megakernel, hipFuncAttributeMaxDynamicSharedMemorySize, LDS_BYTES) != hipSuccess) fprintf(stderr, "kernel_launch: hipFuncSetAttribute failed\n");
    hipOccupancyMaxActiveBlocksPerMultiprocessor(&per_cu, (const void*)fwd_megakernel, NTHREADS, LDS_BYTES);
    (void)hipGetLastError();
    if (per_cu < 1) per_cu = 1;
    grid = cus;
    if (n_in != 33 || ws_size < WS_END) fprintf(stderr, "kernel_launch: unexpected n_in %d or ws %zu\n", n_in, ws_size);
  }
  (void)hipMemsetAsync((char*)d_ws + WS_CTL, 0, 8192, stream);
  Args a{};
  for (int i = 0; i < 33; ++i) a.in[i] = (const float*)d_in[i];
  a.out = (float*)d_out; a.ws = (unsigned char*)d_ws; a.ph_lo = 0; a.ph_hi = NPHASES;
  void* args[] = {&a};
  hipError_t e = hipLaunchCooperativeKernel((const void*)fwd_megakernel, dim3(grid), dim3(NTHREADS), args, LDS_BYTES, stream);
  if (e != hipSuccess) fprintf(stderr, "cooperative launch failed: %s (grid %d)\n", hipGetErrorString(e), grid);
}
```
